# Optimizing an MI355X kernel written in HIP

```python
import jax, jax.numpy as jnp
from jax import lax
import numpy as np

D_MODEL = 2048
BATCH = 4
SEQ = 2048
DEPTH = 2
DEC_BATCH = 128
DEC_SEQ = 1
PAST_LEN = 16384
PAGE_SIZE = 128

BRANCH_W = D_MODEL // 2
N_BRANCH = 3
R_HEAD = 64
R_HEADS = BRANCH_W // R_HEAD
R_LORA_W = 64
R_LORA_A = 64
R_LORA_G = 64
R_GN_EPS = 64e-5
R_COLS = 3 * BRANCH_W + R_LORA_W + R_LORA_A + R_LORA_G
R_SPLITS = [BRANCH_W, 2 * BRANCH_W, 3 * BRANCH_W, 3 * BRANCH_W + R_LORA_W, 3 * BRANCH_W + R_LORA_W + R_LORA_A]
M_HEADS = 4
M_DK = BRANCH_W // M_HEADS
M_DV = BRANCH_W // M_HEADS
CONV_W = 4
M_COLS = 4 * BRANCH_W + 2 * M_HEADS
M_SPLITS = [2 * BRANCH_W, 3 * BRANCH_W, 3 * BRANCH_W + M_HEADS, 3 * BRANCH_W + 2 * M_HEADS]
G_HEADS = 4
G_DK = BRANCH_W // (2 * G_HEADS)
G_DV = BRANCH_W // G_HEADS
G_LR = 16
G_GATE_NORM = 16.0
G_COLS = 2 * G_HEADS * G_DK + 2 * BRANCH_W + G_LR
G_SPLITS = [G_HEADS * G_DK, 2 * G_HEADS * G_DK, 2 * G_HEADS * G_DK + BRANCH_W, 2 * G_HEADS * G_DK + BRANCH_W + G_LR]
GATE_COLS = N_BRANCH * D_MODEL
N_IN = R_COLS + M_COLS + G_COLS + GATE_COLS
IN_SPLITS = [R_COLS, R_COLS + M_COLS, R_COLS + M_COLS + G_COLS]
D_FF = -((-8 * D_MODEL) // (3 * 256)) * 256
CHUNK = 64
EPS = 1e-6

kernel_name = 'hybrid_rwkv7_mlstm_gla_step'


def rmsnorm(x, g):
    xf = x.astype(jnp.float32)
    y = xf * lax.rsqrt(jnp.mean(xf * xf, axis=-1, keepdims=True) + EPS)
    return (y * g).astype(x.dtype)


def _heads(t, n_heads):
    return t.reshape(*t.shape[:-1], n_heads, -1)


def head_rmsnorm(h, g):
    h = h * lax.rsqrt(jnp.mean(h * h, axis=-1, keepdims=True) + EPS)
    return h.reshape(*h.shape[:-2], -1) * g


def _chunk_len(T):
    return CHUNK if T % CHUNK == 0 else T


def _to_chunks(t, L):
    B, H, T = t.shape[:3]
    t = t.reshape(B, H, T // L, L, *t.shape[3:])
    return jnp.moveaxis(t, 2, 0)


def _from_chunks(t):
    t = jnp.moveaxis(t, 0, 2)
    return t.reshape(t.shape[0], t.shape[1], -1, *t.shape[4:])


def rwkv7_branch(p, prev, S0, mu, w0, w2, a0, a2, g2, k_k, k_a, r_k, ln_g, ln_b):
    B, T, _ = p.shape
    f32 = jnp.float32
    p_prev = jnp.concatenate([prev.astype(p.dtype)[:, None, :], p[:, :-1, :]], axis=1)
    xs = p + (p_prev - p) * mu
    r, k, v, xw, xa, xg = jnp.split(xs, R_SPLITS, axis=-1)
    w = -jax.nn.softplus(-(w0 + jnp.tanh(xw) @ w2)) - 0.5
    log_decay = -jnp.exp(w.astype(f32))
    a = jax.nn.sigmoid(a0 + xa @ a2)
    g = jax.nn.sigmoid(xg) @ g2
    kk = _heads((k * k_k).astype(f32), R_HEADS)
    kk = kk / jnp.maximum(jnp.linalg.norm(kk, axis=-1, keepdims=True), 1e-12)
    k = k * (1.0 + (a - 1.0) * k_a)
    rh, kh, vh, ah, ldh = [_heads(t.astype(f32), R_HEADS) for t in (r, k, v, a, log_decay)]

    def step(S, inp):
        r_t, k_t, v_t, kk_t, a_t, ld_t = inp
        S = (S * jnp.exp(ld_t)[:, :, None, :]
             - jnp.einsum('bhvk,bhk->bhv', S, kk_t)[..., None] * (kk_t * a_t)[:, :, None, :]
             + v_t[..., :, None] * k_t[..., None, :])
        return S, jnp.einsum('bhvk,bhk->bhv', S, r_t)

    seq = tuple(jnp.moveaxis(t, 1, 0) for t in (rh, kh, vh, kk, ah, ldh))
    S_T, out = lax.scan(step, S0.astype(f32), seq)
    out = jnp.moveaxis(out, 0, 1)
    mean = jnp.mean(out, axis=-1, keepdims=True)
    var = jnp.mean(jnp.square(out - mean), axis=-1, keepdims=True)
    out = ((out - mean) * lax.rsqrt(var + R_GN_EPS)).reshape(B, T, BRANCH_W) * ln_g + ln_b
    bonus = jnp.sum(rh * kh * r_k, axis=-1, keepdims=True) * vh
    out = (out + bonus.reshape(B, T, BRANCH_W)) * g
    return out.astype(p.dtype), S_T, p[:, -1, :]


def mlstm_chunks(q, k, v, ig, lf, C0, n0, m0):
    L = _chunk_len(q.shape[2])
    mask = jnp.tril(jnp.ones((L, L), dtype=bool))

    def step(carry, inp):
        C, n, m = carry
        qc, kc, vc, ic, fc = inp
        F = jnp.cumsum(fc, axis=-1)
        D = jnp.where(mask, F[..., :, None] - F[..., None, :] + ic[..., None, :], -jnp.inf)
        inter = F + m[..., None]
        m_t = jnp.maximum(inter, jnp.max(D, axis=-1))
        w_inter = jnp.exp(inter - m_t)
        S = jnp.einsum('bhtd,bhsd->bhts', qc, kc) * jnp.exp(D - m_t[..., None])
        num = w_inter[..., None] * jnp.einsum('bhtd,bhde->bhte', qc, C) + jnp.einsum('bhts,bhse->bhte', S, vc)
        den = w_inter * jnp.einsum('bhtd,bhd->bht', qc, n) + jnp.sum(S, axis=-1)
        h = num / jnp.maximum(jnp.abs(den), jnp.exp(-m_t))[..., None]
        FL = F[..., -1]
        g_s = FL[..., None] - F + ic
        m_new = jnp.maximum(FL + m, jnp.max(g_s, axis=-1))
        a_c = jnp.exp(FL + m - m_new)
        w_s = jnp.exp(g_s - m_new[..., None])
        C = a_c[..., None, None] * C + jnp.einsum('bhs,bhsd,bhse->bhde', w_s, kc, vc)
        n = a_c[..., None] * n + jnp.einsum('bhs,bhsd->bhd', w_s, kc)
        return (C, n, m_new), h

    f32 = jnp.float32
    (C, n, m), h = lax.scan(step, (C0.astype(f32), n0.astype(f32), m0.astype(f32)),
                            tuple(_to_chunks(t, L) for t in (q, k, v, ig, lf)))
    return _from_chunks(h), C, n, m


def mlstm_branch(p, conv_buf, C0, n0, m0, conv_w, conv_b, i_b, f_b, norm_g):
    B, T, _ = p.shape
    f32 = jnp.float32
    qk_raw, v, i_pre, f_pre, o = jnp.split(p, M_SPLITS, axis=-1)
    full = jnp.concatenate([conv_buf.astype(p.dtype), qk_raw], axis=1)
    conv = conv_b + sum(full[:, j:j + T, :] * conv_w[j] for j in range(CONV_W))
    q, k = jnp.split(jax.nn.silu(conv), 2, axis=-1)
    qh = _heads(q.astype(f32), M_HEADS).transpose(0, 2, 1, 3)
    kh = _heads(k.astype(f32), M_HEADS).transpose(0, 2, 1, 3) * (M_DK ** -0.5)
    vh = _heads(v.astype(f32), M_HEADS).transpose(0, 2, 1, 3)
    ig = (i_pre + i_b).astype(f32).transpose(0, 2, 1)
    lf = jax.nn.log_sigmoid((f_pre + f_b).astype(f32)).transpose(0, 2, 1)
    h, C, n, m = mlstm_chunks(qh, kh, vh, ig, lf, C0, n0, m0)
    h = head_rmsnorm(h.transpose(0, 2, 1, 3), norm_g)
    out = jax.nn.sigmoid(o) * h
    return out.astype(p.dtype), full[:, -(CONV_W - 1):, :], C, n, m


def gla_branch(p, S0, a2, a_b, norm_g):
    B, T, _ = p.shape
    f32 = jnp.float32
    q, k, v, xa, og = jnp.split(p, G_SPLITS, axis=-1)
    lg = jax.nn.log_sigmoid((xa @ a2 + a_b).astype(f32)) / G_GATE_NORM
    qh = _heads(q.astype(f32), G_HEADS).transpose(0, 2, 1, 3) * (G_DK ** -0.5)
    kh = _heads(k.astype(f32), G_HEADS).transpose(0, 2, 1, 3)
    vh = _heads(v.astype(f32), G_HEADS).transpose(0, 2, 1, 3)
    gh = _heads(lg, G_HEADS).transpose(0, 2, 1, 3)
    L = _chunk_len(T)
    mask = jnp.tril(jnp.ones((L, L), dtype=bool))[..., None]

    def step(S, inp):
        qc, kc, vc, gc = inp
        b = jnp.cumsum(gc, axis=2)
        decay = jnp.exp(jnp.where(mask, b[:, :, :, None, :] - b[:, :, None, :, :], -jnp.inf))
        A = jnp.einsum('bhtd,bhsd,bhtsd->bhts', qc, kc, decay)
        o = jnp.einsum('bhtd,bhde->bhte', qc * jnp.exp(b), S) + jnp.einsum('bhts,bhse->bhte', A, vc)
        bL = b[:, :, -1:, :]
        S = jnp.exp(bL[:, :, 0, :])[..., None] * S + jnp.einsum('bhsd,bhse->bhde', kc * jnp.exp(bL - b), vc)
        return S, o

    S_T, o = lax.scan(step, S0.astype(f32), tuple(_to_chunks(t, L) for t in (qh, kh, vh, gh)))
    o = _from_chunks(o).transpose(0, 2, 1, 3)
    out = head_rmsnorm(o, norm_g) * jax.nn.silu(og)
    return out.astype(p.dtype), S_T


def decoder_layer(x, rw_prev, rw_S, m_conv, m_C, m_n, m_m, g_S,
                  norm1_g, w_in, gate_b, rwkv_mu, rwkv_w0, rwkv_w2, rwkv_a0, rwkv_a2, rwkv_g2,
                  rwkv_k_k, rwkv_k_a, rwkv_r_k, rwkv_ln_g, rwkv_ln_b,
                  mlstm_conv_w, mlstm_conv_b, mlstm_i_b, mlstm_f_b, mlstm_norm_g,
                  gla_a2, gla_a_b, gla_norm_g, w_branch, w_out, norm2_g, ffn_w_gu, ffn_w_down):
    B, T, _ = x.shape
    h = rmsnorm(x, norm1_g)
    proj = h @ w_in
    p_r, p_m, p_g, p_gate = jnp.split(proj, IN_SPLITS, axis=-1)
    o_r, rw_S, rw_prev = rwkv7_branch(p_r, rw_prev, rw_S, rwkv_mu, rwkv_w0, rwkv_w2, rwkv_a0, rwkv_a2,
                                      rwkv_g2, rwkv_k_k, rwkv_k_a, rwkv_r_k, rwkv_ln_g, rwkv_ln_b)
    o_m, m_conv, m_C, m_n, m_m = mlstm_branch(p_m, m_conv, m_C, m_n, m_m, mlstm_conv_w, mlstm_conv_b,
                                              mlstm_i_b, mlstm_f_b, mlstm_norm_g)
    o_g, g_S = gla_branch(p_g, g_S, gla_a2, gla_a_b, gla_norm_g)
    branches = jnp.stack([o_r, o_m, o_g], axis=2)
    gates = jax.nn.sigmoid(p_gate.reshape(B, T, N_BRANCH, D_MODEL) + gate_b)
    widened = jnp.einsum('btjc,jcd->btjd', branches, w_branch)
    x = x + jnp.sum(gates * widened, axis=2) @ w_out
    gg, uu = jnp.split(rmsnorm(x, norm2_g) @ ffn_w_gu, 2, axis=-1)
    x = x + (jax.nn.silu(gg) * uu) @ ffn_w_down
    return x, (rw_prev, rw_S, m_conv, m_C, m_n, m_m, g_S)


def run_trunk(x, states, layer_params, final_norm_g):
    per_layer = []
    for l in range(DEPTH):
        x, new = decoder_layer(x, *[s[l] for s in states], *[w[l] for w in layer_params])
        per_layer.append(new)
    new_states = [jnp.stack([st[i] for st in per_layer], axis=0).astype(x.dtype) for i in range(len(states))]
    return rmsnorm(x, final_norm_g), new_states


def zero_states(batch, dtype):
    return (jnp.zeros((DEPTH, batch, R_COLS), dtype),
            jnp.zeros((DEPTH, batch, R_HEADS, R_HEAD, R_HEAD), dtype),
            jnp.zeros((DEPTH, batch, CONV_W - 1, 2 * BRANCH_W), dtype),
            jnp.zeros((DEPTH, batch, M_HEADS, M_DK, M_DV), dtype),
            jnp.zeros((DEPTH, batch, M_HEADS, M_DK), dtype),
            jnp.zeros((DEPTH, batch, M_HEADS), dtype),
            jnp.zeros((DEPTH, batch, G_HEADS, G_DK, G_DV), dtype))


def setup_inputs(seed: int = 0) -> dict:
    key = jax.random.key(seed)
    ks = iter(jax.random.split(key, 64))
    f32 = jnp.float32
    L = DEPTH

    def nrm(shape, scale):
        return scale * jax.random.normal(next(ks), shape, f32)

    def unif(shape):
        return jax.random.uniform(next(ks), shape, f32)

    return {
        'x_prompt': nrm((BATCH, SEQ, D_MODEL), 1.0),
        'x_sample': nrm((DEC_BATCH, DEC_SEQ, D_MODEL), 1.0),
        'state_rwkv_shift': nrm((L, DEC_BATCH, R_COLS), 1.0),
        'state_rwkv_wkv': nrm((L, DEC_BATCH, R_HEADS, R_HEAD, R_HEAD), 0.5),
        'state_mlstm_conv': nrm((L, DEC_BATCH, CONV_W - 1, 2 * BRANCH_W), 1.0),
        'state_mlstm_C': nrm((L, DEC_BATCH, M_HEADS, M_DK, M_DV), 0.5),
        'state_mlstm_n': nrm((L, DEC_BATCH, M_HEADS, M_DK), 0.5),
        'state_mlstm_m': nrm((L, DEC_BATCH, M_HEADS), 1.0),
        'state_gla_S': nrm((L, DEC_BATCH, G_HEADS, G_DK, G_DV), 0.5),
        'norm1_g': 1.0 + nrm((L, D_MODEL), 0.02),
        'w_in': nrm((L, D_MODEL, N_IN), D_MODEL ** -0.5),
        'gate_b': nrm((L, N_BRANCH, D_MODEL), 0.01),
        'rwkv_mu': unif((L, R_COLS)),
        'rwkv_w0': jnp.linspace(-6.5, -1.5, BRANCH_W, dtype=f32) + nrm((L, BRANCH_W), 0.1),
        'rwkv_w2': nrm((L, R_LORA_W, BRANCH_W), 0.1),
        'rwkv_a0': nrm((L, BRANCH_W), 0.1),
        'rwkv_a2': nrm((L, R_LORA_A, BRANCH_W), 0.1),
        'rwkv_g2': nrm((L, R_LORA_G, BRANCH_W), 0.25),
        'rwkv_k_k': 0.85 + nrm((L, BRANCH_W), 0.05),
        'rwkv_k_a': 1.0 + nrm((L, BRANCH_W), 0.05),
        'rwkv_r_k': -0.04 + nrm((L, R_HEADS, R_HEAD), 0.1),
        'rwkv_ln_g': 1.0 + nrm((L, BRANCH_W), 0.02),
        'rwkv_ln_b': nrm((L, BRANCH_W), 0.02),
        'mlstm_conv_w': nrm((L, CONV_W, 2 * BRANCH_W), CONV_W ** -0.5),
        'mlstm_conv_b': nrm((L, 2 * BRANCH_W), 0.02),
        'mlstm_i_b': nrm((L, M_HEADS), 0.1),
        'mlstm_f_b': jnp.linspace(3.0, 6.0, M_HEADS, dtype=f32) + nrm((L, M_HEADS), 0.1),
        'mlstm_norm_g': 1.0 + nrm((L, BRANCH_W), 0.02),
        'gla_a2': nrm((L, G_LR, G_HEADS * G_DK), G_LR ** -0.5),
        'gla_a_b': nrm((L, G_HEADS * G_DK), 0.1),
        'gla_norm_g': 1.0 + nrm((L, BRANCH_W), 0.02),
        'w_branch': nrm((L, N_BRANCH, BRANCH_W, D_MODEL), BRANCH_W ** -0.5),
        'w_out': nrm((L, D_MODEL, D_MODEL), D_MODEL ** -0.5),
        'norm2_g': 1.0 + nrm((L, D_MODEL), 0.02),
        'ffn_w_gu': nrm((L, D_MODEL, 2 * D_FF), D_MODEL ** -0.5),
        'ffn_w_down': nrm((L, D_FF, D_MODEL), D_FF ** -0.5),
        'final_norm_g': 1.0 + nrm((D_MODEL,), 0.02),
    }


def reference(x_prompt, x_sample, state_rwkv_shift, state_rwkv_wkv, state_mlstm_conv, state_mlstm_C,
              state_mlstm_n, state_mlstm_m, state_gla_S,
              norm1_g, w_in, gate_b, rwkv_mu, rwkv_w0, rwkv_w2, rwkv_a0, rwkv_a2, rwkv_g2,
              rwkv_k_k, rwkv_k_a, rwkv_r_k, rwkv_ln_g, rwkv_ln_b,
              mlstm_conv_w, mlstm_conv_b, mlstm_i_b, mlstm_f_b, mlstm_norm_g,
              gla_a2, gla_a_b, gla_norm_g, w_branch, w_out, norm2_g, ffn_w_gu, ffn_w_down,
              final_norm_g):
    layer_params = (norm1_g, w_in, gate_b, rwkv_mu, rwkv_w0, rwkv_w2, rwkv_a0, rwkv_a2, rwkv_g2,
                    rwkv_k_k, rwkv_k_a, rwkv_r_k, rwkv_ln_g, rwkv_ln_b,
                    mlstm_conv_w, mlstm_conv_b, mlstm_i_b, mlstm_f_b, mlstm_norm_g,
                    gla_a2, gla_a_b, gla_norm_g, w_branch, w_out, norm2_g, ffn_w_gu, ffn_w_down)
    y_prompt, p_states = run_trunk(x_prompt, zero_states(x_prompt.shape[0], x_prompt.dtype),
                                   layer_params, final_norm_g)
    p_shift, p_wkv, p_conv, p_C, p_n, p_m, p_gla = p_states
    sample_states = (state_rwkv_shift, state_rwkv_wkv, state_mlstm_conv, state_mlstm_C,
                     state_mlstm_n, state_mlstm_m, state_gla_S)
    y_sample, s_states = run_trunk(x_sample, sample_states, layer_params, final_norm_g)
    s_shift, s_wkv, s_conv, s_C, s_n, s_m, s_gla = s_states
    return (y_prompt, y_sample, p_shift, p_wkv, p_conv, p_C, p_n, p_m, p_gla,
            s_shift, s_wkv, s_conv, s_C, s_n, s_m, s_gla)
```

```cpp
#include <hip/hip_runtime.h>
#include <cstdio>
#include <cstdint>

#ifndef MK_N_LAUNCHES
#define MK_N_LAUNCHES 1
#endif

#ifndef DBG_LIM
#define DBG_LIM 22
#ifndef DBG_ROLE_MASK
#define DBG_ROLE_MASK 0
#endif
#ifndef DBG_REP_MASK
#define DBG_REP_MASK 0
#endif
#define DBG_SEL 2
#endif
#define LAS __attribute__((address_space(3)))
typedef unsigned short bf16_t;
typedef short bf16x8 __attribute__((ext_vector_type(8)));
typedef float f32x4 __attribute__((ext_vector_type(4)));
typedef unsigned u32x4 __attribute__((ext_vector_type(4)));
typedef unsigned u32x2 __attribute__((ext_vector_type(2)));

constexpr int DM = 2048, MP = 8192, MT = 8320, MPAD = 8448, NINP = 16640, NIN = 16600;
constexpr int RC = 3264, M0 = 3264, G0 = 7368, GT0 = 10456, DFF = 5632;
constexpr int NTHREADS = 512;
constexpr size_t O_YP = 0, O_YS = 16777216, O_PSHIFT = 17039360, O_PWKV = 17065472, O_PCONV = 17589760, O_PC = 17638912, O_PN = 19736064, O_PM = 19744256,
                 O_PGLA = 19744288, O_SSHIFT = 20792864, O_SWKV = 21628448, O_SCONV = 38405664, O_SC = 39978528, O_SN = 107087392, O_SM = 107349536, O_SGLA = 107350560;
constexpr size_t AL(size_t x) { return (x + 255) & ~(size_t)255; }
constexpr size_t WS_CTL = 0, CTL_BYTES = 1u << 20;
constexpr size_t LW_WIN = 0, LW_WBR = LW_WIN + (size_t)NINP * 2048 * 2, LW_WOUT = LW_WBR + (size_t)3 * 2048 * 1024 * 2, LW_WGU = LW_WOUT + (size_t)2048 * 2048 * 2,
                 LW_WDN = LW_WGU + (size_t)11264 * 2048 * 2, LW_LORA = LW_WDN + (size_t)2048 * 5632 * 2, LW_GA2 = LW_LORA + (size_t)3 * 1024 * 64 * 2, LW_BYTES = LW_GA2 + (size_t)512 * 32 * 2;
constexpr size_t WS_W = CTL_BYTES;
constexpr size_t WS_X = AL(WS_W + 2 * LW_BYTES);
constexpr size_t WS_H = AL(WS_X + (size_t)MPAD * 2048 * 4);
constexpr size_t WS_PROJ = AL(WS_H + (size_t)MPAD * 2048 * 2);
constexpr size_t ARR = (size_t)MT * 1024;
constexpr size_t WS_RPRE = AL(WS_PROJ + (size_t)MPAD * NINP * 2);
constexpr size_t WS_ROUT = AL(WS_RPRE + 7 * ARR * 4);
constexpr size_t WS_QM = AL(WS_ROUT + ARR * 4);
constexpr size_t WS_KM = WS_QM + ARR * 2, WS_GQ = WS_KM + ARR * 2, WS_GK = WS_GQ + ARR, WS_GKH = WS_GK + ARR;
constexpr size_t WS_GATES = AL(WS_GKH + ARR);
constexpr size_t WS_EGL = AL(WS_GATES + (size_t)MT * 8 * 4);
constexpr size_t WS_HM = AL(WS_EGL + (size_t)256 * 512 * 4);
constexpr size_t WS_OG = AL(WS_HM + ARR * 4);
constexpr size_t WS_END = AL(WS_OG + ARR * 4);
static_assert((size_t)MPAD * 3072 * 2 <= WS_GATES - WS_QM, "obr alias");
static_assert((size_t)MPAD * 2048 * 4 <= 7 * ARR * 4, "macc alias");

__device__ __forceinline__ float bf2f(bf16_t b) { return __uint_as_float(((unsigned)b) << 16); }
typedef __bf16 bf16x2_t __attribute__((ext_vector_type(2)));
typedef float f32x2_t __attribute__((ext_vector_type(2)));
__device__ __forceinline__ unsigned pk2(float lo, float hi) { const f32x2_t v = {lo, hi}; return __builtin_bit_cast(unsigned, __builtin_convertvector(v, bf16x2_t)); }
__device__ __forceinline__ bf16_t f2bf(float f) { return (bf16_t)(pk2(f, 0.f) & 0xffffu); }
__device__ __forceinline__ void unpack8(const u32x4 w, float (&f)[8]) {
    f[0] = __uint_as_float(w.x << 16); f[1] = __uint_as_float(w.x & 0xffff0000u); f[2] = __uint_as_float(w.y << 16); f[3] = __uint_as_float(w.y & 0xffff0000u);
    f[4] = __uint_as_float(w.z << 16); f[5] = __uint_as_float(w.z & 0xffff0000u); f[6] = __uint_as_float(w.w << 16); f[7] = __uint_as_float(w.w & 0xffff0000u);
}
__device__ __forceinline__ u32x4 pack8(const float (&f)[8]) { u32x4 w; w.x = pk2(f[0], f[1]); w.y = pk2(f[2], f[3]); w.z = pk2(f[4], f[5]); w.w = pk2(f[6], f[7]); return w; }
__device__ __forceinline__ void ld8f(const float* p, float (&f)[8]) { const f32x4 a = *(const f32x4*)p, b = *(const f32x4*)(p + 4); f[0] = a.x; f[1] = a.y; f[2] = a.z; f[3] = a.w; f[4] = b.x; f[5] = b.y; f[6] = b.z; f[7] = b.w; }
__device__ __forceinline__ void st8f(float* p, const float (&f)[8]) { *(f32x4*)p = (f32x4){f[0], f[1], f[2], f[3]}; *(f32x4*)(p + 4) = (f32x4){f[4], f[5], f[6], f[7]}; }
__device__ __forceinline__ void ld8b(const bf16_t* p, float (&f)[8]) { unpack8(*(const u32x4*)p, f); }
__device__ __forceinline__ float sigm(float x) { return 1.f / (1.f + __expf(-x)); }
__device__ __forceinline__ float siluf(float x) { return x / (1.f + __expf(-x)); }
__device__ __forceinline__ float tanh_fast(float x) { const float e = __expf(2.f * x); return 1.f - 2.f / (e + 1.f); }
__device__ __forceinline__ float logsig_fast(float x) { return fminf(x, 0.f) - __logf(1.f + __expf(-fabsf(x))); }
__device__ __forceinline__ float wave_sum(float v) {
#pragma unroll
    for (int o = 1; o < 64; o <<= 1) v += __shfl_xor(v, o);
    return v;
}
template <int CTRL> __device__ __forceinline__ float dppf(float v) { return __int_as_float(__builtin_amdgcn_update_dpp(0, __float_as_int(v), CTRL, 0xF, 0xF, true)); }
__device__ __forceinline__ float row16_sum(float x) { x += dppf<0xB1>(x); x += dppf<0x4E>(x); x += dppf<0x141>(x); x += dppf<0x140>(x); return x; }
__device__ __forceinline__ float quad_sum(float x) { x += dppf<0xB1>(x); x += dppf<0x4E>(x); return x; }
__device__ __forceinline__ int opq(int x) { asm volatile("" : "+s"(x)); return x; }
__device__ __forceinline__ int opaque_tid() { int t = threadIdx.x; asm volatile("" : "+v"(t)); return t; }
__device__ __forceinline__ f32x4 mfma16_safe(const bf16x8 a, const bf16x8 b, const f32x4 c) { f32x4 d = __builtin_amdgcn_mfma_f32_16x16x32_bf16(a, b, c, 0, 0, 0); asm volatile("" : "+v"(d) : "v"(a), "v"(b)); return d; }
#define MFMA16(a, b, c) mfma16_safe((a), (b), (c))
#define LDS_WAIT() asm volatile("s_waitcnt lgkmcnt(0)" ::: "memory")

#define XB_TMO      128
#define XB_XCNT(j)  (256  + 64 * (j))
#define XB_XSUB(j)  (1280 + 64 * (j))
#define XB_XGEN(j)  (2304 + 64 * (j))
#define XB_TOP      3328
#define XB_TOPGEN   3392
#define XCD_BAR_WORDS 3456
#define XB_SPIN_CAP (1u << 18)
__device__ __forceinline__ unsigned xb_ld(unsigned* p)              { return __hip_atomic_load(p, __ATOMIC_RELAXED, __HIP_MEMORY_SCOPE_AGENT); }
__device__ __forceinline__ unsigned xb_add(unsigned* p, unsigned v) { return __hip_atomic_fetch_add(p, v, __ATOMIC_RELAXED, __HIP_MEMORY_SCOPE_AGENT); }
__device__ __forceinline__ unsigned xb_xcc_id() { return (unsigned)__builtin_amdgcn_s_getreg((3 << 11) | 20) & 0xFu; }
#define XB_SPIN(cond, bar) do { unsigned _sp = 0; while (cond) { __builtin_amdgcn_s_sleep(1); \
    if ((++_sp & 255u) == 0u) { if (xb_ld(&(bar)[XB_TMO])) break; if (_sp > XB_SPIN_CAP) { atomicAdd(&(bar)[XB_TMO], 1u); break; } } } } while (0)
struct XcdBarrier { unsigned* bar; unsigned x; volatile LAS unsigned* st; };
__device__ __forceinline__ XcdBarrier xcd_barrier_post(unsigned* bar, volatile LAS unsigned* st) {
    XcdBarrier b; b.bar = bar; b.x = xb_xcc_id(); b.st = st;
    if (threadIdx.x == 0) (void)xb_add(&bar[XB_XCNT(b.x)], 1u);
    return b;
}
__device__ __forceinline__ void xcd_barrier_complete(unsigned* bar, unsigned x, unsigned& nloc, unsigned& nx) {
    const unsigned G = gridDim.x * gridDim.y * gridDim.z;
    unsigned sum, cnt, mine, sp = 0u;
    for (;;) {
        sum = 0u; cnt = 0u; mine = 0u;
#pragma unroll
        for (unsigned j = 0; j < 16; ++j) { const unsigned c = xb_ld(&bar[XB_XCNT(j)]); sum += c; cnt += (c > 0u) ? 1u : 0u; mine = (j == x) ? c : mine; }
        if (sum == G) break;
        __builtin_amdgcn_s_sleep(1);
        if ((++sp & 255u) == 0u) { if (xb_ld(&bar[XB_TMO])) break; if (sp > XB_SPIN_CAP) { atomicAdd(&bar[XB_TMO], 1u); break; } }
    }
    nloc = mine > 0u ? mine : 1u; nx = cnt > 0u ? cnt : 1u;
}
__device__ __forceinline__ void xcd_barrier(const XcdBarrier& b) {
    asm volatile("s_waitcnt vmcnt(0)" ::: "memory");
    __syncthreads();
    if (threadIdx.x == 0) {
        unsigned* bar = b.bar;
        __builtin_amdgcn_s_waitcnt(0);
        unsigned nloc = b.st[0], nx = b.st[1];
        if (nloc == 0u) { xcd_barrier_complete(bar, b.x, nloc, nx); b.st[0] = nloc; b.st[1] = nx; }
        const unsigned old = xb_add(&bar[XB_XSUB(b.x)], 1u);
        const unsigned gen = old / nloc;
        if (old + 1u == (gen + 1u) * nloc) {
            __builtin_amdgcn_fence(__ATOMIC_RELEASE, "agent");
            asm volatile("s_waitcnt vmcnt(0)" ::: "memory");
            const unsigned og = xb_add(&bar[XB_TOP], 1u);
            const unsigned tg = og / nx;
            if (og + 1u == (tg + 1u) * nx) xb_add(&bar[XB_TOPGEN], 1u);
            else XB_SPIN(xb_ld(&bar[XB_TOPGEN]) == tg, bar);
            __builtin_amdgcn_fence(__ATOMIC_ACQUIRE, "agent");
            xb_add(&bar[XB_XGEN(b.x)], 1u);
            asm volatile("s_waitcnt vmcnt(0)" ::: "memory");
        } else {
            XB_SPIN(xb_ld(&bar[XB_XGEN(b.x)]) == gen, bar);
            __builtin_amdgcn_fence(__ATOMIC_ACQUIRE, "agent");
            asm volatile("s_waitcnt vmcnt(0)" ::: "memory");
        }
    }
    __syncthreads();
}

namespace pg8 {
constexpr int BM = 256, BK = 64, HALF = 128, HTB = HALF * BK * 2, STAGE_BYTES = 8 * HTB, NXCD = 8, WGM = 8;
__host__ __device__ __forceinline__ int lds_byte(int r, int c) { const int st = (r >> 4) * 2 + (c >> 5), rr = r & 15, cc = c & 31, ob = rr * 64 + cc * 2; return st * 1024 + (ob ^ (((ob >> 9) & 1) << 5)); }
__host__ __device__ __forceinline__ void stage_rc(int b, int& R, int& C) { const int st = b / 1024, sb = b % 1024, swz = sb ^ (((sb >> 9) & 1) << 5); R = (st >> 1) * 16 + swz / 64; C = (st & 1) * 32 + (swz % 64) / 2; }
__host__ __device__ __forceinline__ int perm32(int rho) { const int n = rho >> 4, i = rho & 15; return 8 * (i >> 2) + 4 * n + (i & 3); }
struct Unit { int pm, pn; };
struct Gemm { const bf16_t* A; const bf16_t* Bt; int M, N, K, lda, ldb; };
struct StaticOrder {
    int nM, nN, nwg, G, c;
    __device__ void init(int M, int N, int G_, int c_) { nM = M / BM; nN = N / BM; nwg = nM * nN; G = G_; c = c_; }
    __device__ bool next(int i, Unit& u) const {
        const long L = (long)i * G + c; if (L >= nwg) return false;
        int wgid = (int)L; { const int q = nwg / NXCD, r = nwg % NXCD, xcd = wgid % NXCD, off = wgid / NXCD; wgid = (xcd < r ? xcd * (q + 1) : r * (q + 1) + (xcd - r) * q) + off; }
        const int nig = WGM * nN, gid = wgid / nig, fm = gid * WGM, gsz = (nM - fm) < WGM ? (nM - fm) : WGM;
        u.pm = fm + ((wgid % nig) % gsz); u.pn = (wgid % nig) / gsz; return true;
    }
};
struct EpiProj {
    static constexpr bool PERM = true, HOOK = false;
    bf16_t* O; int ldc;
    __device__ __forceinline__ void operator()(const f32x4 (&acc)[2][2][4][2], const Unit& u, int wr, int wc, int fr, int fq) const {
        const int row0 = u.pm * BM + wr * 64 + fr, col0 = u.pn * BM + wc * 32 + 8 * fq;
#pragma unroll
        for (int ai = 0; ai < 2; ++ai)
#pragma unroll
            for (int m = 0; m < 4; ++m) { bf16_t* rowp = O + (size_t)(row0 + ai * HALF + m * 16) * ldc + col0;
#pragma unroll
                for (int bj = 0; bj < 2; ++bj) { const f32x4 v0 = acc[ai][bj][m][0], v1 = acc[ai][bj][m][1];
                    u32x4 w; w.x = pk2(v0[0], v0[1]); w.y = pk2(v0[2], v0[3]); w.z = pk2(v1[0], v1[1]); w.w = pk2(v1[2], v1[3]);
                    *(u32x4*)(rowp + bj * HALF) = w; } }
    }
};
struct EpiSwiGLU {
    static constexpr bool PERM = true, HOOK = false;
    bf16_t* O; int ldc;
    __device__ __forceinline__ void operator()(const f32x4 (&acc)[2][2][4][2], const Unit& u, int wr, int wc, int fr, int fq) const {
        const int row0 = u.pm * BM + wr * 64 + fr, col0 = u.pn * HALF + wc * 32 + 8 * fq;
#pragma unroll
        for (int ai = 0; ai < 2; ++ai)
#pragma unroll
            for (int m = 0; m < 4; ++m) { bf16_t* rowp = O + (size_t)(row0 + ai * HALF + m * 16) * ldc + col0;
                float o[8];
#pragma unroll
                for (int n = 0; n < 2; ++n)
#pragma unroll
                    for (int j = 0; j < 4; ++j) o[n * 4 + j] = siluf(acc[ai][0][m][n][j]) * acc[ai][1][m][n][j];
                *(u32x4*)rowp = pack8(o); }
    }
};
struct EpiResid {
    static constexpr bool PERM = false, HOOK = false;
    float* X; int ldc;
    __device__ __forceinline__ void operator()(const f32x4 (&acc)[2][2][4][2], const Unit& u, int wr, int wc, int fr, int fq) const {
        const int row0 = u.pm * BM + wr * 64 + fr, col0 = u.pn * BM + wc * 32 + 4 * fq;
#pragma unroll
        for (int ai = 0; ai < 2; ++ai)
#pragma unroll
            for (int m = 0; m < 4; ++m) { float* rowp = X + (size_t)(row0 + ai * HALF + m * 16) * ldc + col0;
#pragma unroll
                for (int bj = 0; bj < 2; ++bj)
#pragma unroll
                    for (int n = 0; n < 2; ++n) { f32x4* p = (f32x4*)(rowp + bj * HALF + n * 16); *p = *p + acc[ai][bj][m][n]; } }
    }
};
struct EpiBranchK {
    static constexpr bool PERM = true, HOOK = true;
    bf16_t* merged; const bf16_t* gr;
    __device__ __forceinline__ void hook(f32x4 (&acc)[2][2][4][2], const Unit& u, int jn, int wr, int wc, int fr, int fq) const {
        int row0 = u.pm * BM + wr * 64 + fr, col0 = u.pn * BM + wc * 32 + 8 * fq;
        asm volatile("" : "+v"(row0), "+v"(col0));
        u32x4 rv[2][4][2];
#pragma unroll
        for (int ai = 0; ai < 2; ++ai)
#pragma unroll
            for (int m = 0; m < 4; ++m)
#pragma unroll
                for (int bj = 0; bj < 2; ++bj) rv[ai][m][bj] = *(const u32x4*)(gr + (size_t)(row0 + ai * HALF + m * 16) * 6144 + (jn - 1) * 2048 + col0 + bj * HALF);
#pragma unroll
        for (int ai = 0; ai < 2; ++ai)
#pragma unroll
            for (int m = 0; m < 4; ++m)
#pragma unroll
                for (int bj = 0; bj < 2; ++bj) { float r[8]; unpack8(rv[ai][m][bj], r);
#pragma unroll
                    for (int i = 0; i < 8; ++i) acc[ai][bj][m][i >> 2][i & 3] *= r[i]; }
    }
    __device__ __forceinline__ void operator()(const f32x4 (&acc)[2][2][4][2], const Unit& u, int wr, int wc, int fr, int fq) const {
        const int row0 = u.pm * BM + wr * 64 + fr, col0 = u.pn * BM + wc * 32 + 8 * fq;
#pragma unroll
        for (int ai = 0; ai < 2; ++ai)
#pragma unroll
            for (int m = 0; m < 4; ++m) { const int row = row0 + ai * HALF + m * 16;
#pragma unroll
                for (int bj = 0; bj < 2; ++bj) { float r[8], o[8]; ld8b(gr + (size_t)row * 6144 + 4096 + col0 + bj * HALF, r);
#pragma unroll
                    for (int i = 0; i < 8; ++i) o[i] = acc[ai][bj][m][i >> 2][i & 3] * r[i];
                    *(u32x4*)(merged + (size_t)row * 2048 + col0 + bj * HALF) = pack8(o); } }
    }
};

template <class Epi>
__device__ __forceinline__ void gemm_phase(LAS unsigned char* lds, const Gemm g, const StaticOrder& S, const Epi& E) {
    const int tid = opaque_tid(), wid = __builtin_amdgcn_readfirstlane(tid >> 6), lane = tid & 63, wr = wid >> 2, wc = wid & 3, fr = lane & 15, fq = lane >> 4;
    const int K = g.K, nt = K / BK;
    unsigned voffA[2], voffB[2];
#pragma unroll
    for (int i = 0; i < 2; ++i) { int R, C; stage_rc(tid * 16 + i * 8192, R, C); const int Rb = Epi::PERM ? ((R & ~31) + perm32(R & 31)) : R;
        voffA[i] = (unsigned)(R * g.lda + C) * 2u; voffB[i] = (unsigned)(Rb * g.ldb + C) * 2u; }
    const size_t kstep = (size_t)(BK * 2);
    const size_t hstepA = (size_t)HALF * g.lda * 2, hstepB = (size_t)HALF * g.ldb * 2;
    const size_t tstepA = 2 * hstepA, tstepB = 2 * hstepB;
    const unsigned ldsw = (unsigned)wid * 1024u;
    const int aoff = lds_byte(wr * 64 + fr, fq * 8), boff = lds_byte(wc * 32 + fr, fq * 8);
#define PG8_SA(b, h) (((b) * 2 + (h)) * HTB)
#define PG8_SB(b, h) ((4 + (b) * 2 + (h)) * HTB)
#define PG8_STAGE(bufoff, gbase, voff) do { _Pragma("unroll") for (int _i = 0; _i < 2; ++_i) \
        __builtin_amdgcn_global_load_lds((const unsigned*)((const char*)(gbase) + (voff)[_i]), (LAS unsigned*)(lds + (bufoff) + ldsw + _i * 8192), 16, 0, 0); } while (0)
#define PG8_LDA(dst, b, h) do { _Pragma("unroll") for (int m = 0; m < 4; ++m) _Pragma("unroll") for (int k = 0; k < 2; ++k) dst[m][k] = *(const LAS bf16x8*)(lds + PG8_SA(b, h) + aoff + m * 2048 + k * 1024); } while (0)
#define PG8_LDB(dst, b, h) do { _Pragma("unroll") for (int n = 0; n < 2; ++n) _Pragma("unroll") for (int k = 0; k < 2; ++k) dst[n][k] = *(const LAS bf16x8*)(lds + PG8_SB(b, h) + boff + n * 2048 + k * 1024); } while (0)
#define PG8_MMA(ai, bj, At, Bt) do { __builtin_amdgcn_s_setprio(1); _Pragma("unroll") for (int m = 0; m < 4; ++m) _Pragma("unroll") for (int n = 0; n < 2; ++n) _Pragma("unroll") for (int k = 0; k < 2; ++k) \
        acc[ai][bj][m][n] = __builtin_amdgcn_mfma_f32_16x16x32_bf16(Bt[n][k], At[m][k], acc[ai][bj][m][n], 0, 0, 0); __builtin_amdgcn_s_setprio(0); } while (0)
#define PG8_WAIT_V(n) asm volatile("s_waitcnt vmcnt(" #n ")" ::: "memory")
#define PG8_WAIT_L(n) asm volatile("s_waitcnt lgkmcnt(" #n ")" ::: "memory")
#define PG8_BAR __builtin_amdgcn_s_barrier()
#define PG8_SCHED __builtin_amdgcn_sched_barrier(0)
    Unit cur, nxt; int ui = 0;
    if (!S.next(0, cur)) return;
    f32x4 acc[2][2][4][2];
#pragma unroll
    for (int a = 0; a < 2; ++a)
#pragma unroll
        for (int b = 0; b < 2; ++b)
#pragma unroll
            for (int m = 0; m < 4; ++m)
#pragma unroll
                for (int n = 0; n < 2; ++n) acc[a][b][m][n] = (f32x4){0.f, 0.f, 0.f, 0.f};
    bf16x8 At[4][2], B0[2][2], B1[2][2];
    const char* cA = (const char*)g.A + (size_t)cur.pm * tstepA; const char* cB = (const char*)g.Bt + (size_t)cur.pn * tstepB;
    PG8_STAGE(PG8_SB(0, 0), cB, voffB); PG8_STAGE(PG8_SA(0, 0), cA, voffA); PG8_STAGE(PG8_SB(0, 1), cB + hstepB, voffB); PG8_STAGE(PG8_SA(0, 1), cA + hstepA, voffA);
    if (wr == 1) PG8_BAR;
    PG8_WAIT_V(4); PG8_BAR;
    PG8_STAGE(PG8_SB(1, 0), cB + kstep, voffB); PG8_STAGE(PG8_SA(1, 0), cA + kstep, voffA); PG8_STAGE(PG8_SB(1, 1), cB + hstepB + kstep, voffB);
    PG8_WAIT_V(6); PG8_BAR;
    for (;;) {
        const bool has_next = S.next(ui + 1, nxt);
        const char* nA = has_next ? (const char*)g.A + (size_t)nxt.pm * tstepA : cA; const char* nB = has_next ? (const char*)g.Bt + (size_t)nxt.pn * tstepB : cB;
        for (int t = 0; t < nt; t += 2) {
            const bool last = (t == nt - 2);
            const char* a1 = cA + (size_t)(t + 1) * kstep;
            const char* a2 = last ? nA : cA + (size_t)(t + 2) * kstep; const char* b2 = last ? nB : cB + (size_t)(t + 2) * kstep;
            const char* a3 = a2 + kstep; const char* b3 = b2 + kstep;
            if constexpr (Epi::HOOK) { if (t == 16 || t == 32) E.hook(acc, cur, t >> 4, wr, wc, fr, fq); }
            PG8_LDB(B0, 0, 0); PG8_SCHED; PG8_LDA(At, 0, 0); PG8_STAGE(PG8_SA(1, 1), a1 + hstepA, voffA);
            PG8_WAIT_L(8); PG8_BAR; PG8_WAIT_L(0); PG8_MMA(0, 0, At, B0); PG8_BAR; PG8_SCHED;
            PG8_LDB(B1, 0, 1); PG8_STAGE(PG8_SB(0, 0), b2, voffB);
            PG8_BAR; PG8_WAIT_L(0); PG8_MMA(0, 1, At, B1); PG8_BAR;
            PG8_LDA(At, 0, 1); PG8_STAGE(PG8_SA(0, 0), a2, voffA);
            PG8_BAR; PG8_WAIT_L(0); PG8_MMA(1, 0, At, B0); PG8_BAR; PG8_SCHED;
            PG8_STAGE(PG8_SB(0, 1), b2 + hstepB, voffB);
            PG8_WAIT_V(6); PG8_BAR; PG8_MMA(1, 1, At, B1); PG8_BAR;
            PG8_LDB(B0, 1, 0); PG8_SCHED; PG8_LDA(At, 1, 0); PG8_STAGE(PG8_SA(0, 1), a2 + hstepA, voffA);
            PG8_WAIT_L(8); PG8_BAR; PG8_WAIT_L(0); PG8_MMA(0, 0, At, B0); PG8_BAR; PG8_SCHED;
            PG8_LDB(B1, 1, 1); PG8_STAGE(PG8_SB(1, 0), b3, voffB);
            PG8_BAR; PG8_WAIT_L(0); PG8_MMA(0, 1, At, B1); PG8_BAR;
            PG8_LDA(At, 1, 1); PG8_STAGE(PG8_SA(1, 0), a3, voffA);
            PG8_BAR; PG8_WAIT_L(0); PG8_MMA(1, 0, At, B0); PG8_BAR; PG8_SCHED;
            PG8_STAGE(PG8_SB(1, 1), b3 + hstepB, voffB);
            PG8_WAIT_V(6); PG8_BAR; PG8_MMA(1, 1, At, B1); PG8_BAR;
        }
        E(acc, cur, wr, wc, fr, fq);
        if (!has_next) break;
#pragma unroll
        for (int a = 0; a < 2; ++a)
#pragma unroll
            for (int b = 0; b < 2; ++b)
#pragma unroll
                for (int m = 0; m < 4; ++m)
#pragma unroll
                    for (int n = 0; n < 2; ++n) acc[a][b][m][n] = (f32x4){0.f, 0.f, 0.f, 0.f};
        cur = nxt; cA = nA; cB = nB; ++ui;
    }
    PG8_WAIT_V(0);
    if (wr == 0) PG8_BAR;
    PG8_BAR;
#undef PG8_SA
#undef PG8_SB
#undef PG8_STAGE
#undef PG8_LDA
#undef PG8_LDB
#undef PG8_MMA
#undef PG8_WAIT_V
#undef PG8_WAIT_L
#undef PG8_BAR
#undef PG8_SCHED
}
}

constexpr size_t RP_W = 6 * ARR * 2, RP_GR = RP_W + ARR * 4;
static_assert(RP_GR + (size_t)MT * 6144 * 2 <= 7 * ARR * 4, "RPRE region");
struct Args { const float* in[37]; float* out; unsigned char* ws; int ph_lo, ph_hi; };
enum { I_XP = 0, I_XS, I_SSHIFT, I_SWKV, I_SCONV, I_SC, I_SN, I_SM, I_SGLA, I_NORM1, I_WIN, I_GATEB, I_MU, I_W0, I_W2, I_A0, I_A2, I_G2, I_KK, I_KA, I_RK, I_LNG, I_LNB,
       I_CONVW, I_CONVB, I_IB, I_FB, I_MNORM, I_GA2, I_GAB, I_GNORM, I_WBR, I_WOUT, I_NORM2, I_WGU, I_WDN, I_FNORM };

constexpr int LDS_BYTES = 147456;
constexpr int PTAB_OFF = LDS_BYTES - 1024;
__device__ __forceinline__ unsigned long long ctx_raw(LAS unsigned char* lds, int i) {
    const unsigned long long v = ((const LAS unsigned long long*)(lds + PTAB_OFF))[i];
    const unsigned lo = __builtin_amdgcn_readfirstlane((unsigned)v), hi = __builtin_amdgcn_readfirstlane((unsigned)(v >> 32));
    return ((unsigned long long)hi << 32) | lo;
}
#define GAS __attribute__((address_space(1)))
__device__ __forceinline__ const float* ctx_in(LAS unsigned char* lds, int i) { return (const float*)(const GAS float*)ctx_raw(lds, i); }
__device__ __forceinline__ float* ctx_out(LAS unsigned char* lds) { return (float*)(GAS float*)ctx_raw(lds, 37); }
__device__ __forceinline__ unsigned char* ctx_ws(LAS unsigned char* lds) { return (unsigned char*)(GAS unsigned char*)ctx_raw(lds, 38); }

__device__ __forceinline__ void tr_item(const float* W, int ldw, int k0, int n0, int nvalid, bf16_t* WT, int K, int drow0, LAS float* scr, int lane, int dk = 0) {
#pragma unroll 8
    for (int i = 0; i < 32; ++i) { const int kk = 2 * i + (lane >> 5), n = lane & 31; scr[kk * 33 + n] = (n < nvalid) ? __builtin_nontemporal_load(W + (size_t)(k0 + kk) * ldw + n0 + n) : 0.f; }
    LDS_WAIT();
    const int c = lane & 7;
#pragma unroll
    for (int j = 0; j < 4; ++j) { const int n = (lane >> 3) + 8 * j; const LAS float* s = scr + (8 * c) * 33 + n;
        u32x4 o; o.x = pk2(s[0 * 33], s[1 * 33]); o.y = pk2(s[2 * 33], s[3 * 33]); o.z = pk2(s[4 * 33], s[5 * 33]); o.w = pk2(s[6 * 33], s[7 * 33]);
        *(u32x4*)(WT + (size_t)(drow0 + n) * K + dk + k0 + 8 * c) = o; }
    LDS_WAIT();
}
__device__ __forceinline__ void phase_prologue(LAS unsigned char* lds, int G) {
    const int tid = opaque_tid(), lane = tid & 63, wave = tid >> 6;
    LAS float* scr = (LAS float*)(lds + wave * 8704);
    const int gw = blockIdx.x * 8 + wave, NGW = G * 8;
    constexpr int I_IN = 32 * 519, I_BR = 3 * 16 * 64, I_OUT = 32 * 64, I_GU = 32 * 352, I_DN = 88 * 64, I_LO = 3 * 32, PER_L = I_IN + I_BR + I_OUT + I_GU + I_DN + I_LO;
    for (int it = gw; it < 2 * PER_L; it += NGW) {
        const int l = it / PER_L; int r = it % PER_L;
        unsigned char* wl = ctx_ws(lds) + WS_W + (size_t)l * LW_BYTES;
        if (r < I_IN) { const int kb = r / 519, nb = r % 519; const int nv = (NIN - nb * 32) < 32 ? (NIN - nb * 32) : 32;
            tr_item(ctx_in(lds, I_WIN) + (size_t)l * 2048 * NIN, NIN, kb * 64, nb * 32, nv, (bf16_t*)(wl + LW_WIN), 2048, nb * 32, scr, lane); continue; }
        r -= I_IN;
        if (r < I_BR) { const int j = r / 1024, q = r % 1024, kb = q / 64, nb = q % 64;
            tr_item(ctx_in(lds, I_WBR) + (size_t)(l * 3 + j) * 1024 * 2048, 2048, kb * 64, nb * 32, 32, (bf16_t*)(wl + LW_WBR), 3072, nb * 32, scr, lane, j * 1024); continue; }
        r -= I_BR;
        if (r < I_OUT) { const int kb = r / 64, nb = r % 64;
            tr_item(ctx_in(lds, I_WOUT) + (size_t)l * 2048 * 2048, 2048, kb * 64, nb * 32, 32, (bf16_t*)(wl + LW_WOUT), 2048, nb * 32, scr, lane); continue; }
        r -= I_OUT;
        if (r < I_GU) { const int kb = r / 352, nb = r % 352; const int n0 = nb * 32; const int np = n0 < DFF ? n0 : n0 - DFF; const int drow = 256 * (np / 128) + (np % 128) + (n0 < DFF ? 0 : 128);
            tr_item(ctx_in(lds, I_WGU) + (size_t)l * 2048 * 11264, 11264, kb * 64, n0, 32, (bf16_t*)(wl + LW_WGU), 2048, drow, scr, lane); continue; }
        r -= I_GU;
        if (r < I_DN) { const int kb = r / 64, nb = r % 64;
            tr_item(ctx_in(lds, I_WDN) + (size_t)l * DFF * 2048, 2048, kb * 64, nb * 32, 32, (bf16_t*)(wl + LW_WDN), DFF, nb * 32, scr, lane); continue; }
        r -= I_DN;
        { const int mat = r / 32, nb = r % 32; const float* src = (mat == 0 ? ctx_in(lds, I_W2) : (mat == 1 ? ctx_in(lds, I_A2) : ctx_in(lds, I_G2))) + (size_t)l * 64 * 1024;
            tr_item(src, 1024, 0, nb * 32, 32, (bf16_t*)(wl + LW_LORA) + (size_t)mat * 1024 * 64, 64, nb * 32, scr, lane); }
    }
    const int gt = blockIdx.x * NTHREADS + tid, NGT = G * NTHREADS;
    for (int i = gt; i < 2 * 32 * 2048 / 8; i += NGT) { const int l = i / (32 * 256), q = i % (32 * 256);
        *(u32x4*)((bf16_t*)(ctx_ws(lds) + WS_W + (size_t)l * LW_BYTES + LW_WIN) + (size_t)16608 * 2048 + (size_t)q * 8) = (u32x4){0u, 0u, 0u, 0u}; }
    for (int i = gt; i < 2 * 512 * 32; i += NGT) { const int l = i / (512 * 32), q = i % (512 * 32), c = q / 32, k = q % 32;
        ((bf16_t*)(ctx_ws(lds) + WS_W + (size_t)l * LW_BYTES + LW_GA2))[q] = k < 16 ? f2bf(ctx_in(lds, I_GA2)[(size_t)l * 16 * 512 + k * 512 + c]) : (bf16_t)0; }
}

__device__ __forceinline__ void phase_norm(LAS unsigned char* lds, int G, const float* gvec, bool from_input) {
    const int tid = opaque_tid(), lane = tid & 63, wave = tid >> 6;
    float* xbuf = (float*)(ctx_ws(lds) + WS_X); bf16_t* hb = (bf16_t*)(ctx_ws(lds) + WS_H);
    for (int m = blockIdx.x * 8 + wave; m < MPAD; m += G * 8) {
        if (m >= MT) { if (from_input) {
#pragma unroll
            for (int j = 0; j < 4; ++j) *(u32x4*)(hb + (size_t)m * 2048 + (lane + 64 * j) * 8) = (u32x4){0u, 0u, 0u, 0u}; } continue; }
        const float* src = from_input ? (m < MP ? ctx_in(lds, I_XP) + (size_t)m * 2048 : ctx_in(lds, I_XS) + (size_t)(m - MP) * 2048) : xbuf + (size_t)m * 2048;
        f32x4 v[8]; float s = 0.f;
#pragma unroll
        for (int j = 0; j < 8; ++j) { v[j] = *(const f32x4*)(src + (lane + 64 * j) * 4); s += (v[j].x * v[j].x + v[j].y * v[j].y) + (v[j].z * v[j].z + v[j].w * v[j].w); }
        const float rs = rsqrtf(wave_sum(s) * (1.f / 2048.f) + 1e-6f);
#pragma unroll
        for (int j = 0; j < 8; ++j) { const int c = (lane + 64 * j) * 4; const f32x4 gg = *(const f32x4*)(gvec + c);
            if (from_input) *(f32x4*)(xbuf + (size_t)m * 2048 + c) = v[j];
            u32x2 w; w.x = pk2(v[j].x * rs * gg.x, v[j].y * rs * gg.y); w.y = pk2(v[j].z * rs * gg.z, v[j].w * rs * gg.w);
            *(u32x2*)(hb + (size_t)m * 2048 + c) = w; }
    }
}
__device__ __forceinline__ void dump_words(const unsigned* src, unsigned* dst, size_t n, int G) {
    for (size_t i = (size_t)blockIdx.x * NTHREADS + threadIdx.x; i < n; i += (size_t)G * NTHREADS) dst[i] = src[i];
}
__device__ __forceinline__ void phase_dump(LAS unsigned char* lds, int G) {
    unsigned char* ws = ctx_ws(lds); unsigned* out = (unsigned*)ctx_out(lds);
    if (DBG_LIM == 5) { if (DBG_SEL == 0) dump_words((const unsigned*)(ws + WS_ROUT), out + O_YP, ARR, G); if (DBG_SEL == 1) dump_words((const unsigned*)(ws + WS_HM), out + O_YP, ARR, G); if (DBG_SEL == 2) { dump_words((const unsigned*)(ws + WS_OG), out + O_YP, ARR, G); dump_words((const unsigned*)(ws + WS_HM), out + O_SC, ARR, G); } if (DBG_SEL == 3) dump_words((const unsigned*)(ws + WS_QM), out + O_YP, ARR, G); if (DBG_SEL == 4) dump_words((const unsigned*)(ws + WS_HM), out + O_YP, (size_t)MP * 1024, G); }
    else if (DBG_LIM == 6) { dump_words((const unsigned*)(ws + WS_QM), out + O_YP, (size_t)MT * 3072 / 2, G); }
    else if (DBG_LIM == 7) { dump_words((const unsigned*)(ws + WS_H), out + O_YP, (size_t)MT * 2048 / 2, G); }
    else { dump_words((const unsigned*)(ws + WS_X), out + O_YP, (size_t)MP * 2048, G); }
}
__device__ __forceinline__ void phase_final(LAS unsigned char* lds, int G) {
    const int tid = opaque_tid(), lane = tid & 63, wave = tid >> 6;
    const float* xbuf = (const float*)(ctx_ws(lds) + WS_X); const float* gvec = ctx_in(lds, I_FNORM);
    for (int m = blockIdx.x * 8 + wave; m < MT; m += G * 8) {
        const float* src = xbuf + (size_t)m * 2048; float* dst = ctx_out(lds) + (m < MP ? O_YP + (size_t)m * 2048 : O_YS + (size_t)(m - MP) * 2048);
        f32x4 v[8]; float s = 0.f;
#pragma unroll
        for (int j = 0; j < 8; ++j) { v[j] = *(const f32x4*)(src + (lane + 64 * j) * 4); s += (v[j].x * v[j].x + v[j].y * v[j].y) + (v[j].z * v[j].z + v[j].w * v[j].w); }
        const float rs = rsqrtf(wave_sum(s) * (1.f / 2048.f) + 1e-6f);
#pragma unroll
        for (int j = 0; j < 8; ++j) { const int c = (lane + 64 * j) * 4; const f32x4 gg = *(const f32x4*)(gvec + c);
            *(f32x4*)(dst + c) = (f32x4){v[j].x * rs * gg.x, v[j].y * rs * gg.y, v[j].z * rs * gg.z, v[j].w * rs * gg.w}; }
    }
}

__device__ __forceinline__ void load_prev8(const bf16_t* proj, const float* shift_l, int m, int col, float (&o)[8]) {
    if (m >= MP) ld8f(shift_l + (size_t)(m - MP) * RC + col, o);
    else if ((m & 2047) == 0) {
#pragma unroll
        for (int i = 0; i < 8; ++i) o[i] = 0.f; }
    else ld8b(proj + (size_t)(m - 1) * NINP + col, o);
}
__device__ __forceinline__ void ld16b(const bf16_t* p, float (&f)[16]) { ld8b(p, *(float(*)[8])&f[0]); ld8b(p + 8, *(float(*)[8])&f[8]); }
__device__ __forceinline__ void ld16f(const float* p, float (&f)[16]) { ld8f(p, *(float(*)[8])&f[0]); ld8f(p + 8, *(float(*)[8])&f[8]); }
__device__ __forceinline__ void st16f(float* p, const float (&f)[16]) { st8f(p, *(const float(*)[8])&f[0]); st8f(p + 8, *(const float(*)[8])&f[8]); }
__device__ __forceinline__ void st16b(bf16_t* p, const float (&f)[16]) { *(u32x4*)p = pack8(*(const float(*)[8])&f[0]); *(u32x4*)(p + 8) = pack8(*(const float(*)[8])&f[8]); }
__device__ __forceinline__ void pre_rwkv_item(LAS unsigned char* lds, int l, int cidx, int tt, int h0, int nh, int wave, int lane) {
    const int lr = lane & 15, lq = lane >> 4;
    const int m0 = cidx * 64 + tt * 16;
    const bf16_t* proj = (const bf16_t*)(ctx_ws(lds) + WS_PROJ);
    const float* shift_l = ctx_in(lds, I_SSHIFT) + (size_t)l * 128 * RC;
    const float* mu = ctx_in(lds, I_MU) + (size_t)l * RC;
    const bf16_t* loraT = (const bf16_t*)(ctx_ws(lds) + WS_W + (size_t)l * LW_BYTES + LW_LORA);
    bf16_t* rb = (bf16_t*)(ctx_ws(lds) + WS_RPRE); float* rw = (float*)(ctx_ws(lds) + WS_RPRE + RP_W);
    LAS bf16_t* loraA = (LAS bf16_t*)(lds + wave * 14336);
    LAS bf16_t* loraO = (LAS bf16_t*)(lds + wave * 14336 + 7168);
    const int tok = lane >> 2, c4 = lane & 3, m = m0 + tok;
    {
#pragma unroll
        for (int i = 0; i < 6; ++i) {
            const int cgp = c4 + 4 * i, col = 3072 + cgp * 8, mat = cgp >> 3, kc = (cgp & 7) * 8;
            float p[8], pv[8], mm[8], x[8];
            ld8b(proj + (size_t)m * NINP + col, p); load_prev8(proj, shift_l, m, col, pv); ld8f(mu + col, mm);
#pragma unroll
            for (int j = 0; j < 8; ++j) { const float xs = p[j] + (pv[j] - p[j]) * mm[j]; x[j] = mat == 0 ? tanh_fast(xs) : (mat == 1 ? xs : sigm(xs)); }
            *(LAS u32x4*)(loraA + (mat * 16 + tok) * 72 + kc) = pack8(x);
        }
    }
    LDS_WAIT();
    const bool samp = m >= MP, first = !samp && ((m & 2047) == 0);
    const bf16_t* prow = proj + (size_t)m * NINP;
    const bf16_t* qrow = proj + (size_t)((samp || first) ? m : m - 1) * NINP;
    const float* srow = shift_l + (size_t)(samp ? m - MP : 0) * RC;
#pragma unroll 1
    for (int hh = 0; hh < nh; ++hh) {
        const int h = h0 + hh, c0 = h * 64 + c4 * 16;
        bf16x8 bfr[3][4][2];
#pragma unroll
        for (int mat = 0; mat < 3; ++mat)
#pragma unroll
            for (int tc = 0; tc < 4; ++tc)
#pragma unroll
                for (int ks = 0; ks < 2; ++ks) bfr[mat][tc][ks] = *(const bf16x8*)(loraT + (size_t)(mat * 1024 + h * 64 + tc * 16 + lr) * 64 + ks * 32 + lq * 8);
        u32x4 pw[3][2], qw[3][2]; f32x4 qs[3][4];
#pragma unroll
        for (int g = 0; g < 3; ++g) { pw[g][0] = *(const u32x4*)(prow + g * 1024 + c0); pw[g][1] = *(const u32x4*)(prow + g * 1024 + c0 + 8);
            if (samp) {
#pragma unroll
                for (int k = 0; k < 4; ++k) qs[g][k] = *(const f32x4*)(srow + g * 1024 + c0 + 4 * k); }
            else { qw[g][0] = *(const u32x4*)(qrow + g * 1024 + c0); qw[g][1] = *(const u32x4*)(qrow + g * 1024 + c0 + 8); } }
#pragma unroll
        for (int mat = 0; mat < 3; ++mat)
#pragma unroll
            for (int tc = 0; tc < 4; ++tc) { f32x4 acc = {0.f, 0.f, 0.f, 0.f};
#pragma unroll
                for (int ks = 0; ks < 2; ++ks) {
                    const bf16x8 av = *(const LAS bf16x8*)(loraA + (mat * 16 + lr) * 72 + ks * 32 + lq * 8);
                    acc = MFMA16(av, bfr[mat][tc][ks], acc); }
#pragma unroll
                for (int r = 0; r < 4; ++r) loraO[(mat * 16 + lq * 4 + r) * 72 + tc * 16 + lr] = f2bf(acc[r]); }
        LDS_WAIT();
        float xr[16], xk[16], xv[16];
#pragma unroll
        for (int g = 0; g < 3; ++g) { float p[16], q[16], mm[16];
            unpack8(pw[g][0], *(float(*)[8])&p[0]); unpack8(pw[g][1], *(float(*)[8])&p[8]); ld16f(mu + g * 1024 + c0, mm);
            if (samp) {
#pragma unroll
                for (int j = 0; j < 16; ++j) q[j] = qs[g][j >> 2][j & 3]; }
            else { unpack8(qw[g][0], *(float(*)[8])&q[0]); unpack8(qw[g][1], *(float(*)[8])&q[8]);
                if (first) {
#pragma unroll
                    for (int j = 0; j < 16; ++j) q[j] = 0.f; } }
#pragma unroll
            for (int j = 0; j < 16; ++j) { const float x = p[j] + (q[j] - p[j]) * mm[j]; if (g == 0) xr[j] = x; else if (g == 1) xk[j] = x; else xv[j] = x; } }
        const size_t o = (size_t)m * 1024 + c0;
        st16b(rb + 3 * ARR + o, xr); st16b(rb + 4 * ARR + o, xv);
        float lw[16], la[16], lg[16];
        { const LAS bf16_t* lo = loraO + tok * 72 + c4 * 16;
          unpack8(*(const LAS u32x4*)(lo), *(float(*)[8])&lw[0]); unpack8(*(const LAS u32x4*)(lo + 8), *(float(*)[8])&lw[8]);
          unpack8(*(const LAS u32x4*)(lo + 16 * 72), *(float(*)[8])&la[0]); unpack8(*(const LAS u32x4*)(lo + 16 * 72 + 8), *(float(*)[8])&la[8]);
          unpack8(*(const LAS u32x4*)(lo + 32 * 72), *(float(*)[8])&lg[0]); unpack8(*(const LAS u32x4*)(lo + 32 * 72 + 8), *(float(*)[8])&lg[8]); }
        st16b(rb + 5 * ARR + o, lg);
        float pa[16], pb[16], kkr[16], av[16]; float ss = 0.f;
        ld16f(ctx_in(lds, I_KK) + l * 1024 + c0, pa); ld16f(ctx_in(lds, I_A0) + l * 1024 + c0, pb);
#pragma unroll
        for (int j = 0; j < 16; ++j) { kkr[j] = xk[j] * pa[j]; ss += kkr[j] * kkr[j]; av[j] = sigm(pb[j] + la[j]); }
        ss = quad_sum(ss);
        const float inv = 1.f / fmaxf(sqrtf(ss), 1e-12f);
#pragma unroll
        for (int j = 0; j < 16; ++j) { kkr[j] *= inv; pa[j] = kkr[j] * av[j]; }
        st16b(rb + 0 * ARR + o, kkr); st16b(rb + 1 * ARR + o, pa);
        ld16f(ctx_in(lds, I_KA) + l * 1024 + c0, pa); ld16f(ctx_in(lds, I_W0) + l * 1024 + c0, pb);
#pragma unroll
        for (int j = 0; j < 16; ++j) { pa[j] = xk[j] * (1.f + (av[j] - 1.f) * pa[j]);
            const float wp = -(pb[j] + lw[j]); const float sp = fmaxf(wp, 0.f) + __logf(1.f + __expf(-fabsf(wp))); pb[j] = __expf(-__expf(-sp - 0.5f)); }
        st16b(rb + 2 * ARR + o, pa); st16f(rw + o, pb);
        LDS_WAIT();
    }
}
__device__ __forceinline__ void pre_mlstm(LAS unsigned char* lds, int l, int cidx, int m0, int ntok) {
    const int tid = opaque_tid();
    const bf16_t* proj = (const bf16_t*)(ctx_ws(lds) + WS_PROJ);
    bf16_t* qm = (bf16_t*)(ctx_ws(lds) + WS_QM); bf16_t* km = (bf16_t*)(ctx_ws(lds) + WS_KM); float* gates = (float*)(ctx_ws(lds) + WS_GATES);
    const int cgp = tid & 255, th = tid >> 8, c0 = cgp * 8;
    float w0[8], w1[8], w2[8], w3[8], cb[8];
    ld8f(ctx_in(lds, I_CONVW) + (size_t)(l * 4 + 0) * 2048 + c0, w0); ld8f(ctx_in(lds, I_CONVW) + (size_t)(l * 4 + 1) * 2048 + c0, w1);
    ld8f(ctx_in(lds, I_CONVW) + (size_t)(l * 4 + 2) * 2048 + c0, w2); ld8f(ctx_in(lds, I_CONVW) + (size_t)(l * 4 + 3) * 2048 + c0, w3);
    ld8f(ctx_in(lds, I_CONVB) + (size_t)l * 2048 + c0, cb);
    bf16_t* dst = cgp < 128 ? qm + c0 : km + (c0 - 1024); const float sc = cgp < 128 ? 1.f : 0.0625f;
    if (cidx < 128) {
        float x3[8], x2[8], x1[8];
        const int t0 = th * 32, ts0 = (m0 & 2047) + t0;
#pragma unroll
        for (int j = 0; j < 8; ++j) { x3[j] = 0.f; x2[j] = 0.f; x1[j] = 0.f; }
        if (ts0 >= 3) { ld8b(proj + (size_t)(m0 + t0 - 3) * NINP + M0 + c0, x3); ld8b(proj + (size_t)(m0 + t0 - 2) * NINP + M0 + c0, x2); ld8b(proj + (size_t)(m0 + t0 - 1) * NINP + M0 + c0, x1); }
        const bool lastc = (cidx & 31) == 31; const int b = cidx >> 5;
#pragma unroll 1
        for (int tb = t0; tb < t0 + 32; tb += 8) {
            u32x4 xb[8];
#pragma unroll
            for (int i = 0; i < 8; ++i) xb[i] = *(const u32x4*)(proj + (size_t)(m0 + tb + i) * NINP + M0 + c0);
#pragma unroll
            for (int i = 0; i < 8; ++i) { const int m = m0 + tb + i; float x0[8], y[8]; unpack8(xb[i], x0);
#pragma unroll
                for (int j = 0; j < 8; ++j) { const float cv = cb[j] + w0[j] * x3[j] + w1[j] * x2[j] + w2[j] * x1[j] + w3[j] * x0[j]; y[j] = siluf(cv) * sc; x3[j] = x2[j]; x2[j] = x1[j]; x1[j] = x0[j]; }
                *(u32x4*)(dst + (size_t)m * 1024) = pack8(y);
                if (lastc && tb + i >= 61) st8f(ctx_out(lds) + O_PCONV + (size_t)((l * 4 + b) * 3 + (tb + i - 61)) * 2048 + c0, x0); }
        }
    } else {
#pragma unroll 1
        for (int tb = th * (ntok >> 1); tb < (th + 1) * (ntok >> 1); tb += 4) {
            u32x4 xb[4]; f32x4 sa[4][6];
#pragma unroll
            for (int i = 0; i < 4; ++i) { const int m = m0 + tb + i, s = m - MP; const float* cs = ctx_in(lds, I_SCONV) + (size_t)((l * 128 + s) * 3) * 2048 + c0;
                xb[i] = *(const u32x4*)(proj + (size_t)m * NINP + M0 + c0);
#pragma unroll
                for (int k = 0; k < 3; ++k) { sa[i][2 * k] = *(const f32x4*)(cs + k * 2048); sa[i][2 * k + 1] = *(const f32x4*)(cs + k * 2048 + 4); } }
#pragma unroll
            for (int i = 0; i < 4; ++i) { const int m = m0 + tb + i, s = m - MP; float x0[8], y[8]; unpack8(xb[i], x0);
#pragma unroll
                for (int j = 0; j < 8; ++j) { const float x3 = sa[i][0 + (j >> 2)][j & 3], x2 = sa[i][2 + (j >> 2)][j & 3], x1 = sa[i][4 + (j >> 2)][j & 3];
                    const float cv = cb[j] + w0[j] * x3 + w1[j] * x2 + w2[j] * x1 + w3[j] * x0[j]; y[j] = siluf(cv) * sc; }
                *(u32x4*)(dst + (size_t)m * 1024) = pack8(y);
                float* co = ctx_out(lds) + O_SCONV + (size_t)((l * 128 + s) * 3) * 2048 + c0;
                *(f32x4*)co = sa[i][2]; *(f32x4*)(co + 4) = sa[i][3]; *(f32x4*)(co + 2048) = sa[i][4]; *(f32x4*)(co + 2052) = sa[i][5]; st8f(co + 4096, x0); }
        }
    }
    if (tid < ntok * 4) { const int t = tid >> 2, hh = tid & 3, m = m0 + t;
        const float ip = bf2f(proj[(size_t)m * NINP + M0 + 3072 + hh]), fp = bf2f(proj[(size_t)m * NINP + M0 + 3076 + hh]);
        const float xf = fp + ctx_in(lds, I_FB)[l * 4 + hh];
        gates[(size_t)m * 8 + hh] = ip + ctx_in(lds, I_IB)[l * 4 + hh];
        gates[(size_t)m * 8 + 4 + hh] = fminf(xf, 0.f) - log1pf(__expf(-fabsf(xf))); }
}
__device__ __forceinline__ void pre_gla(LAS unsigned char* lds, int l, int cidx, int m0, int ntok) {
    const int tid = opaque_tid(), lane = tid & 63, wave = tid >> 6, lr = lane & 15, lq = lane >> 4;
    const bf16_t* proj = (const bf16_t*)(ctx_ws(lds) + WS_PROJ);
    bf16_t* gq = (bf16_t*)(ctx_ws(lds) + WS_GQ); bf16_t* gk = (bf16_t*)(ctx_ws(lds) + WS_GK); bf16_t* gkh = (bf16_t*)(ctx_ws(lds) + WS_GKH); float* egl = (float*)(ctx_ws(lds) + WS_EGL);
    const bf16_t* a2T = (const bf16_t*)(ctx_ws(lds) + WS_W + (size_t)l * LW_BYTES + LW_GA2);
    LAS float* bb = (LAS float*)lds;
    LAS bf16_t* xa = (LAS bf16_t*)(lds + 64 * 516 * 4);
    const bool samp = cidx >= 128;
    __syncthreads();
    for (int i = tid; i < ntok * 32; i += NTHREADS) { const int t = i >> 5, k = i & 31; xa[t * 40 + k] = k < 16 ? proj[(size_t)(m0 + t) * NINP + G0 + 2048 + k] : (bf16_t)0; }
    __syncthreads();
#pragma unroll
    for (int q = 0; q < 4; ++q) { const int tc = wave * 4 + q;
        const bf16x8 bv = *(const bf16x8*)(a2T + (size_t)(tc * 16 + lr) * 32 + lq * 8);
        const float ab = ctx_in(lds, I_GAB)[l * 512 + tc * 16 + lr];
#pragma unroll
        for (int tt = 0; tt < 4; ++tt) { if (tt * 16 >= ntok) break; const bf16x8 av = *(const LAS bf16x8*)(xa + (tt * 16 + lr) * 40 + lq * 8);
            f32x4 acc = {0.f, 0.f, 0.f, 0.f}; acc = MFMA16(av, bv, acc);
#pragma unroll
            for (int r = 0; r < 4; ++r) bb[(tt * 16 + lq * 4 + r) * 516 + tc * 16 + lr] = logsig_fast(acc[r] + ab) * 0.0625f; } }
    __syncthreads();
    if (!samp) { const int c = tid; float run = 0.f;
#pragma unroll 8
        for (int t = 0; t < 64; ++t) { run += bb[t * 516 + c]; bb[t * 516 + c] = run; }
        egl[(size_t)cidx * 512 + c] = __expf(run); }
    __syncthreads();
    const float scale = 0.08838834764831845f;
    for (int i = tid; i < ntok * 64; i += NTHREADS) { const int t = i >> 6, cg = i & 63, c = cg * 8; const size_t m = m0 + t;
        float q[8], k[8], b8[8], bl[8], oq[8], ok[8], oh[8];
        ld8b(proj + m * NINP + G0 + c, q); ld8b(proj + m * NINP + G0 + 512 + c, k);
#pragma unroll
        for (int j = 0; j < 8; ++j) { b8[j] = bb[t * 516 + c + j]; bl[j] = samp ? b8[j] : bb[63 * 516 + c + j]; }
#pragma unroll
        for (int j = 0; j < 8; ++j) { oq[j] = q[j] * __expf(b8[j]) * scale; ok[j] = k[j] * __expf(-b8[j]); oh[j] = k[j] * __expf(bl[j] - b8[j]); }
        *(u32x4*)(gq + m * 512 + c) = pack8(oq); *(u32x4*)(gk + m * 512 + c) = pack8(ok); *(u32x4*)(gkh + m * 512 + c) = pack8(oh);
        if (samp) { float e[8];
#pragma unroll
            for (int j = 0; j < 8; ++j) e[j] = __expf(b8[j]);
            st8f(egl + (size_t)(128 + (m - MP)) * 512 + c, e); } }
}
__device__ __forceinline__ void phase_pre(LAS unsigned char* lds, int l, int G) {
    { const int tid = opaque_tid(), wave = tid >> 6, lane = tid & 63;
      for (int it = blockIdx.x * 8 + wave; it < 2048 + G * 8; it += G * 8) {
          int cidx, tt, h0, nh;
          if (it < 2048) { cidx = it >> 4; tt = (it >> 2) & 3; h0 = (it & 3) * 4; nh = 4; }
          else { const int j = G * 8 - 1 - (it - 2048); if (j >= 128) continue; cidx = 128 + (j >> 6); tt = (j >> 4) & 3; h0 = j & 15; nh = 1; }
          pre_rwkv_item(lds, l, cidx, tt, h0, nh, wave, lane); } }
    for (int u = blockIdx.x; u < 272; u += G) {
        if (u < 128) pre_gla(lds, l, u, u * 64, 64);
        else if (u < 256) pre_mlstm(lds, l, u - 128, (u - 128) * 64, 64);
        else if (u < 264) pre_gla(lds, l, 128, MP + (u - 256) * 16, 16);
        else pre_mlstm(lds, l, 128, MP + (u - 264) * 16, 16);
    }
    {
        const bf16_t* proj = (const bf16_t*)(ctx_ws(lds) + WS_PROJ);
        for (int i = blockIdx.x * NTHREADS + opaque_tid(); i < 132 * (RC / 8); i += G * NTHREADS) { const int sq = i / (RC / 8), cg8 = i % (RC / 8); float p[8];
            const int m = sq < 4 ? sq * 2048 + 2047 : MP + (sq - 4);
            ld8b(proj + (size_t)m * NINP + cg8 * 8, p);
            st8f(ctx_out(lds) + (sq < 4 ? O_PSHIFT + (size_t)(l * 4 + sq) * RC : O_SSHIFT + (size_t)(l * 128 + (sq - 4)) * RC) + cg8 * 8, p); }
    }
}

__device__ __forceinline__ void scan_rwkv(LAS unsigned char* lds, int l, int u) {
    const int tid = opaque_tid(), bh = u >> 1, half = u & 1, b = bh >> 4, h = bh & 15;
    const int row = tid >> 4, kq = tid & 15;
    const float* rpre = (const float*)(ctx_ws(lds) + WS_RPRE); bf16_t* rout = (bf16_t*)(ctx_ws(lds) + WS_ROUT);
    LAS float* stage = (LAS float*)lds;
    LAS float* obuf = (LAS float*)(lds + 64 * 352 * 4);
    f32x4 S = {0.f, 0.f, 0.f, 0.f};
    const size_t mb = (size_t)b * 2048;
    const unsigned char* rbase = (const unsigned char*)rpre;
    unsigned off[7], inc[7]; int lo[7];
#pragma unroll
    for (int q = 0; q < 7; ++q) { int i = tid + 512 * q; i = i < 3328 ? i : 3327; const int tok = i / 52, j = i % 52;
        if (j < 32) { const int arr = j >> 3, pc = j & 7; off[q] = (unsigned)(arr * (int)ARR + tok * 1024 + h * 64 + pc * 8) * 2u; inc[q] = 64u * 1024u * 2u; lo[q] = tok * 352 + (arr == 0 ? 0 : arr == 1 ? 64 : arr == 2 ? 192 : 256) + pc * 8; }
        else if (j < 48) { const int pc = j - 32; off[q] = (unsigned)RP_W + (unsigned)(tok * 1024 + h * 64 + pc * 4) * 4u; inc[q] = 64u * 1024u * 4u; lo[q] = -(tok * 352 + 128 + pc * 4) - 1; }
        else { const int pc = j - 48; off[q] = (unsigned)(4 * (int)ARR + tok * 1024 + h * 64 + half * 32 + pc * 8) * 2u; inc[q] = 64u * 1024u * 2u; lo[q] = tok * 352 + 320 + pc * 8; } }
    u32x4 pf[7];
    const size_t cb0 = mb / 64;
#pragma unroll
    for (int q = 0; q < 7; ++q) pf[q] = *(const u32x4*)(rbase + off[q] + cb0 * inc[q]);
    __syncthreads();
    for (int ch = 0; ch < 32; ++ch) {
#pragma unroll
        for (int q = 0; q < 7; ++q) {
            if (lo[q] < 0) *(LAS u32x4*)(stage + (-lo[q] - 1)) = pf[q];
            else { float f[8]; unpack8(pf[q], f); *(LAS f32x4*)(stage + lo[q]) = (f32x4){f[0], f[1], f[2], f[3]}; *(LAS f32x4*)(stage + lo[q] + 4) = (f32x4){f[4], f[5], f[6], f[7]}; } }
        __syncthreads();
        { const size_t chn = cb0 + (ch + 1 < 32 ? ch + 1 : 31);
#pragma unroll
          for (int q = 0; q < 7; ++q) pf[q] = *(const u32x4*)(rbase + off[q] + chn * inc[q]); }
        f32x4 kkn, bbn, wwn, k2n, rrn; float vvn;
        { const LAS float* sp = stage + kq * 4; kkn = *(const LAS f32x4*)(sp); bbn = *(const LAS f32x4*)(sp + 64); wwn = *(const LAS f32x4*)(sp + 128); k2n = *(const LAS f32x4*)(sp + 192); rrn = *(const LAS f32x4*)(sp + 256); vvn = stage[320 + row]; }
        float o0 = 0.f, o1 = 0.f, o2 = 0.f, o3 = 0.f;
#pragma unroll
        for (int t = 0; t < 64; ++t) {
            const f32x4 kk = kkn, bb = bbn, ww = wwn, k2 = k2n, rr = rrn; const float vv = vvn;
            if (t + 1 < 64) { const LAS float* sp = stage + (t + 1) * 352 + kq * 4; kkn = *(const LAS f32x4*)(sp); bbn = *(const LAS f32x4*)(sp + 64); wwn = *(const LAS f32x4*)(sp + 128); k2n = *(const LAS f32x4*)(sp + 192); rrn = *(const LAS f32x4*)(sp + 256); vvn = stage[(t + 1) * 352 + 320 + row]; }
            float sa = (S.x * kk.x + S.y * kk.y) + (S.z * kk.z + S.w * kk.w);
            sa = row16_sum(sa);
            S = S * ww - sa * bb + vv * k2;
            float o = (S.x * rr.x + S.y * rr.y) + (S.z * rr.z + S.w * rr.w);
            o = row16_sum(o);
            if ((t & 15) == kq) { if (t < 16) o0 = o; else if (t < 32) o1 = o; else if (t < 48) o2 = o; else o3 = o; }
        }
        obuf[kq * 32 + row] = o0; obuf[(16 + kq) * 32 + row] = o1; obuf[(32 + kq) * 32 + row] = o2; obuf[(48 + kq) * 32 + row] = o3;
        __syncthreads();
        for (int i = tid; i < 1024; i += NTHREADS) *(unsigned*)(rout + (mb + ch * 64 + (i >> 4)) * 1024 + h * 64 + half * 32 + (i & 15) * 2) = pk2(obuf[i * 2], obuf[i * 2 + 1]);
    }
    *(f32x4*)(ctx_out(lds) + O_PWKV + ((size_t)((l * 4 + b) * 16 + h) * 64 + half * 32 + row) * 64 + kq * 4) = S;
    __syncthreads();
}
__device__ __forceinline__ void scan_mlstm(LAS unsigned char* lds, int l, int u) {
    const int tid = opaque_tid(), lane = tid & 63, wave = tid >> 6, lr = lane & 15, lq = lane >> 4;
    const int bh = u >> 2, sl = u & 3, b = bh >> 2, h = bh & 3;
    const bf16_t* proj = (const bf16_t*)(ctx_ws(lds) + WS_PROJ); const bf16_t* qm = (const bf16_t*)(ctx_ws(lds) + WS_QM); const bf16_t* km = (const bf16_t*)(ctx_ws(lds) + WS_KM);
    const float* gates = (const float*)(ctx_ws(lds) + WS_GATES); bf16_t* hm = (bf16_t*)(ctx_ws(lds) + WS_HM);
    LAS bf16_t* kS = (LAS bf16_t*)lds;
    LAS bf16_t* kwT = (LAS bf16_t*)(lds + 33792);
    LAS bf16_t* vT = (LAS bf16_t*)(lds + 33792 + 36864);
    LAS bf16_t* Sp = (LAS bf16_t*)(lds + 33792 + 36864 + 11520);
    LAS bf16_t* CT = (LAS bf16_t*)(lds + 33792 + 36864 + 11520 + 9216);
    LAS float* gF = (LAS float*)(lds + 33792 + 36864 + 11520 + 9216 + 42240);
    LAS float* gU = gF + 64; LAS float* gM = gF + 128; LAS float* gS = gF + 192; LAS float* gD = gF + 196;
    __syncthreads();
    for (int i = tid; i < 80 * 264 / 2; i += NTHREADS) ((LAS unsigned*)CT)[i] = 0u;
    for (int i = tid; i < 16 * 72; i += NTHREADS) vT[64 * 72 + i] = (i < 72) ? (bf16_t)0x3F80 : (bf16_t)0;
    f32x4 acc[2][5];
#pragma unroll
    for (int i = 0; i < 2; ++i)
#pragma unroll
        for (int j = 0; j < 5; ++j) acc[i][j] = (f32x4){0.f, 0.f, 0.f, 0.f};
    float m_prev = 0.f;
    const int tt = wave >> 1, wodd = wave & 1, s = tid & 63, eg = tid >> 6;
    const size_t mb = (size_t)b * 2048;
    u32x4 pv = *(const u32x4*)(proj + (mb + s) * NINP + M0 + 2048 + h * 256 + sl * 64 + eg * 8);
    u32x4 pk[4];
#pragma unroll
    for (int j = 0; j < 4; ++j) pk[j] = *(const u32x4*)(km + (mb + s) * 1024 + h * 256 + (eg + 8 * j) * 8);
    bf16x8 qf[8];
#pragma unroll
    for (int ks = 0; ks < 8; ++ks) qf[ks] = *(const bf16x8*)(qm + (mb + tt * 16 + lr) * 1024 + h * 256 + ks * 32 + lq * 8);
    float pig = gates[(mb + lane) * 8 + h], plf = gates[(mb + lane) * 8 + 4 + h];
    for (int c = 0; c < 32; ++c) {
        const size_t m0 = mb + c * 64;
        if (wave == 0) {
            float F = plf;
#pragma unroll
            for (int o = 1; o < 64; o <<= 1) { const float t = __shfl_up(F, o); if (lane >= o) F += t; }
            const float uu = pig - F; float am = uu;
#pragma unroll
            for (int o = 1; o < 64; o <<= 1) { const float t = __shfl_up(am, o); if (lane >= o) am = fmaxf(am, t); }
            const float Mt = fmaxf(m_prev, am);
            gF[lane] = F; gU[lane] = uu; gM[lane] = Mt;
            if (lane == 63) { gS[0] = __expf(m_prev - Mt); gS[1] = Mt; gS[2] = F + Mt; }
        }
        { vT[(eg * 8 + 0) * 72 + s] = (bf16_t)(pv.x & 0xffffu); vT[(eg * 8 + 1) * 72 + s] = (bf16_t)(pv.x >> 16); vT[(eg * 8 + 2) * 72 + s] = (bf16_t)(pv.y & 0xffffu); vT[(eg * 8 + 3) * 72 + s] = (bf16_t)(pv.y >> 16);
          vT[(eg * 8 + 4) * 72 + s] = (bf16_t)(pv.z & 0xffffu); vT[(eg * 8 + 5) * 72 + s] = (bf16_t)(pv.z >> 16); vT[(eg * 8 + 6) * 72 + s] = (bf16_t)(pv.w & 0xffffu); vT[(eg * 8 + 7) * 72 + s] = (bf16_t)(pv.w >> 16);
#pragma unroll
          for (int j = 0; j < 4; ++j) *(LAS u32x4*)(kS + s * 264 + (eg + 8 * j) * 8) = pk[j]; }
        __syncthreads();
        const float a_c = gS[0], ML = gS[1], m_new = gS[2];
        { const float ws = __expf(gU[s] - ML);
#pragma unroll
          for (int j = 0; j < 4; ++j) { const int d0 = (eg + 8 * j) * 8; float k[8]; unpack8(pk[j], k);
#pragma unroll
              for (int i = 0; i < 8; ++i) kwT[(d0 + i) * 72 + s] = f2bf(k[i] * ws); } }
        const size_t m1 = mb + (size_t)(c + 1 < 32 ? c + 1 : 31) * 64;
        pig = gates[(m1 + lane) * 8 + h]; plf = gates[(m1 + lane) * 8 + 4 + h];
        pv = *(const u32x4*)(proj + (m1 + s) * NINP + M0 + 2048 + h * 256 + sl * 64 + eg * 8);
#pragma unroll
        for (int j = 0; j < 4; ++j) pk[j] = *(const u32x4*)(km + (m1 + s) * 1024 + h * 256 + (eg + 8 * j) * 8);
#pragma unroll
        for (int q = 0; q < 2; ++q) { const int ts = 2 * wodd + q;
            f32x4 sacc = {0.f, 0.f, 0.f, 0.f};
            if (ts <= tt) {
#pragma unroll
                for (int ks = 0; ks < 8; ++ks) { const bf16x8 kf = *(const LAS bf16x8*)(kS + (ts * 16 + lr) * 264 + ks * 32 + lq * 8); sacc = MFMA16(qf[ks], kf, sacc); }
            }
            const int sc = ts * 16 + lr; const float us = gU[sc];
#pragma unroll
            for (int r = 0; r < 4; ++r) { const int t = tt * 16 + lq * 4 + r; const float v = (sc <= t) ? sacc[r] * __expf(us - gM[t]) : 0.f; Sp[t * 72 + sc] = f2bf(v); }
        }
        __syncthreads();
        f32x4 hn[3];
#pragma unroll
        for (int q = 0; q < 3; ++q) { const int te = wodd ? 3 + q : q; hn[q] = (f32x4){0.f, 0.f, 0.f, 0.f}; if (te < 5) {
            f32x4 aq = {0.f, 0.f, 0.f, 0.f}, as = {0.f, 0.f, 0.f, 0.f};
#pragma unroll
            for (int ks = 0; ks < 8; ++ks) { const bf16x8 cf = *(const LAS bf16x8*)(CT + (te * 16 + lr) * 264 + ks * 32 + lq * 8); aq = MFMA16(qf[ks], cf, aq); }
#pragma unroll
            for (int ks = 0; ks < 2; ++ks) { const bf16x8 sf = *(const LAS bf16x8*)(Sp + (tt * 16 + lr) * 72 + ks * 32 + lq * 8); const bf16x8 vf = *(const LAS bf16x8*)(vT + (te * 16 + lr) * 72 + ks * 32 + lq * 8); as = MFMA16(sf, vf, as); }
#pragma unroll
            for (int r = 0; r < 4; ++r) { const int t = tt * 16 + lq * 4 + r; hn[q][r] = __expf(m_prev - gM[t]) * aq[r] + as[r]; }
            if (te == 4 && lr == 0) {
#pragma unroll
                for (int r = 0; r < 4; ++r) gD[tt * 16 + lq * 4 + r] = hn[q][r]; }
        } }
#pragma unroll
        for (int ks = 0; ks < 8; ++ks) qf[ks] = *(const bf16x8*)(qm + (m1 + tt * 16 + lr) * 1024 + h * 256 + ks * 32 + lq * 8);
#pragma unroll
        for (int i = 0; i < 2; ++i) { const int dt = wave * 2 + i;
            bf16x8 kf[2];
#pragma unroll
            for (int ks = 0; ks < 2; ++ks) kf[ks] = *(const LAS bf16x8*)(kwT + (dt * 16 + lr) * 72 + ks * 32 + lq * 8);
#pragma unroll
            for (int et = 0; et < 5; ++et) { acc[i][et] = acc[i][et] * a_c;
#pragma unroll
                for (int ks = 0; ks < 2; ++ks) { const bf16x8 vf = *(const LAS bf16x8*)(vT + (et * 16 + lr) * 72 + ks * 32 + lq * 8); acc[i][et] = MFMA16(kf[ks], vf, acc[i][et]); } } }
        __syncthreads();
#pragma unroll
        for (int i = 0; i < 2; ++i) { const int dt = wave * 2 + i;
#pragma unroll
            for (int et = 0; et < 5; ++et) { u32x2 w; w.x = pk2(acc[i][et][0], acc[i][et][1]); w.y = pk2(acc[i][et][2], acc[i][et][3]);
                *(LAS u32x2*)(CT + (et * 16 + lr) * 264 + dt * 16 + lq * 4) = w; } }
        { float dd[4];
#pragma unroll
          for (int r = 0; r < 4; ++r) { const int t = tt * 16 + lq * 4 + r; dd[r] = 1.f / fmaxf(fabsf(gD[t]), __expf(-(gF[t] + gM[t]))); }
#pragma unroll
          for (int q = 0; q < 3; ++q) { const int te = wodd ? 3 + q : q; if (te < 4) {
#pragma unroll
              for (int r = 0; r < 4; ++r) hm[(m0 + tt * 16 + lq * 4 + r) * 1024 + h * 256 + sl * 64 + te * 16 + lr] = f2bf(hn[q][r] * dd[r]); } } }
        m_prev = m_new;
        __syncthreads();
    }
#pragma unroll
    for (int i = 0; i < 2; ++i) { const int dt = wave * 2 + i;
#pragma unroll
        for (int et = 0; et < 5; ++et)
#pragma unroll
            for (int r = 0; r < 4; ++r) { const int d = dt * 16 + lq * 4 + r;
                if (et < 4) ctx_out(lds)[O_PC + ((size_t)((l * 4 + b) * 4 + h) * 256 + d) * 256 + sl * 64 + et * 16 + lr] = acc[i][et][r];
                else if (sl == 0 && lr == 0) ctx_out(lds)[O_PN + (size_t)((l * 4 + b) * 4 + h) * 256 + d] = acc[i][et][r]; } }
    if (sl == 0 && tid == 0) ctx_out(lds)[O_PM + (l * 4 + b) * 4 + h] = m_prev;
    __syncthreads();
}
__device__ __forceinline__ void scan_gla(LAS unsigned char* lds, int l, int u) {
    const int tid = opaque_tid(), lane = tid & 63, wave = tid >> 6, lr = lane & 15, lq = lane >> 4;
    const int bh = u >> 2, sl = u & 3, b = bh >> 2, h = bh & 3;
    const bf16_t* proj = (const bf16_t*)(ctx_ws(lds) + WS_PROJ); const bf16_t* gq = (const bf16_t*)(ctx_ws(lds) + WS_GQ); const bf16_t* gk = (const bf16_t*)(ctx_ws(lds) + WS_GK); const bf16_t* gkh = (const bf16_t*)(ctx_ws(lds) + WS_GKH);
    const float* egl = (const float*)(ctx_ws(lds) + WS_EGL); bf16_t* og = (bf16_t*)(ctx_ws(lds) + WS_OG);
    LAS bf16_t* khT = (LAS bf16_t*)lds;
    LAS bf16_t* vT = (LAS bf16_t*)(lds + 18432);
    LAS bf16_t* Ap = (LAS bf16_t*)(lds + 18432 + 9216);
    LAS bf16_t* ST = (LAS bf16_t*)(lds + 36864);
    LAS bf16_t* kS = (LAS bf16_t*)(lds + 36864 + 17408);
    __syncthreads();
    for (int i = tid; i < 64 * 136 / 2; i += NTHREADS) ((LAS unsigned*)ST)[i] = 0u;
    f32x4 acc[4];
#pragma unroll
    for (int j = 0; j < 4; ++j) acc[j] = (f32x4){0.f, 0.f, 0.f, 0.f};
    const int tt = wave >> 1, wodd = wave & 1, s = tid & 63, eg = tid >> 6;
    const size_t mb = (size_t)b * 2048;
    u32x4 pv = *(const u32x4*)(proj + (mb + s) * NINP + G0 + 1024 + h * 256 + sl * 64 + eg * 8);
    u32x4 pkh[2], pgk[2];
#pragma unroll
    for (int j = 0; j < 2; ++j) { pkh[j] = *(const u32x4*)(gkh + (mb + s) * 512 + h * 128 + (eg + 8 * j) * 8); pgk[j] = *(const u32x4*)(gk + (mb + s) * 512 + h * 128 + (eg + 8 * j) * 8); }
    bf16x8 qf[4];
#pragma unroll
    for (int ks = 0; ks < 4; ++ks) qf[ks] = *(const bf16x8*)(gq + (mb + tt * 16 + lr) * 512 + h * 128 + ks * 32 + lq * 8);
    float eg4[4];
#pragma unroll
    for (int r = 0; r < 4; ++r) eg4[r] = egl[(size_t)(b * 32) * 512 + h * 128 + wave * 16 + lq * 4 + r];
    for (int c = 0; c < 32; ++c) {
        const int cidx = b * 32 + c; const size_t m0 = (size_t)cidx * 64;
        { vT[(eg * 8 + 0) * 72 + s] = (bf16_t)(pv.x & 0xffffu); vT[(eg * 8 + 1) * 72 + s] = (bf16_t)(pv.x >> 16); vT[(eg * 8 + 2) * 72 + s] = (bf16_t)(pv.y & 0xffffu); vT[(eg * 8 + 3) * 72 + s] = (bf16_t)(pv.y >> 16);
          vT[(eg * 8 + 4) * 72 + s] = (bf16_t)(pv.z & 0xffffu); vT[(eg * 8 + 5) * 72 + s] = (bf16_t)(pv.z >> 16); vT[(eg * 8 + 6) * 72 + s] = (bf16_t)(pv.w & 0xffffu); vT[(eg * 8 + 7) * 72 + s] = (bf16_t)(pv.w >> 16);
#pragma unroll
          for (int j = 0; j < 2; ++j) { const int d0 = (eg + 8 * j) * 8; const u32x4 w = pkh[j];
              khT[(d0 + 0) * 72 + s] = (bf16_t)(w.x & 0xffffu); khT[(d0 + 1) * 72 + s] = (bf16_t)(w.x >> 16); khT[(d0 + 2) * 72 + s] = (bf16_t)(w.y & 0xffffu); khT[(d0 + 3) * 72 + s] = (bf16_t)(w.y >> 16);
              khT[(d0 + 4) * 72 + s] = (bf16_t)(w.z & 0xffffu); khT[(d0 + 5) * 72 + s] = (bf16_t)(w.z >> 16); khT[(d0 + 6) * 72 + s] = (bf16_t)(w.w & 0xffffu); khT[(d0 + 7) * 72 + s] = (bf16_t)(w.w >> 16);
              *(LAS u32x4*)(kS + s * 136 + d0) = pgk[j]; } }
        __syncthreads();
        const float e0 = eg4[0], e1 = eg4[1], e2 = eg4[2], e3 = eg4[3];
        const int cn = c + 1 < 32 ? cidx + 1 : cidx; const size_t m1 = (size_t)cn * 64;
        pv = *(const u32x4*)(proj + (m1 + s) * NINP + G0 + 1024 + h * 256 + sl * 64 + eg * 8);
#pragma unroll
        for (int j = 0; j < 2; ++j) { pkh[j] = *(const u32x4*)(gkh + (m1 + s) * 512 + h * 128 + (eg + 8 * j) * 8); pgk[j] = *(const u32x4*)(gk + (m1 + s) * 512 + h * 128 + (eg + 8 * j) * 8); }
#pragma unroll
        for (int r = 0; r < 4; ++r) eg4[r] = egl[(size_t)cn * 512 + h * 128 + wave * 16 + lq * 4 + r];
#pragma unroll
        for (int q = 0; q < 2; ++q) { const int ts = 2 * wodd + q;
            f32x4 sacc = {0.f, 0.f, 0.f, 0.f};
            if (ts <= tt) {
#pragma unroll
                for (int ks = 0; ks < 4; ++ks) { const bf16x8 kf = *(const LAS bf16x8*)(kS + (ts * 16 + lr) * 136 + ks * 32 + lq * 8); sacc = MFMA16(qf[ks], kf, sacc); }
            }
            const int sc = ts * 16 + lr;
#pragma unroll
            for (int r = 0; r < 4; ++r) { const int t = tt * 16 + lq * 4 + r; Ap[t * 72 + sc] = f2bf((sc <= t) ? sacc[r] : 0.f); }
        }
        __syncthreads();
#pragma unroll
        for (int q = 0; q < 2; ++q) { const int te = 2 * wodd + q;
            f32x4 ao = {0.f, 0.f, 0.f, 0.f};
#pragma unroll
            for (int ks = 0; ks < 4; ++ks) { const bf16x8 sf = *(const LAS bf16x8*)(ST + (te * 16 + lr) * 136 + ks * 32 + lq * 8); ao = MFMA16(qf[ks], sf, ao); }
#pragma unroll
            for (int ks = 0; ks < 2; ++ks) { const bf16x8 af = *(const LAS bf16x8*)(Ap + (tt * 16 + lr) * 72 + ks * 32 + lq * 8); const bf16x8 vf = *(const LAS bf16x8*)(vT + (te * 16 + lr) * 72 + ks * 32 + lq * 8); ao = MFMA16(af, vf, ao); }
#pragma unroll
            for (int r = 0; r < 4; ++r) og[(m0 + tt * 16 + lq * 4 + r) * 1024 + h * 256 + sl * 64 + te * 16 + lr] = f2bf(ao[r]);
        }
#pragma unroll
        for (int ks = 0; ks < 4; ++ks) qf[ks] = *(const bf16x8*)(gq + (m1 + tt * 16 + lr) * 512 + h * 128 + ks * 32 + lq * 8);
        { const int dt = wave;
          bf16x8 kf[2];
#pragma unroll
          for (int ks = 0; ks < 2; ++ks) kf[ks] = *(const LAS bf16x8*)(khT + (dt * 16 + lr) * 72 + ks * 32 + lq * 8);
#pragma unroll
          for (int et = 0; et < 4; ++et) {
              acc[et][0] *= e0; acc[et][1] *= e1; acc[et][2] *= e2; acc[et][3] *= e3;
#pragma unroll
              for (int ks = 0; ks < 2; ++ks) { const bf16x8 vf = *(const LAS bf16x8*)(vT + (et * 16 + lr) * 72 + ks * 32 + lq * 8); acc[et] = MFMA16(kf[ks], vf, acc[et]); } } }
        __syncthreads();
#pragma unroll
        for (int et = 0; et < 4; ++et) { u32x2 w; w.x = pk2(acc[et][0], acc[et][1]); w.y = pk2(acc[et][2], acc[et][3]);
            *(LAS u32x2*)(ST + (et * 16 + lr) * 136 + wave * 16 + lq * 4) = w; }
        __syncthreads();
    }
#pragma unroll
    for (int et = 0; et < 4; ++et)
#pragma unroll
        for (int r = 0; r < 4; ++r) ctx_out(lds)[O_PGLA + ((size_t)((l * 4 + b) * 4 + h) * 128 + wave * 16 + lq * 4 + r) * 256 + sl * 64 + et * 16 + lr] = acc[et][r];
    __syncthreads();
}
__device__ __forceinline__ void samp_rwkv(LAS unsigned char* lds, int l, int u) {
    const int tid = opaque_tid(), s = u >> 3, h = (u & 7) * 2 + (tid >> 8), row = (tid & 255) >> 2, kq = tid & 3;
    const float* rpre = (const float*)(ctx_ws(lds) + WS_RPRE); bf16_t* rout = (bf16_t*)(ctx_ws(lds) + WS_ROUT);
    const size_t m = MP + s, po = m * 1024 + h * 64 + kq * 16;
    const size_t so = ((size_t)((l * 128 + s) * 16 + h) * 64 + row) * 64 + kq * 16;
    const float* sp = ctx_in(lds, I_SWKV) + so;
    f32x4 S[4], kk[4], bb[4], ww[4], k2[4], rr[4];
    const bf16_t* rb = (const bf16_t*)rpre; const float* rw = (const float*)((const unsigned char*)rpre + RP_W);
    { float t0[16], t1[16], t2[16], t3[16];
      ld16b(rb + po, t0); ld16b(rb + ARR + po, t1); ld16b(rb + 2 * ARR + po, t2); ld16b(rb + 3 * ARR + po, t3);
#pragma unroll
      for (int j = 0; j < 4; ++j) { S[j] = *(const f32x4*)(sp + j * 4); ww[j] = *(const f32x4*)(rw + po + j * 4);
          kk[j] = (f32x4){t0[4 * j], t0[4 * j + 1], t0[4 * j + 2], t0[4 * j + 3]}; bb[j] = (f32x4){t1[4 * j], t1[4 * j + 1], t1[4 * j + 2], t1[4 * j + 3]};
          k2[j] = (f32x4){t2[4 * j], t2[4 * j + 1], t2[4 * j + 2], t2[4 * j + 3]}; rr[j] = (f32x4){t3[4 * j], t3[4 * j + 1], t3[4 * j + 2], t3[4 * j + 3]}; } }
    const float vv = bf2f(rb[4 * ARR + m * 1024 + h * 64 + row]);
    float sa = 0.f;
#pragma unroll
    for (int j = 0; j < 4; ++j) sa += (S[j].x * kk[j].x + S[j].y * kk[j].y) + (S[j].z * kk[j].z + S[j].w * kk[j].w);
    sa = quad_sum(sa);
    float o = 0.f;
#pragma unroll
    for (int j = 0; j < 4; ++j) { S[j] = S[j] * ww[j] - sa * bb[j] + vv * k2[j]; o += (S[j].x * rr[j].x + S[j].y * rr[j].y) + (S[j].z * rr[j].z + S[j].w * rr[j].w);
        *(f32x4*)(ctx_out(lds) + O_SWKV + so + j * 4) = S[j]; }
    o = quad_sum(o);
    if (kq == 0) rout[m * 1024 + h * 64 + row] = f2bf(o);
}
__device__ __forceinline__ float block_sum2(LAS float* red, float v, int tid) {
    v = wave_sum(v);
    __syncthreads();
    if ((tid & 63) == 0) red[tid >> 6] = v;
    __syncthreads();
    return ((red[0] + red[1]) + (red[2] + red[3])) + ((red[4] + red[5]) + (red[6] + red[7]));
}
__device__ __forceinline__ void samp_mlstm(LAS unsigned char* lds, int l, int u) {
    const int tid = opaque_tid(), s = u >> 2, h = u & 3;
    const bf16_t* proj = (const bf16_t*)(ctx_ws(lds) + WS_PROJ); const bf16_t* qm = (const bf16_t*)(ctx_ws(lds) + WS_QM); const bf16_t* km = (const bf16_t*)(ctx_ws(lds) + WS_KM);
    const float* gates = (const float*)(ctx_ws(lds) + WS_GATES); bf16_t* hm = (bf16_t*)(ctx_ws(lds) + WS_HM);
    LAS float* qs = (LAS float*)lds; LAS float* ks = qs + 256; LAS float* red = ks + 256; LAS float* rs = red + 8 * 256;
    const size_t m = MP + s; const size_t sb = (size_t)(l * 128 + s) * 4 + h;
    __syncthreads();
    float pq = 0.f, pn = 0.f;
    if (tid < 256) { const float q = bf2f(qm[m * 1024 + h * 256 + tid]), k = bf2f(km[m * 1024 + h * 256 + tid]); qs[tid] = q; ks[tid] = k; pq = q * k; pn = q * ctx_in(lds, I_SN)[sb * 256 + tid]; }
    const float qk = block_sum2(rs, pq, tid);
    const float qn = block_sum2(rs + 8, pn, tid);
    const float ig = gates[m * 8 + h], lf = gates[m * 8 + 4 + h], m_prev = ctx_in(lds, I_SM)[sb];
    const float uu = ig - lf, Mx = fmaxf(m_prev, uu), m_t = lf + Mx, w_inter = __expf(m_prev - Mx), ws = __expf(uu - Mx), Sv = qk * ws;
    const int eg = tid & 63, dp = tid >> 6;
    const u32x2 vw = *(const u32x2*)(proj + m * NINP + M0 + 2048 + h * 256 + eg * 4);
    const f32x4 v4 = {__uint_as_float(vw.x << 16), __uint_as_float(vw.x & 0xffff0000u), __uint_as_float(vw.y << 16), __uint_as_float(vw.y & 0xffff0000u)};
    f32x4 num = {0.f, 0.f, 0.f, 0.f};
    const float* Cs = ctx_in(lds, I_SC) + sb * 65536 + eg * 4; float* Co = ctx_out(lds) + O_SC + sb * 65536 + eg * 4;
#pragma unroll 8
    for (int i = 0; i < 32; ++i) { const int d = dp + 8 * i; const f32x4 c4 = *(const f32x4*)(Cs + (size_t)d * 256);
        num = num + qs[d] * c4; *(f32x4*)(Co + (size_t)d * 256) = w_inter * c4 + (ws * ks[d]) * v4; }
    *(LAS f32x4*)(red + dp * 256 + eg * 4) = num;
    __syncthreads();
    if (tid < 256) {
        float nsum = 0.f;
#pragma unroll
        for (int j = 0; j < 8; ++j) nsum += red[j * 256 + tid];
        const float ve = bf2f(proj[m * NINP + M0 + 2048 + h * 256 + tid]);
        const float nm = w_inter * nsum + Sv * ve, den = w_inter * qn + Sv;
        hm[m * 1024 + h * 256 + tid] = f2bf(nm / fmaxf(fabsf(den), __expf(-m_t)));
        ctx_out(lds)[O_SN + sb * 256 + tid] = w_inter * ctx_in(lds, I_SN)[sb * 256 + tid] + ws * ks[tid];
        if (tid == 0) ctx_out(lds)[O_SM + sb] = m_t;
    }
}
__device__ __forceinline__ void samp_gla(LAS unsigned char* lds, int l, int u) {
    const int tid = opaque_tid(), s = u >> 2, h = u & 3;
    const bf16_t* proj = (const bf16_t*)(ctx_ws(lds) + WS_PROJ); const bf16_t* gq = (const bf16_t*)(ctx_ws(lds) + WS_GQ); const bf16_t* gk = (const bf16_t*)(ctx_ws(lds) + WS_GK); const bf16_t* gkh = (const bf16_t*)(ctx_ws(lds) + WS_GKH);
    const float* egl = (const float*)(ctx_ws(lds) + WS_EGL); bf16_t* og = (bf16_t*)(ctx_ws(lds) + WS_OG);
    LAS float* qs = (LAS float*)lds; LAS float* ks = qs + 128; LAS float* es = ks + 128; LAS float* red = es + 128; LAS float* rs = red + 8 * 256;
    const size_t m = MP + s; const size_t sb = (size_t)(l * 128 + s) * 4 + h;
    __syncthreads();
    float pa = 0.f;
    if (tid < 128) { const float q = bf2f(gq[m * 512 + h * 128 + tid]), k = bf2f(gk[m * 512 + h * 128 + tid]); qs[tid] = q; ks[tid] = bf2f(gkh[m * 512 + h * 128 + tid]); es[tid] = egl[(size_t)(128 + s) * 512 + h * 128 + tid]; pa = q * k; }
    const float A = block_sum2(rs, pa, tid);
    const int eg = tid & 63, dp = tid >> 6;
    const u32x2 vw = *(const u32x2*)(proj + m * NINP + G0 + 1024 + h * 256 + eg * 4);
    const f32x4 v4 = {__uint_as_float(vw.x << 16), __uint_as_float(vw.x & 0xffff0000u), __uint_as_float(vw.y << 16), __uint_as_float(vw.y & 0xffff0000u)};
    f32x4 o4 = {0.f, 0.f, 0.f, 0.f};
    const float* Ss = ctx_in(lds, I_SGLA) + sb * 32768 + eg * 4; float* So = ctx_out(lds) + O_SGLA + sb * 32768 + eg * 4;
#pragma unroll 8
    for (int i = 0; i < 16; ++i) { const int d = dp + 8 * i; const f32x4 s4 = *(const f32x4*)(Ss + (size_t)d * 256);
        o4 = o4 + qs[d] * s4; *(f32x4*)(So + (size_t)d * 256) = es[d] * s4 + ks[d] * v4; }
    *(LAS f32x4*)(red + dp * 256 + eg * 4) = o4;
    __syncthreads();
    if (tid < 256) { float osum = 0.f;
#pragma unroll
        for (int j = 0; j < 8; ++j) osum += red[j * 256 + tid];
        og[m * 1024 + h * 256 + tid] = f2bf(osum + A * bf2f(proj[m * NINP + G0 + 1024 + h * 256 + tid])); }
}
__device__ __forceinline__ void phase_scan(LAS unsigned char* lds, int l, int G, unsigned* queue, int rmask) {
    for (int u = blockIdx.x; u < 256; u += G) {
        const int slot = u >> 3, x = u & 7, role = slot & 3, s2 = slot >> 2;
        const int idx = role < 2 ? (s2 * 8 + x) : ((x * 2 + (s2 >> 2)) * 4 + (s2 & 3));
#ifndef SC_MASK
#define SC_MASK 63
#endif
        if (rmask && !((rmask >> (role < 2 ? 0 : role - 1)) & 1)) continue;
        if (role < 2) { if (SC_MASK & 1) scan_rwkv(lds, l, idx * 2 + role); }
        else if (role == 2) { if (SC_MASK & 2) scan_mlstm(lds, l, idx); }
        else { if (SC_MASK & 4) scan_gla(lds, l, idx); }
    }
    LAS unsigned* qw = (LAS unsigned*)(lds + 140000);
    for (;;) {
        __syncthreads();
        if (threadIdx.x == 0) *qw = __hip_atomic_fetch_add(queue, 1u, __ATOMIC_RELAXED, __HIP_MEMORY_SCOPE_AGENT);
        __syncthreads();
        const unsigned u = *qw;
        if (u >= 2048u) break;
        if (u < 512u) { if (SC_MASK & 16) samp_mlstm(lds, l, (int)u); }
        else if (u < 1024u) { if (SC_MASK & 32) samp_gla(lds, l, (int)u - 512); }
        else { if (SC_MASK & 8) samp_rwkv(lds, l, (int)u - 1024); }
    }
}

__device__ __forceinline__ void phase_post(LAS unsigned char* lds, int l, int G) {
    const int tid = opaque_tid(), lane = tid & 63, wave = tid >> 6, c0 = lane * 16;
    const bf16_t* proj = (const bf16_t*)(ctx_ws(lds) + WS_PROJ); const float* rpre = (const float*)(ctx_ws(lds) + WS_RPRE); const bf16_t* rout = (const bf16_t*)(ctx_ws(lds) + WS_ROUT);
    const bf16_t* hm = (const bf16_t*)(ctx_ws(lds) + WS_HM); const bf16_t* og = (const bf16_t*)(ctx_ws(lds) + WS_OG); bf16_t* obr = (bf16_t*)(ctx_ws(lds) + WS_QM);
    for (int it = blockIdx.x * 8 + wave; it < MP + 512; it += G * 8) {
        const int m = it < MP ? it : MP + ((it - MP) >> 2); const int part = it < MP ? -1 : (it - MP) & 3;
        const size_t o = (size_t)m * 1024 + c0;
        const bf16_t* prow = proj + (size_t)m * NINP;
        u32x4 L[30];
#define POST_LD(slot, ptr) do { L[slot] = *(const u32x4*)(ptr); L[(slot) + 1] = *(const u32x4*)((ptr) + 8); } while (0)
        if (part < 0 || part == 0) { POST_LD(0, rout + o); POST_LD(2, (const bf16_t*)rpre + 3 * ARR + o); POST_LD(4, (const bf16_t*)rpre + 2 * ARR + o); POST_LD(6, (const bf16_t*)rpre + 4 * ARR + o); POST_LD(8, (const bf16_t*)rpre + 5 * ARR + o); }
        if (part < 0 || part == 1) { POST_LD(10, hm + o); POST_LD(12, prow + M0 + 3080 + c0); }
        if (part < 0 || part == 2) { POST_LD(14, og + o); POST_LD(16, prow + G0 + 2064 + c0); }
        if (part < 0 || part == 3) {
#pragma unroll
            for (int q = 0; q < 2; ++q)
#pragma unroll
                for (int j = 0; j < 3; ++j) POST_LD(18 + (q * 3 + j) * 2, prow + GT0 + j * 2048 + q * 1024 + c0); }
#undef POST_LD
#define POST_UP(slot, arr) do { unpack8(L[slot], *(float(*)[8])&arr[0]); unpack8(L[(slot) + 1], *(float(*)[8])&arr[8]); } while (0)
        if (part < 0 || part == 0) {
            float x[16], r[16], k2[16], v[16], g[16], rk[16], lg[16], lb[16];
            POST_UP(0, x); POST_UP(2, r); POST_UP(4, k2); POST_UP(6, v); POST_UP(8, g);
            ld16f(ctx_in(lds, I_RK) + l * 1024 + c0, rk); ld16f(ctx_in(lds, I_LNG) + l * 1024 + c0, lg); ld16f(ctx_in(lds, I_LNB) + l * 1024 + c0, lb);
            float s = 0.f, bs = 0.f;
#pragma unroll
            for (int j = 0; j < 16; ++j) { s += x[j]; bs += r[j] * k2[j] * rk[j]; }
            s += __shfl_xor(s, 1); s += __shfl_xor(s, 2); bs += __shfl_xor(bs, 1); bs += __shfl_xor(bs, 2);
            const float mean = s * (1.f / 64.f); float q = 0.f;
#pragma unroll
            for (int j = 0; j < 16; ++j) { const float d = x[j] - mean; q += d * d; }
            q += __shfl_xor(q, 1); q += __shfl_xor(q, 2);
            const float rstd = rsqrtf(q * (1.f / 64.f) + 64e-5f);
            float y[16];
#pragma unroll
            for (int j = 0; j < 16; ++j) y[j] = ((x[j] - mean) * rstd * lg[j] + lb[j] + bs * v[j]) * g[j];
            st16b(obr + (size_t)m * 3072 + c0, y);
        }
        if (part < 0 || part == 1) {
            float x[16], ng[16], go[16];
            POST_UP(10, x); POST_UP(12, go); ld16f(ctx_in(lds, I_MNORM) + l * 1024 + c0, ng);
            float q = 0.f;
#pragma unroll
            for (int j = 0; j < 16; ++j) q += x[j] * x[j];
            q += __shfl_xor(q, 1); q += __shfl_xor(q, 2); q += __shfl_xor(q, 4); q += __shfl_xor(q, 8);
            const float rs = rsqrtf(q * (1.f / 256.f) + 1e-6f);
            float y[16];
#pragma unroll
            for (int j = 0; j < 16; ++j) y[j] = x[j] * rs * ng[j] * sigm(go[j]);
            st16b(obr + (size_t)m * 3072 + 1024 + c0, y);
        }
        if (part < 0 || part == 2) {
            float x[16], ng[16], go[16];
            POST_UP(14, x); POST_UP(16, go); ld16f(ctx_in(lds, I_GNORM) + l * 1024 + c0, ng);
            float q = 0.f;
#pragma unroll
            for (int j = 0; j < 16; ++j) q += x[j] * x[j];
            q += __shfl_xor(q, 1); q += __shfl_xor(q, 2); q += __shfl_xor(q, 4); q += __shfl_xor(q, 8);
            const float rs = rsqrtf(q * (1.f / 256.f) + 1e-6f);
            float y[16];
#pragma unroll
            for (int j = 0; j < 16; ++j) y[j] = x[j] * rs * ng[j] * siluf(go[j]);
            st16b(obr + (size_t)m * 3072 + 2048 + c0, y);
        }
        if (part < 0 || part == 3) {
            bf16_t* gr = (bf16_t*)(ctx_ws(lds) + WS_RPRE + RP_GR) + (size_t)m * 6144; const float* gbv = ctx_in(lds, I_GATEB) + (size_t)l * 3 * 2048;
#pragma unroll
            for (int q = 0; q < 2; ++q) { const int d0 = q * 1024 + c0;
                float e0[16], e1[16], e2[16], gb[16];
                POST_UP(18 + (q * 3 + 0) * 2, e0); POST_UP(18 + (q * 3 + 1) * 2, e1); POST_UP(18 + (q * 3 + 2) * 2, e2);
                ld16f(gbv + d0, gb);
#pragma unroll
                for (int j = 0; j < 16; ++j) e0[j] = 1.f + __expf(-(e0[j] + gb[j]));
                ld16f(gbv + 2048 + d0, gb);
#pragma unroll
                for (int j = 0; j < 16; ++j) e1[j] = 1.f + __expf(-(e1[j] + gb[j]));
                ld16f(gbv + 4096 + d0, gb);
#pragma unroll
                for (int j = 0; j < 16; ++j) { e2[j] = 1.f + __expf(-(e2[j] + gb[j])); const float i0 = __builtin_amdgcn_rcpf(e0[j]), i1 = __builtin_amdgcn_rcpf(e1[j]), i2 = __builtin_amdgcn_rcpf(e2[j]);
                    e0[j] = e1[j] * i0; e1[j] = e2[j] * i1; e2[j] = i2; }
                st16b(gr + d0, e0); st16b(gr + 2048 + d0, e1); st16b(gr + 4096 + d0, e2); }
        }
#undef POST_UP
    }
}

template <int MODE>
__device__ __forceinline__ void skinny_phase(LAS unsigned char* lds, const bf16_t* A, int lda, const bf16_t* Bt, int ldb, int K, float* X, bf16_t* merged, const bf16_t* gr, const float* unused, int G) {
    const int tid = opaque_tid(), lane = tid & 63, wave = tid >> 6, lr = lane & 15, lq = lane >> 4, rt = wave & 3, kh = wave >> 2;
    LAS float* xch = (LAS float*)lds;
    for (int u = blockIdx.x; u < 256; u += G) {
        const int cg = u >> 1, rh = u & 1;
        const bf16_t* ap = A + (size_t)(MP + rh * 64 + rt * 16 + lr) * lda + lq * 8;
        const bf16_t* bp = Bt + (size_t)(cg * 16 + lr) * ldb + lq * 8;
        const int row0 = MP + rh * 64 + rt * 16 + lq * 4, col = cg * 16 + lr;
        constexpr int NJ = MODE == 0 ? 1 : 3;
        const int Kj = MODE == 0 ? K : 1024, Kh = Kj / 2;
        f32x4 acc[NJ];
#pragma unroll
        for (int j = 0; j < NJ; ++j) {
            f32x4 a0c = {0.f, 0.f, 0.f, 0.f}, a1c = {0.f, 0.f, 0.f, 0.f};
            const bf16_t* aj = ap + j * 1024 + kh * Kh; const bf16_t* bj = bp + j * 1024 + kh * Kh;
            bf16x8 av[8], bv[8], an[8], bn[8];
#pragma unroll
            for (int i = 0; i < 8; ++i) { av[i] = *(const bf16x8*)(aj + i * 32); bv[i] = *(const bf16x8*)(bj + i * 32); }
            for (int k0 = 0; k0 < Kh; k0 += 256) {
                const int kn = k0 + 256 < Kh ? k0 + 256 : k0;
#pragma unroll
                for (int i = 0; i < 8; ++i) { an[i] = *(const bf16x8*)(aj + kn + i * 32); bn[i] = *(const bf16x8*)(bj + kn + i * 32); }
#pragma unroll
                for (int i = 0; i < 8; i += 2) { a0c = MFMA16(av[i], bv[i], a0c); a1c = MFMA16(av[i + 1], bv[i + 1], a1c); }
#pragma unroll
                for (int i = 0; i < 8; ++i) { av[i] = an[i]; bv[i] = bn[i]; }
            }
            acc[j] = a0c + a1c;
        }
        __syncthreads();
        if (kh == 1) {
#pragma unroll
            for (int j = 0; j < NJ; ++j) *(LAS f32x4*)(xch + ((j * 4 + rt) * 64 + lane) * 4) = acc[j]; }
        __syncthreads();
        if (kh == 0) {
#pragma unroll
            for (int j = 0; j < NJ; ++j) acc[j] = acc[j] + *(const LAS f32x4*)(xch + ((j * 4 + rt) * 64 + lane) * 4);
            if (MODE == 0) {
#pragma unroll
                for (int r = 0; r < 4; ++r) { float* p = X + (size_t)(row0 + r) * 2048 + col; *p = *p + acc[0][r]; }
            } else {
#pragma unroll
                for (int r = 0; r < 4; ++r) { float o = 0.f;
#pragma unroll
                    for (int j = 0; j < NJ; ++j) o = (o + acc[j][r]) * bf2f(gr[(size_t)(row0 + r) * 6144 + j * 2048 + col]);
                    merged[(size_t)(row0 + r) * 2048 + col] = f2bf(o); }
            }
        }
    }
}

constexpr int N_PHASES = 22;
constexpr int CW_BAR = 1024, CW_QUEUE = 8192;

__global__ void __launch_bounds__(NTHREADS, 2) fwd_kernel(Args a) {
    extern __shared__ __attribute__((aligned(16))) unsigned char lds_raw[];
    LAS unsigned char* lds = (LAS unsigned char*)lds_raw;
    const int tid = opaque_tid(), G = gridDim.x;
    volatile LAS unsigned* misc = (volatile LAS unsigned*)(lds + 147456 - 64);
    if (tid < 16) misc[tid] = 0u;
    if (tid < 39) ((LAS unsigned long long*)(lds + PTAB_OFF))[tid] = ((const unsigned long long*)&a)[tid];
    __syncthreads();
    unsigned* ctl = (unsigned*)(ctx_ws(lds) + WS_CTL);
    XcdBarrier bar; bar.bar = ctl + CW_BAR; bar.x = 0; bar.st = misc;
    if (MK_N_LAUNCHES == 1) bar = xcd_barrier_post(ctl + CW_BAR, misc);
    const int lo = a.ph_lo, hi = a.ph_hi & 0xff, rmask = (a.ph_hi >> 8) & 0xff;
#ifndef PH_MASK
#define PH_MASK 0xFFFu
#endif
#define PHM(b) ((PH_MASK >> (b)) & 1u)
#define IN(k) (lo <= (k) && (k) < hi)
#define SEAM(k) do { if (MK_N_LAUNCHES == 1 && IN(k) && IN((k) + 1)) xcd_barrier(bar); } while (0)
    if (PHM(0) && IN(0)) { phase_prologue(lds, opq(G)); SEAM(0); }
#pragma nounroll
    for (int l = 0; l < 2; ++l) {
        const int pb = 1 + 10 * l;
        if (PHM(1) && IN(pb + 0)) { phase_norm(lds, opq(G), ctx_in(lds, I_NORM1) + opq(l) * 2048, opq(l) == 0); SEAM(pb + 0); }
        if (PHM(2) && IN(pb + 1)) {
            pg8::Gemm g{(const bf16_t*)(ctx_ws(lds) + WS_H), (const bf16_t*)(ctx_ws(lds) + WS_W + (size_t)opq(l) * LW_BYTES + LW_WIN), MPAD, NINP, 2048, 2048, 2048};
            pg8::StaticOrder S; S.init(MPAD, NINP, opq(G), (int)blockIdx.x);
            pg8::EpiProj E{(bf16_t*)(ctx_ws(lds) + WS_PROJ), NINP};
            pg8::gemm_phase(lds, g, S, E);
            SEAM(pb + 1);
        }
        if (PHM(3) && IN(pb + 2)) { phase_pre(lds, opq(l), opq(G)); SEAM(pb + 2); }
        if (PHM(4) && IN(pb + 3)) { phase_scan(lds, opq(l), opq(G), (unsigned*)(ctx_ws(lds) + WS_CTL) + CW_QUEUE + 64 * opq(l), rmask); SEAM(pb + 3); }
        if (PHM(5) && IN(pb + 4)) { phase_post(lds, opq(l), opq(G)); SEAM(pb + 4); }
        if (PHM(6) && IN(pb + 5)) {
            pg8::StaticOrder S; S.init(MP, 2048, opq(G), (int)blockIdx.x);
            const bf16_t* obr = (const bf16_t*)(ctx_ws(lds) + WS_QM); const bf16_t* wbr = (const bf16_t*)(ctx_ws(lds) + WS_W + (size_t)opq(l) * LW_BYTES + LW_WBR);
            bf16_t* merged = (bf16_t*)(ctx_ws(lds) + WS_H); const bf16_t* gr = (const bf16_t*)(ctx_ws(lds) + WS_RPRE + RP_GR);
            { pg8::Gemm g{obr, wbr, MP, 2048, 3072, 3072, 3072}; pg8::EpiBranchK E{merged, gr}; pg8::gemm_phase(lds, g, S, E); }
            skinny_phase<1>(lds, obr, 3072, wbr, 3072, 3072, nullptr, merged, gr, nullptr, opq(G));
            SEAM(pb + 5);
        }
        if (PHM(7) && IN(pb + 6)) {
            pg8::Gemm g{(const bf16_t*)(ctx_ws(lds) + WS_H), (const bf16_t*)(ctx_ws(lds) + WS_W + (size_t)opq(l) * LW_BYTES + LW_WOUT), MP, 2048, 2048, 2048, 2048};
            pg8::StaticOrder S; S.init(MP, 2048, opq(G), (int)blockIdx.x);
            pg8::EpiResid E{(float*)(ctx_ws(lds) + WS_X), 2048};
            pg8::gemm_phase(lds, g, S, E);
            skinny_phase<0>(lds, g.A, 2048, g.Bt, 2048, 2048, (float*)(ctx_ws(lds) + WS_X), nullptr, nullptr, nullptr, opq(G));
            SEAM(pb + 6);
        }
        if (PHM(8) && IN(pb + 7)) { phase_norm(lds, opq(G), ctx_in(lds, I_NORM2) + opq(l) * 2048, false); SEAM(pb + 7); }
        if (PHM(9) && IN(pb + 8)) {
            pg8::Gemm g{(const bf16_t*)(ctx_ws(lds) + WS_H), (const bf16_t*)(ctx_ws(lds) + WS_W + (size_t)opq(l) * LW_BYTES + LW_WGU), MPAD, 11264, 2048, 2048, 2048};
            pg8::StaticOrder S; S.init(MPAD, 11264, opq(G), (int)blockIdx.x);
            pg8::EpiSwiGLU E{(bf16_t*)(ctx_ws(lds) + WS_PROJ), DFF};
            pg8::gemm_phase(lds, g, S, E);
            SEAM(pb + 8);
        }
        if (PHM(10) && IN(pb + 9)) {
            pg8::Gemm g{(const bf16_t*)(ctx_ws(lds) + WS_PROJ), (const bf16_t*)(ctx_ws(lds) + WS_W + (size_t)opq(l) * LW_BYTES + LW_WDN), MP, 2048, DFF, DFF, DFF};
            pg8::StaticOrder S; S.init(MP, 2048, opq(G), (int)blockIdx.x);
            pg8::EpiResid E{(float*)(ctx_ws(lds) + WS_X), 2048};
            pg8::gemm_phase(lds, g, S, E);
            skinny_phase<0>(lds, g.A, DFF, g.Bt, DFF, DFF, (float*)(ctx_ws(lds) + WS_X), nullptr, nullptr, nullptr, opq(G));
            SEAM(pb + 9);
        }
    }
    if (PHM(11) && IN(21)) phase_final(lds, opq(G));
    if (IN(22)) phase_dump(lds, G);
#undef IN
#undef SEAM
}

extern "C" void kernel_launch(void* const* d_in, const int* in_sizes, int n_in, void* d_out, int out_size, void* d_ws, size_t ws_size, hipStream_t stream) {
    static int grid = 0;
    if (grid == 0) {
        if (n_in != 37 || ws_size < WS_END) { fprintf(stderr, "kernel_launch: expected 37 inputs and >= %zu bytes of workspace; got %d, %zu\n", (size_t)WS_END, n_in, ws_size); grid = -1; return; }
        int dev = 0, cus = 0, per_cu = 0;
        if (hipGetDevice(&dev) != hipSuccess || hipDeviceGetAttribute(&cus, hipDeviceAttributeMultiprocessorCount, dev) != hipSuccess) { grid = -1; return; }
        if (hipFuncSetAttribute((const void*)fwd_kernel, hipFuncAttributeMaxDynamicSharedMemorySize, LDS_BYTES) != hipSuccess) { fprintf(stderr, "kernel_launch: hipFuncSetAttribute failed\n"); grid = -1; return; }
        if (hipOccupancyMaxActiveBlocksPerMultiprocessor(&per_cu, (const void*)fwd_kernel, NTHREADS, LDS_BYTES) != hipSuccess || per_cu < 1) { fprintf(stderr, "kernel_launch: occupancy query says %d\n", per_cu); }
        (void)hipGetLastError();
        grid = cus;
    }
    if (grid < 0) return;
    (void)hipMemsetAsync((char*)d_ws + WS_CTL, 0, CTL_BYTES, stream);
    Args a{};
    for (int i = 0; i < 37; ++i) a.in[i] = (const float*)d_in[i];
    a.out = (float*)d_out; a.ws = (unsigned char*)d_ws;
    if (MK_N_LAUNCHES == 1) { a.ph_lo = 0; a.ph_hi = N_PHASES; hipLaunchKernelGGL(fwd_kernel, dim3(grid), dim3(NTHREADS), LDS_BYTES, stream, a); }
    else { for (int p = 0; p < DBG_LIM; ++p) { a.ph_lo = p; a.ph_hi = p + 1; hipLaunchKernelGGL(fwd_kernel, dim3(grid), dim3(NTHREADS), LDS_BYTES, stream, a);
            const int kind = p == 0 ? 0 : (p == 21 ? 11 : 1 + (p - 1) % 10);
            if ((DBG_REP_MASK >> kind) & 1) { a.ph_hi = (p + 1) | (DBG_ROLE_MASK << 8); hipLaunchKernelGGL(fwd_kernel, dim3(grid), dim3(NTHREADS), LDS_BYTES, stream, a); } }
        if (DBG_LIM < 22) { a.ph_lo = 22; a.ph_hi = 23; hipLaunchKernelGGL(fwd_kernel, dim3(grid), dim3(NTHREADS), LDS_BYTES, stream, a); } }
}
```

```cpp
#include <hip/hip_runtime.h>
#include <cstdio>
#include <cstdint>

#ifndef MK_N_LAUNCHES
#define MK_N_LAUNCHES 1
#endif

#ifndef DBG_LIM
#define DBG_LIM 22
#ifndef DBG_ROLE_MASK
#define DBG_ROLE_MASK 0
#endif
#ifndef DBG_REP_MASK
#define DBG_REP_MASK 0
#endif
#define DBG_SEL 2
#endif
#define LAS __attribute__((address_space(3)))
typedef unsigned short bf16_t;
typedef short bf16x8 __attribute__((ext_vector_type(8)));
typedef float f32x4 __attribute__((ext_vector_type(4)));
typedef unsigned u32x4 __attribute__((ext_vector_type(4)));
typedef unsigned u32x2 __attribute__((ext_vector_type(2)));

constexpr int DM = 2048, MP = 8192, MT = 8320, MPAD = 8448, NINP = 16640, NIN = 16600;
constexpr int RC = 3264, M0 = 3264, G0 = 7368, GT0 = 10456, DFF = 5632;
constexpr int NTHREADS = 512;
constexpr size_t O_YP = 0, O_YS = 16777216, O_PSHIFT = 17039360, O_PWKV = 17065472, O_PCONV = 17589760, O_PC = 17638912, O_PN = 19736064, O_PM = 19744256,
                 O_PGLA = 19744288, O_SSHIFT = 20792864, O_SWKV = 21628448, O_SCONV = 38405664, O_SC = 39978528, O_SN = 107087392, O_SM = 107349536, O_SGLA = 107350560;
constexpr size_t AL(size_t x) { return (x + 255) & ~(size_t)255; }
constexpr size_t WS_CTL = 0, CTL_BYTES = 1u << 20;
constexpr size_t LW_WIN = 0, LW_WBR = LW_WIN + (size_t)NINP * 2048 * 2, LW_WOUT = LW_WBR + (size_t)3 * 2048 * 1024 * 2, LW_WGU = LW_WOUT + (size_t)2048 * 2048 * 2,
                 LW_WDN = LW_WGU + (size_t)11264 * 2048 * 2, LW_LORA = LW_WDN + (size_t)2048 * 5632 * 2, LW_GA2 = LW_LORA + (size_t)3 * 1024 * 64 * 2, LW_BYTES = LW_GA2 + (size_t)512 * 32 * 2;
constexpr size_t WS_W = CTL_BYTES;
constexpr size_t WS_X = AL(WS_W + 2 * LW_BYTES);
constexpr size_t WS_H = AL(WS_X + (size_t)MPAD * 2048 * 4);
constexpr size_t WS_PROJ = AL(WS_H + (size_t)MPAD * 2048 * 2);
constexpr size_t ARR = (size_t)MT * 1024;
constexpr size_t WS_RPRE = AL(WS_PROJ + (size_t)MPAD * NINP * 2);
constexpr size_t WS_ROUT = AL(WS_RPRE + 7 * ARR * 4);
constexpr size_t WS_QM = AL(WS_ROUT + ARR * 4);
constexpr size_t WS_KM = WS_QM + ARR * 2, WS_GQ = WS_KM + ARR * 2, WS_GK = WS_GQ + ARR, WS_GKH = WS_GK + ARR;
constexpr size_t WS_GATES = AL(WS_GKH + ARR);
constexpr size_t WS_EGL = AL(WS_GATES + (size_t)MT * 8 * 4);
constexpr size_t WS_HM = AL(WS_EGL + (size_t)256 * 512 * 4);
constexpr size_t WS_OG = AL(WS_HM + ARR * 4);
constexpr size_t WS_END = AL(WS_OG + ARR * 4);
static_assert((size_t)MPAD * 3072 * 2 <= WS_GATES - WS_QM, "obr alias");
static_assert((size_t)MPAD * 2048 * 4 <= 7 * ARR * 4, "macc alias");

__device__ __forceinline__ float bf2f(bf16_t b) { return __uint_as_float(((unsigned)b) << 16); }
typedef __bf16 bf16x2_t __attribute__((ext_vector_type(2)));
typedef float f32x2_t __attribute__((ext_vector_type(2)));
__device__ __forceinline__ unsigned pk2(float lo, float hi) { const f32x2_t v = {lo, hi}; return __builtin_bit_cast(unsigned, __builtin_convertvector(v, bf16x2_t)); }
__device__ __forceinline__ bf16_t f2bf(float f) { return (bf16_t)(pk2(f, 0.f) & 0xffffu); }
__device__ __forceinline__ void unpack8(const u32x4 w, float (&f)[8]) {
    f[0] = __uint_as_float(w.x << 16); f[1] = __uint_as_float(w.x & 0xffff0000u); f[2] = __uint_as_float(w.y << 16); f[3] = __uint_as_float(w.y & 0xffff0000u);
    f[4] = __uint_as_float(w.z << 16); f[5] = __uint_as_float(w.z & 0xffff0000u); f[6] = __uint_as_float(w.w << 16); f[7] = __uint_as_float(w.w & 0xffff0000u);
}
__device__ __forceinline__ u32x4 pack8(const float (&f)[8]) { u32x4 w; w.x = pk2(f[0], f[1]); w.y = pk2(f[2], f[3]); w.z = pk2(f[4], f[5]); w.w = pk2(f[6], f[7]); return w; }
__device__ __forceinline__ void ld8f(const float* p, float (&f)[8]) { const f32x4 a = *(const f32x4*)p, b = *(const f32x4*)(p + 4); f[0] = a.x; f[1] = a.y; f[2] = a.z; f[3] = a.w; f[4] = b.x; f[5] = b.y; f[6] = b.z; f[7] = b.w; }
__device__ __forceinline__ void st8f(float* p, const float (&f)[8]) { *(f32x4*)p = (f32x4){f[0], f[1], f[2], f[3]}; *(f32x4*)(p + 4) = (f32x4){f[4], f[5], f[6], f[7]}; }
__device__ __forceinline__ void ld8b(const bf16_t* p, float (&f)[8]) { unpack8(*(const u32x4*)p, f); }
__device__ __forceinline__ float sigm(float x) { return 1.f / (1.f + __expf(-x)); }
__device__ __forceinline__ float siluf(float x) { return x / (1.f + __expf(-x)); }
__device__ __forceinline__ float tanh_fast(float x) { const float e = __expf(2.f * x); return 1.f - 2.f / (e + 1.f); }
__device__ __forceinline__ float logsig_fast(float x) { return fminf(x, 0.f) - __logf(1.f + __expf(-fabsf(x))); }
__device__ __forceinline__ float wave_sum(float v) {
#pragma unroll
    for (int o = 1; o < 64; o <<= 1) v += __shfl_xor(v, o);
    return v;
}
template <int CTRL> __device__ __forceinline__ float dppf(float v) { return __int_as_float(__builtin_amdgcn_update_dpp(0, __float_as_int(v), CTRL, 0xF, 0xF, true)); }
__device__ __forceinline__ float row16_sum(float x) { x += dppf<0xB1>(x); x += dppf<0x4E>(x); x += dppf<0x141>(x); x += dppf<0x140>(x); return x; }
__device__ __forceinline__ float quad_sum(float x) { x += dppf<0xB1>(x); x += dppf<0x4E>(x); return x; }
__device__ __forceinline__ int opq(int x) { asm volatile("" : "+s"(x)); return x; }
__device__ __forceinline__ int opaque_tid() { int t = threadIdx.x; asm volatile("" : "+v"(t)); return t; }
__device__ __forceinline__ f32x4 mfma16_safe(const bf16x8 a, const bf16x8 b, const f32x4 c) { f32x4 d = __builtin_amdgcn_mfma_f32_16x16x32_bf16(a, b, c, 0, 0, 0); asm volatile("" : "+v"(d) : "v"(a), "v"(b)); return d; }
#define MFMA16(a, b, c) mfma16_safe((a), (b), (c))
#define LDS_WAIT() asm volatile("s_waitcnt lgkmcnt(0)" ::: "memory")

#define XB_TMO      128
#define XB_XCNT(j)  (256  + 64 * (j))
#define XB_XSUB(j)  (1280 + 64 * (j))
#define XB_XGEN(j)  (2304 + 64 * (j))
#define XB_TOP      3328
#define XB_TOPGEN   3392
#define XCD_BAR_WORDS 3456
#define XB_SPIN_CAP (1u << 18)
__device__ __forceinline__ unsigned xb_ld(unsigned* p)              { return __hip_atomic_load(p, __ATOMIC_RELAXED, __HIP_MEMORY_SCOPE_AGENT); }
__device__ __forceinline__ unsigned xb_add(unsigned* p, unsigned v) { return __hip_atomic_fetch_add(p, v, __ATOMIC_RELAXED, __HIP_MEMORY_SCOPE_AGENT); }
__device__ __forceinline__ unsigned xb_xcc_id() { return (unsigned)__builtin_amdgcn_s_getreg((3 << 11) | 20) & 0xFu; }
#define XB_SPIN(cond, bar) do { unsigned _sp = 0; while (cond) { __builtin_amdgcn_s_sleep(1); \
    if ((++_sp & 255u) == 0u) { if (xb_ld(&(bar)[XB_TMO])) break; if (_sp > XB_SPIN_CAP) { atomicAdd(&(bar)[XB_TMO], 1u); break; } } } } while (0)
struct XcdBarrier { unsigned* bar; unsigned x; volatile LAS unsigned* st; };
__device__ __forceinline__ XcdBarrier xcd_barrier_post(unsigned* bar, volatile LAS unsigned* st) {
    XcdBarrier b; b.bar = bar; b.x = xb_xcc_id(); b.st = st;
    if (threadIdx.x == 0) (void)xb_add(&bar[XB_XCNT(b.x)], 1u);
    return b;
}
__device__ __forceinline__ void xcd_barrier_complete(unsigned* bar, unsigned x, unsigned& nloc, unsigned& nx) {
    const unsigned G = gridDim.x * gridDim.y * gridDim.z;
    unsigned sum, cnt, mine, sp = 0u;
    for (;;) {
        sum = 0u; cnt = 0u; mine = 0u;
#pragma unroll
        for (unsigned j = 0; j < 16; ++j) { const unsigned c = xb_ld(&bar[XB_XCNT(j)]); sum += c; cnt += (c > 0u) ? 1u : 0u; mine = (j == x) ? c : mine; }
        if (sum == G) break;
        __builtin_amdgcn_s_sleep(1);
        if ((++sp & 255u) == 0u) { if (xb_ld(&bar[XB_TMO])) break; if (sp > XB_SPIN_CAP) { atomicAdd(&bar[XB_TMO], 1u); break; } }
    }
    nloc = mine > 0u ? mine : 1u; nx = cnt > 0u ? cnt : 1u;
}
__device__ __forceinline__ void xcd_barrier(const XcdBarrier& b) {
    asm volatile("s_waitcnt vmcnt(0)" ::: "memory");
    __syncthreads();
    if (threadIdx.x == 0) {
        unsigned* bar = b.bar;
        __builtin_amdgcn_s_waitcnt(0);
        unsigned nloc = b.st[0], nx = b.st[1];
        if (nloc == 0u) { xcd_barrier_complete(bar, b.x, nloc, nx); b.st[0] = nloc; b.st[1] = nx; }
        const unsigned old = xb_add(&bar[XB_XSUB(b.x)], 1u);
        const unsigned gen = old / nloc;
        if (old + 1u == (gen + 1u) * nloc) {
            __builtin_amdgcn_fence(__ATOMIC_RELEASE, "agent");
            asm volatile("s_waitcnt vmcnt(0)" ::: "memory");
            const unsigned og = xb_add(&bar[XB_TOP], 1u);
            const unsigned tg = og / nx;
            if (og + 1u == (tg + 1u) * nx) xb_add(&bar[XB_TOPGEN], 1u);
            else XB_SPIN(xb_ld(&bar[XB_TOPGEN]) == tg, bar);
            __builtin_amdgcn_fence(__ATOMIC_ACQUIRE, "agent");
            xb_add(&bar[XB_XGEN(b.x)], 1u);
            asm volatile("s_waitcnt vmcnt(0)" ::: "memory");
        } else {
            XB_SPIN(xb_ld(&bar[XB_XGEN(b.x)]) == gen, bar);
            __builtin_amdgcn_fence(__ATOMIC_ACQUIRE, "agent");
            asm volatile("s_waitcnt vmcnt(0)" ::: "memory");
        }
    }
    __syncthreads();
}

namespace pg8 {
constexpr int BM = 256, BK = 64, HALF = 128, HTB = HALF * BK * 2, STAGE_BYTES = 8 * HTB, NXCD = 8, WGM = 8;
__host__ __device__ __forceinline__ int lds_byte(int r, int c) { const int st = (r >> 4) * 2 + (c >> 5), rr = r & 15, cc = c & 31, ob = rr * 64 + cc * 2; return st * 1024 + (ob ^ (((ob >> 9) & 1) << 5)); }
__host__ __device__ __forceinline__ void stage_rc(int b, int& R, int& C) { const int st = b / 1024, sb = b % 1024, swz = sb ^ (((sb >> 9) & 1) << 5); R = (st >> 1) * 16 + swz / 64; C = (st & 1) * 32 + (swz % 64) / 2; }
__host__ __device__ __forceinline__ int perm32(int rho) { const int n = rho >> 4, i = rho & 15; return 8 * (i >> 2) + 4 * n + (i & 3); }
struct Unit { int pm, pn; };
struct Gemm { const bf16_t* A; const bf16_t* Bt; int M, N, K, lda, ldb; };
struct StaticOrder {
    int nM, nN, nwg, G, c;
    __device__ void init(int M, int N, int G_, int c_) { nM = M / BM; nN = N / BM; nwg = nM * nN; G = G_; c = c_; }
    __device__ bool next(int i, Unit& u) const {
        const long L = (long)i * G + c; if (L >= nwg) return false;
        int wgid = (int)L; { const int q = nwg / NXCD, r = nwg % NXCD, xcd = wgid % NXCD, off = wgid / NXCD; wgid = (xcd < r ? xcd * (q + 1) : r * (q + 1) + (xcd - r) * q) + off; }
        const int nig = WGM * nN, gid = wgid / nig, fm = gid * WGM, gsz = (nM - fm) < WGM ? (nM - fm) : WGM;
        u.pm = fm + ((wgid % nig) % gsz); u.pn = (wgid % nig) / gsz; return true;
    }
};
struct EpiProj {
    static constexpr bool PERM = true, HOOK = false;
    bf16_t* O; int ldc;
    __device__ __forceinline__ void operator()(const f32x4 (&acc)[2][2][4][2], const Unit& u, int wr, int wc, int fr, int fq) const {
        const int row0 = u.pm * BM + wr * 64 + fr, col0 = u.pn * BM + wc * 32 + 8 * fq;
#pragma unroll
        for (int ai = 0; ai < 2; ++ai)
#pragma unroll
            for (int m = 0; m < 4; ++m) { bf16_t* rowp = O + (size_t)(row0 + ai * HALF + m * 16) * ldc + col0;
#pragma unroll
                for (int bj = 0; bj < 2; ++bj) { const f32x4 v0 = acc[ai][bj][m][0], v1 = acc[ai][bj][m][1];
                    u32x4 w; w.x = pk2(v0[0], v0[1]); w.y = pk2(v0[2], v0[3]); w.z = pk2(v1[0], v1[1]); w.w = pk2(v1[2], v1[3]);
                    *(u32x4*)(rowp + bj * HALF) = w; } }
    }
};
struct EpiSwiGLU {
    static constexpr bool PERM = true, HOOK = false;
    bf16_t* O; int ldc;
    __device__ __forceinline__ void operator()(const f32x4 (&acc)[2][2][4][2], const Unit& u, int wr, int wc, int fr, int fq) const {
        const int row0 = u.pm * BM + wr * 64 + fr, col0 = u.pn * HALF + wc * 32 + 8 * fq;
#pragma unroll
        for (int ai = 0; ai < 2; ++ai)
#pragma unroll
            for (int m = 0; m < 4; ++m) { bf16_t* rowp = O + (size_t)(row0 + ai * HALF + m * 16) * ldc + col0;
                float o[8];
#pragma unroll
                for (int n = 0; n < 2; ++n)
#pragma unroll
                    for (int j = 0; j < 4; ++j) o[n * 4 + j] = siluf(acc[ai][0][m][n][j]) * acc[ai][1][m][n][j];
                *(u32x4*)rowp = pack8(o); }
    }
};
struct EpiResid {
    static constexpr bool PERM = false, HOOK = false;
    float* X; int ldc;
    __device__ __forceinline__ void operator()(const f32x4 (&acc)[2][2][4][2], const Unit& u, int wr, int wc, int fr, int fq) const {
        const int row0 = u.pm * BM + wr * 64 + fr, col0 = u.pn * BM + wc * 32 + 4 * fq;
#pragma unroll
        for (int ai = 0; ai < 2; ++ai)
#pragma unroll
            for (int m = 0; m < 4; ++m) { float* rowp = X + (size_t)(row0 + ai * HALF + m * 16) * ldc + col0;
#pragma unroll
                for (int bj = 0; bj < 2; ++bj)
#pragma unroll
                    for (int n = 0; n < 2; ++n) { f32x4* p = (f32x4*)(rowp + bj * HALF + n * 16); *p = *p + acc[ai][bj][m][n]; } }
    }
};
struct EpiBranchK {
    static constexpr bool PERM = true, HOOK = true;
    bf16_t* merged; const bf16_t* gr;
    __device__ __forceinline__ void hook(f32x4 (&acc)[2][2][4][2], const Unit& u, int jn, int wr, int wc, int fr, int fq) const {
        int row0 = u.pm * BM + wr * 64 + fr, col0 = u.pn * BM + wc * 32 + 8 * fq;
        asm volatile("" : "+v"(row0), "+v"(col0));
        u32x4 rv[2][4][2];
#pragma unroll
        for (int ai = 0; ai < 2; ++ai)
#pragma unroll
            for (int m = 0; m < 4; ++m)
#pragma unroll
                for (int bj = 0; bj < 2; ++bj) rv[ai][m][bj] = *(const u32x4*)(gr + (size_t)(row0 + ai * HALF + m * 16) * 6144 + (jn - 1) * 2048 + col0 + bj * HALF);
#pragma unroll
        for (int ai = 0; ai < 2; ++ai)
#pragma unroll
            for (int m = 0; m < 4; ++m)
#pragma unroll
                for (int bj = 0; bj < 2; ++bj) { float r[8]; unpack8(rv[ai][m][bj], r);
#pragma unroll
                    for (int i = 0; i < 8; ++i) acc[ai][bj][m][i >> 2][i & 3] *= r[i]; }
    }
    __device__ __forceinline__ void operator()(const f32x4 (&acc)[2][2][4][2], const Unit& u, int wr, int wc, int fr, int fq) const {
        const int row0 = u.pm * BM + wr * 64 + fr, col0 = u.pn * BM + wc * 32 + 8 * fq;
#pragma unroll
        for (int ai = 0; ai < 2; ++ai)
#pragma unroll
            for (int m = 0; m < 4; ++m) { const int row = row0 + ai * HALF + m * 16;
#pragma unroll
                for (int bj = 0; bj < 2; ++bj) { float r[8], o[8]; ld8b(gr + (size_t)row * 6144 + 4096 + col0 + bj * HALF, r);
#pragma unroll
                    for (int i = 0; i < 8; ++i) o[i] = acc[ai][bj][m][i >> 2][i & 3] * r[i];
                    *(u32x4*)(merged + (size_t)row * 2048 + col0 + bj * HALF) = pack8(o); } }
    }
};

template <class Epi>
__device__ __forceinline__ void gemm_phase(LAS unsigned char* lds, const Gemm g, const StaticOrder& S, const Epi& E) {
    const int tid = opaque_tid(), wid = __builtin_amdgcn_readfirstlane(tid >> 6), lane = tid & 63, wr = wid >> 2, wc = wid & 3, fr = lane & 15, fq = lane >> 4;
    const int K = g.K, nt = K / BK;
    unsigned voffA[2], voffB[2];
#pragma unroll
    for (int i = 0; i < 2; ++i) { int R, C; stage_rc(tid * 16 + i * 8192, R, C); const int Rb = Epi::PERM ? ((R & ~31) + perm32(R & 31)) : R;
        voffA[i] = (unsigned)(R * g.lda + C) * 2u; voffB[i] = (unsigned)(Rb * g.ldb + C) * 2u; }
    const size_t kstep = (size_t)(BK * 2);
    const size_t hstepA = (size_t)HALF * g.lda * 2, hstepB = (size_t)HALF * g.ldb * 2;
    const size_t tstepA = 2 * hstepA, tstepB = 2 * hstepB;
    const unsigned ldsw = (unsigned)wid * 1024u;
    const int aoff = lds_byte(wr * 64 + fr, fq * 8), boff = lds_byte(wc * 32 + fr, fq * 8);
#define PG8_SA(b, h) (((b) * 2 + (h)) * HTB)
#define PG8_SB(b, h) ((4 + (b) * 2 + (h)) * HTB)
#define PG8_STAGE(bufoff, gbase, voff) do { _Pragma("unroll") for (int _i = 0; _i < 2; ++_i) \
        __builtin_amdgcn_global_load_lds((const unsigned*)((const char*)(gbase) + (voff)[_i]), (LAS unsigned*)(lds + (bufoff) + ldsw + _i * 8192), 16, 0, 0); } while (0)
#define PG8_LDA(dst, b, h) do { _Pragma("unroll") for (int m = 0; m < 4; ++m) _Pragma("unroll") for (int k = 0; k < 2; ++k) dst[m][k] = *(const LAS bf16x8*)(lds + PG8_SA(b, h) + aoff + m * 2048 + k * 1024); } while (0)
#define PG8_LDB(dst, b, h) do { _Pragma("unroll") for (int n = 0; n < 2; ++n) _Pragma("unroll") for (int k = 0; k < 2; ++k) dst[n][k] = *(const LAS bf16x8*)(lds + PG8_SB(b, h) + boff + n * 2048 + k * 1024); } while (0)
#define PG8_MMA(ai, bj, At, Bt) do { __builtin_amdgcn_s_setprio(1); _Pragma("unroll") for (int m = 0; m < 4; ++m) _Pragma("unroll") for (int n = 0; n < 2; ++n) _Pragma("unroll") for (int k = 0; k < 2; ++k) \
        acc[ai][bj][m][n] = __builtin_amdgcn_mfma_f32_16x16x32_bf16(Bt[n][k], At[m][k], acc[ai][bj][m][n], 0, 0, 0); __builtin_amdgcn_s_setprio(0); } while (0)
#define PG8_WAIT_V(n) asm volatile("s_waitcnt vmcnt(" #n ")" ::: "memory")
#define PG8_WAIT_L(n) asm volatile("s_waitcnt lgkmcnt(" #n ")" ::: "memory")
#define PG8_BAR __builtin_amdgcn_s_barrier()
#define PG8_SCHED __builtin_amdgcn_sched_barrier(0)
    Unit cur, nxt; int ui = 0;
    if (!S.next(0, cur)) return;
    f32x4 acc[2][2][4][2];
#pragma unroll
    for (int a = 0; a < 2; ++a)
#pragma unroll
        for (int b = 0; b < 2; ++b)
#pragma unroll
            for (int m = 0; m < 4; ++m)
#pragma unroll
                for (int n = 0; n < 2; ++n) acc[a][b][m][n] = (f32x4){0.f, 0.f, 0.f, 0.f};
    bf16x8 At[4][2], B0[2][2], B1[2][2];
    const char* cA = (const char*)g.A + (size_t)cur.pm * tstepA; const char* cB = (const char*)g.Bt + (size_t)cur.pn * tstepB;
    PG8_STAGE(PG8_SB(0, 0), cB, voffB); PG8_STAGE(PG8_SA(0, 0), cA, voffA); PG8_STAGE(PG8_SB(0, 1), cB + hstepB, voffB); PG8_STAGE(PG8_SA(0, 1), cA + hstepA, voffA);
    if (wr == 1) PG8_BAR;
    PG8_WAIT_V(4); PG8_BAR;
    PG8_STAGE(PG8_SB(1, 0), cB + kstep, voffB); PG8_STAGE(PG8_SA(1, 0), cA + kstep, voffA); PG8_STAGE(PG8_SB(1, 1), cB + hstepB + kstep, voffB);
    PG8_WAIT_V(6); PG8_BAR;
    for (;;) {
        const bool has_next = S.next(ui + 1, nxt);
        const char* nA = has_next ? (const char*)g.A + (size_t)nxt.pm * tstepA : cA; const char* nB = has_next ? (const char*)g.Bt + (size_t)nxt.pn * tstepB : cB;
        for (int t = 0; t < nt; t += 2) {
            const bool last = (t == nt - 2);
            const char* a1 = cA + (size_t)(t + 1) * kstep;
            const char* a2 = last ? nA : cA + (size_t)(t + 2) * kstep; const char* b2 = last ? nB : cB + (size_t)(t + 2) * kstep;
            const char* a3 = a2 + kstep; const char* b3 = b2 + kstep;
            if constexpr (Epi::HOOK) { if (t == 16 || t == 32) E.hook(acc, cur, t >> 4, wr, wc, fr, fq); }
            PG8_LDB(B0, 0, 0); PG8_SCHED; PG8_LDA(At, 0, 0); PG8_STAGE(PG8_SA(1, 1), a1 + hstepA, voffA);
            PG8_WAIT_L(8); PG8_BAR; PG8_WAIT_L(0); PG8_MMA(0, 0, At, B0); PG8_BAR; PG8_SCHED;
            PG8_LDB(B1, 0, 1); PG8_STAGE(PG8_SB(0, 0), b2, voffB);
            PG8_BAR; PG8_WAIT_L(0); PG8_MMA(0, 1, At, B1); PG8_BAR;
            PG8_LDA(At, 0, 1); PG8_STAGE(PG8_SA(0, 0), a2, voffA);
            PG8_BAR; PG8_WAIT_L(0); PG8_MMA(1, 0, At, B0); PG8_BAR; PG8_SCHED;
            PG8_STAGE(PG8_SB(0, 1), b2 + hstepB, voffB);
            PG8_WAIT_V(6); PG8_BAR; PG8_MMA(1, 1, At, B1); PG8_BAR;
            PG8_LDB(B0, 1, 0); PG8_SCHED; PG8_LDA(At, 1, 0); PG8_STAGE(PG8_SA(0, 1), a2 + hstepA, voffA);
            PG8_WAIT_L(8); PG8_BAR; PG8_WAIT_L(0); PG8_MMA(0, 0, At, B0); PG8_BAR; PG8_SCHED;
            PG8_LDB(B1, 1, 1); PG8_STAGE(PG8_SB(1, 0), b3, voffB);
            PG8_BAR; PG8_WAIT_L(0); PG8_MMA(0, 1, At, B1); PG8_BAR;
            PG8_LDA(At, 1, 1); PG8_STAGE(PG8_SA(1, 0), a3, voffA);
            PG8_BAR; PG8_WAIT_L(0); PG8_MMA(1, 0, At, B0); PG8_BAR; PG8_SCHED;
            PG8_STAGE(PG8_SB(1, 1), b3 + hstepB, voffB);
            PG8_WAIT_V(6); PG8_BAR; PG8_MMA(1, 1, At, B1); PG8_BAR;
        }
        E(acc, cur, wr, wc, fr, fq);
        if (!has_next) break;
#pragma unroll
        for (int a = 0; a < 2; ++a)
#pragma unroll
            for (int b = 0; b < 2; ++b)
#pragma unroll
                for (int m = 0; m < 4; ++m)
#pragma unroll
                    for (int n = 0; n < 2; ++n) acc[a][b][m][n] = (f32x4){0.f, 0.f, 0.f, 0.f};
        cur = nxt; cA = nA; cB = nB; ++ui;
    }
    PG8_WAIT_V(0);
    if (wr == 0) PG8_BAR;
    PG8_BAR;
#undef PG8_SA
#undef PG8_SB
#undef PG8_STAGE
#undef PG8_LDA
#undef PG8_LDB
#undef PG8_MMA
#undef PG8_WAIT_V
#undef PG8_WAIT_L
#undef PG8_BAR
#undef PG8_SCHED
}
}

constexpr size_t RP_W = 6 * ARR * 2, RP_GR = RP_W + ARR * 4;
static_assert(RP_GR + (size_t)MT * 6144 * 2 <= 7 * ARR * 4, "RPRE region");
struct Args { const float* in[37]; float* out; unsigned char* ws; int ph_lo, ph_hi; };
enum { I_XP = 0, I_XS, I_SSHIFT, I_SWKV, I_SCONV, I_SC, I_SN, I_SM, I_SGLA, I_NORM1, I_WIN, I_GATEB, I_MU, I_W0, I_W2, I_A0, I_A2, I_G2, I_KK, I_KA, I_RK, I_LNG, I_LNB,
       I_CONVW, I_CONVB, I_IB, I_FB, I_MNORM, I_GA2, I_GAB, I_GNORM, I_WBR, I_WOUT, I_NORM2, I_WGU, I_WDN, I_FNORM };

constexpr int LDS_BYTES = 147456;
constexpr int PTAB_OFF = LDS_BYTES - 1024;
__device__ __forceinline__ unsigned long long ctx_raw(LAS unsigned char* lds, int i) {
    const unsigned long long v = ((const LAS unsigned long long*)(lds + PTAB_OFF))[i];
    const unsigned lo = __builtin_amdgcn_readfirstlane((unsigned)v), hi = __builtin_amdgcn_readfirstlane((unsigned)(v >> 32));
    return ((unsigned long long)hi << 32) | lo;
}
#define GAS __attribute__((address_space(1)))
__device__ __forceinline__ const float* ctx_in(LAS unsigned char* lds, int i) { return (const float*)(const GAS float*)ctx_raw(lds, i); }
__device__ __forceinline__ float* ctx_out(LAS unsigned char* lds) { return (float*)(GAS float*)ctx_raw(lds, 37); }
__device__ __forceinline__ unsigned char* ctx_ws(LAS unsigned char* lds) { return (unsigned char*)(GAS unsigned char*)ctx_raw(lds, 38); }

__device__ __forceinline__ void tr_item(const float* W, int ldw, int k0, int n0, int nvalid, bf16_t* WT, int K, int drow0, LAS float* scr, int lane, int dk = 0) {
#pragma unroll 8
    for (int i = 0; i < 32; ++i) { const int kk = 2 * i + (lane >> 5), n = lane & 31; scr[kk * 33 + n] = (n < nvalid) ? __builtin_nontemporal_load(W + (size_t)(k0 + kk) * ldw + n0 + n) : 0.f; }
    LDS_WAIT();
    const int c = lane & 7;
#pragma unroll
    for (int j = 0; j < 4; ++j) { const int n = (lane >> 3) + 8 * j; const LAS float* s = scr + (8 * c) * 33 + n;
        u32x4 o; o.x = pk2(s[0 * 33], s[1 * 33]); o.y = pk2(s[2 * 33], s[3 * 33]); o.z = pk2(s[4 * 33], s[5 * 33]); o.w = pk2(s[6 * 33], s[7 * 33]);
        *(u32x4*)(WT + (size_t)(drow0 + n) * K + dk + k0 + 8 * c) = o; }
    LDS_WAIT();
}
__device__ __forceinline__ void phase_prologue(LAS unsigned char* lds, int G) {
    const int tid = opaque_tid(), lane = tid & 63, wave = tid >> 6;
    LAS float* scr = (LAS float*)(lds + wave * 8704);
    const int gw = blockIdx.x * 8 + wave, NGW = G * 8;
    constexpr int I_IN = 32 * 519, I_BR = 3 * 16 * 64, I_OUT = 32 * 64, I_GU = 32 * 352, I_DN = 88 * 64, I_LO = 3 * 32, PER_L = I_IN + I_BR + I_OUT + I_GU + I_DN + I_LO;
    for (int it = gw; it < 2 * PER_L; it += NGW) {
        const int l = it / PER_L; int r = it % PER_L;
        unsigned char* wl = ctx_ws(lds) + WS_W + (size_t)l * LW_BYTES;
        if (r < I_IN) { const int kb = r / 519, nb = r % 519; const int nv = (NIN - nb * 32) < 32 ? (NIN - nb * 32) : 32;
            tr_item(ctx_in(lds, I_WIN) + (size_t)l * 2048 * NIN, NIN, kb * 64, nb * 32, nv, (bf16_t*)(wl + LW_WIN), 2048, nb * 32, scr, lane); continue; }
        r -= I_IN;
        if (r < I_BR) { const int j = r / 1024, q = r % 1024, kb = q / 64, nb = q % 64;
            tr_item(ctx_in(lds, I_WBR) + (size_t)(l * 3 + j) * 1024 * 2048, 2048, kb * 64, nb * 32, 32, (bf16_t*)(wl + LW_WBR), 3072, nb * 32, scr, lane, j * 1024); continue; }
        r -= I_BR;
        if (r < I_OUT) { const int kb = r / 64, nb = r % 64;
            tr_item(ctx_in(lds, I_WOUT) + (size_t)l * 2048 * 2048, 2048, kb * 64, nb * 32, 32, (bf16_t*)(wl + LW_WOUT), 2048, nb * 32, scr, lane); continue; }
        r -= I_OUT;
        if (r < I_GU) { const int kb = r / 352, nb = r % 352; const int n0 = nb * 32; const int np = n0 < DFF ? n0 : n0 - DFF; const int drow = 256 * (np / 128) + (np % 128) + (n0 < DFF ? 0 : 128);
            tr_item(ctx_in(lds, I_WGU) + (size_t)l * 2048 * 11264, 11264, kb * 64, n0, 32, (bf16_t*)(wl + LW_WGU), 2048, drow, scr, lane); continue; }
        r -= I_GU;
        if (r < I_DN) { const int kb = r / 64, nb = r % 64;
            tr_item(ctx_in(lds, I_WDN) + (size_t)l * DFF * 2048, 2048, kb * 64, nb * 32, 32, (bf16_t*)(wl + LW_WDN), DFF, nb * 32, scr, lane); continue; }
        r -= I_DN;
        { const int mat = r / 32, nb = r % 32; const float* src = (mat == 0 ? ctx_in(lds, I_W2) : (mat == 1 ? ctx_in(lds, I_A2) : ctx_in(lds, I_G2))) + (size_t)l * 64 * 1024;
            tr_item(src, 1024, 0, nb * 32, 32, (bf16_t*)(wl + LW_LORA) + (size_t)mat * 1024 * 64, 64, nb * 32, scr, lane); }
    }
    const int gt = blockIdx.x * NTHREADS + tid, NGT = G * NTHREADS;
    for (int i = gt; i < 2 * 32 * 2048 / 8; i += NGT) { const int l = i / (32 * 256), q = i % (32 * 256);
        *(u32x4*)((bf16_t*)(ctx_ws(lds) + WS_W + (size_t)l * LW_BYTES + LW_WIN) + (size_t)16608 * 2048 + (size_t)q * 8) = (u32x4){0u, 0u, 0u, 0u}; }
    for (int i = gt; i < 2 * 512 * 32; i += NGT) { const int l = i / (512 * 32), q = i % (512 * 32), c = q / 32, k = q % 32;
        ((bf16_t*)(ctx_ws(lds) + WS_W + (size_t)l * LW_BYTES + LW_GA2))[q] = k < 16 ? f2bf(ctx_in(lds, I_GA2)[(size_t)l * 16 * 512 + k * 512 + c]) : (bf16_t)0; }
}

__device__ __forceinline__ void phase_norm(LAS unsigned char* lds, int G, const float* gvec, bool from_input) {
    const int tid = opaque_tid(), lane = tid & 63, wave = tid >> 6;
    float* xbuf = (float*)(ctx_ws(lds) + WS_X); bf16_t* hb = (bf16_t*)(ctx_ws(lds) + WS_H);
    for (int m = blockIdx.x * 8 + wave; m < MPAD; m += G * 8) {
        if (m >= MT) { if (from_input) {
#pragma unroll
            for (int j = 0; j < 4; ++j) *(u32x4*)(hb + (size_t)m * 2048 + (lane + 64 * j) * 8) = (u32x4){0u, 0u, 0u, 0u}; } continue; }
        const float* src = from_input ? (m < MP ? ctx_in(lds, I_XP) + (size_t)m * 2048 : ctx_in(lds, I_XS) + (size_t)(m - MP) * 2048) : xbuf + (size_t)m * 2048;
        f32x4 v[8]; float s = 0.f;
#pragma unroll
        for (int j = 0; j < 8; ++j) { v[j] = *(const f32x4*)(src + (lane + 64 * j) * 4); s += (v[j].x * v[j].x + v[j].y * v[j].y) + (v[j].z * v[j].z + v[j].w * v[j].w); }
        const float rs = rsqrtf(wave_sum(s) * (1.f / 2048.f) + 1e-6f);
#pragma unroll
        for (int j = 0; j < 8; ++j) { const int c = (lane + 64 * j) * 4; const f32x4 gg = *(const f32x4*)(gvec + c);
            if (from_input) *(f32x4*)(xbuf + (size_t)m * 2048 + c) = v[j];
            u32x2 w; w.x = pk2(v[j].x * rs * gg.x, v[j].y * rs * gg.y); w.y = pk2(v[j].z * rs * gg.z, v[j].w * rs * gg.w);
            *(u32x2*)(hb + (size_t)m * 2048 + c) = w; }
    }
}
__device__ __forceinline__ void dump_words(const unsigned* src, unsigned* dst, size_t n, int G) {
    for (size_t i = (size_t)blockIdx.x * NTHREADS + threadIdx.x; i < n; i += (size_t)G * NTHREADS) dst[i] = src[i];
}
__device__ __forceinline__ void phase_dump(LAS unsigned char* lds, int G) {
    unsigned char* ws = ctx_ws(lds); unsigned* out = (unsigned*)ctx_out(lds);
    if (DBG_LIM == 5) { if (DBG_SEL == 0) dump_words((const unsigned*)(ws + WS_ROUT), out + O_YP, ARR, G); if (DBG_SEL == 1) dump_words((const unsigned*)(ws + WS_HM), out + O_YP, ARR, G); if (DBG_SEL == 2) { dump_words((const unsigned*)(ws + WS_OG), out + O_YP, ARR, G); dump_words((const unsigned*)(ws + WS_HM), out + O_SC, ARR, G); } if (DBG_SEL == 3) dump_words((const unsigned*)(ws + WS_QM), out + O_YP, ARR, G); if (DBG_SEL == 4) dump_words((const unsigned*)(ws + WS_HM), out + O_YP, (size_t)MP * 1024, G); }
    else if (DBG_LIM == 6) { dump_words((const unsigned*)(ws + WS_QM), out + O_YP, (size_t)MT * 3072 / 2, G); }
    else if (DBG_LIM == 7) { dump_words((const unsigned*)(ws + WS_H), out + O_YP, (size_t)MT * 2048 / 2, G); }
    else { dump_words((const unsigned*)(ws + WS_X), out + O_YP, (size_t)MP * 2048, G); }
}
__device__ __forceinline__ void phase_final(LAS unsigned char* lds, int G) {
    const int tid = opaque_tid(), lane = tid & 63, wave = tid >> 6;
    const float* xbuf = (const float*)(ctx_ws(lds) + WS_X); const float* gvec = ctx_in(lds, I_FNORM);
    for (int m = blockIdx.x * 8 + wave; m < MT; m += G * 8) {
        const float* src = xbuf + (size_t)m * 2048; float* dst = ctx_out(lds) + (m < MP ? O_YP + (size_t)m * 2048 : O_YS + (size_t)(m - MP) * 2048);
        f32x4 v[8]; float s = 0.f;
#pragma unroll
        for (int j = 0; j < 8; ++j) { v[j] = *(const f32x4*)(src + (lane + 64 * j) * 4); s += (v[j].x * v[j].x + v[j].y * v[j].y) + (v[j].z * v[j].z + v[j].w * v[j].w); }
        const float rs = rsqrtf(wave_sum(s) * (1.f / 2048.f) + 1e-6f);
#pragma unroll
        for (int j = 0; j < 8; ++j) { const int c = (lane + 64 * j) * 4; const f32x4 gg = *(const f32x4*)(gvec + c);
            *(f32x4*)(dst + c) = (f32x4){v[j].x * rs * gg.x, v[j].y * rs * gg.y, v[j].z * rs * gg.z, v[j].w * rs * gg.w}; }
    }
}

__device__ __forceinline__ void load_prev8(const bf16_t* proj, const float* shift_l, int m, int col, float (&o)[8]) {
    if (m >= MP) ld8f(shift_l + (size_t)(m - MP) * RC + col, o);
    else if ((m & 2047) == 0) {
#pragma unroll
        for (int i = 0; i < 8; ++i) o[i] = 0.f; }
    else ld8b(proj + (size_t)(m - 1) * NINP + col, o);
}
__device__ __forceinline__ void ld16b(const bf16_t* p, float (&f)[16]) { ld8b(p, *(float(*)[8])&f[0]); ld8b(p + 8, *(float(*)[8])&f[8]); }
__device__ __forceinline__ void ld16f(const float* p, float (&f)[16]) { ld8f(p, *(float(*)[8])&f[0]); ld8f(p + 8, *(float(*)[8])&f[8]); }
__device__ __forceinline__ void st16f(float* p, const float (&f)[16]) { st8f(p, *(const float(*)[8])&f[0]); st8f(p + 8, *(const float(*)[8])&f[8]); }
__device__ __forceinline__ void st16b(bf16_t* p, const float (&f)[16]) { *(u32x4*)p = pack8(*(const float(*)[8])&f[0]); *(u32x4*)(p + 8) = pack8(*(const float(*)[8])&f[8]); }
__device__ __forceinline__ void pre_rwkv_item(LAS unsigned char* lds, int l, int cidx, int tt, int h0, int nh, int wave, int lane) {
    const int lr = lane & 15, lq = lane >> 4;
    const int m0 = cidx * 64 + tt * 16;
    const bf16_t* proj = (const bf16_t*)(ctx_ws(lds) + WS_PROJ);
    const float* shift_l = ctx_in(lds, I_SSHIFT) + (size_t)l * 128 * RC;
    const float* mu = ctx_in(lds, I_MU) + (size_t)l * RC;
    const bf16_t* loraT = (const bf16_t*)(ctx_ws(lds) + WS_W + (size_t)l * LW_BYTES + LW_LORA);
    bf16_t* rb = (bf16_t*)(ctx_ws(lds) + WS_RPRE); float* rw = (float*)(ctx_ws(lds) + WS_RPRE + RP_W);
    LAS bf16_t* loraA = (LAS bf16_t*)(lds + wave * 14336);
    LAS bf16_t* loraO = (LAS bf16_t*)(lds + wave * 14336 + 7168);
    const int tok = lane >> 2, c4 = lane & 3, m = m0 + tok;
    {
#pragma unroll
        for (int i = 0; i < 6; ++i) {
            const int cgp = c4 + 4 * i, col = 3072 + cgp * 8, mat = cgp >> 3, kc = (cgp & 7) * 8;
            float p[8], pv[8], mm[8], x[8];
            ld8b(proj + (size_t)m * NINP + col, p); load_prev8(proj, shift_l, m, col, pv); ld8f(mu + col, mm);
#pragma unroll
            for (int j = 0; j < 8; ++j) { const float xs = p[j] + (pv[j] - p[j]) * mm[j]; x[j] = mat == 0 ? tanh_fast(xs) : (mat == 1 ? xs : sigm(xs)); }
            *(LAS u32x4*)(loraA + (mat * 16 + tok) * 72 + kc) = pack8(x);
        }
    }
    LDS_WAIT();
    const bool samp = m >= MP, first = !samp && ((m & 2047) == 0);
    const bf16_t* prow = proj + (size_t)m * NINP;
    const bf16_t* qrow = proj + (size_t)((samp || first) ? m : m - 1) * NINP;
    const float* srow = shift_l + (size_t)(samp ? m - MP : 0) * RC;
#pragma unroll 1
    for (int hh = 0; hh < nh; ++hh) {
        const int h = h0 + hh, c0 = h * 64 + c4 * 16;
        bf16x8 bfr[3][4][2];
#pragma unroll
        for (int mat = 0; mat < 3; ++mat)
#pragma unroll
            for (int tc = 0; tc < 4; ++tc)
#pragma unroll
                for (int ks = 0; ks < 2; ++ks) bfr[mat][tc][ks] = *(const bf16x8*)(loraT + (size_t)(mat * 1024 + h * 64 + tc * 16 + lr) * 64 + ks * 32 + lq * 8);
        u32x4 pw[3][2], qw[3][2]; f32x4 qs[3][4];
#pragma unroll
        for (int g = 0; g < 3; ++g) { pw[g][0] = *(const u32x4*)(prow + g * 1024 + c0); pw[g][1] = *(const u32x4*)(prow + g * 1024 + c0 + 8);
            if (samp) {
#pragma unroll
                for (int k = 0; k < 4; ++k) qs[g][k] = *(const f32x4*)(srow + g * 1024 + c0 + 4 * k); }
            else { qw[g][0] = *(const u32x4*)(qrow + g * 1024 + c0); qw[g][1] = *(const u32x4*)(qrow + g * 1024 + c0 + 8); } }
#pragma unroll
        for (int mat = 0; mat < 3; ++mat)
#pragma unroll
            for (int tc = 0; tc < 4; ++tc) { f32x4 acc = {0.f, 0.f, 0.f, 0.f};
#pragma unroll
                for (int ks = 0; ks < 2; ++ks) {
                    const bf16x8 av = *(const LAS bf16x8*)(loraA + (mat * 16 + lr) * 72 + ks * 32 + lq * 8);
                    acc = MFMA16(av, bfr[mat][tc][ks], acc); }
#pragma unroll
                for (int r = 0; r < 4; ++r) loraO[(mat * 16 + lq * 4 + r) * 72 + tc * 16 + lr] = f2bf(acc[r]); }
        LDS_WAIT();
        float xr[16], xk[16], xv[16];
#pragma unroll
        for (int g = 0; g < 3; ++g) { float p[16], q[16], mm[16];
            unpack8(pw[g][0], *(float(*)[8])&p[0]); unpack8(pw[g][1], *(float(*)[8])&p[8]); ld16f(mu + g * 1024 + c0, mm);
            if (samp) {
#pragma unroll
                for (int j = 0; j < 16; ++j) q[j] = qs[g][j >> 2][j & 3]; }
            else { unpack8(qw[g][0], *(float(*)[8])&q[0]); unpack8(qw[g][1], *(float(*)[8])&q[8]);
                if (first) {
#pragma unroll
                    for (int j = 0; j < 16; ++j) q[j] = 0.f; } }
#pragma unroll
            for (int j = 0; j < 16; ++j) { const float x = p[j] + (q[j] - p[j]) * mm[j]; if (g == 0) xr[j] = x; else if (g == 1) xk[j] = x; else xv[j] = x; } }
        const size_t o = (size_t)m * 1024 + c0;
        st16b(rb + 3 * ARR + o, xr); st16b(rb + 4 * ARR + o, xv);
        float lw[16], la[16], lg[16];
        { const LAS bf16_t* lo = loraO + tok * 72 + c4 * 16;
          unpack8(*(const LAS u32x4*)(lo), *(float(*)[8])&lw[0]); unpack8(*(const LAS u32x4*)(lo + 8), *(float(*)[8])&lw[8]);
          unpack8(*(const LAS u32x4*)(lo + 16 * 72), *(float(*)[8])&la[0]); unpack8(*(const LAS u32x4*)(lo + 16 * 72 + 8), *(float(*)[8])&la[8]);
          unpack8(*(const LAS u32x4*)(lo + 32 * 72), *(float(*)[8])&lg[0]); unpack8(*(const LAS u32x4*)(lo + 32 * 72 + 8), *(float(*)[8])&lg[8]); }
        st16b(rb + 5 * ARR + o, lg);
        float pa[16], pb[16], kkr[16], av[16]; float ss = 0.f;
        ld16f(ctx_in(lds, I_KK) + l * 1024 + c0, pa); ld16f(ctx_in(lds, I_A0) + l * 1024 + c0, pb);
#pragma unroll
        for (int j = 0; j < 16; ++j) { kkr[j] = xk[j] * pa[j]; ss += kkr[j] * kkr[j]; av[j] = sigm(pb[j] + la[j]); }
        ss = quad_sum(ss);
        const float inv = 1.f / fmaxf(sqrtf(ss), 1e-12f);
#pragma unroll
        for (int j = 0; j < 16; ++j) { kkr[j] *= inv; pa[j] = kkr[j] * av[j]; }
        st16b(rb + 0 * ARR + o, kkr); st16b(rb + 1 * ARR + o, pa);
        ld16f(ctx_in(lds, I_KA) + l * 1024 + c0, pa); ld16f(ctx_in(lds, I_W0) + l * 1024 + c0, pb);
#pragma unroll
        for (int j = 0; j < 16; ++j) { pa[j] = xk[j] * (1.f + (av[j] - 1.f) * pa[j]);
            const float wp = -(pb[j] + lw[j]); const float sp = fmaxf(wp, 0.f) + __logf(1.f + __expf(-fabsf(wp))); pb[j] = __expf(-__expf(-sp - 0.5f)); }
        st16b(rb + 2 * ARR + o, pa); st16f(rw + o, pb);
        LDS_WAIT();
    }
}
__device__ __forceinline__ void pre_mlstm(LAS unsigned char* lds, int l, int cidx, int m0, int ntok) {
    const int tid = opaque_tid();
    const bf16_t* proj = (const bf16_t*)(ctx_ws(lds) + WS_PROJ);
    bf16_t* qm = (bf16_t*)(ctx_ws(lds) + WS_QM); bf16_t* km = (bf16_t*)(ctx_ws(lds) + WS_KM); float* gates = (float*)(ctx_ws(lds) + WS_GATES);
    const int cgp = tid & 255, th = tid >> 8, c0 = cgp * 8;
    float w0[8], w1[8], w2[8], w3[8], cb[8];
    ld8f(ctx_in(lds, I_CONVW) + (size_t)(l * 4 + 0) * 2048 + c0, w0); ld8f(ctx_in(lds, I_CONVW) + (size_t)(l * 4 + 1) * 2048 + c0, w1);
    ld8f(ctx_in(lds, I_CONVW) + (size_t)(l * 4 + 2) * 2048 + c0, w2); ld8f(ctx_in(lds, I_CONVW) + (size_t)(l * 4 + 3) * 2048 + c0, w3);
    ld8f(ctx_in(lds, I_CONVB) + (size_t)l * 2048 + c0, cb);
    bf16_t* dst = cgp < 128 ? qm + c0 : km + (c0 - 1024); const float sc = cgp < 128 ? 1.f : 0.0625f;
    if (cidx < 128) {
        float x3[8], x2[8], x1[8];
        const int t0 = th * 32, ts0 = (m0 & 2047) + t0;
#pragma unroll
        for (int j = 0; j < 8; ++j) { x3[j] = 0.f; x2[j] = 0.f; x1[j] = 0.f; }
        if (ts0 >= 3) { ld8b(proj + (size_t)(m0 + t0 - 3) * NINP + M0 + c0, x3); ld8b(proj + (size_t)(m0 + t0 - 2) * NINP + M0 + c0, x2); ld8b(proj + (size_t)(m0 + t0 - 1) * NINP + M0 + c0, x1); }
        const bool lastc = (cidx & 31) == 31; const int b = cidx >> 5;
#pragma unroll 1
        for (int tb = t0; tb < t0 + 32; tb += 8) {
            u32x4 xb[8];
#pragma unroll
            for (int i = 0; i < 8; ++i) xb[i] = *(const u32x4*)(proj + (size_t)(m0 + tb + i) * NINP + M0 + c0);
#pragma unroll
            for (int i = 0; i < 8; ++i) { const int m = m0 + tb + i; float x0[8], y[8]; unpack8(xb[i], x0);
#pragma unroll
                for (int j = 0; j < 8; ++j) { const float cv = cb[j] + w0[j] * x3[j] + w1[j] * x2[j] + w2[j] * x1[j] + w3[j] * x0[j]; y[j] = siluf(cv) * sc; x3[j] = x2[j]; x2[j] = x1[j]; x1[j] = x0[j]; }
                *(u32x4*)(dst + (size_t)m * 1024) = pack8(y);
                if (lastc && tb + i >= 61) st8f(ctx_out(lds) + O_PCONV + (size_t)((l * 4 + b) * 3 + (tb + i - 61)) * 2048 + c0, x0); }
        }
    } else {
#pragma unroll 1
        for (int tb = th * (ntok >> 1); tb < (th + 1) * (ntok >> 1); tb += 4) {
            u32x4 xb[4]; f32x4 sa[4][6];
#pragma unroll
            for (int i = 0; i < 4; ++i) { const int m = m0 + tb + i, s = m - MP; const float* cs = ctx_in(lds, I_SCONV) + (size_t)((l * 128 + s) * 3) * 2048 + c0;
                xb[i] = *(const u32x4*)(proj + (size_t)m * NINP + M0 + c0);
#pragma unroll
                for (int k = 0; k < 3; ++k) { sa[i][2 * k] = *(const f32x4*)(cs + k * 2048); sa[i][2 * k + 1] = *(const f32x4*)(cs + k * 2048 + 4); } }
#pragma unroll
            for (int i = 0; i < 4; ++i) { const int m = m0 + tb + i, s = m - MP; float x0[8], y[8]; unpack8(xb[i], x0);
#pragma unroll
                for (int j = 0; j < 8; ++j) { const float x3 = sa[i][0 + (j >> 2)][j & 3], x2 = sa[i][2 + (j >> 2)][j & 3], x1 = sa[i][4 + (j >> 2)][j & 3];
                    const float cv = cb[j] + w0[j] * x3 + w1[j] * x2 + w2[j] * x1 + w3[j] * x0[j]; y[j] = siluf(cv) * sc; }
                *(u32x4*)(dst + (size_t)m * 1024) = pack8(y);
                float* co = ctx_out(lds) + O_SCONV + (size_t)((l * 128 + s) * 3) * 2048 + c0;
                *(f32x4*)co = sa[i][2]; *(f32x4*)(co + 4) = sa[i][3]; *(f32x4*)(co + 2048) = sa[i][4]; *(f32x4*)(co + 2052) = sa[i][5]; st8f(co + 4096, x0); }
        }
    }
    if (tid < ntok * 4) { const int t = tid >> 2, hh = tid & 3, m = m0 + t;
        const float ip = bf2f(proj[(size_t)m * NINP + M0 + 3072 + hh]), fp = bf2f(proj[(size_t)m * NINP + M0 + 3076 + hh]);
        const float xf = fp + ctx_in(lds, I_FB)[l * 4 + hh];
        gates[(size_t)m * 8 + hh] = ip + ctx_in(lds, I_IB)[l * 4 + hh];
        gates[(size_t)m * 8 + 4 + hh] = fminf(xf, 0.f) - log1pf(__expf(-fabsf(xf))); }
}
__device__ __forceinline__ void pre_gla(LAS unsigned char* lds, int l, int cidx, int m0, int ntok) {
    const int tid = opaque_tid(), lane = tid & 63, wave = tid >> 6, lr = lane & 15, lq = lane >> 4;
    const bf16_t* proj = (const bf16_t*)(ctx_ws(lds) + WS_PROJ);
    bf16_t* gq = (bf16_t*)(ctx_ws(lds) + WS_GQ); bf16_t* gk = (bf16_t*)(ctx_ws(lds) + WS_GK); bf16_t* gkh = (bf16_t*)(ctx_ws(lds) + WS_GKH); float* egl = (float*)(ctx_ws(lds) + WS_EGL);
    const bf16_t* a2T = (const bf16_t*)(ctx_ws(lds) + WS_W + (size_t)l * LW_BYTES + LW_GA2);
    LAS float* bb = (LAS float*)lds;
    LAS bf16_t* xa = (LAS bf16_t*)(lds + 64 * 516 * 4);
    const bool samp = cidx >= 128;
    __syncthreads();
    for (int i = tid; i < ntok * 32; i += NTHREADS) { const int t = i >> 5, k = i & 31; xa[t * 40 + k] = k < 16 ? proj[(size_t)(m0 + t) * NINP + G0 + 2048 + k] : (bf16_t)0; }
    __syncthreads();
#pragma unroll
    for (int q = 0; q < 4; ++q) { const int tc = wave * 4 + q;
        const bf16x8 bv = *(const bf16x8*)(a2T + (size_t)(tc * 16 + lr) * 32 + lq * 8);
        const float ab = ctx_in(lds, I_GAB)[l * 512 + tc * 16 + lr];
#pragma unroll
        for (int tt = 0; tt < 4; ++tt) { if (tt * 16 >= ntok) break; const bf16x8 av = *(const LAS bf16x8*)(xa + (tt * 16 + lr) * 40 + lq * 8);
            f32x4 acc = {0.f, 0.f, 0.f, 0.f}; acc = MFMA16(av, bv, acc);
#pragma unroll
            for (int r = 0; r < 4; ++r) bb[(tt * 16 + lq * 4 + r) * 516 + tc * 16 + lr] = logsig_fast(acc[r] + ab) * 0.0625f; } }
    __syncthreads();
    if (!samp) { const int c = tid; float run = 0.f;
#pragma unroll 8
        for (int t = 0; t < 64; ++t) { run += bb[t * 516 + c]; bb[t * 516 + c] = run; }
        egl[(size_t)cidx * 512 + c] = __expf(run); }
    __syncthreads();
    const float scale = 0.08838834764831845f;
    for (int i = tid; i < ntok * 64; i += NTHREADS) { const int t = i >> 6, cg = i & 63, c = cg * 8; const size_t m = m0 + t;
        float q[8], k[8], b8[8], bl[8], oq[8], ok[8], oh[8];
        ld8b(proj + m * NINP + G0 + c, q); ld8b(proj + m * NINP + G0 + 512 + c, k);
#pragma unroll
        for (int j = 0; j < 8; ++j) { b8[j] = bb[t * 516 + c + j]; bl[j] = samp ? b8[j] : bb[63 * 516 + c + j]; }
#pragma unroll
        for (int j = 0; j < 8; ++j) { oq[j] = q[j] * __expf(b8[j]) * scale; ok[j] = k[j] * __expf(-b8[j]); oh[j] = k[j] * __expf(bl[j] - b8[j]); }
        *(u32x4*)(gq + m * 512 + c) = pack8(oq); *(u32x4*)(gk + m * 512 + c) = pack8(ok); *(u32x4*)(gkh + m * 512 + c) = pack8(oh);
        if (samp) { float e[8];
#pragma unroll
            for (int j = 0; j < 8; ++j) e[j] = __expf(b8[j]);
            st8f(egl + (size_t)(128 + (m - MP)) * 512 + c, e); } }
}
__device__ __forceinline__ void phase_pre(LAS unsigned char* lds, int l, int G) {
    { const int tid = opaque_tid(), wave = tid >> 6, lane = tid & 63;
      for (int it = blockIdx.x * 8 + wave; it < 2048 + G * 8; it += G * 8) {
          int cidx, tt, h0, nh;
          if (it < 2048) { cidx = it >> 4; tt = (it >> 2) & 3; h0 = (it & 3) * 4; nh = 4; }
          else { const int j = G * 8 - 1 - (it - 2048); if (j >= 128) continue; cidx = 128 + (j >> 6); tt = (j >> 4) & 3; h0 = j & 15; nh = 1; }
          pre_rwkv_item(lds, l, cidx, tt, h0, nh, wave, lane); } }
    for (int u = blockIdx.x; u < 272; u += G) {
        if (u < 128) pre_gla(lds, l, u, u * 64, 64);
        else if (u < 256) pre_mlstm(lds, l, u - 128, (u - 128) * 64, 64);
        else if (u < 264) pre_gla(lds, l, 128, MP + (u - 256) * 16, 16);
        else pre_mlstm(lds, l, 128, MP + (u - 264) * 16, 16);
    }
    {
        const bf16_t* proj = (const bf16_t*)(ctx_ws(lds) + WS_PROJ);
        for (int i = blockIdx.x * NTHREADS + opaque_tid(); i < 132 * (RC / 8); i += G * NTHREADS) { const int sq = i / (RC / 8), cg8 = i % (RC / 8); float p[8];
            const int m = sq < 4 ? sq * 2048 + 2047 : MP + (sq - 4);
            ld8b(proj + (size_t)m * NINP + cg8 * 8, p);
            st8f(ctx_out(lds) + (sq < 4 ? O_PSHIFT + (size_t)(l * 4 + sq) * RC : O_SSHIFT + (size_t)(l * 128 + (sq - 4)) * RC) + cg8 * 8, p); }
    }
}

__device__ __forceinline__ void scan_rwkv(LAS unsigned char* lds, int l, int u) {
    const int tid = opaque_tid(), bh = u >> 1, half = u & 1, b = bh >> 4, h = bh & 15;
    const int row = tid >> 4, kq = tid & 15;
    const float* rpre = (const float*)(ctx_ws(lds) + WS_RPRE); bf16_t* rout = (bf16_t*)(ctx_ws(lds) + WS_ROUT);
    LAS float* stage = (LAS float*)lds;
    LAS float* obuf = (LAS float*)(lds + 64 * 352 * 4);
    f32x4 S = {0.f, 0.f, 0.f, 0.f};
    const size_t mb = (size_t)b * 2048;
    const unsigned char* rbase = (const unsigned char*)rpre;
    unsigned off[7], inc[7]; int lo[7];
#pragma unroll
    for (int q = 0; q < 7; ++q) { int i = tid + 512 * q; i = i < 3328 ? i : 3327; const int tok = i / 52, j = i % 52;
        if (j < 32) { const int arr = j >> 3, pc = j & 7; off[q] = (unsigned)(arr * (int)ARR + tok * 1024 + h * 64 + pc * 8) * 2u; inc[q] = 64u * 1024u * 2u; lo[q] = tok * 352 + (arr == 0 ? 0 : arr == 1 ? 64 : arr == 2 ? 192 : 256) + pc * 8; }
        else if (j < 48) { const int pc = j - 32; off[q] = (unsigned)RP_W + (unsigned)(tok * 1024 + h * 64 + pc * 4) * 4u; inc[q] = 64u * 1024u * 4u; lo[q] = -(tok * 352 + 128 + pc * 4) - 1; }
        else { const int pc = j - 48; off[q] = (unsigned)(4 * (int)ARR + tok * 1024 + h * 64 + half * 32 + pc * 8) * 2u; inc[q] = 64u * 1024u * 2u; lo[q] = tok * 352 + 320 + pc * 8; } }
    u32x4 pf[7];
    const size_t cb0 = mb / 64;
#pragma unroll
    for (int q = 0; q < 7; ++q) pf[q] = *(const u32x4*)(rbase + off[q] + cb0 * inc[q]);
    __syncthreads();
    for (int ch = 0; ch < 32; ++ch) {
#pragma unroll
        for (int q = 0; q < 7; ++q) {
            if (lo[q] < 0) *(LAS u32x4*)(stage + (-lo[q] - 1)) = pf[q];
            else { float f[8]; unpack8(pf[q], f); *(LAS f32x4*)(stage + lo[q]) = (f32x4){f[0], f[1], f[2], f[3]}; *(LAS f32x4*)(stage + lo[q] + 4) = (f32x4){f[4], f[5], f[6], f[7]}; } }
        __syncthreads();
        { const size_t chn = cb0 + (ch + 1 < 32 ? ch + 1 : 31);
#pragma unroll
          for (int q = 0; q < 7; ++q) pf[q] = *(const u32x4*)(rbase + off[q] + chn * inc[q]); }
        f32x4 B5[3][5]; float Bv[3];
#define RW_LD(slot, t) do { const LAS float* sp_ = stage + (t) * 352 + kq * 4; B5[slot][0] = *(const LAS f32x4*)(sp_); B5[slot][1] = *(const LAS f32x4*)(sp_ + 64); B5[slot][2] = *(const LAS f32x4*)(sp_ + 128); \
            B5[slot][3] = *(const LAS f32x4*)(sp_ + 192); B5[slot][4] = *(const LAS f32x4*)(sp_ + 256); Bv[slot] = stage[(t) * 352 + 320 + row]; } while (0)
        RW_LD(0, 0); RW_LD(1, 1);
        float o0 = 0.f, o1 = 0.f, o2 = 0.f, o3 = 0.f;
#pragma unroll
        for (int t = 0; t < 64; ++t) {
            if (t + 2 < 64) RW_LD((t + 2) % 3, t + 2);
            const f32x4 kk = B5[t % 3][0], bb = B5[t % 3][1], ww = B5[t % 3][2], k2 = B5[t % 3][3], rr = B5[t % 3][4]; const float vv = Bv[t % 3];
            float sa = (S.x * kk.x + S.y * kk.y) + (S.z * kk.z + S.w * kk.w);
            sa = row16_sum(sa);
            S = S * ww - sa * bb + vv * k2;
            float o = (S.x * rr.x + S.y * rr.y) + (S.z * rr.z + S.w * rr.w);
            o = row16_sum(o);
            if ((t & 15) == kq) { if (t < 16) o0 = o; else if (t < 32) o1 = o; else if (t < 48) o2 = o; else o3 = o; }
        }
#undef RW_LD
        obuf[kq * 32 + row] = o0; obuf[(16 + kq) * 32 + row] = o1; obuf[(32 + kq) * 32 + row] = o2; obuf[(48 + kq) * 32 + row] = o3;
        __syncthreads();
        for (int i = tid; i < 1024; i += NTHREADS) *(unsigned*)(rout + (mb + ch * 64 + (i >> 4)) * 1024 + h * 64 + half * 32 + (i & 15) * 2) = pk2(obuf[i * 2], obuf[i * 2 + 1]);
    }
    *(f32x4*)(ctx_out(lds) + O_PWKV + ((size_t)((l * 4 + b) * 16 + h) * 64 + half * 32 + row) * 64 + kq * 4) = S;
    __syncthreads();
}
__device__ __forceinline__ void scan_mlstm(LAS unsigned char* lds, int l, int u) {
    const int tid = opaque_tid(), lane = tid & 63, wave = tid >> 6, lr = lane & 15, lq = lane >> 4;
    const int bh = u >> 2, sl = u & 3, b = bh >> 2, h = bh & 3;
    const bf16_t* proj = (const bf16_t*)(ctx_ws(lds) + WS_PROJ); const bf16_t* qm = (const bf16_t*)(ctx_ws(lds) + WS_QM); const bf16_t* km = (const bf16_t*)(ctx_ws(lds) + WS_KM);
    const float* gates = (const float*)(ctx_ws(lds) + WS_GATES); bf16_t* hm = (bf16_t*)(ctx_ws(lds) + WS_HM);
    LAS bf16_t* kS = (LAS bf16_t*)lds;
    LAS bf16_t* kwT = (LAS bf16_t*)(lds + 33792);
    LAS bf16_t* vT = (LAS bf16_t*)(lds + 33792 + 36864);
    LAS bf16_t* Sp = (LAS bf16_t*)(lds + 33792 + 36864 + 11520);
    LAS bf16_t* CT = (LAS bf16_t*)(lds + 33792 + 36864 + 11520 + 9216);
    LAS float* gF = (LAS float*)(lds + 33792 + 36864 + 11520 + 9216 + 42240);
    LAS float* gU = gF + 64; LAS float* gM = gF + 128; LAS float* gS = gF + 192; LAS float* gD = gF + 196;
    __syncthreads();
    for (int i = tid; i < 80 * 264 / 2; i += NTHREADS) ((LAS unsigned*)CT)[i] = 0u;
    for (int i = tid; i < 16 * 72; i += NTHREADS) vT[64 * 72 + i] = (i < 72) ? (bf16_t)0x3F80 : (bf16_t)0;
    f32x4 acc[2][5];
#pragma unroll
    for (int i = 0; i < 2; ++i)
#pragma unroll
        for (int j = 0; j < 5; ++j) acc[i][j] = (f32x4){0.f, 0.f, 0.f, 0.f};
    float m_prev = 0.f;
    const int tt = wave >> 1, wodd = wave & 1, s = tid & 63, eg = tid >> 6;
    const size_t mb = (size_t)b * 2048;
    u32x4 pv = *(const u32x4*)(proj + (mb + s) * NINP + M0 + 2048 + h * 256 + sl * 64 + eg * 8);
    u32x4 pk[4];
#pragma unroll
    for (int j = 0; j < 4; ++j) pk[j] = *(const u32x4*)(km + (mb + s) * 1024 + h * 256 + (eg + 8 * j) * 8);
    bf16x8 qf[8];
#pragma unroll
    for (int ks = 0; ks < 8; ++ks) qf[ks] = *(const bf16x8*)(qm + (mb + tt * 16 + lr) * 1024 + h * 256 + ks * 32 + lq * 8);
    float pig = gates[(mb + lane) * 8 + h], plf = gates[(mb + lane) * 8 + 4 + h];
    for (int c = 0; c < 32; ++c) {
        const size_t m0 = mb + c * 64;
        if (wave == 0) {
            float F = plf;
#pragma unroll
            for (int o = 1; o < 64; o <<= 1) { const float t = __shfl_up(F, o); if (lane >= o) F += t; }
            const float uu = pig - F; float am = uu;
#pragma unroll
            for (int o = 1; o < 64; o <<= 1) { const float t = __shfl_up(am, o); if (lane >= o) am = fmaxf(am, t); }
            const float Mt = fmaxf(m_prev, am);
            gF[lane] = F; gU[lane] = uu; gM[lane] = Mt;
            if (lane == 63) { gS[0] = __expf(m_prev - Mt); gS[1] = Mt; gS[2] = F + Mt; }
        }
        { vT[(eg * 8 + 0) * 72 + s] = (bf16_t)(pv.x & 0xffffu); vT[(eg * 8 + 1) * 72 + s] = (bf16_t)(pv.x >> 16); vT[(eg * 8 + 2) * 72 + s] = (bf16_t)(pv.y & 0xffffu); vT[(eg * 8 + 3) * 72 + s] = (bf16_t)(pv.y >> 16);
          vT[(eg * 8 + 4) * 72 + s] = (bf16_t)(pv.z & 0xffffu); vT[(eg * 8 + 5) * 72 + s] = (bf16_t)(pv.z >> 16); vT[(eg * 8 + 6) * 72 + s] = (bf16_t)(pv.w & 0xffffu); vT[(eg * 8 + 7) * 72 + s] = (bf16_t)(pv.w >> 16);
#pragma unroll
          for (int j = 0; j < 4; ++j) *(LAS u32x4*)(kS + s * 264 + (eg + 8 * j) * 8) = pk[j]; }
        __syncthreads();
        const float a_c = gS[0], ML = gS[1], m_new = gS[2];
        { const float ws = __expf(gU[s] - ML);
#pragma unroll
          for (int j = 0; j < 4; ++j) { const int d0 = (eg + 8 * j) * 8; float k[8]; unpack8(pk[j], k);
#pragma unroll
              for (int i = 0; i < 8; ++i) kwT[(d0 + i) * 72 + s] = f2bf(k[i] * ws); } }
        const size_t m1 = mb + (size_t)(c + 1 < 32 ? c + 1 : 31) * 64;
        pig = gates[(m1 + lane) * 8 + h]; plf = gates[(m1 + lane) * 8 + 4 + h];
        pv = *(const u32x4*)(proj + (m1 + s) * NINP + M0 + 2048 + h * 256 + sl * 64 + eg * 8);
#pragma unroll
        for (int j = 0; j < 4; ++j) pk[j] = *(const u32x4*)(km + (m1 + s) * 1024 + h * 256 + (eg + 8 * j) * 8);
#pragma unroll
        for (int q = 0; q < 2; ++q) { const int ts = 2 * wodd + q;
            f32x4 sacc = {0.f, 0.f, 0.f, 0.f};
            if (ts <= tt) {
#pragma unroll
                for (int ks = 0; ks < 8; ++ks) { const bf16x8 kf = *(const LAS bf16x8*)(kS + (ts * 16 + lr) * 264 + ks * 32 + lq * 8); sacc = MFMA16(qf[ks], kf, sacc); }
            }
            const int sc = ts * 16 + lr; const float us = gU[sc];
#pragma unroll
            for (int r = 0; r < 4; ++r) { const int t = tt * 16 + lq * 4 + r; const float v = (sc <= t) ? sacc[r] * __expf(us - gM[t]) : 0.f; Sp[t * 72 + sc] = f2bf(v); }
        }
        __syncthreads();
        f32x4 hn[3];
#pragma unroll
        for (int q = 0; q < 3; ++q) { const int te = wodd ? 3 + q : q; hn[q] = (f32x4){0.f, 0.f, 0.f, 0.f}; if (te < 5) {
            f32x4 aq = {0.f, 0.f, 0.f, 0.f}, as = {0.f, 0.f, 0.f, 0.f};
#pragma unroll
            for (int ks = 0; ks < 8; ++ks) { const bf16x8 cf = *(const LAS bf16x8*)(CT + (te * 16 + lr) * 264 + ks * 32 + lq * 8); aq = MFMA16(qf[ks], cf, aq); }
#pragma unroll
            for (int ks = 0; ks < 2; ++ks) { const bf16x8 sf = *(const LAS bf16x8*)(Sp + (tt * 16 + lr) * 72 + ks * 32 + lq * 8); const bf16x8 vf = *(const LAS bf16x8*)(vT + (te * 16 + lr) * 72 + ks * 32 + lq * 8); as = MFMA16(sf, vf, as); }
#pragma unroll
            for (int r = 0; r < 4; ++r) { const int t = tt * 16 + lq * 4 + r; hn[q][r] = __expf(m_prev - gM[t]) * aq[r] + as[r]; }
            if (te == 4 && lr == 0) {
#pragma unroll
                for (int r = 0; r < 4; ++r) gD[tt * 16 + lq * 4 + r] = hn[q][r]; }
        } }
#pragma unroll
        for (int ks = 0; ks < 8; ++ks) qf[ks] = *(const bf16x8*)(qm + (m1 + tt * 16 + lr) * 1024 + h * 256 + ks * 32 + lq * 8);
#pragma unroll
        for (int i = 0; i < 2; ++i) { const int dt = wave * 2 + i;
            bf16x8 kf[2];
#pragma unroll
            for (int ks = 0; ks < 2; ++ks) kf[ks] = *(const LAS bf16x8*)(kwT + (dt * 16 + lr) * 72 + ks * 32 + lq * 8);
#pragma unroll
            for (int et = 0; et < 5; ++et) { acc[i][et] = acc[i][et] * a_c;
#pragma unroll
                for (int ks = 0; ks < 2; ++ks) { const bf16x8 vf = *(const LAS bf16x8*)(vT + (et * 16 + lr) * 72 + ks * 32 + lq * 8); acc[i][et] = MFMA16(kf[ks], vf, acc[i][et]); } } }
        __syncthreads();
#pragma unroll
        for (int i = 0; i < 2; ++i) { const int dt = wave * 2 + i;
#pragma unroll
            for (int et = 0; et < 5; ++et) { u32x2 w; w.x = pk2(acc[i][et][0], acc[i][et][1]); w.y = pk2(acc[i][et][2], acc[i][et][3]);
                *(LAS u32x2*)(CT + (et * 16 + lr) * 264 + dt * 16 + lq * 4) = w; } }
        { float dd[4];
#pragma unroll
          for (int r = 0; r < 4; ++r) { const int t = tt * 16 + lq * 4 + r; dd[r] = 1.f / fmaxf(fabsf(gD[t]), __expf(-(gF[t] + gM[t]))); }
#pragma unroll
          for (int q = 0; q < 3; ++q) { const int te = wodd ? 3 + q : q; if (te < 4) {
#pragma unroll
              for (int r = 0; r < 4; ++r) hm[(m0 + tt * 16 + lq * 4 + r) * 1024 + h * 256 + sl * 64 + te * 16 + lr] = f2bf(hn[q][r] * dd[r]); } } }
        m_prev = m_new;
        __syncthreads();
    }
#pragma unroll
    for (int i = 0; i < 2; ++i) { const int dt = wave * 2 + i;
#pragma unroll
        for (int et = 0; et < 5; ++et)
#pragma unroll
            for (int r = 0; r < 4; ++r) { const int d = dt * 16 + lq * 4 + r;
                if (et < 4) ctx_out(lds)[O_PC + ((size_t)((l * 4 + b) * 4 + h) * 256 + d) * 256 + sl * 64 + et * 16 + lr] = acc[i][et][r];
                else if (sl == 0 && lr == 0) ctx_out(lds)[O_PN + (size_t)((l * 4 + b) * 4 + h) * 256 + d] = acc[i][et][r]; } }
    if (sl == 0 && tid == 0) ctx_out(lds)[O_PM + (l * 4 + b) * 4 + h] = m_prev;
    __syncthreads();
}
__device__ __forceinline__ void scan_gla(LAS unsigned char* lds, int l, int u) {
    const int tid = opaque_tid(), lane = tid & 63, wave = tid >> 6, lr = lane & 15, lq = lane >> 4;
    const int bh = u >> 2, sl = u & 3, b = bh >> 2, h = bh & 3;
    const bf16_t* proj = (const bf16_t*)(ctx_ws(lds) + WS_PROJ); const bf16_t* gq = (const bf16_t*)(ctx_ws(lds) + WS_GQ); const bf16_t* gk = (const bf16_t*)(ctx_ws(lds) + WS_GK); const bf16_t* gkh = (const bf16_t*)(ctx_ws(lds) + WS_GKH);
    const float* egl = (const float*)(ctx_ws(lds) + WS_EGL); bf16_t* og = (bf16_t*)(ctx_ws(lds) + WS_OG);
    LAS bf16_t* khT = (LAS bf16_t*)lds;
    LAS bf16_t* vT = (LAS bf16_t*)(lds + 18432);
    LAS bf16_t* Ap = (LAS bf16_t*)(lds + 18432 + 9216);
    LAS bf16_t* ST = (LAS bf16_t*)(lds + 36864);
    LAS bf16_t* kS = (LAS bf16_t*)(lds + 36864 + 17408);
    __syncthreads();
    for (int i = tid; i < 64 * 136 / 2; i += NTHREADS) ((LAS unsigned*)ST)[i] = 0u;
    f32x4 acc[4];
#pragma unroll
    for (int j = 0; j < 4; ++j) acc[j] = (f32x4){0.f, 0.f, 0.f, 0.f};
    const int tt = wave >> 1, wodd = wave & 1, s = tid & 63, eg = tid >> 6;
    const size_t mb = (size_t)b * 2048;
    u32x4 pv = *(const u32x4*)(proj + (mb + s) * NINP + G0 + 1024 + h * 256 + sl * 64 + eg * 8);
    u32x4 pkh[2], pgk[2];
#pragma unroll
    for (int j = 0; j < 2; ++j) { pkh[j] = *(const u32x4*)(gkh + (mb + s) * 512 + h * 128 + (eg + 8 * j) * 8); pgk[j] = *(const u32x4*)(gk + (mb + s) * 512 + h * 128 + (eg + 8 * j) * 8); }
    bf16x8 qf[4];
#pragma unroll
    for (int ks = 0; ks < 4; ++ks) qf[ks] = *(const bf16x8*)(gq + (mb + tt * 16 + lr) * 512 + h * 128 + ks * 32 + lq * 8);
    float eg4[4];
#pragma unroll
    for (int r = 0; r < 4; ++r) eg4[r] = egl[(size_t)(b * 32) * 512 + h * 128 + wave * 16 + lq * 4 + r];
    for (int c = 0; c < 32; ++c) {
        const int cidx = b * 32 + c; const size_t m0 = (size_t)cidx * 64;
        { vT[(eg * 8 + 0) * 72 + s] = (bf16_t)(pv.x & 0xffffu); vT[(eg * 8 + 1) * 72 + s] = (bf16_t)(pv.x >> 16); vT[(eg * 8 + 2) * 72 + s] = (bf16_t)(pv.y & 0xffffu); vT[(eg * 8 + 3) * 72 + s] = (bf16_t)(pv.y >> 16);
          vT[(eg * 8 + 4) * 72 + s] = (bf16_t)(pv.z & 0xffffu); vT[(eg * 8 + 5) * 72 + s] = (bf16_t)(pv.z >> 16); vT[(eg * 8 + 6) * 72 + s] = (bf16_t)(pv.w & 0xffffu); vT[(eg * 8 + 7) * 72 + s] = (bf16_t)(pv.w >> 16);
#pragma unroll
          for (int j = 0; j < 2; ++j) { const int d0 = (eg + 8 * j) * 8; const u32x4 w = pkh[j];
              khT[(d0 + 0) * 72 + s] = (bf16_t)(w.x & 0xffffu); khT[(d0 + 1) * 72 + s] = (bf16_t)(w.x >> 16); khT[(d0 + 2) * 72 + s] = (bf16_t)(w.y & 0xffffu); khT[(d0 + 3) * 72 + s] = (bf16_t)(w.y >> 16);
              khT[(d0 + 4) * 72 + s] = (bf16_t)(w.z & 0xffffu); khT[(d0 + 5) * 72 + s] = (bf16_t)(w.z >> 16); khT[(d0 + 6) * 72 + s] = (bf16_t)(w.w & 0xffffu); khT[(d0 + 7) * 72 + s] = (bf16_t)(w.w >> 16);
              *(LAS u32x4*)(kS + s * 136 + d0) = pgk[j]; } }
        __syncthreads();
        const float e0 = eg4[0], e1 = eg4[1], e2 = eg4[2], e3 = eg4[3];
        const int cn = c + 1 < 32 ? cidx + 1 : cidx; const size_t m1 = (size_t)cn * 64;
        pv = *(const u32x4*)(proj + (m1 + s) * NINP + G0 + 1024 + h * 256 + sl * 64 + eg * 8);
#pragma unroll
        for (int j = 0; j < 2; ++j) { pkh[j] = *(const u32x4*)(gkh + (m1 + s) * 512 + h * 128 + (eg + 8 * j) * 8); pgk[j] = *(const u32x4*)(gk + (m1 + s) * 512 + h * 128 + (eg + 8 * j) * 8); }
#pragma unroll
        for (int r = 0; r < 4; ++r) eg4[r] = egl[(size_t)cn * 512 + h * 128 + wave * 16 + lq * 4 + r];
#pragma unroll
        for (int q = 0; q < 2; ++q) { const int ts = 2 * wodd + q;
            f32x4 sacc = {0.f, 0.f, 0.f, 0.f};
            if (ts <= tt) {
#pragma unroll
                for (int ks = 0; ks < 4; ++ks) { const bf16x8 kf = *(const LAS bf16x8*)(kS + (ts * 16 + lr) * 136 + ks * 32 + lq * 8); sacc = MFMA16(qf[ks], kf, sacc); }
            }
            const int sc = ts * 16 + lr;
#pragma unroll
            for (int r = 0; r < 4; ++r) { const int t = tt * 16 + lq * 4 + r; Ap[t * 72 + sc] = f2bf((sc <= t) ? sacc[r] : 0.f); }
        }
        __syncthreads();
#pragma unroll
        for (int q = 0; q < 2; ++q) { const int te = 2 * wodd + q;
            f32x4 ao = {0.f, 0.f, 0.f, 0.f};
#pragma unroll
            for (int ks = 0; ks < 4; ++ks) { const bf16x8 sf = *(const LAS bf16x8*)(ST + (te * 16 + lr) * 136 + ks * 32 + lq * 8); ao = MFMA16(qf[ks], sf, ao); }
#pragma unroll
            for (int ks = 0; ks < 2; ++ks) { const bf16x8 af = *(const LAS bf16x8*)(Ap + (tt * 16 + lr) * 72 + ks * 32 + lq * 8); const bf16x8 vf = *(const LAS bf16x8*)(vT + (te * 16 + lr) * 72 + ks * 32 + lq * 8); ao = MFMA16(af, vf, ao); }
#pragma unroll
            for (int r = 0; r < 4; ++r) og[(m0 + tt * 16 + lq * 4 + r) * 1024 + h * 256 + sl * 64 + te * 16 + lr] = f2bf(ao[r]);
        }
#pragma unroll
        for (int ks = 0; ks < 4; ++ks) qf[ks] = *(const bf16x8*)(gq + (m1 + tt * 16 + lr) * 512 + h * 128 + ks * 32 + lq * 8);
        { const int dt = wave;
          bf16x8 kf[2];
#pragma unroll
          for (int ks = 0; ks < 2; ++ks) kf[ks] = *(const LAS bf16x8*)(khT + (dt * 16 + lr) * 72 + ks * 32 + lq * 8);
#pragma unroll
          for (int et = 0; et < 4; ++et) {
              acc[et][0] *= e0; acc[et][1] *= e1; acc[et][2] *= e2; acc[et][3] *= e3;
#pragma unroll
              for (int ks = 0; ks < 2; ++ks) { const bf16x8 vf = *(const LAS bf16x8*)(vT + (et * 16 + lr) * 72 + ks * 32 + lq * 8); acc[et] = MFMA16(kf[ks], vf, acc[et]); } } }
        __syncthreads();
#pragma unroll
        for (int et = 0; et < 4; ++et) { u32x2 w; w.x = pk2(acc[et][0], acc[et][1]); w.y = pk2(acc[et][2], acc[et][3]);
            *(LAS u32x2*)(ST + (et * 16 + lr) * 136 + wave * 16 + lq * 4) = w; }
        __syncthreads();
    }
#pragma unroll
    for (int et = 0; et < 4; ++et)
#pragma unroll
        for (int r = 0; r < 4; ++r) ctx_out(lds)[O_PGLA + ((size_t)((l * 4 + b) * 4 + h) * 128 + wave * 16 + lq * 4 + r) * 256 + sl * 64 + et * 16 + lr] = acc[et][r];
    __syncthreads();
}
__device__ __forceinline__ void samp_rwkv(LAS unsigned char* lds, int l, int u) {
    const int tid = opaque_tid(), s = u >> 3, h = (u & 7) * 2 + (tid >> 8), row = (tid & 255) >> 2, kq = tid & 3;
    const float* rpre = (const float*)(ctx_ws(lds) + WS_RPRE); bf16_t* rout = (bf16_t*)(ctx_ws(lds) + WS_ROUT);
    const size_t m = MP + s, po = m * 1024 + h * 64 + kq * 16;
    const size_t so = ((size_t)((l * 128 + s) * 16 + h) * 64 + row) * 64 + kq * 16;
    const float* sp = ctx_in(lds, I_SWKV) + so;
    f32x4 S[4], kk[4], bb[4], ww[4], k2[4], rr[4];
    const bf16_t* rb = (const bf16_t*)rpre; const float* rw = (const float*)((const unsigned char*)rpre + RP_W);
    { float t0[16], t1[16], t2[16], t3[16];
      ld16b(rb + po, t0); ld16b(rb + ARR + po, t1); ld16b(rb + 2 * ARR + po, t2); ld16b(rb + 3 * ARR + po, t3);
#pragma unroll
      for (int j = 0; j < 4; ++j) { S[j] = *(const f32x4*)(sp + j * 4); ww[j] = *(const f32x4*)(rw + po + j * 4);
          kk[j] = (f32x4){t0[4 * j], t0[4 * j + 1], t0[4 * j + 2], t0[4 * j + 3]}; bb[j] = (f32x4){t1[4 * j], t1[4 * j + 1], t1[4 * j + 2], t1[4 * j + 3]};
          k2[j] = (f32x4){t2[4 * j], t2[4 * j + 1], t2[4 * j + 2], t2[4 * j + 3]}; rr[j] = (f32x4){t3[4 * j], t3[4 * j + 1], t3[4 * j + 2], t3[4 * j + 3]}; } }
    const float vv = bf2f(rb[4 * ARR + m * 1024 + h * 64 + row]);
    float sa = 0.f;
#pragma unroll
    for (int j = 0; j < 4; ++j) sa += (S[j].x * kk[j].x + S[j].y * kk[j].y) + (S[j].z * kk[j].z + S[j].w * kk[j].w);
    sa = quad_sum(sa);
    float o = 0.f;
#pragma unroll
    for (int j = 0; j < 4; ++j) { S[j] = S[j] * ww[j] - sa * bb[j] + vv * k2[j]; o += (S[j].x * rr[j].x + S[j].y * rr[j].y) + (S[j].z * rr[j].z + S[j].w * rr[j].w);
        *(f32x4*)(ctx_out(lds) + O_SWKV + so + j * 4) = S[j]; }
    o = quad_sum(o);
    if (kq == 0) rout[m * 1024 + h * 64 + row] = f2bf(o);
}
__device__ __forceinline__ float block_sum2(LAS float* red, float v, int tid) {
    v = wave_sum(v);
    __syncthreads();
    if ((tid & 63) == 0) red[tid >> 6] = v;
    __syncthreads();
    return ((red[0] + red[1]) + (red[2] + red[3])) + ((red[4] + red[5]) + (red[6] + red[7]));
}
__device__ __forceinline__ void samp_mlstm(LAS unsigned char* lds, int l, int u) {
    const int tid = opaque_tid(), s = u >> 2, h = u & 3;
    const bf16_t* proj = (const bf16_t*)(ctx_ws(lds) + WS_PROJ); const bf16_t* qm = (const bf16_t*)(ctx_ws(lds) + WS_QM); const bf16_t* km = (const bf16_t*)(ctx_ws(lds) + WS_KM);
    const float* gates = (const float*)(ctx_ws(lds) + WS_GATES); bf16_t* hm = (bf16_t*)(ctx_ws(lds) + WS_HM);
    LAS float* qs = (LAS float*)lds; LAS float* ks = qs + 256; LAS float* red = ks + 256; LAS float* rs = red + 8 * 256;
    const size_t m = MP + s; const size_t sb = (size_t)(l * 128 + s) * 4 + h;
    __syncthreads();
    float pq = 0.f, pn = 0.f;
    if (tid < 256) { const float q = bf2f(qm[m * 1024 + h * 256 + tid]), k = bf2f(km[m * 1024 + h * 256 + tid]); qs[tid] = q; ks[tid] = k; pq = q * k; pn = q * ctx_in(lds, I_SN)[sb * 256 + tid]; }
    const float qk = block_sum2(rs, pq, tid);
    const float qn = block_sum2(rs + 8, pn, tid);
    const float ig = gates[m * 8 + h], lf = gates[m * 8 + 4 + h], m_prev = ctx_in(lds, I_SM)[sb];
    const float uu = ig - lf, Mx = fmaxf(m_prev, uu), m_t = lf + Mx, w_inter = __expf(m_prev - Mx), ws = __expf(uu - Mx), Sv = qk * ws;
    const int eg = tid & 63, dp = tid >> 6;
    const u32x2 vw = *(const u32x2*)(proj + m * NINP + M0 + 2048 + h * 256 + eg * 4);
    const f32x4 v4 = {__uint_as_float(vw.x << 16), __uint_as_float(vw.x & 0xffff0000u), __uint_as_float(vw.y << 16), __uint_as_float(vw.y & 0xffff0000u)};
    f32x4 num = {0.f, 0.f, 0.f, 0.f};
    const float* Cs = ctx_in(lds, I_SC) + sb * 65536 + eg * 4; float* Co = ctx_out(lds) + O_SC + sb * 65536 + eg * 4;
#pragma unroll 8
    for (int i = 0; i < 32; ++i) { const int d = dp + 8 * i; const f32x4 c4 = *(const f32x4*)(Cs + (size_t)d * 256);
        num = num + qs[d] * c4; *(f32x4*)(Co + (size_t)d * 256) = w_inter * c4 + (ws * ks[d]) * v4; }
    *(LAS f32x4*)(red + dp * 256 + eg * 4) = num;
    __syncthreads();
    if (tid < 256) {
        float nsum = 0.f;
#pragma unroll
        for (int j = 0; j < 8; ++j) nsum += red[j * 256 + tid];
        const float ve = bf2f(proj[m * NINP + M0 + 2048 + h * 256 + tid]);
        const float nm = w_inter * nsum + Sv * ve, den = w_inter * qn + Sv;
        hm[m * 1024 + h * 256 + tid] = f2bf(nm / fmaxf(fabsf(den), __expf(-m_t)));
        ctx_out(lds)[O_SN + sb * 256 + tid] = w_inter * ctx_in(lds, I_SN)[sb * 256 + tid] + ws * ks[tid];
        if (tid == 0) ctx_out(lds)[O_SM + sb] = m_t;
    }
}
__device__ __forceinline__ void samp_gla(LAS unsigned char* lds, int l, int u) {
    const int tid = opaque_tid(), s = u >> 2, h = u & 3;
    const bf16_t* proj = (const bf16_t*)(ctx_ws(lds) + WS_PROJ); const bf16_t* gq = (const bf16_t*)(ctx_ws(lds) + WS_GQ); const bf16_t* gk = (const bf16_t*)(ctx_ws(lds) + WS_GK); const bf16_t* gkh = (const bf16_t*)(ctx_ws(lds) + WS_GKH);
    const float* egl = (const float*)(ctx_ws(lds) + WS_EGL); bf16_t* og = (bf16_t*)(ctx_ws(lds) + WS_OG);
    LAS float* qs = (LAS float*)lds; LAS float* ks = qs + 128; LAS float* es = ks + 128; LAS float* red = es + 128; LAS float* rs = red + 8 * 256;
    const size_t m = MP + s; const size_t sb = (size_t)(l * 128 + s) * 4 + h;
    __syncthreads();
    float pa = 0.f;
    if (tid < 128) { const float q = bf2f(gq[m * 512 + h * 128 + tid]), k = bf2f(gk[m * 512 + h * 128 + tid]); qs[tid] = q; ks[tid] = bf2f(gkh[m * 512 + h * 128 + tid]); es[tid] = egl[(size_t)(128 + s) * 512 + h * 128 + tid]; pa = q * k; }
    const float A = block_sum2(rs, pa, tid);
    const int eg = tid & 63, dp = tid >> 6;
    const u32x2 vw = *(const u32x2*)(proj + m * NINP + G0 + 1024 + h * 256 + eg * 4);
    const f32x4 v4 = {__uint_as_float(vw.x << 16), __uint_as_float(vw.x & 0xffff0000u), __uint_as_float(vw.y << 16), __uint_as_float(vw.y & 0xffff0000u)};
    f32x4 o4 = {0.f, 0.f, 0.f, 0.f};
    const float* Ss = ctx_in(lds, I_SGLA) + sb * 32768 + eg * 4; float* So = ctx_out(lds) + O_SGLA + sb * 32768 + eg * 4;
#pragma unroll 8
    for (int i = 0; i < 16; ++i) { const int d = dp + 8 * i; const f32x4 s4 = *(const f32x4*)(Ss + (size_t)d * 256);
        o4 = o4 + qs[d] * s4; *(f32x4*)(So + (size_t)d * 256) = es[d] * s4 + ks[d] * v4; }
    *(LAS f32x4*)(red + dp * 256 + eg * 4) = o4;
    __syncthreads();
    if (tid < 256) { float osum = 0.f;
#pragma unroll
        for (int j = 0; j < 8; ++j) osum += red[j * 256 + tid];
        og[m * 1024 + h * 256 + tid] = f2bf(osum + A * bf2f(proj[m * NINP + G0 + 1024 + h * 256 + tid])); }
}
__device__ __forceinline__ void phase_scan(LAS unsigned char* lds, int l, int G, unsigned* queue, int rmask) {
    for (int u = blockIdx.x; u < 256; u += G) {
        const int slot = u >> 3, x = u & 7, role = slot & 3, s2 = slot >> 2;
        const int idx = role < 2 ? (s2 * 8 + x) : ((x * 2 + (s2 >> 2)) * 4 + (s2 & 3));
#ifndef SC_MASK
#define SC_MASK 63
#endif
        if (rmask && !((rmask >> (role < 2 ? 0 : role - 1)) & 1)) continue;
        if (role < 2) { if (SC_MASK & 1) scan_rwkv(lds, l, idx * 2 + role); }
        else if (role == 2) { if (SC_MASK & 2) scan_mlstm(lds, l, idx); }
        else { if (SC_MASK & 4) scan_gla(lds, l, idx); }
    }
    LAS unsigned* qw = (LAS unsigned*)(lds + 140000);
    for (;;) {
        __syncthreads();
        if (threadIdx.x == 0) *qw = __hip_atomic_fetch_add(queue, 1u, __ATOMIC_RELAXED, __HIP_MEMORY_SCOPE_AGENT);
        __syncthreads();
        const unsigned u = *qw;
        if (u >= 2048u) break;
        if (u < 512u) { if (SC_MASK & 16) samp_mlstm(lds, l, (int)u); }
        else if (u < 1024u) { if (SC_MASK & 32) samp_gla(lds, l, (int)u - 512); }
        else { if (SC_MASK & 8) samp_rwkv(lds, l, (int)u - 1024); }
    }
}

__device__ __forceinline__ void phase_post(LAS unsigned char* lds, int l, int G) {
    const int tid = opaque_tid(), lane = tid & 63, wave = tid >> 6, c0 = lane * 16;
    const bf16_t* proj = (const bf16_t*)(ctx_ws(lds) + WS_PROJ); const float* rpre = (const float*)(ctx_ws(lds) + WS_RPRE); const bf16_t* rout = (const bf16_t*)(ctx_ws(lds) + WS_ROUT);
    const bf16_t* hm = (const bf16_t*)(ctx_ws(lds) + WS_HM); const bf16_t* og = (const bf16_t*)(ctx_ws(lds) + WS_OG); bf16_t* obr = (bf16_t*)(ctx_ws(lds) + WS_QM);
    for (int it = blockIdx.x * 8 + wave; it < MP + 512; it += G * 8) {
        const int m = it < MP ? it : MP + ((it - MP) >> 2); const int part = it < MP ? -1 : (it - MP) & 3;
        const size_t o = (size_t)m * 1024 + c0;
        const bf16_t* prow = proj + (size_t)m * NINP;
        u32x4 L[30];
#define POST_LD(slot, ptr) do { L[slot] = *(const u32x4*)(ptr); L[(slot) + 1] = *(const u32x4*)((ptr) + 8); } while (0)
        if (part < 0 || part == 0) { POST_LD(0, rout + o); POST_LD(2, (const bf16_t*)rpre + 3 * ARR + o); POST_LD(4, (const bf16_t*)rpre + 2 * ARR + o); POST_LD(6, (const bf16_t*)rpre + 4 * ARR + o); POST_LD(8, (const bf16_t*)rpre + 5 * ARR + o); }
        if (part < 0 || part == 1) { POST_LD(10, hm + o); POST_LD(12, prow + M0 + 3080 + c0); }
        if (part < 0 || part == 2) { POST_LD(14, og + o); POST_LD(16, prow + G0 + 2064 + c0); }
        if (part < 0 || part == 3) {
#pragma unroll
            for (int q = 0; q < 2; ++q)
#pragma unroll
                for (int j = 0; j < 3; ++j) POST_LD(18 + (q * 3 + j) * 2, prow + GT0 + j * 2048 + q * 1024 + c0); }
#undef POST_LD
#define POST_UP(slot, arr) do { unpack8(L[slot], *(float(*)[8])&arr[0]); unpack8(L[(slot) + 1], *(float(*)[8])&arr[8]); } while (0)
        if (part < 0 || part == 0) {
            float x[16], r[16], k2[16], v[16], g[16], rk[16], lg[16], lb[16];
            POST_UP(0, x); POST_UP(2, r); POST_UP(4, k2); POST_UP(6, v); POST_UP(8, g);
            ld16f(ctx_in(lds, I_RK) + l * 1024 + c0, rk); ld16f(ctx_in(lds, I_LNG) + l * 1024 + c0, lg); ld16f(ctx_in(lds, I_LNB) + l * 1024 + c0, lb);
            float s = 0.f, bs = 0.f;
#pragma unroll
            for (int j = 0; j < 16; ++j) { s += x[j]; bs += r[j] * k2[j] * rk[j]; }
            s += __shfl_xor(s, 1); s += __shfl_xor(s, 2); bs += __shfl_xor(bs, 1); bs += __shfl_xor(bs, 2);
            const float mean = s * (1.f / 64.f); float q = 0.f;
#pragma unroll
            for (int j = 0; j < 16; ++j) { const float d = x[j] - mean; q += d * d; }
            q += __shfl_xor(q, 1); q += __shfl_xor(q, 2);
            const float rstd = rsqrtf(q * (1.f / 64.f) + 64e-5f);
            float y[16];
#pragma unroll
            for (int j = 0; j < 16; ++j) y[j] = ((x[j] - mean) * rstd * lg[j] + lb[j] + bs * v[j]) * g[j];
            st16b(obr + (size_t)m * 3072 + c0, y);
        }
        if (part < 0 || part == 1) {
            float x[16], ng[16], go[16];
            POST_UP(10, x); POST_UP(12, go); ld16f(ctx_in(lds, I_MNORM) + l * 1024 + c0, ng);
            float q = 0.f;
#pragma unroll
            for (int j = 0; j < 16; ++j) q += x[j] * x[j];
            q += __shfl_xor(q, 1); q += __shfl_xor(q, 2); q += __shfl_xor(q, 4); q += __shfl_xor(q, 8);
            const float rs = rsqrtf(q * (1.f / 256.f) + 1e-6f);
            float y[16];
#pragma unroll
            for (int j = 0; j < 16; ++j) y[j] = x[j] * rs * ng[j] * sigm(go[j]);
            st16b(obr + (size_t)m * 3072 + 1024 + c0, y);
        }
        if (part < 0 || part == 2) {
            float x[16], ng[16], go[16];
            POST_UP(14, x); POST_UP(16, go); ld16f(ctx_in(lds, I_GNORM) + l * 1024 + c0, ng);
            float q = 0.f;
#pragma unroll
            for (int j = 0; j < 16; ++j) q += x[j] * x[j];
            q += __shfl_xor(q, 1); q += __shfl_xor(q, 2); q += __shfl_xor(q, 4); q += __shfl_xor(q, 8);
            const float rs = rsqrtf(q * (1.f / 256.f) + 1e-6f);
            float y[16];
#pragma unroll
            for (int j = 0; j < 16; ++j) y[j] = x[j] * rs * ng[j] * siluf(go[j]);
            st16b(obr + (size_t)m * 3072 + 2048 + c0, y);
        }
        if (part < 0 || part == 3) {
            bf16_t* gr = (bf16_t*)(ctx_ws(lds) + WS_RPRE + RP_GR) + (size_t)m * 6144; const float* gbv = ctx_in(lds, I_GATEB) + (size_t)l * 3 * 2048;
#pragma unroll
            for (int q = 0; q < 2; ++q) { const int d0 = q * 1024 + c0;
                float e0[16], e1[16], e2[16], gb[16];
                POST_UP(18 + (q * 3 + 0) * 2, e0); POST_UP(18 + (q * 3 + 1) * 2, e1); POST_UP(18 + (q * 3 + 2) * 2, e2);
                ld16f(gbv + d0, gb);
#pragma unroll
                for (int j = 0; j < 16; ++j) e0[j] = 1.f + __expf(-(e0[j] + gb[j]));
                ld16f(gbv + 2048 + d0, gb);
#pragma unroll
                for (int j = 0; j < 16; ++j) e1[j] = 1.f + __expf(-(e1[j] + gb[j]));
                ld16f(gbv + 4096 + d0, gb);
#pragma unroll
                for (int j = 0; j < 16; ++j) { e2[j] = 1.f + __expf(-(e2[j] + gb[j])); const float i0 = __builtin_amdgcn_rcpf(e0[j]), i1 = __builtin_amdgcn_rcpf(e1[j]), i2 = __builtin_amdgcn_rcpf(e2[j]);
                    e0[j] = e1[j] * i0; e1[j] = e2[j] * i1; e2[j] = i2; }
                st16b(gr + d0, e0); st16b(gr + 2048 + d0, e1); st16b(gr + 4096 + d0, e2); }
        }
#undef POST_UP
    }
}

template <int MODE>
__device__ __forceinline__ void skinny_phase(LAS unsigned char* lds, const bf16_t* A, int lda, const bf16_t* Bt, int ldb, int K, float* X, bf16_t* merged, const bf16_t* gr, const float* unused, int G) {
    const int tid = opaque_tid(), lane = tid & 63, wave = tid >> 6, lr = lane & 15, lq = lane >> 4, rt = wave & 3, kh = wave >> 2;
    LAS float* xch = (LAS float*)lds;
    for (int u = blockIdx.x; u < 256; u += G) {
        const int cg = u >> 1, rh = u & 1;
        const bf16_t* ap = A + (size_t)(MP + rh * 64 + rt * 16 + lr) * lda + lq * 8;
        const bf16_t* bp = Bt + (size_t)(cg * 16 + lr) * ldb + lq * 8;
        const int row0 = MP + rh * 64 + rt * 16 + lq * 4, col = cg * 16 + lr;
        constexpr int NJ = MODE == 0 ? 1 : 3;
        const int Kj = MODE == 0 ? K : 1024, Kh = Kj / 2;
        f32x4 acc[NJ];
#pragma unroll
        for (int j = 0; j < NJ; ++j) {
            f32x4 a0c = {0.f, 0.f, 0.f, 0.f}, a1c = {0.f, 0.f, 0.f, 0.f};
            const bf16_t* aj = ap + j * 1024 + kh * Kh; const bf16_t* bj = bp + j * 1024 + kh * Kh;
            bf16x8 av[8], bv[8], an[8], bn[8];
#pragma unroll
            for (int i = 0; i < 8; ++i) { av[i] = *(const bf16x8*)(aj + i * 32); bv[i] = *(const bf16x8*)(bj + i * 32); }
            for (int k0 = 0; k0 < Kh; k0 += 256) {
                const int kn = k0 + 256 < Kh ? k0 + 256 : k0;
#pragma unroll
                for (int i = 0; i < 8; ++i) { an[i] = *(const bf16x8*)(aj + kn + i * 32); bn[i] = *(const bf16x8*)(bj + kn + i * 32); }
#pragma unroll
                for (int i = 0; i < 8; i += 2) { a0c = MFMA16(av[i], bv[i], a0c); a1c = MFMA16(av[i + 1], bv[i + 1], a1c); }
#pragma unroll
                for (int i = 0; i < 8; ++i) { av[i] = an[i]; bv[i] = bn[i]; }
            }
            acc[j] = a0c + a1c;
        }
        __syncthreads();
        if (kh == 1) {
#pragma unroll
            for (int j = 0; j < NJ; ++j) *(LAS f32x4*)(xch + ((j * 4 + rt) * 64 + lane) * 4) = acc[j]; }
        __syncthreads();
        if (kh == 0) {
#pragma unroll
            for (int j = 0; j < NJ; ++j) acc[j] = acc[j] + *(const LAS f32x4*)(xch + ((j * 4 + rt) * 64 + lane) * 4);
            if (MODE == 0) {
#pragma unroll
                for (int r = 0; r < 4; ++r) { float* p = X + (size_t)(row0 + r) * 2048 + col; *p = *p + acc[0][r]; }
            } else {
#pragma unroll
                for (int r = 0; r < 4; ++r) { float o = 0.f;
#pragma unroll
                    for (int j = 0; j < NJ; ++j) o = (o + acc[j][r]) * bf2f(gr[(size_t)(row0 + r) * 6144 + j * 2048 + col]);
                    merged[(size_t)(row0 + r) * 2048 + col] = f2bf(o); }
            }
        }
    }
}

constexpr int N_PHASES = 22;
constexpr int CW_BAR = 1024, CW_QUEUE = 8192;

__global__ void __launch_bounds__(NTHREADS, 2) fwd_kernel(Args a) {
    extern __shared__ __attribute__((aligned(16))) unsigned char lds_raw[];
    LAS unsigned char* lds = (LAS unsigned char*)lds_raw;
    const int tid = opaque_tid(), G = gridDim.x;
    volatile LAS unsigned* misc = (volatile LAS unsigned*)(lds + 147456 - 64);
    if (tid < 16) misc[tid] = 0u;
    if (tid < 39) ((LAS unsigned long long*)(lds + PTAB_OFF))[tid] = ((const unsigned long long*)&a)[tid];
    __syncthreads();
    unsigned* ctl = (unsigned*)(ctx_ws(lds) + WS_CTL);
    XcdBarrier bar; bar.bar = ctl + CW_BAR; bar.x = 0; bar.st = misc;
    if (MK_N_LAUNCHES == 1) bar = xcd_barrier_post(ctl + CW_BAR, misc);
    const int lo = a.ph_lo, hi = a.ph_hi & 0xff, rmask = (a.ph_hi >> 8) & 0xff;
#ifndef PH_MASK
#define PH_MASK 0xFFFu
#endif
#define PHM(b) ((PH_MASK >> (b)) & 1u)
#define IN(k) (lo <= (k) && (k) < hi)
#define SEAM(k) do { if (MK_N_LAUNCHES == 1 && IN(k) && IN((k) + 1)) xcd_barrier(bar); } while (0)
    if (PHM(0) && IN(0)) { phase_prologue(lds, opq(G)); SEAM(0); }
#pragma nounroll
    for (int l = 0; l < 2; ++l) {
        const int pb = 1 + 10 * l;
        if (PHM(1) && IN(pb + 0)) { phase_norm(lds, opq(G), ctx_in(lds, I_NORM1) + opq(l) * 2048, opq(l) == 0); SEAM(pb + 0); }
        if (PHM(2) && IN(pb + 1)) {
            pg8::Gemm g{(const bf16_t*)(ctx_ws(lds) + WS_H), (const bf16_t*)(ctx_ws(lds) + WS_W + (size_t)opq(l) * LW_BYTES + LW_WIN), MPAD, NINP, 2048, 2048, 2048};
            pg8::StaticOrder S; S.init(MPAD, NINP, opq(G), (int)blockIdx.x);
            pg8::EpiProj E{(bf16_t*)(ctx_ws(lds) + WS_PROJ), NINP};
            pg8::gemm_phase(lds, g, S, E);
            SEAM(pb + 1);
        }
        if (PHM(3) && IN(pb + 2)) { phase_pre(lds, opq(l), opq(G)); SEAM(pb + 2); }
        if (PHM(4) && IN(pb + 3)) { phase_scan(lds, opq(l), opq(G), (unsigned*)(ctx_ws(lds) + WS_CTL) + CW_QUEUE + 64 * opq(l), rmask); SEAM(pb + 3); }
        if (PHM(5) && IN(pb + 4)) { phase_post(lds, opq(l), opq(G)); SEAM(pb + 4); }
        if (PHM(6) && IN(pb + 5)) {
            pg8::StaticOrder S; S.init(MP, 2048, opq(G), (int)blockIdx.x);
            const bf16_t* obr = (const bf16_t*)(ctx_ws(lds) + WS_QM); const bf16_t* wbr = (const bf16_t*)(ctx_ws(lds) + WS_W + (size_t)opq(l) * LW_BYTES + LW_WBR);
            bf16_t* merged = (bf16_t*)(ctx_ws(lds) + WS_H); const bf16_t* gr = (const bf16_t*)(ctx_ws(lds) + WS_RPRE + RP_GR);
            { pg8::Gemm g{obr, wbr, MP, 2048, 3072, 3072, 3072}; pg8::EpiBranchK E{merged, gr}; pg8::gemm_phase(lds, g, S, E); }
            skinny_phase<1>(lds, obr, 3072, wbr, 3072, 3072, nullptr, merged, gr, nullptr, opq(G));
            SEAM(pb + 5);
        }
        if (PHM(7) && IN(pb + 6)) {
            pg8::Gemm g{(const bf16_t*)(ctx_ws(lds) + WS_H), (const bf16_t*)(ctx_ws(lds) + WS_W + (size_t)opq(l) * LW_BYTES + LW_WOUT), MP, 2048, 2048, 2048, 2048};
            pg8::StaticOrder S; S.init(MP, 2048, opq(G), (int)blockIdx.x);
            pg8::EpiResid E{(float*)(ctx_ws(lds) + WS_X), 2048};
            pg8::gemm_phase(lds, g, S, E);
            skinny_phase<0>(lds, g.A, 2048, g.Bt, 2048, 2048, (float*)(ctx_ws(lds) + WS_X), nullptr, nullptr, nullptr, opq(G));
            SEAM(pb + 6);
        }
        if (PHM(8) && IN(pb + 7)) { phase_norm(lds, opq(G), ctx_in(lds, I_NORM2) + opq(l) * 2048, false); SEAM(pb + 7); }
        if (PHM(9) && IN(pb + 8)) {
            pg8::Gemm g{(const bf16_t*)(ctx_ws(lds) + WS_H), (const bf16_t*)(ctx_ws(lds) + WS_W + (size_t)opq(l) * LW_BYTES + LW_WGU), MPAD, 11264, 2048, 2048, 2048};
            pg8::StaticOrder S; S.init(MPAD, 11264, opq(G), (int)blockIdx.x);
            pg8::EpiSwiGLU E{(bf16_t*)(ctx_ws(lds) + WS_PROJ), DFF};
            pg8::gemm_phase(lds, g, S, E);
            SEAM(pb + 8);
        }
        if (PHM(10) && IN(pb + 9)) {
            pg8::Gemm g{(const bf16_t*)(ctx_ws(lds) + WS_PROJ), (const bf16_t*)(ctx_ws(lds) + WS_W + (size_t)opq(l) * LW_BYTES + LW_WDN), MP, 2048, DFF, DFF, DFF};
            pg8::StaticOrder S; S.init(MP, 2048, opq(G), (int)blockIdx.x);
            pg8::EpiResid E{(float*)(ctx_ws(lds) + WS_X), 2048};
            pg8::gemm_phase(lds, g, S, E);
            skinny_phase<0>(lds, g.A, DFF, g.Bt, DFF, DFF, (float*)(ctx_ws(lds) + WS_X), nullptr, nullptr, nullptr, opq(G));
            SEAM(pb + 9);
        }
    }
    if (PHM(11) && IN(21)) phase_final(lds, opq(G));
    if (IN(22)) phase_dump(lds, G);
#undef IN
#undef SEAM
}

extern "C" void kernel_launch(void* const* d_in, const int* in_sizes, int n_in, void* d_out, int out_size, void* d_ws, size_t ws_size, hipStream_t stream) {
    static int grid = 0;
    if (grid == 0) {
        if (n_in != 37 || ws_size < WS_END) { fprintf(stderr, "kernel_launch: expected 37 inputs and >= %zu bytes of workspace; got %d, %zu\n", (size_t)WS_END, n_in, ws_size); grid = -1; return; }
        int dev = 0, cus = 0, per_cu = 0;
        if (hipGetDevice(&dev) != hipSuccess || hipDeviceGetAttribute(&cus, hipDeviceAttributeMultiprocessorCount, dev) != hipSuccess) { grid = -1; return; }
        if (hipFuncSetAttribute((const void*)fwd_kernel, hipFuncAttributeMaxDynamicSharedMemorySize, LDS_BYTES) != hipSuccess) { fprintf(stderr, "kernel_launch: hipFuncSetAttribute failed\n"); grid = -1; return; }
        if (hipOccupancyMaxActiveBlocksPerMultiprocessor(&per_cu, (const void*)fwd_kernel, NTHREADS, LDS_BYTES) != hipSuccess || per_cu < 1) { fprintf(stderr, "kernel_launch: occupancy query says %d\n", per_cu); }
        (void)hipGetLastError();
        grid = cus;
    }
    if (grid < 0) return;
    (void)hipMemsetAsync((char*)d_ws + WS_CTL, 0, CTL_BYTES, stream);
    Args a{};
    for (int i = 0; i < 37; ++i) a.in[i] = (const float*)d_in[i];
    a.out = (float*)d_out; a.ws = (unsigned char*)d_ws;
    if (MK_N_LAUNCHES == 1) { a.ph_lo = 0; a.ph_hi = N_PHASES; hipLaunchKernelGGL(fwd_kernel, dim3(grid), dim3(NTHREADS), LDS_BYTES, stream, a); }
    else { for (int p = 0; p < DBG_LIM; ++p) { a.ph_lo = p; a.ph_hi = p + 1; hipLaunchKernelGGL(fwd_kernel, dim3(grid), dim3(NTHREADS), LDS_BYTES, stream, a);
            const int kind = p == 0 ? 0 : (p == 21 ? 11 : 1 + (p - 1) % 10);
            if ((DBG_REP_MASK >> kind) & 1) { a.ph_hi = (p + 1) | (DBG_ROLE_MASK << 8); hipLaunchKernelGGL(fwd_kernel, dim3(grid), dim3(NTHREADS), LDS_BYTES, stream, a); } }
        if (DBG_LIM < 22) { a.ph_lo = 22; a.ph_hi = 23; hipLaunchKernelGGL(fwd_kernel, dim3(grid), dim3(NTHREADS), LDS_BYTES, stream, a); } }
}
```

```cpp
#include <hip/hip_runtime.h>
#include <cstdio>
#include <cstdint>

#ifndef MK_N_LAUNCHES
#define MK_N_LAUNCHES 1
#endif

#ifndef DBG_LIM
#define DBG_LIM 22
#ifndef DBG_ROLE_MASK
#define DBG_ROLE_MASK 0
#endif
#ifndef DBG_REP_MASK
#define DBG_REP_MASK 0
#endif
#define DBG_SEL 2
#endif
#define LAS __attribute__((address_space(3)))
typedef unsigned short bf16_t;
typedef short bf16x8 __attribute__((ext_vector_type(8)));
typedef float f32x4 __attribute__((ext_vector_type(4)));
typedef unsigned u32x4 __attribute__((ext_vector_type(4)));
typedef unsigned u32x2 __attribute__((ext_vector_type(2)));

constexpr int DM = 2048, MP = 8192, MT = 8320, MPAD = 8448, NINP = 16640, NIN = 16600;
constexpr int RC = 3264, M0 = 3264, G0 = 7368, GT0 = 10456, DFF = 5632;
constexpr int NTHREADS = 512;
constexpr size_t O_YP = 0, O_YS = 16777216, O_PSHIFT = 17039360, O_PWKV = 17065472, O_PCONV = 17589760, O_PC = 17638912, O_PN = 19736064, O_PM = 19744256,
                 O_PGLA = 19744288, O_SSHIFT = 20792864, O_SWKV = 21628448, O_SCONV = 38405664, O_SC = 39978528, O_SN = 107087392, O_SM = 107349536, O_SGLA = 107350560;
constexpr size_t AL(size_t x) { return (x + 255) & ~(size_t)255; }
constexpr size_t WS_CTL = 0, CTL_BYTES = 1u << 20;
constexpr size_t LW_WIN = 0, LW_WBR = LW_WIN + (size_t)NINP * 2048 * 2, LW_WOUT = LW_WBR + (size_t)3 * 2048 * 1024 * 2, LW_WGU = LW_WOUT + (size_t)2048 * 2048 * 2,
                 LW_WDN = LW_WGU + (size_t)11264 * 2048 * 2, LW_LORA = LW_WDN + (size_t)2048 * 5632 * 2, LW_GA2 = LW_LORA + (size_t)3 * 1024 * 64 * 2, LW_BYTES = LW_GA2 + (size_t)512 * 32 * 2;
constexpr size_t WS_W = CTL_BYTES;
constexpr size_t WS_X = AL(WS_W + 2 * LW_BYTES);
constexpr size_t WS_H = AL(WS_X + (size_t)MPAD * 2048 * 4);
constexpr size_t WS_PROJ = AL(WS_H + (size_t)MPAD * 2048 * 2);
constexpr size_t ARR = (size_t)MT * 1024;
constexpr size_t WS_RPRE = AL(WS_PROJ + (size_t)MPAD * NINP * 2);
constexpr size_t WS_ROUT = AL(WS_RPRE + 7 * ARR * 4);
constexpr size_t WS_QM = AL(WS_ROUT + ARR * 4);
constexpr size_t WS_KM = WS_QM + ARR * 2, WS_GQ = WS_KM + ARR * 2, WS_GK = WS_GQ + ARR, WS_GKH = WS_GK + ARR;
constexpr size_t WS_GATES = AL(WS_GKH + ARR);
constexpr size_t WS_EGL = AL(WS_GATES + (size_t)MT * 8 * 4);
constexpr size_t WS_HM = AL(WS_EGL + (size_t)256 * 512 * 4);
constexpr size_t WS_OG = AL(WS_HM + ARR * 4);
constexpr size_t WS_END = AL(WS_OG + ARR * 4);
static_assert((size_t)MPAD * 3072 * 2 <= WS_GATES - WS_QM, "obr alias");
static_assert((size_t)MPAD * 2048 * 4 <= 7 * ARR * 4, "macc alias");

__device__ __forceinline__ float bf2f(bf16_t b) { return __uint_as_float(((unsigned)b) << 16); }
typedef __bf16 bf16x2_t __attribute__((ext_vector_type(2)));
typedef float f32x2_t __attribute__((ext_vector_type(2)));
__device__ __forceinline__ unsigned pk2(float lo, float hi) { const f32x2_t v = {lo, hi}; return __builtin_bit_cast(unsigned, __builtin_convertvector(v, bf16x2_t)); }
__device__ __forceinline__ bf16_t f2bf(float f) { return (bf16_t)(pk2(f, 0.f) & 0xffffu); }
__device__ __forceinline__ void unpack8(const u32x4 w, float (&f)[8]) {
    f[0] = __uint_as_float(w.x << 16); f[1] = __uint_as_float(w.x & 0xffff0000u); f[2] = __uint_as_float(w.y << 16); f[3] = __uint_as_float(w.y & 0xffff0000u);
    f[4] = __uint_as_float(w.z << 16); f[5] = __uint_as_float(w.z & 0xffff0000u); f[6] = __uint_as_float(w.w << 16); f[7] = __uint_as_float(w.w & 0xffff0000u);
}
__device__ __forceinline__ u32x4 pack8(const float (&f)[8]) { u32x4 w; w.x = pk2(f[0], f[1]); w.y = pk2(f[2], f[3]); w.z = pk2(f[4], f[5]); w.w = pk2(f[6], f[7]); return w; }
__device__ __forceinline__ void ld8f(const float* p, float (&f)[8]) { const f32x4 a = *(const f32x4*)p, b = *(const f32x4*)(p + 4); f[0] = a.x; f[1] = a.y; f[2] = a.z; f[3] = a.w; f[4] = b.x; f[5] = b.y; f[6] = b.z; f[7] = b.w; }
__device__ __forceinline__ void st8f(float* p, const float (&f)[8]) { *(f32x4*)p = (f32x4){f[0], f[1], f[2], f[3]}; *(f32x4*)(p + 4) = (f32x4){f[4], f[5], f[6], f[7]}; }
__device__ __forceinline__ void ld8b(const bf16_t* p, float (&f)[8]) { unpack8(*(const u32x4*)p, f); }
__device__ __forceinline__ float sigm(float x) { return 1.f / (1.f + __expf(-x)); }
__device__ __forceinline__ float siluf(float x) { return x / (1.f + __expf(-x)); }
__device__ __forceinline__ float tanh_fast(float x) { const float e = __expf(2.f * x); return 1.f - 2.f / (e + 1.f); }
__device__ __forceinline__ float logsig_fast(float x) { return fminf(x, 0.f) - __logf(1.f + __expf(-fabsf(x))); }
__device__ __forceinline__ float wave_sum(float v) {
#pragma unroll
    for (int o = 1; o < 64; o <<= 1) v += __shfl_xor(v, o);
    return v;
}
template <int CTRL> __device__ __forceinline__ float dppf(float v) { return __int_as_float(__builtin_amdgcn_update_dpp(0, __float_as_int(v), CTRL, 0xF, 0xF, true)); }
__device__ __forceinline__ float row16_sum(float x) { x += dppf<0xB1>(x); x += dppf<0x4E>(x); x += dppf<0x141>(x); x += dppf<0x140>(x); return x; }
__device__ __forceinline__ float quad_sum(float x) { x += dppf<0xB1>(x); x += dppf<0x4E>(x); return x; }
__device__ __forceinline__ int opq(int x) { asm volatile("" : "+s"(x)); return x; }
__device__ __forceinline__ int opaque_tid() { int t = threadIdx.x; asm volatile("" : "+v"(t)); return t; }
__device__ __forceinline__ f32x4 mfma16_safe(const bf16x8 a, const bf16x8 b, const f32x4 c) { f32x4 d = __builtin_amdgcn_mfma_f32_16x16x32_bf16(a, b, c, 0, 0, 0); asm volatile("" : "+v"(d) : "v"(a), "v"(b)); return d; }
#define MFMA16(a, b, c) mfma16_safe((a), (b), (c))
#define LDS_WAIT() asm volatile("s_waitcnt lgkmcnt(0)" ::: "memory")

#define XB_TMO      128
#define XB_XCNT(j)  (256  + 64 * (j))
#define XB_XSUB(j)  (1280 + 64 * (j))
#define XB_XGEN(j)  (2304 + 64 * (j))
#define XB_TOP      3328
#define XB_TOPGEN   3392
#define XCD_BAR_WORDS 3456
#define XB_SPIN_CAP (1u << 18)
__device__ __forceinline__ unsigned xb_ld(unsigned* p)              { return __hip_atomic_load(p, __ATOMIC_RELAXED, __HIP_MEMORY_SCOPE_AGENT); }
__device__ __forceinline__ unsigned xb_add(unsigned* p, unsigned v) { return __hip_atomic_fetch_add(p, v, __ATOMIC_RELAXED, __HIP_MEMORY_SCOPE_AGENT); }
__device__ __forceinline__ unsigned xb_xcc_id() { return (unsigned)__builtin_amdgcn_s_getreg((3 << 11) | 20) & 0xFu; }
#define XB_SPIN(cond, bar) do { unsigned _sp = 0; while (cond) { __builtin_amdgcn_s_sleep(1); \
    if ((++_sp & 255u) == 0u) { if (xb_ld(&(bar)[XB_TMO])) break; if (_sp > XB_SPIN_CAP) { atomicAdd(&(bar)[XB_TMO], 1u); break; } } } } while (0)
struct XcdBarrier { unsigned* bar; unsigned x; volatile LAS unsigned* st; };
__device__ __forceinline__ XcdBarrier xcd_barrier_post(unsigned* bar, volatile LAS unsigned* st) {
    XcdBarrier b; b.bar = bar; b.x = xb_xcc_id(); b.st = st;
    if (threadIdx.x == 0) (void)xb_add(&bar[XB_XCNT(b.x)], 1u);
    return b;
}
__device__ __forceinline__ void xcd_barrier_complete(unsigned* bar, unsigned x, unsigned& nloc, unsigned& nx) {
    const unsigned G = gridDim.x * gridDim.y * gridDim.z;
    unsigned sum, cnt, mine, sp = 0u;
    for (;;) {
        sum = 0u; cnt = 0u; mine = 0u;
#pragma unroll
        for (unsigned j = 0; j < 16; ++j) { const unsigned c = xb_ld(&bar[XB_XCNT(j)]); sum += c; cnt += (c > 0u) ? 1u : 0u; mine = (j == x) ? c : mine; }
        if (sum == G) break;
        __builtin_amdgcn_s_sleep(1);
        if ((++sp & 255u) == 0u) { if (xb_ld(&bar[XB_TMO])) break; if (sp > XB_SPIN_CAP) { atomicAdd(&bar[XB_TMO], 1u); break; } }
    }
    nloc = mine > 0u ? mine : 1u; nx = cnt > 0u ? cnt : 1u;
}
__device__ __forceinline__ void xcd_barrier(const XcdBarrier& b) {
    asm volatile("s_waitcnt vmcnt(0)" ::: "memory");
    __syncthreads();
    if (threadIdx.x == 0) {
        unsigned* bar = b.bar;
        __builtin_amdgcn_s_waitcnt(0);
        unsigned nloc = b.st[0], nx = b.st[1];
        if (nloc == 0u) { xcd_barrier_complete(bar, b.x, nloc, nx); b.st[0] = nloc; b.st[1] = nx; }
        const unsigned old = xb_add(&bar[XB_XSUB(b.x)], 1u);
        const unsigned gen = old / nloc;
        if (old + 1u == (gen + 1u) * nloc) {
            __builtin_amdgcn_fence(__ATOMIC_RELEASE, "agent");
            asm volatile("s_waitcnt vmcnt(0)" ::: "memory");
            const unsigned og = xb_add(&bar[XB_TOP], 1u);
            const unsigned tg = og / nx;
            if (og + 1u == (tg + 1u) * nx) xb_add(&bar[XB_TOPGEN], 1u);
            else XB_SPIN(xb_ld(&bar[XB_TOPGEN]) == tg, bar);
            __builtin_amdgcn_fence(__ATOMIC_ACQUIRE, "agent");
            xb_add(&bar[XB_XGEN(b.x)], 1u);
            asm volatile("s_waitcnt vmcnt(0)" ::: "memory");
        } else {
            XB_SPIN(xb_ld(&bar[XB_XGEN(b.x)]) == gen, bar);
            __builtin_amdgcn_fence(__ATOMIC_ACQUIRE, "agent");
            asm volatile("s_waitcnt vmcnt(0)" ::: "memory");
        }
    }
    __syncthreads();
}

namespace pg8 {
constexpr int BM = 256, BK = 64, HALF = 128, HTB = HALF * BK * 2, STAGE_BYTES = 8 * HTB, NXCD = 8, WGM = 8;
__host__ __device__ __forceinline__ int lds_byte(int r, int c) { const int st = (r >> 4) * 2 + (c >> 5), rr = r & 15, cc = c & 31, ob = rr * 64 + cc * 2; return st * 1024 + (ob ^ (((ob >> 9) & 1) << 5)); }
__host__ __device__ __forceinline__ void stage_rc(int b, int& R, int& C) { const int st = b / 1024, sb = b % 1024, swz = sb ^ (((sb >> 9) & 1) << 5); R = (st >> 1) * 16 + swz / 64; C = (st & 1) * 32 + (swz % 64) / 2; }
__host__ __device__ __forceinline__ int perm32(int rho) { const int n = rho >> 4, i = rho & 15; return 8 * (i >> 2) + 4 * n + (i & 3); }
struct Unit { int pm, pn; };
struct Gemm { const bf16_t* A; const bf16_t* Bt; int M, N, K, lda, ldb; };
struct StaticOrder {
    int nM, nN, nwg, G, c;
    __device__ void init(int M, int N, int G_, int c_) { nM = M / BM; nN = N / BM; nwg = nM * nN; G = G_; c = c_; }
    __device__ bool next(int i, Unit& u) const {
        const long L = (long)i * G + c; if (L >= nwg) return false;
        int wgid = (int)L; { const int q = nwg / NXCD, r = nwg % NXCD, xcd = wgid % NXCD, off = wgid / NXCD; wgid = (xcd < r ? xcd * (q + 1) : r * (q + 1) + (xcd - r) * q) + off; }
        const int nig = WGM * nN, gid = wgid / nig, fm = gid * WGM, gsz = (nM - fm) < WGM ? (nM - fm) : WGM;
        u.pm = fm + ((wgid % nig) % gsz); u.pn = (wgid % nig) / gsz; return true;
    }
};
struct EpiProj {
    static constexpr bool PERM = true, HOOK = false;
    bf16_t* O; int ldc;
    __device__ __forceinline__ void operator()(const f32x4 (&acc)[2][2][4][2], const Unit& u, int wr, int wc, int fr, int fq) const {
        const int row0 = u.pm * BM + wr * 64 + fr, col0 = u.pn * BM + wc * 32 + 8 * fq;
#pragma unroll
        for (int ai = 0; ai < 2; ++ai)
#pragma unroll
            for (int m = 0; m < 4; ++m) { bf16_t* rowp = O + (size_t)(row0 + ai * HALF + m * 16) * ldc + col0;
#pragma unroll
                for (int bj = 0; bj < 2; ++bj) { const f32x4 v0 = acc[ai][bj][m][0], v1 = acc[ai][bj][m][1];
                    u32x4 w; w.x = pk2(v0[0], v0[1]); w.y = pk2(v0[2], v0[3]); w.z = pk2(v1[0], v1[1]); w.w = pk2(v1[2], v1[3]);
                    *(u32x4*)(rowp + bj * HALF) = w; } }
    }
};
struct EpiSwiGLU {
    static constexpr bool PERM = true, HOOK = false;
    bf16_t* O; int ldc;
    __device__ __forceinline__ void operator()(const f32x4 (&acc)[2][2][4][2], const Unit& u, int wr, int wc, int fr, int fq) const {
        const int row0 = u.pm * BM + wr * 64 + fr, col0 = u.pn * HALF + wc * 32 + 8 * fq;
#pragma unroll
        for (int ai = 0; ai < 2; ++ai)
#pragma unroll
            for (int m = 0; m < 4; ++m) { bf16_t* rowp = O + (size_t)(row0 + ai * HALF + m * 16) * ldc + col0;
                float o[8];
#pragma unroll
                for (int n = 0; n < 2; ++n)
#pragma unroll
                    for (int j = 0; j < 4; ++j) o[n * 4 + j] = siluf(acc[ai][0][m][n][j]) * acc[ai][1][m][n][j];
                *(u32x4*)rowp = pack8(o); }
    }
};
struct EpiResid {
    static constexpr bool PERM = false, HOOK = false;
    float* X; int ldc;
    __device__ __forceinline__ void operator()(const f32x4 (&acc)[2][2][4][2], const Unit& u, int wr, int wc, int fr, int fq) const {
        const int row0 = u.pm * BM + wr * 64 + fr, col0 = u.pn * BM + wc * 32 + 4 * fq;
#pragma unroll
        for (int ai = 0; ai < 2; ++ai) {
            f32x4 xv[4][2][2];
#pragma unroll
            for (int m = 0; m < 4; ++m)
#pragma unroll
                for (int bj = 0; bj < 2; ++bj)
#pragma unroll
                    for (int n = 0; n < 2; ++n) xv[m][bj][n] = *(const f32x4*)(X + (size_t)(row0 + ai * HALF + m * 16) * ldc + col0 + bj * HALF + n * 16);
#pragma unroll
            for (int m = 0; m < 4; ++m) asm volatile("" : "+v"(xv[m][0][0]), "+v"(xv[m][0][1]), "+v"(xv[m][1][0]), "+v"(xv[m][1][1]));
#pragma unroll
            for (int m = 0; m < 4; ++m)
#pragma unroll
                for (int bj = 0; bj < 2; ++bj)
#pragma unroll
                    for (int n = 0; n < 2; ++n) *(f32x4*)(X + (size_t)(row0 + ai * HALF + m * 16) * ldc + col0 + bj * HALF + n * 16) = xv[m][bj][n] + acc[ai][bj][m][n];
        }
    }
};
struct EpiBranchK {
    static constexpr bool PERM = true, HOOK = true;
    bf16_t* merged; const bf16_t* gr;
    __device__ __forceinline__ void hook(f32x4 (&acc)[2][2][4][2], const Unit& u, int jn, int wr, int wc, int fr, int fq) const {
        int row0 = u.pm * BM + wr * 64 + fr, col0 = u.pn * BM + wc * 32 + 8 * fq;
        asm volatile("" : "+v"(row0), "+v"(col0));
        u32x4 rv[2][4][2];
#pragma unroll
        for (int ai = 0; ai < 2; ++ai)
#pragma unroll
            for (int m = 0; m < 4; ++m)
#pragma unroll
                for (int bj = 0; bj < 2; ++bj) rv[ai][m][bj] = *(const u32x4*)(gr + (size_t)(row0 + ai * HALF + m * 16) * 6144 + (jn - 1) * 2048 + col0 + bj * HALF);
#pragma unroll
        for (int ai = 0; ai < 2; ++ai)
#pragma unroll
            for (int m = 0; m < 4; ++m)
#pragma unroll
                for (int bj = 0; bj < 2; ++bj) { float r[8]; unpack8(rv[ai][m][bj], r);
#pragma unroll
                    for (int i = 0; i < 8; ++i) acc[ai][bj][m][i >> 2][i & 3] *= r[i]; }
    }
    __device__ __forceinline__ void operator()(const f32x4 (&acc)[2][2][4][2], const Unit& u, int wr, int wc, int fr, int fq) const {
        const int row0 = u.pm * BM + wr * 64 + fr, col0 = u.pn * BM + wc * 32 + 8 * fq;
        u32x4 rv[2][4][2];
#pragma unroll
        for (int ai = 0; ai < 2; ++ai)
#pragma unroll
            for (int m = 0; m < 4; ++m)
#pragma unroll
                for (int bj = 0; bj < 2; ++bj) rv[ai][m][bj] = *(const u32x4*)(gr + (size_t)(row0 + ai * HALF + m * 16) * 6144 + 4096 + col0 + bj * HALF);
#pragma unroll
        for (int ai = 0; ai < 2; ++ai)
#pragma unroll
            for (int m = 0; m < 4; ++m) asm volatile("" : "+v"(rv[ai][m][0]), "+v"(rv[ai][m][1]));
#pragma unroll
        for (int ai = 0; ai < 2; ++ai)
#pragma unroll
            for (int m = 0; m < 4; ++m) { const int row = row0 + ai * HALF + m * 16;
#pragma unroll
                for (int bj = 0; bj < 2; ++bj) { float r[8], o[8]; unpack8(rv[ai][m][bj], r);
#pragma unroll
                    for (int i = 0; i < 8; ++i) o[i] = acc[ai][bj][m][i >> 2][i & 3] * r[i];
                    *(u32x4*)(merged + (size_t)row * 2048 + col0 + bj * HALF) = pack8(o); } }
    }
};

template <class Epi>
__device__ __forceinline__ void gemm_phase(LAS unsigned char* lds, const Gemm g, const StaticOrder& S, const Epi& E) {
    const int tid = opaque_tid(), wid = __builtin_amdgcn_readfirstlane(tid >> 6), lane = tid & 63, wr = wid >> 2, wc = wid & 3, fr = lane & 15, fq = lane >> 4;
    const int K = g.K, nt = K / BK;
    unsigned voffA[2], voffB[2];
#pragma unroll
    for (int i = 0; i < 2; ++i) { int R, C; stage_rc(tid * 16 + i * 8192, R, C); const int Rb = Epi::PERM ? ((R & ~31) + perm32(R & 31)) : R;
        voffA[i] = (unsigned)(R * g.lda + C) * 2u; voffB[i] = (unsigned)(Rb * g.ldb + C) * 2u; }
    const size_t kstep = (size_t)(BK * 2);
    const size_t hstepA = (size_t)HALF * g.lda * 2, hstepB = (size_t)HALF * g.ldb * 2;
    const size_t tstepA = 2 * hstepA, tstepB = 2 * hstepB;
    const unsigned ldsw = (unsigned)wid * 1024u;
    const int aoff = lds_byte(wr * 64 + fr, fq * 8), boff = lds_byte(wc * 32 + fr, fq * 8);
#define PG8_SA(b, h) (((b) * 2 + (h)) * HTB)
#define PG8_SB(b, h) ((4 + (b) * 2 + (h)) * HTB)
#define PG8_STAGE(bufoff, gbase, voff) do { _Pragma("unroll") for (int _i = 0; _i < 2; ++_i) \
        __builtin_amdgcn_global_load_lds((const unsigned*)((const char*)(gbase) + (voff)[_i]), (LAS unsigned*)(lds + (bufoff) + ldsw + _i * 8192), 16, 0, 0); } while (0)
#define PG8_LDA(dst, b, h) do { _Pragma("unroll") for (int m = 0; m < 4; ++m) _Pragma("unroll") for (int k = 0; k < 2; ++k) dst[m][k] = *(const LAS bf16x8*)(lds + PG8_SA(b, h) + aoff + m * 2048 + k * 1024); } while (0)
#define PG8_LDB(dst, b, h) do { _Pragma("unroll") for (int n = 0; n < 2; ++n) _Pragma("unroll") for (int k = 0; k < 2; ++k) dst[n][k] = *(const LAS bf16x8*)(lds + PG8_SB(b, h) + boff + n * 2048 + k * 1024); } while (0)
#define PG8_MMA(ai, bj, At, Bt) do { __builtin_amdgcn_s_setprio(1); _Pragma("unroll") for (int m = 0; m < 4; ++m) _Pragma("unroll") for (int n = 0; n < 2; ++n) _Pragma("unroll") for (int k = 0; k < 2; ++k) \
        acc[ai][bj][m][n] = __builtin_amdgcn_mfma_f32_16x16x32_bf16(Bt[n][k], At[m][k], acc[ai][bj][m][n], 0, 0, 0); __builtin_amdgcn_s_setprio(0); } while (0)
#define PG8_WAIT_V(n) asm volatile("s_waitcnt vmcnt(" #n ")" ::: "memory")
#define PG8_WAIT_L(n) asm volatile("s_waitcnt lgkmcnt(" #n ")" ::: "memory")
#define PG8_BAR __builtin_amdgcn_s_barrier()
#define PG8_SCHED __builtin_amdgcn_sched_barrier(0)
    Unit cur, nxt; int ui = 0;
    if (!S.next(0, cur)) return;
    f32x4 acc[2][2][4][2];
#pragma unroll
    for (int a = 0; a < 2; ++a)
#pragma unroll
        for (int b = 0; b < 2; ++b)
#pragma unroll
            for (int m = 0; m < 4; ++m)
#pragma unroll
                for (int n = 0; n < 2; ++n) acc[a][b][m][n] = (f32x4){0.f, 0.f, 0.f, 0.f};
    bf16x8 At[4][2], B0[2][2], B1[2][2];
    const char* cA = (const char*)g.A + (size_t)cur.pm * tstepA; const char* cB = (const char*)g.Bt + (size_t)cur.pn * tstepB;
    PG8_STAGE(PG8_SB(0, 0), cB, voffB); PG8_STAGE(PG8_SA(0, 0), cA, voffA); PG8_STAGE(PG8_SB(0, 1), cB + hstepB, voffB); PG8_STAGE(PG8_SA(0, 1), cA + hstepA, voffA);
    if (wr == 1) PG8_BAR;
    PG8_WAIT_V(4); PG8_BAR;
    PG8_STAGE(PG8_SB(1, 0), cB + kstep, voffB); PG8_STAGE(PG8_SA(1, 0), cA + kstep, voffA); PG8_STAGE(PG8_SB(1, 1), cB + hstepB + kstep, voffB);
    PG8_WAIT_V(6); PG8_BAR;
    for (;;) {
        const bool has_next = S.next(ui + 1, nxt);
        const char* nA = has_next ? (const char*)g.A + (size_t)nxt.pm * tstepA : cA; const char* nB = has_next ? (const char*)g.Bt + (size_t)nxt.pn * tstepB : cB;
        for (int t = 0; t < nt; t += 2) {
            const bool last = (t == nt - 2);
            const char* a1 = cA + (size_t)(t + 1) * kstep;
            const char* a2 = last ? nA : cA + (size_t)(t + 2) * kstep; const char* b2 = last ? nB : cB + (size_t)(t + 2) * kstep;
            const char* a3 = a2 + kstep; const char* b3 = b2 + kstep;
            if constexpr (Epi::HOOK) { if (t == 16 || t == 32) E.hook(acc, cur, t >> 4, wr, wc, fr, fq); }
            PG8_LDB(B0, 0, 0); PG8_SCHED; PG8_LDA(At, 0, 0); PG8_STAGE(PG8_SA(1, 1), a1 + hstepA, voffA);
            PG8_WAIT_L(8); PG8_BAR; PG8_WAIT_L(0); PG8_MMA(0, 0, At, B0); PG8_BAR; PG8_SCHED;
            PG8_LDB(B1, 0, 1); PG8_STAGE(PG8_SB(0, 0), b2, voffB);
            PG8_BAR; PG8_WAIT_L(0); PG8_MMA(0, 1, At, B1); PG8_BAR;
            PG8_LDA(At, 0, 1); PG8_STAGE(PG8_SA(0, 0), a2, voffA);
            PG8_BAR; PG8_WAIT_L(0); PG8_MMA(1, 0, At, B0); PG8_BAR; PG8_SCHED;
            PG8_STAGE(PG8_SB(0, 1), b2 + hstepB, voffB);
            PG8_WAIT_V(6); PG8_BAR; PG8_MMA(1, 1, At, B1); PG8_BAR;
            PG8_LDB(B0, 1, 0); PG8_SCHED; PG8_LDA(At, 1, 0); PG8_STAGE(PG8_SA(0, 1), a2 + hstepA, voffA);
            PG8_WAIT_L(8); PG8_BAR; PG8_WAIT_L(0); PG8_MMA(0, 0, At, B0); PG8_BAR; PG8_SCHED;
            PG8_LDB(B1, 1, 1); PG8_STAGE(PG8_SB(1, 0), b3, voffB);
            PG8_BAR; PG8_WAIT_L(0); PG8_MMA(0, 1, At, B1); PG8_BAR;
            PG8_LDA(At, 1, 1); PG8_STAGE(PG8_SA(1, 0), a3, voffA);
            PG8_BAR; PG8_WAIT_L(0); PG8_MMA(1, 0, At, B0); PG8_BAR; PG8_SCHED;
            PG8_STAGE(PG8_SB(1, 1), b3 + hstepB, voffB);
            PG8_WAIT_V(6); PG8_BAR; PG8_MMA(1, 1, At, B1); PG8_BAR;
        }
        E(acc, cur, wr, wc, fr, fq);
        if (!has_next) break;
#pragma unroll
        for (int a = 0; a < 2; ++a)
#pragma unroll
            for (int b = 0; b < 2; ++b)
#pragma unroll
                for (int m = 0; m < 4; ++m)
#pragma unroll
                    for (int n = 0; n < 2; ++n) acc[a][b][m][n] = (f32x4){0.f, 0.f, 0.f, 0.f};
        cur = nxt; cA = nA; cB = nB; ++ui;
    }
    PG8_WAIT_V(0);
    if (wr == 0) PG8_BAR;
    PG8_BAR;
#undef PG8_SA
#undef PG8_SB
#undef PG8_STAGE
#undef PG8_LDA
#undef PG8_LDB
#undef PG8_MMA
#undef PG8_WAIT_V
#undef PG8_WAIT_L
#undef PG8_BAR
#undef PG8_SCHED
}
}

constexpr size_t RP_W = 6 * ARR * 2, RP_GR = RP_W + ARR * 4;
static_assert(RP_GR + (size_t)MT * 6144 * 2 <= 7 * ARR * 4, "RPRE region");
struct Args { const float* in[37]; float* out; unsigned char* ws; int ph_lo, ph_hi; };
enum { I_XP = 0, I_XS, I_SSHIFT, I_SWKV, I_SCONV, I_SC, I_SN, I_SM, I_SGLA, I_NORM1, I_WIN, I_GATEB, I_MU, I_W0, I_W2, I_A0, I_A2, I_G2, I_KK, I_KA, I_RK, I_LNG, I_LNB,
       I_CONVW, I_CONVB, I_IB, I_FB, I_MNORM, I_GA2, I_GAB, I_GNORM, I_WBR, I_WOUT, I_NORM2, I_WGU, I_WDN, I_FNORM };

constexpr int LDS_BYTES = 147456;
constexpr int PTAB_OFF = LDS_BYTES - 1024;
__device__ __forceinline__ unsigned long long ctx_raw(LAS unsigned char* lds, int i) {
    const unsigned long long v = ((const LAS unsigned long long*)(lds + PTAB_OFF))[i];
    const unsigned lo = __builtin_amdgcn_readfirstlane((unsigned)v), hi = __builtin_amdgcn_readfirstlane((unsigned)(v >> 32));
    return ((unsigned long long)hi << 32) | lo;
}
#define GAS __attribute__((address_space(1)))
__device__ __forceinline__ const float* ctx_in(LAS unsigned char* lds, int i) { return (const float*)(const GAS float*)ctx_raw(lds, i); }
__device__ __forceinline__ float* ctx_out(LAS unsigned char* lds) { return (float*)(GAS float*)ctx_raw(lds, 37); }
__device__ __forceinline__ unsigned char* ctx_ws(LAS unsigned char* lds) { return (unsigned char*)(GAS unsigned char*)ctx_raw(lds, 38); }

struct TrD { const float* p; bf16_t* dst; int ldw, K; bool ok; };
__device__ __forceinline__ TrD tr_decode(LAS unsigned char* lds, int it, int lane) {
    constexpr int I_IN = 32 * 519, I_BR = 3 * 16 * 64, I_OUT = 32 * 64, I_GU = 32 * 352, I_DN = 88 * 64, I_LO = 3 * 32, PER_L = I_IN + I_BR + I_OUT + I_GU + I_DN + I_LO;
    const int l = it / PER_L; int r = it % PER_L;
    unsigned char* wl = ctx_ws(lds) + WS_W + (size_t)l * LW_BYTES;
    const float* W; bf16_t* WT; int ldw, K, k0, n0, nv = 32, drow0, dk = 0;
    if (r < I_IN) { const int kb = r / 519, nb = r % 519; nv = (NIN - nb * 32) < 32 ? (NIN - nb * 32) : 32;
        W = ctx_in(lds, I_WIN) + (size_t)l * 2048 * NIN; ldw = NIN; k0 = kb * 64; n0 = nb * 32; WT = (bf16_t*)(wl + LW_WIN); K = 2048; drow0 = nb * 32; }
    else if ((r -= I_IN) < I_BR) { const int j = r / 1024, q = r % 1024, kb = q / 64, nb = q % 64;
        W = ctx_in(lds, I_WBR) + (size_t)(l * 3 + j) * 1024 * 2048; ldw = 2048; k0 = kb * 64; n0 = nb * 32; WT = (bf16_t*)(wl + LW_WBR); K = 3072; drow0 = nb * 32; dk = j * 1024; }
    else if ((r -= I_BR) < I_OUT) { const int kb = r / 64, nb = r % 64;
        W = ctx_in(lds, I_WOUT) + (size_t)l * 2048 * 2048; ldw = 2048; k0 = kb * 64; n0 = nb * 32; WT = (bf16_t*)(wl + LW_WOUT); K = 2048; drow0 = nb * 32; }
    else if ((r -= I_OUT) < I_GU) { const int kb = r / 352, nb = r % 352; n0 = nb * 32; const int np = n0 < DFF ? n0 : n0 - DFF;
        W = ctx_in(lds, I_WGU) + (size_t)l * 2048 * 11264; ldw = 11264; k0 = kb * 64; WT = (bf16_t*)(wl + LW_WGU); K = 2048; drow0 = 256 * (np / 128) + (np % 128) + (n0 < DFF ? 0 : 128); }
    else if ((r -= I_GU) < I_DN) { const int kb = r / 64, nb = r % 64;
        W = ctx_in(lds, I_WDN) + (size_t)l * DFF * 2048; ldw = 2048; k0 = kb * 64; n0 = nb * 32; WT = (bf16_t*)(wl + LW_WDN); K = DFF; drow0 = nb * 32; }
    else { r -= I_DN; const int mat = r / 32, nb = r % 32;
        W = (mat == 0 ? ctx_in(lds, I_W2) : (mat == 1 ? ctx_in(lds, I_A2) : ctx_in(lds, I_G2))) + (size_t)l * 64 * 1024; ldw = 1024; k0 = 0; n0 = nb * 32; WT = (bf16_t*)(wl + LW_LORA) + (size_t)mat * 1024 * 64; K = 64; drow0 = nb * 32; }
    TrD t; const int n = lane & 31; t.ok = n < nv; t.ldw = ldw; t.K = K;
    t.p = W + (size_t)(k0 + (lane >> 5)) * ldw + n0 + (t.ok ? n : 0); t.dst = WT + (size_t)drow0 * K + dk + k0; return t;
}
#define TR_PIN16(v, o) asm volatile("" : "+v"(v[o]), "+v"(v[o + 1]), "+v"(v[o + 2]), "+v"(v[o + 3]), "+v"(v[o + 4]), "+v"(v[o + 5]), "+v"(v[o + 6]), "+v"(v[o + 7]), "+v"(v[o + 8]), "+v"(v[o + 9]), "+v"(v[o + 10]), "+v"(v[o + 11]), "+v"(v[o + 12]), "+v"(v[o + 13]), "+v"(v[o + 14]), "+v"(v[o + 15]))
__device__ __forceinline__ void tr_load(const TrD& t, float (&v)[32]) {
#pragma unroll
    for (int i = 0; i < 32; ++i) v[i] = __builtin_nontemporal_load(t.p + (size_t)(2 * i) * t.ldw);
}
__device__ __forceinline__ void tr_store(const TrD& t, const float (&v)[32], LAS float* scr, int lane) {
    const int n = lane & 31;
#pragma unroll
    for (int i = 0; i < 32; ++i) scr[(2 * i + (lane >> 5)) * 33 + n] = t.ok ? v[i] : 0.f;
    LDS_WAIT();
    const int c = lane & 7;
#pragma unroll
    for (int j = 0; j < 4; ++j) { const int nn = (lane >> 3) + 8 * j; const LAS float* s = scr + (8 * c) * 33 + nn;
        u32x4 o; o.x = pk2(s[0 * 33], s[1 * 33]); o.y = pk2(s[2 * 33], s[3 * 33]); o.z = pk2(s[4 * 33], s[5 * 33]); o.w = pk2(s[6 * 33], s[7 * 33]);
        *(u32x4*)(t.dst + (size_t)nn * t.K + 8 * c) = o; }
    LDS_WAIT();
}
__device__ __forceinline__ void phase_prologue(LAS unsigned char* lds, int G) {
    const int tid = opaque_tid(), lane = tid & 63, wave = tid >> 6;
    LAS float* scr = (LAS float*)(lds + wave * 8704);
    const int gw = blockIdx.x * 8 + wave, NGW = G * 8;
    constexpr int NITEMS = 2 * (32 * 519 + 3 * 16 * 64 + 32 * 64 + 32 * 352 + 88 * 64 + 3 * 32);
    if (gw < NITEMS) {
        const int last = gw + ((NITEMS - 1 - gw) / NGW) * NGW;
        TrD ta = tr_decode(lds, gw, lane); float va[32]; tr_load(ta, va);
        for (int it = gw; it < NITEMS; it += 2 * NGW) {
            const int i1 = it + NGW <= last ? it + NGW : last, i2 = it + 2 * NGW <= last ? it + 2 * NGW : last;
            const TrD tb = tr_decode(lds, i1, lane); float vb[32]; tr_load(tb, vb);
            TR_PIN16(va, 0); TR_PIN16(va, 16);
            tr_store(ta, va, scr, lane);
            ta = tr_decode(lds, i2, lane); tr_load(ta, va);
            TR_PIN16(vb, 0); TR_PIN16(vb, 16);
            if (it + NGW < NITEMS) tr_store(tb, vb, scr, lane);
        }
    }
    const int gt = blockIdx.x * NTHREADS + tid, NGT = G * NTHREADS;
    for (int i = gt; i < 2 * 32 * 2048 / 8; i += NGT) { const int l = i / (32 * 256), q = i % (32 * 256);
        *(u32x4*)((bf16_t*)(ctx_ws(lds) + WS_W + (size_t)l * LW_BYTES + LW_WIN) + (size_t)16608 * 2048 + (size_t)q * 8) = (u32x4){0u, 0u, 0u, 0u}; }
    for (int i = gt; i < 2 * 512 * 32; i += NGT) { const int l = i / (512 * 32), q = i % (512 * 32), c = q / 32, k = q % 32;
        ((bf16_t*)(ctx_ws(lds) + WS_W + (size_t)l * LW_BYTES + LW_GA2))[q] = k < 16 ? f2bf(ctx_in(lds, I_GA2)[(size_t)l * 16 * 512 + k * 512 + c]) : (bf16_t)0; }
}

__device__ __forceinline__ void phase_norm(LAS unsigned char* lds, int G, const float* gvec, bool from_input) {
    const int tid = opaque_tid(), lane = tid & 63, wave = tid >> 6;
    float* __restrict__ xbuf = (float*)(ctx_ws(lds) + WS_X); bf16_t* __restrict__ hb = (bf16_t*)(ctx_ws(lds) + WS_H);
    for (int m = blockIdx.x * 8 + wave; m < MPAD; m += G * 8) {
        if (m >= MT) { if (from_input) {
#pragma unroll
            for (int j = 0; j < 4; ++j) *(u32x4*)(hb + (size_t)m * 2048 + (lane + 64 * j) * 8) = (u32x4){0u, 0u, 0u, 0u}; } continue; }
        const float* src = from_input ? (m < MP ? ctx_in(lds, I_XP) + (size_t)m * 2048 : ctx_in(lds, I_XS) + (size_t)(m - MP) * 2048) : xbuf + (size_t)m * 2048;
        f32x4 v[8]; float s = 0.f;
#pragma unroll
        for (int j = 0; j < 8; ++j) { v[j] = *(const f32x4*)(src + (lane + 64 * j) * 4); s += (v[j].x * v[j].x + v[j].y * v[j].y) + (v[j].z * v[j].z + v[j].w * v[j].w); }
        const float rs = rsqrtf(wave_sum(s) * (1.f / 2048.f) + 1e-6f);
#pragma unroll
        for (int j = 0; j < 8; ++j) { const int c = (lane + 64 * j) * 4; const f32x4 gg = *(const f32x4*)(gvec + c);
            if (from_input) *(f32x4*)(xbuf + (size_t)m * 2048 + c) = v[j];
            u32x2 w; w.x = pk2(v[j].x * rs * gg.x, v[j].y * rs * gg.y); w.y = pk2(v[j].z * rs * gg.z, v[j].w * rs * gg.w);
            *(u32x2*)(hb + (size_t)m * 2048 + c) = w; }
    }
}
__device__ __forceinline__ void dump_words(const unsigned* src, unsigned* dst, size_t n, int G) {
    for (size_t i = (size_t)blockIdx.x * NTHREADS + threadIdx.x; i < n; i += (size_t)G * NTHREADS) dst[i] = src[i];
}
__device__ __forceinline__ void phase_dump(LAS unsigned char* lds, int G) {
    unsigned char* ws = ctx_ws(lds); unsigned* out = (unsigned*)ctx_out(lds);
    if (DBG_LIM == 5) { if (DBG_SEL == 0) dump_words((const unsigned*)(ws + WS_ROUT), out + O_YP, ARR, G); if (DBG_SEL == 1) dump_words((const unsigned*)(ws + WS_HM), out + O_YP, ARR, G); if (DBG_SEL == 2) { dump_words((const unsigned*)(ws + WS_OG), out + O_YP, ARR, G); dump_words((const unsigned*)(ws + WS_HM), out + O_SC, ARR, G); } if (DBG_SEL == 3) dump_words((const unsigned*)(ws + WS_QM), out + O_YP, ARR, G); if (DBG_SEL == 4) dump_words((const unsigned*)(ws + WS_HM), out + O_YP, (size_t)MP * 1024, G); }
    else if (DBG_LIM == 6) { dump_words((const unsigned*)(ws + WS_QM), out + O_YP, (size_t)MT * 3072 / 2, G); }
    else if (DBG_LIM == 7) { dump_words((const unsigned*)(ws + WS_H), out + O_YP, (size_t)MT * 2048 / 2, G); }
    else { dump_words((const unsigned*)(ws + WS_X), out + O_YP, (size_t)MP * 2048, G); }
}
__device__ __forceinline__ void phase_final(LAS unsigned char* lds, int G) {
    const int tid = opaque_tid(), lane = tid & 63, wave = tid >> 6;
    const float* __restrict__ xbuf = (const float*)(ctx_ws(lds) + WS_X); const float* __restrict__ gvec = ctx_in(lds, I_FNORM);
    for (int m = blockIdx.x * 8 + wave; m < MT; m += G * 8) {
        const float* src = xbuf + (size_t)m * 2048; float* dst = ctx_out(lds) + (m < MP ? O_YP + (size_t)m * 2048 : O_YS + (size_t)(m - MP) * 2048);
        f32x4 v[8]; float s = 0.f;
#pragma unroll
        for (int j = 0; j < 8; ++j) { v[j] = *(const f32x4*)(src + (lane + 64 * j) * 4); s += (v[j].x * v[j].x + v[j].y * v[j].y) + (v[j].z * v[j].z + v[j].w * v[j].w); }
        const float rs = rsqrtf(wave_sum(s) * (1.f / 2048.f) + 1e-6f);
#pragma unroll
        for (int j = 0; j < 8; ++j) { const int c = (lane + 64 * j) * 4; const f32x4 gg = *(const f32x4*)(gvec + c);
            *(f32x4*)(dst + c) = (f32x4){v[j].x * rs * gg.x, v[j].y * rs * gg.y, v[j].z * rs * gg.z, v[j].w * rs * gg.w}; }
    }
}

__device__ __forceinline__ void load_prev8(const bf16_t* proj, const float* shift_l, int m, int col, float (&o)[8]) {
    if (m >= MP) ld8f(shift_l + (size_t)(m - MP) * RC + col, o);
    else if ((m & 2047) == 0) {
#pragma unroll
        for (int i = 0; i < 8; ++i) o[i] = 0.f; }
    else ld8b(proj + (size_t)(m - 1) * NINP + col, o);
}
__device__ __forceinline__ void ld16b(const bf16_t* p, float (&f)[16]) { ld8b(p, *(float(*)[8])&f[0]); ld8b(p + 8, *(float(*)[8])&f[8]); }
__device__ __forceinline__ void ld16f(const float* p, float (&f)[16]) { ld8f(p, *(float(*)[8])&f[0]); ld8f(p + 8, *(float(*)[8])&f[8]); }
__device__ __forceinline__ void st16f(float* p, const float (&f)[16]) { st8f(p, *(const float(*)[8])&f[0]); st8f(p + 8, *(const float(*)[8])&f[8]); }
__device__ __forceinline__ void st16b(bf16_t* p, const float (&f)[16]) { *(u32x4*)p = pack8(*(const float(*)[8])&f[0]); *(u32x4*)(p + 8) = pack8(*(const float(*)[8])&f[8]); }
__device__ __forceinline__ void pre_rwkv_item(LAS unsigned char* lds, int l, int cidx, int tt, int h0, int nh, int wave, int lane) {
    const int lr = lane & 15, lq = lane >> 4;
    const int m0 = cidx * 64 + tt * 16;
    const bf16_t* __restrict__ proj = (const bf16_t*)(ctx_ws(lds) + WS_PROJ);
    const float* __restrict__ shift_l = ctx_in(lds, I_SSHIFT) + (size_t)l * 128 * RC;
    const float* __restrict__ mu = ctx_in(lds, I_MU) + (size_t)l * RC;
    const bf16_t* __restrict__ loraT = (const bf16_t*)(ctx_ws(lds) + WS_W + (size_t)l * LW_BYTES + LW_LORA);
    bf16_t* __restrict__ rb = (bf16_t*)(ctx_ws(lds) + WS_RPRE); float* __restrict__ rw = (float*)(ctx_ws(lds) + WS_RPRE + RP_W);
    LAS bf16_t* loraA = (LAS bf16_t*)(lds + wave * 14336);
    LAS bf16_t* loraO = (LAS bf16_t*)(lds + wave * 14336 + 7168);
    const int tok = lane >> 2, c4 = lane & 3, m = m0 + tok;
    {
#pragma unroll
        for (int i = 0; i < 6; ++i) {
            const int cgp = c4 + 4 * i, col = 3072 + cgp * 8, mat = cgp >> 3, kc = (cgp & 7) * 8;
            float p[8], pv[8], mm[8], x[8];
            ld8b(proj + (size_t)m * NINP + col, p); load_prev8(proj, shift_l, m, col, pv); ld8f(mu + col, mm);
#pragma unroll
            for (int j = 0; j < 8; ++j) { const float xs = p[j] + (pv[j] - p[j]) * mm[j]; x[j] = mat == 0 ? tanh_fast(xs) : (mat == 1 ? xs : sigm(xs)); }
            *(LAS u32x4*)(loraA + (mat * 16 + tok) * 72 + kc) = pack8(x);
        }
    }
    LDS_WAIT();
    const bool samp = m >= MP, first = !samp && ((m & 2047) == 0);
    const bf16_t* prow = proj + (size_t)m * NINP;
    const bf16_t* qrow = proj + (size_t)((samp || first) ? m : m - 1) * NINP;
    const float* srow = shift_l + (size_t)(samp ? m - MP : 0) * RC;
#pragma unroll 1
    for (int hh = 0; hh < nh; ++hh) {
        const int h = h0 + hh, c0 = h * 64 + c4 * 16;
        bf16x8 bfr[3][4][2];
#pragma unroll
        for (int mat = 0; mat < 3; ++mat)
#pragma unroll
            for (int tc = 0; tc < 4; ++tc)
#pragma unroll
                for (int ks = 0; ks < 2; ++ks) bfr[mat][tc][ks] = *(const bf16x8*)(loraT + (size_t)(mat * 1024 + h * 64 + tc * 16 + lr) * 64 + ks * 32 + lq * 8);
        u32x4 pw[3][2], qw[3][2]; f32x4 qs[3][4];
#pragma unroll
        for (int g = 0; g < 3; ++g) { pw[g][0] = *(const u32x4*)(prow + g * 1024 + c0); pw[g][1] = *(const u32x4*)(prow + g * 1024 + c0 + 8);
            if (samp) {
#pragma unroll
                for (int k = 0; k < 4; ++k) qs[g][k] = *(const f32x4*)(srow + g * 1024 + c0 + 4 * k); }
            else { qw[g][0] = *(const u32x4*)(qrow + g * 1024 + c0); qw[g][1] = *(const u32x4*)(qrow + g * 1024 + c0 + 8); } }
#pragma unroll
        for (int mat = 0; mat < 3; ++mat)
#pragma unroll
            for (int tc = 0; tc < 4; ++tc) { f32x4 acc = {0.f, 0.f, 0.f, 0.f};
#pragma unroll
                for (int ks = 0; ks < 2; ++ks) {
                    const bf16x8 av = *(const LAS bf16x8*)(loraA + (mat * 16 + lr) * 72 + ks * 32 + lq * 8);
                    acc = MFMA16(av, bfr[mat][tc][ks], acc); }
#pragma unroll
                for (int r = 0; r < 4; ++r) loraO[(mat * 16 + lq * 4 + r) * 72 + tc * 16 + lr] = f2bf(acc[r]); }
        LDS_WAIT();
        float xr[16], xk[16], xv[16];
#pragma unroll
        for (int g = 0; g < 3; ++g) { float p[16], q[16], mm[16];
            unpack8(pw[g][0], *(float(*)[8])&p[0]); unpack8(pw[g][1], *(float(*)[8])&p[8]); ld16f(mu + g * 1024 + c0, mm);
            if (samp) {
#pragma unroll
                for (int j = 0; j < 16; ++j) q[j] = qs[g][j >> 2][j & 3]; }
            else { unpack8(qw[g][0], *(float(*)[8])&q[0]); unpack8(qw[g][1], *(float(*)[8])&q[8]);
                if (first) {
#pragma unroll
                    for (int j = 0; j < 16; ++j) q[j] = 0.f; } }
#pragma unroll
            for (int j = 0; j < 16; ++j) { const float x = p[j] + (q[j] - p[j]) * mm[j]; if (g == 0) xr[j] = x; else if (g == 1) xk[j] = x; else xv[j] = x; } }
        const size_t o = (size_t)m * 1024 + c0;
        st16b(rb + 3 * ARR + o, xr); st16b(rb + 4 * ARR + o, xv);
        float lw[16], la[16], lg[16];
        { const LAS bf16_t* lo = loraO + tok * 72 + c4 * 16;
          unpack8(*(const LAS u32x4*)(lo), *(float(*)[8])&lw[0]); unpack8(*(const LAS u32x4*)(lo + 8), *(float(*)[8])&lw[8]);
          unpack8(*(const LAS u32x4*)(lo + 16 * 72), *(float(*)[8])&la[0]); unpack8(*(const LAS u32x4*)(lo + 16 * 72 + 8), *(float(*)[8])&la[8]);
          unpack8(*(const LAS u32x4*)(lo + 32 * 72), *(float(*)[8])&lg[0]); unpack8(*(const LAS u32x4*)(lo + 32 * 72 + 8), *(float(*)[8])&lg[8]); }
        st16b(rb + 5 * ARR + o, lg);
        float pa[16], pb[16], kkr[16], av[16]; float ss = 0.f;
        ld16f(ctx_in(lds, I_KK) + l * 1024 + c0, pa); ld16f(ctx_in(lds, I_A0) + l * 1024 + c0, pb);
#pragma unroll
        for (int j = 0; j < 16; ++j) { kkr[j] = xk[j] * pa[j]; ss += kkr[j] * kkr[j]; av[j] = sigm(pb[j] + la[j]); }
        ss = quad_sum(ss);
        const float inv = 1.f / fmaxf(sqrtf(ss), 1e-12f);
#pragma unroll
        for (int j = 0; j < 16; ++j) { kkr[j] *= inv; pa[j] = kkr[j] * av[j]; }
        st16b(rb + 0 * ARR + o, kkr); st16b(rb + 1 * ARR + o, pa);
        ld16f(ctx_in(lds, I_KA) + l * 1024 + c0, pa); ld16f(ctx_in(lds, I_W0) + l * 1024 + c0, pb);
#pragma unroll
        for (int j = 0; j < 16; ++j) { pa[j] = xk[j] * (1.f + (av[j] - 1.f) * pa[j]);
            const float wp = -(pb[j] + lw[j]); const float sp = fmaxf(wp, 0.f) + __logf(1.f + __expf(-fabsf(wp))); pb[j] = __expf(-__expf(-sp - 0.5f)); }
        st16b(rb + 2 * ARR + o, pa); st16f(rw + o, pb);
        LDS_WAIT();
    }
}
__device__ __forceinline__ void pre_mlstm(LAS unsigned char* lds, int l, int cidx, int m0, int ntok) {
    const int tid = opaque_tid();
    const bf16_t* __restrict__ proj = (const bf16_t*)(ctx_ws(lds) + WS_PROJ);
    bf16_t* __restrict__ qm = (bf16_t*)(ctx_ws(lds) + WS_QM); bf16_t* __restrict__ km = (bf16_t*)(ctx_ws(lds) + WS_KM); float* __restrict__ gates = (float*)(ctx_ws(lds) + WS_GATES);
    const int cgp = tid & 255, th = tid >> 8, c0 = cgp * 8;
    float w0[8], w1[8], w2[8], w3[8], cb[8];
    ld8f(ctx_in(lds, I_CONVW) + (size_t)(l * 4 + 0) * 2048 + c0, w0); ld8f(ctx_in(lds, I_CONVW) + (size_t)(l * 4 + 1) * 2048 + c0, w1);
    ld8f(ctx_in(lds, I_CONVW) + (size_t)(l * 4 + 2) * 2048 + c0, w2); ld8f(ctx_in(lds, I_CONVW) + (size_t)(l * 4 + 3) * 2048 + c0, w3);
    ld8f(ctx_in(lds, I_CONVB) + (size_t)l * 2048 + c0, cb);
    bf16_t* dst = cgp < 128 ? qm + c0 : km + (c0 - 1024); const float sc = cgp < 128 ? 1.f : 0.0625f;
    if (cidx < 128) {
        float x3[8], x2[8], x1[8];
        const int t0 = th * 32, ts0 = (m0 & 2047) + t0;
#pragma unroll
        for (int j = 0; j < 8; ++j) { x3[j] = 0.f; x2[j] = 0.f; x1[j] = 0.f; }
        if (ts0 >= 3) { ld8b(proj + (size_t)(m0 + t0 - 3) * NINP + M0 + c0, x3); ld8b(proj + (size_t)(m0 + t0 - 2) * NINP + M0 + c0, x2); ld8b(proj + (size_t)(m0 + t0 - 1) * NINP + M0 + c0, x1); }
        const bool lastc = (cidx & 31) == 31; const int b = cidx >> 5;
#pragma unroll 1
        for (int tb = t0; tb < t0 + 32; tb += 8) {
            u32x4 xb[8];
#pragma unroll
            for (int i = 0; i < 8; ++i) xb[i] = *(const u32x4*)(proj + (size_t)(m0 + tb + i) * NINP + M0 + c0);
#pragma unroll
            for (int i = 0; i < 8; ++i) { const int m = m0 + tb + i; float x0[8], y[8]; unpack8(xb[i], x0);
#pragma unroll
                for (int j = 0; j < 8; ++j) { const float cv = cb[j] + w0[j] * x3[j] + w1[j] * x2[j] + w2[j] * x1[j] + w3[j] * x0[j]; y[j] = siluf(cv) * sc; x3[j] = x2[j]; x2[j] = x1[j]; x1[j] = x0[j]; }
                *(u32x4*)(dst + (size_t)m * 1024) = pack8(y);
                if (lastc && tb + i >= 61) st8f(ctx_out(lds) + O_PCONV + (size_t)((l * 4 + b) * 3 + (tb + i - 61)) * 2048 + c0, x0); }
        }
    } else {
#pragma unroll 1
        for (int tb = th * (ntok >> 1); tb < (th + 1) * (ntok >> 1); tb += 4) {
            u32x4 xb[4]; f32x4 sa[4][6];
#pragma unroll
            for (int i = 0; i < 4; ++i) { const int m = m0 + tb + i, s = m - MP; const float* __restrict__ cs = ctx_in(lds, I_SCONV) + (size_t)((l * 128 + s) * 3) * 2048 + c0;
                xb[i] = *(const u32x4*)(proj + (size_t)m * NINP + M0 + c0);
#pragma unroll
                for (int k = 0; k < 3; ++k) { sa[i][2 * k] = *(const f32x4*)(cs + k * 2048); sa[i][2 * k + 1] = *(const f32x4*)(cs + k * 2048 + 4); } }
#pragma unroll
            for (int i = 0; i < 4; ++i) { const int m = m0 + tb + i, s = m - MP; float x0[8], y[8]; unpack8(xb[i], x0);
#pragma unroll
                for (int j = 0; j < 8; ++j) { const float x3 = sa[i][0 + (j >> 2)][j & 3], x2 = sa[i][2 + (j >> 2)][j & 3], x1 = sa[i][4 + (j >> 2)][j & 3];
                    const float cv = cb[j] + w0[j] * x3 + w1[j] * x2 + w2[j] * x1 + w3[j] * x0[j]; y[j] = siluf(cv) * sc; }
                *(u32x4*)(dst + (size_t)m * 1024) = pack8(y);
                float* co = ctx_out(lds) + O_SCONV + (size_t)((l * 128 + s) * 3) * 2048 + c0;
                *(f32x4*)co = sa[i][2]; *(f32x4*)(co + 4) = sa[i][3]; *(f32x4*)(co + 2048) = sa[i][4]; *(f32x4*)(co + 2052) = sa[i][5]; st8f(co + 4096, x0); }
        }
    }
    if (tid < ntok * 4) { const int t = tid >> 2, hh = tid & 3, m = m0 + t;
        const float ip = bf2f(proj[(size_t)m * NINP + M0 + 3072 + hh]), fp = bf2f(proj[(size_t)m * NINP + M0 + 3076 + hh]);
        const float xf = fp + ctx_in(lds, I_FB)[l * 4 + hh];
        gates[(size_t)m * 8 + hh] = ip + ctx_in(lds, I_IB)[l * 4 + hh];
        gates[(size_t)m * 8 + 4 + hh] = fminf(xf, 0.f) - log1pf(__expf(-fabsf(xf))); }
}
__device__ __forceinline__ void pre_gla(LAS unsigned char* lds, int l, int cidx, int m0, int ntok) {
    const int tid = opaque_tid(), lane = tid & 63, wave = tid >> 6, lr = lane & 15, lq = lane >> 4;
    const bf16_t* __restrict__ proj = (const bf16_t*)(ctx_ws(lds) + WS_PROJ);
    bf16_t* __restrict__ gq = (bf16_t*)(ctx_ws(lds) + WS_GQ); bf16_t* __restrict__ gk = (bf16_t*)(ctx_ws(lds) + WS_GK); bf16_t* __restrict__ gkh = (bf16_t*)(ctx_ws(lds) + WS_GKH); float* __restrict__ egl = (float*)(ctx_ws(lds) + WS_EGL);
    const bf16_t* __restrict__ a2T = (const bf16_t*)(ctx_ws(lds) + WS_W + (size_t)l * LW_BYTES + LW_GA2);
    LAS float* bb = (LAS float*)lds;
    LAS bf16_t* xa = (LAS bf16_t*)(lds + 64 * 516 * 4);
    const bool samp = cidx >= 128;
    __syncthreads();
    for (int i = tid; i < ntok * 32; i += NTHREADS) { const int t = i >> 5, k = i & 31; xa[t * 40 + k] = k < 16 ? proj[(size_t)(m0 + t) * NINP + G0 + 2048 + k] : (bf16_t)0; }
    __syncthreads();
#pragma unroll
    for (int q = 0; q < 4; ++q) { const int tc = wave * 4 + q;
        const bf16x8 bv = *(const bf16x8*)(a2T + (size_t)(tc * 16 + lr) * 32 + lq * 8);
        const float ab = ctx_in(lds, I_GAB)[l * 512 + tc * 16 + lr];
#pragma unroll
        for (int tt = 0; tt < 4; ++tt) { if (tt * 16 >= ntok) break; const bf16x8 av = *(const LAS bf16x8*)(xa + (tt * 16 + lr) * 40 + lq * 8);
            f32x4 acc = {0.f, 0.f, 0.f, 0.f}; acc = MFMA16(av, bv, acc);
#pragma unroll
            for (int r = 0; r < 4; ++r) bb[(tt * 16 + lq * 4 + r) * 516 + tc * 16 + lr] = logsig_fast(acc[r] + ab) * 0.0625f; } }
    __syncthreads();
    if (!samp) { const int c = tid; float run = 0.f;
#pragma unroll 8
        for (int t = 0; t < 64; ++t) { run += bb[t * 516 + c]; bb[t * 516 + c] = run; }
        egl[(size_t)cidx * 512 + c] = __expf(run); }
    __syncthreads();
    const float scale = 0.08838834764831845f;
    for (int i = tid; i < ntok * 64; i += NTHREADS) { const int t = i >> 6, cg = i & 63, c = cg * 8; const size_t m = m0 + t;
        float q[8], k[8], b8[8], bl[8], oq[8], ok[8], oh[8];
        ld8b(proj + m * NINP + G0 + c, q); ld8b(proj + m * NINP + G0 + 512 + c, k);
#pragma unroll
        for (int j = 0; j < 8; ++j) { b8[j] = bb[t * 516 + c + j]; bl[j] = samp ? b8[j] : bb[63 * 516 + c + j]; }
#pragma unroll
        for (int j = 0; j < 8; ++j) { oq[j] = q[j] * __expf(b8[j]) * scale; ok[j] = k[j] * __expf(-b8[j]); oh[j] = k[j] * __expf(bl[j] - b8[j]); }
        *(u32x4*)(gq + m * 512 + c) = pack8(oq); *(u32x4*)(gk + m * 512 + c) = pack8(ok); *(u32x4*)(gkh + m * 512 + c) = pack8(oh);
        if (samp) { float e[8];
#pragma unroll
            for (int j = 0; j < 8; ++j) e[j] = __expf(b8[j]);
            st8f(egl + (size_t)(128 + (m - MP)) * 512 + c, e); } }
}
__device__ __forceinline__ void phase_pre(LAS unsigned char* lds, int l, int G) {
    { const int tid = opaque_tid(), wave = tid >> 6, lane = tid & 63;
      for (int it = blockIdx.x * 8 + wave; it < 2048 + G * 8; it += G * 8) {
          int cidx, tt, h0, nh;
          if (it < 2048) { cidx = it >> 4; tt = (it >> 2) & 3; h0 = (it & 3) * 4; nh = 4; }
          else { const int j = G * 8 - 1 - (it - 2048); if (j >= 128) continue; cidx = 128 + (j >> 6); tt = (j >> 4) & 3; h0 = j & 15; nh = 1; }
          pre_rwkv_item(lds, l, cidx, tt, h0, nh, wave, lane); } }
    for (int u = blockIdx.x; u < 272; u += G) {
        if (u < 128) pre_gla(lds, l, u, u * 64, 64);
        else if (u < 256) pre_mlstm(lds, l, u - 128, (u - 128) * 64, 64);
        else if (u < 264) pre_gla(lds, l, 128, MP + (u - 256) * 16, 16);
        else pre_mlstm(lds, l, 128, MP + (u - 264) * 16, 16);
    }
    {
        const bf16_t* __restrict__ proj = (const bf16_t*)(ctx_ws(lds) + WS_PROJ);
        for (int i = blockIdx.x * NTHREADS + opaque_tid(); i < 132 * (RC / 8); i += G * NTHREADS) { const int sq = i / (RC / 8), cg8 = i % (RC / 8); float p[8];
            const int m = sq < 4 ? sq * 2048 + 2047 : MP + (sq - 4);
            ld8b(proj + (size_t)m * NINP + cg8 * 8, p);
            st8f(ctx_out(lds) + (sq < 4 ? O_PSHIFT + (size_t)(l * 4 + sq) * RC : O_SSHIFT + (size_t)(l * 128 + (sq - 4)) * RC) + cg8 * 8, p); }
    }
}

__device__ __forceinline__ void scan_rwkv(LAS unsigned char* lds, int l, int u) {
    const int tid = opaque_tid(), bh = u >> 1, half = u & 1, b = bh >> 4, h = bh & 15;
    const int row = tid >> 4, kq = tid & 15;
    const float* __restrict__ rpre = (const float*)(ctx_ws(lds) + WS_RPRE); bf16_t* __restrict__ rout = (bf16_t*)(ctx_ws(lds) + WS_ROUT);
    LAS float* stage = (LAS float*)lds;
    LAS float* obuf = (LAS float*)(lds + 64 * 352 * 4);
    f32x4 S = {0.f, 0.f, 0.f, 0.f};
    const size_t mb = (size_t)b * 2048;
    const unsigned char* rbase = (const unsigned char*)rpre;
    unsigned off[7], inc[7]; int lo[7];
#pragma unroll
    for (int q = 0; q < 7; ++q) { int i = tid + 512 * q; i = i < 3328 ? i : 3327; const int tok = i / 52, j = i % 52;
        if (j < 32) { const int arr = j >> 3, pc = j & 7; off[q] = (unsigned)(arr * (int)ARR + tok * 1024 + h * 64 + pc * 8) * 2u; inc[q] = 64u * 1024u * 2u; lo[q] = tok * 352 + (arr == 0 ? 0 : arr == 1 ? 64 : arr == 2 ? 192 : 256) + pc * 8; }
        else if (j < 48) { const int pc = j - 32; off[q] = (unsigned)RP_W + (unsigned)(tok * 1024 + h * 64 + pc * 4) * 4u; inc[q] = 64u * 1024u * 4u; lo[q] = -(tok * 352 + 128 + pc * 4) - 1; }
        else { const int pc = j - 48; off[q] = (unsigned)(4 * (int)ARR + tok * 1024 + h * 64 + half * 32 + pc * 8) * 2u; inc[q] = 64u * 1024u * 2u; lo[q] = tok * 352 + 320 + pc * 8; } }
    u32x4 pf[7];
    const size_t cb0 = mb / 64;
#pragma unroll
    for (int q = 0; q < 7; ++q) pf[q] = *(const u32x4*)(rbase + off[q] + cb0 * inc[q]);
    __syncthreads();
    for (int ch = 0; ch < 32; ++ch) {
#pragma unroll
        for (int q = 0; q < 7; ++q) {
            if (lo[q] < 0) *(LAS u32x4*)(stage + (-lo[q] - 1)) = pf[q];
            else { float f[8]; unpack8(pf[q], f); *(LAS f32x4*)(stage + lo[q]) = (f32x4){f[0], f[1], f[2], f[3]}; *(LAS f32x4*)(stage + lo[q] + 4) = (f32x4){f[4], f[5], f[6], f[7]}; } }
        __syncthreads();
        { const size_t chn = cb0 + (ch + 1 < 32 ? ch + 1 : 31);
#pragma unroll
          for (int q = 0; q < 7; ++q) pf[q] = *(const u32x4*)(rbase + off[q] + chn * inc[q]); }
        f32x4 B5[3][5]; float Bv[3];
#define RW_LD(slot, t) do { const LAS float* sp_ = stage + (t) * 352 + kq * 4; B5[slot][0] = *(const LAS f32x4*)(sp_); B5[slot][1] = *(const LAS f32x4*)(sp_ + 64); B5[slot][2] = *(const LAS f32x4*)(sp_ + 128); \
            B5[slot][3] = *(const LAS f32x4*)(sp_ + 192); B5[slot][4] = *(const LAS f32x4*)(sp_ + 256); Bv[slot] = stage[(t) * 352 + 320 + row]; } while (0)
        RW_LD(0, 0); RW_LD(1, 1);
        float o0 = 0.f, o1 = 0.f, o2 = 0.f, o3 = 0.f;
#pragma unroll
        for (int t = 0; t < 64; ++t) {
            if (t + 2 < 64) RW_LD((t + 2) % 3, t + 2);
            const f32x4 kk = B5[t % 3][0], bb = B5[t % 3][1], ww = B5[t % 3][2], k2 = B5[t % 3][3], rr = B5[t % 3][4]; const float vv = Bv[t % 3];
            float sa = (S.x * kk.x + S.y * kk.y) + (S.z * kk.z + S.w * kk.w);
            sa = row16_sum(sa);
            S = S * ww - sa * bb + vv * k2;
            float o = (S.x * rr.x + S.y * rr.y) + (S.z * rr.z + S.w * rr.w);
            o = row16_sum(o);
            if ((t & 15) == kq) { if (t < 16) o0 = o; else if (t < 32) o1 = o; else if (t < 48) o2 = o; else o3 = o; }
        }
#undef RW_LD
        obuf[kq * 32 + row] = o0; obuf[(16 + kq) * 32 + row] = o1; obuf[(32 + kq) * 32 + row] = o2; obuf[(48 + kq) * 32 + row] = o3;
        __syncthreads();
        for (int i = tid; i < 1024; i += NTHREADS) *(unsigned*)(rout + (mb + ch * 64 + (i >> 4)) * 1024 + h * 64 + half * 32 + (i & 15) * 2) = pk2(obuf[i * 2], obuf[i * 2 + 1]);
    }
    *(f32x4*)(ctx_out(lds) + O_PWKV + ((size_t)((l * 4 + b) * 16 + h) * 64 + half * 32 + row) * 64 + kq * 4) = S;
    __syncthreads();
}
__device__ __forceinline__ void scan_mlstm(LAS unsigned char* lds, int l, int u) {
    const int tid = opaque_tid(), lane = tid & 63, wave = tid >> 6, lr = lane & 15, lq = lane >> 4;
    const int bh = u >> 2, sl = u & 3, b = bh >> 2, h = bh & 3;
    const bf16_t* __restrict__ proj = (const bf16_t*)(ctx_ws(lds) + WS_PROJ); const bf16_t* __restrict__ qm = (const bf16_t*)(ctx_ws(lds) + WS_QM); const bf16_t* __restrict__ km = (const bf16_t*)(ctx_ws(lds) + WS_KM);
    const float* __restrict__ gates = (const float*)(ctx_ws(lds) + WS_GATES); bf16_t* __restrict__ hm = (bf16_t*)(ctx_ws(lds) + WS_HM);
    LAS bf16_t* kS = (LAS bf16_t*)lds;
    LAS bf16_t* kwT = (LAS bf16_t*)(lds + 33792);
    LAS bf16_t* vT = (LAS bf16_t*)(lds + 33792 + 36864);
    LAS bf16_t* Sp = (LAS bf16_t*)(lds + 33792 + 36864 + 11520);
    LAS bf16_t* CT = (LAS bf16_t*)(lds + 33792 + 36864 + 11520 + 9216);
    LAS float* gF = (LAS float*)(lds + 33792 + 36864 + 11520 + 9216 + 42240);
    LAS float* gU = gF + 64; LAS float* gM = gF + 128; LAS float* gS = gF + 192; LAS float* gD = gF + 196;
    __syncthreads();
    for (int i = tid; i < 80 * 264 / 2; i += NTHREADS) ((LAS unsigned*)CT)[i] = 0u;
    for (int i = tid; i < 16 * 72; i += NTHREADS) vT[64 * 72 + i] = (i < 72) ? (bf16_t)0x3F80 : (bf16_t)0;
    f32x4 acc[2][5];
#pragma unroll
    for (int i = 0; i < 2; ++i)
#pragma unroll
        for (int j = 0; j < 5; ++j) acc[i][j] = (f32x4){0.f, 0.f, 0.f, 0.f};
    float m_prev = 0.f;
    const int tt = wave >> 1, wodd = wave & 1, s = tid & 63, eg = tid >> 6;
    const size_t mb = (size_t)b * 2048;
    u32x4 pv = *(const u32x4*)(proj + (mb + s) * NINP + M0 + 2048 + h * 256 + sl * 64 + eg * 8);
    u32x4 pk[4];
#pragma unroll
    for (int j = 0; j < 4; ++j) pk[j] = *(const u32x4*)(km + (mb + s) * 1024 + h * 256 + (eg + 8 * j) * 8);
    bf16x8 qf[8];
#pragma unroll
    for (int ks = 0; ks < 8; ++ks) qf[ks] = *(const bf16x8*)(qm + (mb + tt * 16 + lr) * 1024 + h * 256 + ks * 32 + lq * 8);
    float pig = gates[(mb + lane) * 8 + h], plf = gates[(mb + lane) * 8 + 4 + h];
    for (int c = 0; c < 32; ++c) {
        const size_t m0 = mb + c * 64;
        if (wave == 0) {
            float F = plf;
#pragma unroll
            for (int o = 1; o < 64; o <<= 1) { const float t = __shfl_up(F, o); if (lane >= o) F += t; }
            const float uu = pig - F; float am = uu;
#pragma unroll
            for (int o = 1; o < 64; o <<= 1) { const float t = __shfl_up(am, o); if (lane >= o) am = fmaxf(am, t); }
            const float Mt = fmaxf(m_prev, am);
            gF[lane] = F; gU[lane] = uu; gM[lane] = Mt;
            if (lane == 63) { gS[0] = __expf(m_prev - Mt); gS[1] = Mt; gS[2] = F + Mt; }
        }
        { vT[(eg * 8 + 0) * 72 + s] = (bf16_t)(pv.x & 0xffffu); vT[(eg * 8 + 1) * 72 + s] = (bf16_t)(pv.x >> 16); vT[(eg * 8 + 2) * 72 + s] = (bf16_t)(pv.y & 0xffffu); vT[(eg * 8 + 3) * 72 + s] = (bf16_t)(pv.y >> 16);
          vT[(eg * 8 + 4) * 72 + s] = (bf16_t)(pv.z & 0xffffu); vT[(eg * 8 + 5) * 72 + s] = (bf16_t)(pv.z >> 16); vT[(eg * 8 + 6) * 72 + s] = (bf16_t)(pv.w & 0xffffu); vT[(eg * 8 + 7) * 72 + s] = (bf16_t)(pv.w >> 16);
#pragma unroll
          for (int j = 0; j < 4; ++j) *(LAS u32x4*)(kS + s * 264 + (eg + 8 * j) * 8) = pk[j]; }
        __syncthreads();
        const float a_c = gS[0], ML = gS[1], m_new = gS[2];
        { const float ws = __expf(gU[s] - ML);
#pragma unroll
          for (int j = 0; j < 4; ++j) { const int d0 = (eg + 8 * j) * 8; float k[8]; unpack8(pk[j], k);
#pragma unroll
              for (int i = 0; i < 8; ++i) kwT[(d0 + i) * 72 + s] = f2bf(k[i] * ws); } }
        const size_t m1 = mb + (size_t)(c + 1 < 32 ? c + 1 : 31) * 64;
        pig = gates[(m1 + lane) * 8 + h]; plf = gates[(m1 + lane) * 8 + 4 + h];
        pv = *(const u32x4*)(proj + (m1 + s) * NINP + M0 + 2048 + h * 256 + sl * 64 + eg * 8);
#pragma unroll
        for (int j = 0; j < 4; ++j) pk[j] = *(const u32x4*)(km + (m1 + s) * 1024 + h * 256 + (eg + 8 * j) * 8);
#pragma unroll
        for (int q = 0; q < 2; ++q) { const int ts = 2 * wodd + q;
            f32x4 sacc = {0.f, 0.f, 0.f, 0.f};
            if (ts <= tt) {
#pragma unroll
                for (int ks = 0; ks < 8; ++ks) { const bf16x8 kf = *(const LAS bf16x8*)(kS + (ts * 16 + lr) * 264 + ks * 32 + lq * 8); sacc = MFMA16(qf[ks], kf, sacc); }
            }
            const int sc = ts * 16 + lr; const float us = gU[sc];
#pragma unroll
            for (int r = 0; r < 4; ++r) { const int t = tt * 16 + lq * 4 + r; const float v = (sc <= t) ? sacc[r] * __expf(us - gM[t]) : 0.f; Sp[t * 72 + sc] = f2bf(v); }
        }
        __syncthreads();
        f32x4 hn[3];
#pragma unroll
        for (int q = 0; q < 3; ++q) { const int te = wodd ? 3 + q : q; hn[q] = (f32x4){0.f, 0.f, 0.f, 0.f}; if (te < 5) {
            f32x4 aq = {0.f, 0.f, 0.f, 0.f}, as = {0.f, 0.f, 0.f, 0.f};
#pragma unroll
            for (int ks = 0; ks < 8; ++ks) { const bf16x8 cf = *(const LAS bf16x8*)(CT + (te * 16 + lr) * 264 + ks * 32 + lq * 8); aq = MFMA16(qf[ks], cf, aq); }
#pragma unroll
            for (int ks = 0; ks < 2; ++ks) { const bf16x8 sf = *(const LAS bf16x8*)(Sp + (tt * 16 + lr) * 72 + ks * 32 + lq * 8); const bf16x8 vf = *(const LAS bf16x8*)(vT + (te * 16 + lr) * 72 + ks * 32 + lq * 8); as = MFMA16(sf, vf, as); }
#pragma unroll
            for (int r = 0; r < 4; ++r) { const int t = tt * 16 + lq * 4 + r; hn[q][r] = __expf(m_prev - gM[t]) * aq[r] + as[r]; }
            if (te == 4 && lr == 0) {
#pragma unroll
                for (int r = 0; r < 4; ++r) gD[tt * 16 + lq * 4 + r] = hn[q][r]; }
        } }
#pragma unroll
        for (int ks = 0; ks < 8; ++ks) qf[ks] = *(const bf16x8*)(qm + (m1 + tt * 16 + lr) * 1024 + h * 256 + ks * 32 + lq * 8);
#pragma unroll
        for (int i = 0; i < 2; ++i) { const int dt = wave * 2 + i;
            bf16x8 kf[2];
#pragma unroll
            for (int ks = 0; ks < 2; ++ks) kf[ks] = *(const LAS bf16x8*)(kwT + (dt * 16 + lr) * 72 + ks * 32 + lq * 8);
#pragma unroll
            for (int et = 0; et < 5; ++et) { acc[i][et] = acc[i][et] * a_c;
#pragma unroll
                for (int ks = 0; ks < 2; ++ks) { const bf16x8 vf = *(const LAS bf16x8*)(vT + (et * 16 + lr) * 72 + ks * 32 + lq * 8); acc[i][et] = MFMA16(kf[ks], vf, acc[i][et]); } } }
        __syncthreads();
#pragma unroll
        for (int i = 0; i < 2; ++i) { const int dt = wave * 2 + i;
#pragma unroll
            for (int et = 0; et < 5; ++et) { u32x2 w; w.x = pk2(acc[i][et][0], acc[i][et][1]); w.y = pk2(acc[i][et][2], acc[i][et][3]);
                *(LAS u32x2*)(CT + (et * 16 + lr) * 264 + dt * 16 + lq * 4) = w; } }
        { float dd[4];
#pragma unroll
          for (int r = 0; r < 4; ++r) { const int t = tt * 16 + lq * 4 + r; dd[r] = 1.f / fmaxf(fabsf(gD[t]), __expf(-(gF[t] + gM[t]))); }
#pragma unroll
          for (int q = 0; q < 3; ++q) { const int te = wodd ? 3 + q : q; if (te < 4) {
#pragma unroll
              for (int r = 0; r < 4; ++r) hm[(m0 + tt * 16 + lq * 4 + r) * 1024 + h * 256 + sl * 64 + te * 16 + lr] = f2bf(hn[q][r] * dd[r]); } } }
        m_prev = m_new;
        __syncthreads();
    }
#pragma unroll
    for (int i = 0; i < 2; ++i) { const int dt = wave * 2 + i;
#pragma unroll
        for (int et = 0; et < 5; ++et)
#pragma unroll
            for (int r = 0; r < 4; ++r) { const int d = dt * 16 + lq * 4 + r;
                if (et < 4) ctx_out(lds)[O_PC + ((size_t)((l * 4 + b) * 4 + h) * 256 + d) * 256 + sl * 64 + et * 16 + lr] = acc[i][et][r];
                else if (sl == 0 && lr == 0) ctx_out(lds)[O_PN + (size_t)((l * 4 + b) * 4 + h) * 256 + d] = acc[i][et][r]; } }
    if (sl == 0 && tid == 0) ctx_out(lds)[O_PM + (l * 4 + b) * 4 + h] = m_prev;
    __syncthreads();
}
__device__ __forceinline__ void scan_gla(LAS unsigned char* lds, int l, int u) {
    const int tid = opaque_tid(), lane = tid & 63, wave = tid >> 6, lr = lane & 15, lq = lane >> 4;
    const int bh = u >> 2, sl = u & 3, b = bh >> 2, h = bh & 3;
    const bf16_t* __restrict__ proj = (const bf16_t*)(ctx_ws(lds) + WS_PROJ); const bf16_t* __restrict__ gq = (const bf16_t*)(ctx_ws(lds) + WS_GQ); const bf16_t* __restrict__ gk = (const bf16_t*)(ctx_ws(lds) + WS_GK); const bf16_t* __restrict__ gkh = (const bf16_t*)(ctx_ws(lds) + WS_GKH);
    const float* __restrict__ egl = (const float*)(ctx_ws(lds) + WS_EGL); bf16_t* __restrict__ og = (bf16_t*)(ctx_ws(lds) + WS_OG);
    LAS bf16_t* khT = (LAS bf16_t*)lds;
    LAS bf16_t* vT = (LAS bf16_t*)(lds + 18432);
    LAS bf16_t* Ap = (LAS bf16_t*)(lds + 18432 + 9216);
    LAS bf16_t* ST = (LAS bf16_t*)(lds + 36864);
    LAS bf16_t* kS = (LAS bf16_t*)(lds + 36864 + 17408);
    __syncthreads();
    for (int i = tid; i < 64 * 136 / 2; i += NTHREADS) ((LAS unsigned*)ST)[i] = 0u;
    f32x4 acc[4];
#pragma unroll
    for (int j = 0; j < 4; ++j) acc[j] = (f32x4){0.f, 0.f, 0.f, 0.f};
    const int tt = wave >> 1, wodd = wave & 1, s = tid & 63, eg = tid >> 6;
    const size_t mb = (size_t)b * 2048;
    u32x4 pv = *(const u32x4*)(proj + (mb + s) * NINP + G0 + 1024 + h * 256 + sl * 64 + eg * 8);
    u32x4 pkh[2], pgk[2];
#pragma unroll
    for (int j = 0; j < 2; ++j) { pkh[j] = *(const u32x4*)(gkh + (mb + s) * 512 + h * 128 + (eg + 8 * j) * 8); pgk[j] = *(const u32x4*)(gk + (mb + s) * 512 + h * 128 + (eg + 8 * j) * 8); }
    bf16x8 qf[4];
#pragma unroll
    for (int ks = 0; ks < 4; ++ks) qf[ks] = *(const bf16x8*)(gq + (mb + tt * 16 + lr) * 512 + h * 128 + ks * 32 + lq * 8);
    float eg4[4];
#pragma unroll
    for (int r = 0; r < 4; ++r) eg4[r] = egl[(size_t)(b * 32) * 512 + h * 128 + wave * 16 + lq * 4 + r];
    for (int c = 0; c < 32; ++c) {
        const int cidx = b * 32 + c; const size_t m0 = (size_t)cidx * 64;
        { vT[(eg * 8 + 0) * 72 + s] = (bf16_t)(pv.x & 0xffffu); vT[(eg * 8 + 1) * 72 + s] = (bf16_t)(pv.x >> 16); vT[(eg * 8 + 2) * 72 + s] = (bf16_t)(pv.y & 0xffffu); vT[(eg * 8 + 3) * 72 + s] = (bf16_t)(pv.y >> 16);
          vT[(eg * 8 + 4) * 72 + s] = (bf16_t)(pv.z & 0xffffu); vT[(eg * 8 + 5) * 72 + s] = (bf16_t)(pv.z >> 16); vT[(eg * 8 + 6) * 72 + s] = (bf16_t)(pv.w & 0xffffu); vT[(eg * 8 + 7) * 72 + s] = (bf16_t)(pv.w >> 16);
#pragma unroll
          for (int j = 0; j < 2; ++j) { const int d0 = (eg + 8 * j) * 8; const u32x4 w = pkh[j];
              khT[(d0 + 0) * 72 + s] = (bf16_t)(w.x & 0xffffu); khT[(d0 + 1) * 72 + s] = (bf16_t)(w.x >> 16); khT[(d0 + 2) * 72 + s] = (bf16_t)(w.y & 0xffffu); khT[(d0 + 3) * 72 + s] = (bf16_t)(w.y >> 16);
              khT[(d0 + 4) * 72 + s] = (bf16_t)(w.z & 0xffffu); khT[(d0 + 5) * 72 + s] = (bf16_t)(w.z >> 16); khT[(d0 + 6) * 72 + s] = (bf16_t)(w.w & 0xffffu); khT[(d0 + 7) * 72 + s] = (bf16_t)(w.w >> 16);
              *(LAS u32x4*)(kS + s * 136 + d0) = pgk[j]; } }
        __syncthreads();
        const float e0 = eg4[0], e1 = eg4[1], e2 = eg4[2], e3 = eg4[3];
        const int cn = c + 1 < 32 ? cidx + 1 : cidx; const size_t m1 = (size_t)cn * 64;
        pv = *(const u32x4*)(proj + (m1 + s) * NINP + G0 + 1024 + h * 256 + sl * 64 + eg * 8);
#pragma unroll
        for (int j = 0; j < 2; ++j) { pkh[j] = *(const u32x4*)(gkh + (m1 + s) * 512 + h * 128 + (eg + 8 * j) * 8); pgk[j] = *(const u32x4*)(gk + (m1 + s) * 512 + h * 128 + (eg + 8 * j) * 8); }
#pragma unroll
        for (int r = 0; r < 4; ++r) eg4[r] = egl[(size_t)cn * 512 + h * 128 + wave * 16 + lq * 4 + r];
#pragma unroll
        for (int q = 0; q < 2; ++q) { const int ts = 2 * wodd + q;
            f32x4 sacc = {0.f, 0.f, 0.f, 0.f};
            if (ts <= tt) {
#pragma unroll
                for (int ks = 0; ks < 4; ++ks) { const bf16x8 kf = *(const LAS bf16x8*)(kS + (ts * 16 + lr) * 136 + ks * 32 + lq * 8); sacc = MFMA16(qf[ks], kf, sacc); }
            }
            const int sc = ts * 16 + lr;
#pragma unroll
            for (int r = 0; r < 4; ++r) { const int t = tt * 16 + lq * 4 + r; Ap[t * 72 + sc] = f2bf((sc <= t) ? sacc[r] : 0.f); }
        }
        __syncthreads();
#pragma unroll
        for (int q = 0; q < 2; ++q) { const int te = 2 * wodd + q;
            f32x4 ao = {0.f, 0.f, 0.f, 0.f};
#pragma unroll
            for (int ks = 0; ks < 4; ++ks) { const bf16x8 sf = *(const LAS bf16x8*)(ST + (te * 16 + lr) * 136 + ks * 32 + lq * 8); ao = MFMA16(qf[ks], sf, ao); }
#pragma unroll
            for (int ks = 0; ks < 2; ++ks) { const bf16x8 af = *(const LAS bf16x8*)(Ap + (tt * 16 + lr) * 72 + ks * 32 + lq * 8); const bf16x8 vf = *(const LAS bf16x8*)(vT + (te * 16 + lr) * 72 + ks * 32 + lq * 8); ao = MFMA16(af, vf, ao); }
#pragma unroll
            for (int r = 0; r < 4; ++r) og[(m0 + tt * 16 + lq * 4 + r) * 1024 + h * 256 + sl * 64 + te * 16 + lr] = f2bf(ao[r]);
        }
#pragma unroll
        for (int ks = 0; ks < 4; ++ks) qf[ks] = *(const bf16x8*)(gq + (m1 + tt * 16 + lr) * 512 + h * 128 + ks * 32 + lq * 8);
        { const int dt = wave;
          bf16x8 kf[2];
#pragma unroll
          for (int ks = 0; ks < 2; ++ks) kf[ks] = *(const LAS bf16x8*)(khT + (dt * 16 + lr) * 72 + ks * 32 + lq * 8);
#pragma unroll
          for (int et = 0; et < 4; ++et) {
              acc[et][0] *= e0; acc[et][1] *= e1; acc[et][2] *= e2; acc[et][3] *= e3;
#pragma unroll
              for (int ks = 0; ks < 2; ++ks) { const bf16x8 vf = *(const LAS bf16x8*)(vT + (et * 16 + lr) * 72 + ks * 32 + lq * 8); acc[et] = MFMA16(kf[ks], vf, acc[et]); } } }
        __syncthreads();
#pragma unroll
        for (int et = 0; et < 4; ++et) { u32x2 w; w.x = pk2(acc[et][0], acc[et][1]); w.y = pk2(acc[et][2], acc[et][3]);
            *(LAS u32x2*)(ST + (et * 16 + lr) * 136 + wave * 16 + lq * 4) = w; }
        __syncthreads();
    }
#pragma unroll
    for (int et = 0; et < 4; ++et)
#pragma unroll
        for (int r = 0; r < 4; ++r) ctx_out(lds)[O_PGLA + ((size_t)((l * 4 + b) * 4 + h) * 128 + wave * 16 + lq * 4 + r) * 256 + sl * 64 + et * 16 + lr] = acc[et][r];
    __syncthreads();
}
__device__ __forceinline__ void samp_rwkv(LAS unsigned char* lds, int l, int u) {
    const int tid = opaque_tid(), s = u >> 3, h = (u & 7) * 2 + (tid >> 8), row = (tid & 255) >> 2, kq = tid & 3;
    const float* __restrict__ rpre = (const float*)(ctx_ws(lds) + WS_RPRE); bf16_t* __restrict__ rout = (bf16_t*)(ctx_ws(lds) + WS_ROUT);
    const size_t m = MP + s, po = m * 1024 + h * 64 + kq * 16;
    const size_t so = ((size_t)((l * 128 + s) * 16 + h) * 64 + row) * 64 + kq * 16;
    const float* __restrict__ sp = ctx_in(lds, I_SWKV) + so;
    f32x4 S[4], kk[4], bb[4], ww[4], k2[4], rr[4];
    const bf16_t* rb = (const bf16_t*)rpre; const float* rw = (const float*)((const unsigned char*)rpre + RP_W);
    { float t0[16], t1[16], t2[16], t3[16];
      ld16b(rb + po, t0); ld16b(rb + ARR + po, t1); ld16b(rb + 2 * ARR + po, t2); ld16b(rb + 3 * ARR + po, t3);
#pragma unroll
      for (int j = 0; j < 4; ++j) { S[j] = *(const f32x4*)(sp + j * 4); ww[j] = *(const f32x4*)(rw + po + j * 4);
          kk[j] = (f32x4){t0[4 * j], t0[4 * j + 1], t0[4 * j + 2], t0[4 * j + 3]}; bb[j] = (f32x4){t1[4 * j], t1[4 * j + 1], t1[4 * j + 2], t1[4 * j + 3]};
          k2[j] = (f32x4){t2[4 * j], t2[4 * j + 1], t2[4 * j + 2], t2[4 * j + 3]}; rr[j] = (f32x4){t3[4 * j], t3[4 * j + 1], t3[4 * j + 2], t3[4 * j + 3]}; } }
    const float vv = bf2f(rb[4 * ARR + m * 1024 + h * 64 + row]);
    float sa = 0.f;
#pragma unroll
    for (int j = 0; j < 4; ++j) sa += (S[j].x * kk[j].x + S[j].y * kk[j].y) + (S[j].z * kk[j].z + S[j].w * kk[j].w);
    sa = quad_sum(sa);
    float o = 0.f;
#pragma unroll
    for (int j = 0; j < 4; ++j) { S[j] = S[j] * ww[j] - sa * bb[j] + vv * k2[j]; o += (S[j].x * rr[j].x + S[j].y * rr[j].y) + (S[j].z * rr[j].z + S[j].w * rr[j].w);
        *(f32x4*)(ctx_out(lds) + O_SWKV + so + j * 4) = S[j]; }
    o = quad_sum(o);
    if (kq == 0) rout[m * 1024 + h * 64 + row] = f2bf(o);
}
__device__ __forceinline__ float block_sum2(LAS float* red, float v, int tid) {
    v = wave_sum(v);
    __syncthreads();
    if ((tid & 63) == 0) red[tid >> 6] = v;
    __syncthreads();
    return ((red[0] + red[1]) + (red[2] + red[3])) + ((red[4] + red[5]) + (red[6] + red[7]));
}
__device__ __forceinline__ void samp_mlstm(LAS unsigned char* lds, int l, int u) {
    const int tid = opaque_tid(), s = u >> 2, h = u & 3;
    const bf16_t* __restrict__ proj = (const bf16_t*)(ctx_ws(lds) + WS_PROJ); const bf16_t* __restrict__ qm = (const bf16_t*)(ctx_ws(lds) + WS_QM); const bf16_t* __restrict__ km = (const bf16_t*)(ctx_ws(lds) + WS_KM);
    const float* __restrict__ gates = (const float*)(ctx_ws(lds) + WS_GATES); bf16_t* __restrict__ hm = (bf16_t*)(ctx_ws(lds) + WS_HM);
    LAS float* qs = (LAS float*)lds; LAS float* ks = qs + 256; LAS float* red = ks + 256; LAS float* rs = red + 8 * 256;
    const size_t m = MP + s; const size_t sb = (size_t)(l * 128 + s) * 4 + h;
    __syncthreads();
    float pq = 0.f, pn = 0.f;
    if (tid < 256) { const float q = bf2f(qm[m * 1024 + h * 256 + tid]), k = bf2f(km[m * 1024 + h * 256 + tid]); qs[tid] = q; ks[tid] = k; pq = q * k; pn = q * ctx_in(lds, I_SN)[sb * 256 + tid]; }
    const float qk = block_sum2(rs, pq, tid);
    const float qn = block_sum2(rs + 8, pn, tid);
    const float ig = gates[m * 8 + h], lf = gates[m * 8 + 4 + h], m_prev = ctx_in(lds, I_SM)[sb];
    const float uu = ig - lf, Mx = fmaxf(m_prev, uu), m_t = lf + Mx, w_inter = __expf(m_prev - Mx), ws = __expf(uu - Mx), Sv = qk * ws;
    const int eg = tid & 63, dp = tid >> 6;
    const u32x2 vw = *(const u32x2*)(proj + m * NINP + M0 + 2048 + h * 256 + eg * 4);
    const f32x4 v4 = {__uint_as_float(vw.x << 16), __uint_as_float(vw.x & 0xffff0000u), __uint_as_float(vw.y << 16), __uint_as_float(vw.y & 0xffff0000u)};
    f32x4 num = {0.f, 0.f, 0.f, 0.f};
    const float* __restrict__ Cs = ctx_in(lds, I_SC) + sb * 65536 + eg * 4; float* Co = ctx_out(lds) + O_SC + sb * 65536 + eg * 4;
#pragma unroll 1
    for (int i0 = 0; i0 < 32; i0 += 16) {
        f32x4 cb[16];
#pragma unroll
        for (int i = 0; i < 16; ++i) cb[i] = *(const f32x4*)(Cs + (size_t)(dp + 8 * (i0 + i)) * 256);
        asm volatile("" : "+v"(cb[0]), "+v"(cb[1]), "+v"(cb[2]), "+v"(cb[3]), "+v"(cb[4]), "+v"(cb[5]), "+v"(cb[6]), "+v"(cb[7]));
        asm volatile("" : "+v"(cb[8]), "+v"(cb[9]), "+v"(cb[10]), "+v"(cb[11]), "+v"(cb[12]), "+v"(cb[13]), "+v"(cb[14]), "+v"(cb[15]));
#pragma unroll
        for (int i = 0; i < 16; ++i) { const int d = dp + 8 * (i0 + i); const f32x4 c4 = cb[i];
            num = num + qs[d] * c4; *(f32x4*)(Co + (size_t)d * 256) = w_inter * c4 + (ws * ks[d]) * v4; } }
    *(LAS f32x4*)(red + dp * 256 + eg * 4) = num;
    __syncthreads();
    if (tid < 256) {
        float nsum = 0.f;
#pragma unroll
        for (int j = 0; j < 8; ++j) nsum += red[j * 256 + tid];
        const float ve = bf2f(proj[m * NINP + M0 + 2048 + h * 256 + tid]);
        const float nm = w_inter * nsum + Sv * ve, den = w_inter * qn + Sv;
        hm[m * 1024 + h * 256 + tid] = f2bf(nm / fmaxf(fabsf(den), __expf(-m_t)));
        ctx_out(lds)[O_SN + sb * 256 + tid] = w_inter * ctx_in(lds, I_SN)[sb * 256 + tid] + ws * ks[tid];
        if (tid == 0) ctx_out(lds)[O_SM + sb] = m_t;
    }
}
__device__ __forceinline__ void samp_gla(LAS unsigned char* lds, int l, int u) {
    const int tid = opaque_tid(), s = u >> 2, h = u & 3;
    const bf16_t* __restrict__ proj = (const bf16_t*)(ctx_ws(lds) + WS_PROJ); const bf16_t* __restrict__ gq = (const bf16_t*)(ctx_ws(lds) + WS_GQ); const bf16_t* __restrict__ gk = (const bf16_t*)(ctx_ws(lds) + WS_GK); const bf16_t* __restrict__ gkh = (const bf16_t*)(ctx_ws(lds) + WS_GKH);
    const float* __restrict__ egl = (const float*)(ctx_ws(lds) + WS_EGL); bf16_t* __restrict__ og = (bf16_t*)(ctx_ws(lds) + WS_OG);
    LAS float* qs = (LAS float*)lds; LAS float* ks = qs + 128; LAS float* es = ks + 128; LAS float* red = es + 128; LAS float* rs = red + 8 * 256;
    const size_t m = MP + s; const size_t sb = (size_t)(l * 128 + s) * 4 + h;
    __syncthreads();
    float pa = 0.f;
    if (tid < 128) { const float q = bf2f(gq[m * 512 + h * 128 + tid]), k = bf2f(gk[m * 512 + h * 128 + tid]); qs[tid] = q; ks[tid] = bf2f(gkh[m * 512 + h * 128 + tid]); es[tid] = egl[(size_t)(128 + s) * 512 + h * 128 + tid]; pa = q * k; }
    const float A = block_sum2(rs, pa, tid);
    const int eg = tid & 63, dp = tid >> 6;
    const u32x2 vw = *(const u32x2*)(proj + m * NINP + G0 + 1024 + h * 256 + eg * 4);
    const f32x4 v4 = {__uint_as_float(vw.x << 16), __uint_as_float(vw.x & 0xffff0000u), __uint_as_float(vw.y << 16), __uint_as_float(vw.y & 0xffff0000u)};
    f32x4 o4 = {0.f, 0.f, 0.f, 0.f};
    const float* __restrict__ Ss = ctx_in(lds, I_SGLA) + sb * 32768 + eg * 4; float* So = ctx_out(lds) + O_SGLA + sb * 32768 + eg * 4;
    { f32x4 sb[16];
#pragma unroll
      for (int i = 0; i < 16; ++i) sb[i] = *(const f32x4*)(Ss + (size_t)(dp + 8 * i) * 256);
      asm volatile("" : "+v"(sb[0]), "+v"(sb[1]), "+v"(sb[2]), "+v"(sb[3]), "+v"(sb[4]), "+v"(sb[5]), "+v"(sb[6]), "+v"(sb[7]));
      asm volatile("" : "+v"(sb[8]), "+v"(sb[9]), "+v"(sb[10]), "+v"(sb[11]), "+v"(sb[12]), "+v"(sb[13]), "+v"(sb[14]), "+v"(sb[15]));
#pragma unroll
      for (int i = 0; i < 16; ++i) { const int d = dp + 8 * i; const f32x4 s4 = sb[i];
          o4 = o4 + qs[d] * s4; *(f32x4*)(So + (size_t)d * 256) = es[d] * s4 + ks[d] * v4; } }
    *(LAS f32x4*)(red + dp * 256 + eg * 4) = o4;
    __syncthreads();
    if (tid < 256) { float osum = 0.f;
#pragma unroll
        for (int j = 0; j < 8; ++j) osum += red[j * 256 + tid];
        og[m * 1024 + h * 256 + tid] = f2bf(osum + A * bf2f(proj[m * NINP + G0 + 1024 + h * 256 + tid])); }
}
__device__ __forceinline__ void phase_scan(LAS unsigned char* lds, int l, int G, unsigned* queue, int rmask) {
    for (int u = blockIdx.x; u < 256; u += G) {
        const int slot = u >> 3, x = u & 7, role = slot & 3, s2 = slot >> 2;
        const int idx = role < 2 ? (s2 * 8 + x) : ((x * 2 + (s2 >> 2)) * 4 + (s2 & 3));
#ifndef SC_MASK
#define SC_MASK 63
#endif
        if (rmask && !((rmask >> (role < 2 ? 0 : role - 1)) & 1)) continue;
        if (role < 2) { if (SC_MASK & 1) scan_rwkv(lds, l, idx * 2 + role); }
        else if (role == 2) { if (SC_MASK & 2) scan_mlstm(lds, l, idx); }
        else { if (SC_MASK & 4) scan_gla(lds, l, idx); }
    }
    LAS unsigned* qw = (LAS unsigned*)(lds + 140000);
    for (;;) {
        __syncthreads();
        if (threadIdx.x == 0) *qw = __hip_atomic_fetch_add(queue, 1u, __ATOMIC_RELAXED, __HIP_MEMORY_SCOPE_AGENT);
        __syncthreads();
        const unsigned u = *qw;
        if (u >= 2048u) break;
        if (u < 512u) { if (SC_MASK & 16) samp_mlstm(lds, l, (int)u); }
        else if (u < 1024u) { if (SC_MASK & 32) samp_gla(lds, l, (int)u - 512); }
        else { if (SC_MASK & 8) samp_rwkv(lds, l, (int)u - 1024); }
    }
}

__device__ __forceinline__ void phase_post(LAS unsigned char* lds, int l, int G) {
    const int tid = opaque_tid(), lane = tid & 63, wave = tid >> 6, c0 = lane * 16;
    const bf16_t* __restrict__ proj = (const bf16_t*)(ctx_ws(lds) + WS_PROJ); const float* __restrict__ rpre = (const float*)(ctx_ws(lds) + WS_RPRE); const bf16_t* __restrict__ rout = (const bf16_t*)(ctx_ws(lds) + WS_ROUT);
    const bf16_t* __restrict__ hm = (const bf16_t*)(ctx_ws(lds) + WS_HM); const bf16_t* __restrict__ og = (const bf16_t*)(ctx_ws(lds) + WS_OG); bf16_t* __restrict__ obr = (bf16_t*)(ctx_ws(lds) + WS_QM);
    for (int it = blockIdx.x * 8 + wave; it < MP + 512; it += G * 8) {
        const int m = it < MP ? it : MP + ((it - MP) >> 2); const int part = it < MP ? -1 : (it - MP) & 3;
        const size_t o = (size_t)m * 1024 + c0;
        const bf16_t* prow = proj + (size_t)m * NINP;
        u32x4 L[30];
#define POST_LD(slot, ptr) do { L[slot] = *(const u32x4*)(ptr); L[(slot) + 1] = *(const u32x4*)((ptr) + 8); } while (0)
        if (part < 0 || part == 0) { POST_LD(0, rout + o); POST_LD(2, (const bf16_t*)rpre + 3 * ARR + o); POST_LD(4, (const bf16_t*)rpre + 2 * ARR + o); POST_LD(6, (const bf16_t*)rpre + 4 * ARR + o); POST_LD(8, (const bf16_t*)rpre + 5 * ARR + o); }
        if (part < 0 || part == 1) { POST_LD(10, hm + o); POST_LD(12, prow + M0 + 3080 + c0); }
        if (part < 0 || part == 2) { POST_LD(14, og + o); POST_LD(16, prow + G0 + 2064 + c0); }
        if (part < 0 || part == 3) {
#pragma unroll
            for (int q = 0; q < 2; ++q)
#pragma unroll
                for (int j = 0; j < 3; ++j) POST_LD(18 + (q * 3 + j) * 2, prow + GT0 + j * 2048 + q * 1024 + c0); }
#undef POST_LD
#define POST_UP(slot, arr) do { unpack8(L[slot], *(float(*)[8])&arr[0]); unpack8(L[(slot) + 1], *(float(*)[8])&arr[8]); } while (0)
        if (part < 0 || part == 0) {
            float x[16], r[16], k2[16], v[16], g[16], rk[16], lg[16], lb[16];
            POST_UP(0, x); POST_UP(2, r); POST_UP(4, k2); POST_UP(6, v); POST_UP(8, g);
            ld16f(ctx_in(lds, I_RK) + l * 1024 + c0, rk); ld16f(ctx_in(lds, I_LNG) + l * 1024 + c0, lg); ld16f(ctx_in(lds, I_LNB) + l * 1024 + c0, lb);
            float s = 0.f, bs = 0.f;
#pragma unroll
            for (int j = 0; j < 16; ++j) { s += x[j]; bs += r[j] * k2[j] * rk[j]; }
            s += __shfl_xor(s, 1); s += __shfl_xor(s, 2); bs += __shfl_xor(bs, 1); bs += __shfl_xor(bs, 2);
            const float mean = s * (1.f / 64.f); float q = 0.f;
#pragma unroll
            for (int j = 0; j < 16; ++j) { const float d = x[j] - mean; q += d * d; }
            q += __shfl_xor(q, 1); q += __shfl_xor(q, 2);
            const float rstd = rsqrtf(q * (1.f / 64.f) + 64e-5f);
            float y[16];
#pragma unroll
            for (int j = 0; j < 16; ++j) y[j] = ((x[j] - mean) * rstd * lg[j] + lb[j] + bs * v[j]) * g[j];
            st16b(obr + (size_t)m * 3072 + c0, y);
        }
        if (part < 0 || part == 1) {
            float x[16], ng[16], go[16];
            POST_UP(10, x); POST_UP(12, go); ld16f(ctx_in(lds, I_MNORM) + l * 1024 + c0, ng);
            float q = 0.f;
#pragma unroll
            for (int j = 0; j < 16; ++j) q += x[j] * x[j];
            q += __shfl_xor(q, 1); q += __shfl_xor(q, 2); q += __shfl_xor(q, 4); q += __shfl_xor(q, 8);
            const float rs = rsqrtf(q * (1.f / 256.f) + 1e-6f);
            float y[16];
#pragma unroll
            for (int j = 0; j < 16; ++j) y[j] = x[j] * rs * ng[j] * sigm(go[j]);
            st16b(obr + (size_t)m * 3072 + 1024 + c0, y);
        }
        if (part < 0 || part == 2) {
            float x[16], ng[16], go[16];
            POST_UP(14, x); POST_UP(16, go); ld16f(ctx_in(lds, I_GNORM) + l * 1024 + c0, ng);
            float q = 0.f;
#pragma unroll
            for (int j = 0; j < 16; ++j) q += x[j] * x[j];
            q += __shfl_xor(q, 1); q += __shfl_xor(q, 2); q += __shfl_xor(q, 4); q += __shfl_xor(q, 8);
            const float rs = rsqrtf(q * (1.f / 256.f) + 1e-6f);
            float y[16];
#pragma unroll
            for (int j = 0; j < 16; ++j) y[j] = x[j] * rs * ng[j] * siluf(go[j]);
            st16b(obr + (size_t)m * 3072 + 2048 + c0, y);
        }
        if (part < 0 || part == 3) {
            bf16_t* __restrict__ gr = (bf16_t*)(ctx_ws(lds) + WS_RPRE + RP_GR) + (size_t)m * 6144; const float* __restrict__ gbv = ctx_in(lds, I_GATEB) + (size_t)l * 3 * 2048;
#pragma unroll
            for (int q = 0; q < 2; ++q) { const int d0 = q * 1024 + c0;
                float e0[16], e1[16], e2[16], gb[16];
                POST_UP(18 + (q * 3 + 0) * 2, e0); POST_UP(18 + (q * 3 + 1) * 2, e1); POST_UP(18 + (q * 3 + 2) * 2, e2);
                ld16f(gbv + d0, gb);
#pragma unroll
                for (int j = 0; j < 16; ++j) e0[j] = 1.f + __expf(-(e0[j] + gb[j]));
                ld16f(gbv + 2048 + d0, gb);
#pragma unroll
                for (int j = 0; j < 16; ++j) e1[j] = 1.f + __expf(-(e1[j] + gb[j]));
                ld16f(gbv + 4096 + d0, gb);
#pragma unroll
                for (int j = 0; j < 16; ++j) { e2[j] = 1.f + __expf(-(e2[j] + gb[j])); const float i0 = __builtin_amdgcn_rcpf(e0[j]), i1 = __builtin_amdgcn_rcpf(e1[j]), i2 = __builtin_amdgcn_rcpf(e2[j]);
                    e0[j] = e1[j] * i0; e1[j] = e2[j] * i1; e2[j] = i2; }
                st16b(gr + d0, e0); st16b(gr + 2048 + d0, e1); st16b(gr + 4096 + d0, e2); }
        }
#undef POST_UP
    }
}

template <int MODE>
__device__ __forceinline__ void skinny_phase(LAS unsigned char* lds, const bf16_t* A, int lda, const bf16_t* Bt, int ldb, int K, float* X, bf16_t* merged, const bf16_t* gr, const float* unused, int G) {
    const int tid = opaque_tid(), lane = tid & 63, wave = tid >> 6, lr = lane & 15, lq = lane >> 4, rt = wave & 3, kh = wave >> 2;
    LAS float* xch = (LAS float*)lds;
    for (int u = blockIdx.x; u < 256; u += G) {
        const int cg = u >> 1, rh = u & 1;
        const bf16_t* ap = A + (size_t)(MP + rh * 64 + rt * 16 + lr) * lda + lq * 8;
        const bf16_t* bp = Bt + (size_t)(cg * 16 + lr) * ldb + lq * 8;
        const int row0 = MP + rh * 64 + rt * 16 + lq * 4, col = cg * 16 + lr;
        constexpr int NJ = MODE == 0 ? 1 : 3;
        const int Kj = MODE == 0 ? K : 1024, Kh = Kj / 2;
        f32x4 acc[NJ];
#pragma unroll
        for (int j = 0; j < NJ; ++j) {
            f32x4 a0c = {0.f, 0.f, 0.f, 0.f}, a1c = {0.f, 0.f, 0.f, 0.f};
            const bf16_t* aj = ap + j * 1024 + kh * Kh; const bf16_t* bj = bp + j * 1024 + kh * Kh;
            bf16x8 av[8], bv[8], an[8], bn[8];
#pragma unroll
            for (int i = 0; i < 8; ++i) { av[i] = *(const bf16x8*)(aj + i * 32); bv[i] = *(const bf16x8*)(bj + i * 32); }
            for (int k0 = 0; k0 < Kh; k0 += 256) {
                const int kn = k0 + 256 < Kh ? k0 + 256 : k0;
#pragma unroll
                for (int i = 0; i < 8; ++i) { an[i] = *(const bf16x8*)(aj + kn + i * 32); bn[i] = *(const bf16x8*)(bj + kn + i * 32); }
#pragma unroll
                for (int i = 0; i < 8; i += 2) { a0c = MFMA16(av[i], bv[i], a0c); a1c = MFMA16(av[i + 1], bv[i + 1], a1c); }
#pragma unroll
                for (int i = 0; i < 8; ++i) { av[i] = an[i]; bv[i] = bn[i]; }
            }
            acc[j] = a0c + a1c;
        }
        __syncthreads();
        if (kh == 1) {
#pragma unroll
            for (int j = 0; j < NJ; ++j) *(LAS f32x4*)(xch + ((j * 4 + rt) * 64 + lane) * 4) = acc[j]; }
        __syncthreads();
        if (kh == 0) {
#pragma unroll
            for (int j = 0; j < NJ; ++j) acc[j] = acc[j] + *(const LAS f32x4*)(xch + ((j * 4 + rt) * 64 + lane) * 4);
            if (MODE == 0) {
                { float xo[4];
#pragma unroll
                  for (int r = 0; r < 4; ++r) xo[r] = X[(size_t)(row0 + r) * 2048 + col];
                  asm volatile("" : "+v"(xo[0]), "+v"(xo[1]), "+v"(xo[2]), "+v"(xo[3]));
#pragma unroll
                  for (int r = 0; r < 4; ++r) X[(size_t)(row0 + r) * 2048 + col] = xo[r] + acc[0][r]; }
            } else {
#pragma unroll
                for (int r = 0; r < 4; ++r) { float o = 0.f;
#pragma unroll
                    for (int j = 0; j < NJ; ++j) o = (o + acc[j][r]) * bf2f(gr[(size_t)(row0 + r) * 6144 + j * 2048 + col]);
                    merged[(size_t)(row0 + r) * 2048 + col] = f2bf(o); }
            }
        }
    }
}

constexpr int N_PHASES = 22;
constexpr int CW_BAR = 1024, CW_QUEUE = 8192;

__global__ void __launch_bounds__(NTHREADS, 2) fwd_kernel(Args a) {
    extern __shared__ __attribute__((aligned(16))) unsigned char lds_raw[];
    LAS unsigned char* lds = (LAS unsigned char*)lds_raw;
    const int tid = opaque_tid(), G = gridDim.x;
    volatile LAS unsigned* misc = (volatile LAS unsigned*)(lds + 147456 - 64);
    if (tid < 16) misc[tid] = 0u;
    if (tid < 39) ((LAS unsigned long long*)(lds + PTAB_OFF))[tid] = ((const unsigned long long*)&a)[tid];
    __syncthreads();
    unsigned* ctl = (unsigned*)(ctx_ws(lds) + WS_CTL);
    XcdBarrier bar; bar.bar = ctl + CW_BAR; bar.x = 0; bar.st = misc;
    if (MK_N_LAUNCHES == 1) bar = xcd_barrier_post(ctl + CW_BAR, misc);
    const int lo = a.ph_lo, hi = a.ph_hi & 0xff, rmask = (a.ph_hi >> 8) & 0xff;
#ifndef PH_MASK
#define PH_MASK 0xFFFu
#endif
#define PHM(b) ((PH_MASK >> (b)) & 1u)
#define IN(k) (lo <= (k) && (k) < hi)
#define SEAM(k) do { if (MK_N_LAUNCHES == 1 && IN(k) && IN((k) + 1)) xcd_barrier(bar); } while (0)
    if (PHM(0) && IN(0)) { phase_prologue(lds, opq(G)); SEAM(0); }
#pragma nounroll
    for (int l = 0; l < 2; ++l) {
        const int pb = 1 + 10 * l;
        if (PHM(1) && IN(pb + 0)) { phase_norm(lds, opq(G), ctx_in(lds, I_NORM1) + opq(l) * 2048, opq(l) == 0); SEAM(pb + 0); }
        if (PHM(2) && IN(pb + 1)) {
            pg8::Gemm g{(const bf16_t*)(ctx_ws(lds) + WS_H), (const bf16_t*)(ctx_ws(lds) + WS_W + (size_t)opq(l) * LW_BYTES + LW_WIN), MPAD, NINP, 2048, 2048, 2048};
            pg8::StaticOrder S; S.init(MPAD, NINP, opq(G), (int)blockIdx.x);
            pg8::EpiProj E{(bf16_t*)(ctx_ws(lds) + WS_PROJ), NINP};
            pg8::gemm_phase(lds, g, S, E);
            SEAM(pb + 1);
        }
        if (PHM(3) && IN(pb + 2)) { phase_pre(lds, opq(l), opq(G)); SEAM(pb + 2); }
        if (PHM(4) && IN(pb + 3)) { phase_scan(lds, opq(l), opq(G), (unsigned*)(ctx_ws(lds) + WS_CTL) + CW_QUEUE + 64 * opq(l), rmask); SEAM(pb + 3); }
        if (PHM(5) && IN(pb + 4)) { phase_post(lds, opq(l), opq(G)); SEAM(pb + 4); }
        if (PHM(6) && IN(pb + 5)) {
            pg8::StaticOrder S; S.init(MP, 2048, opq(G), (int)blockIdx.x);
            const bf16_t* obr = (const bf16_t*)(ctx_ws(lds) + WS_QM); const bf16_t* wbr = (const bf16_t*)(ctx_ws(lds) + WS_W + (size_t)opq(l) * LW_BYTES + LW_WBR);
            bf16_t* merged = (bf16_t*)(ctx_ws(lds) + WS_H); const bf16_t* gr = (const bf16_t*)(ctx_ws(lds) + WS_RPRE + RP_GR);
            { pg8::Gemm g{obr, wbr, MP, 2048, 3072, 3072, 3072}; pg8::EpiBranchK E{merged, gr}; pg8::gemm_phase(lds, g, S, E); }
            skinny_phase<1>(lds, obr, 3072, wbr, 3072, 3072, nullptr, merged, gr, nullptr, opq(G));
            SEAM(pb + 5);
        }
        if (PHM(7) && IN(pb + 6)) {
            pg8::Gemm g{(const bf16_t*)(ctx_ws(lds) + WS_H), (const bf16_t*)(ctx_ws(lds) + WS_W + (size_t)opq(l) * LW_BYTES + LW_WOUT), MP, 2048, 2048, 2048, 2048};
            pg8::StaticOrder S; S.init(MP, 2048, opq(G), (int)blockIdx.x);
            pg8::EpiResid E{(float*)(ctx_ws(lds) + WS_X), 2048};
            pg8::gemm_phase(lds, g, S, E);
            skinny_phase<0>(lds, g.A, 2048, g.Bt, 2048, 2048, (float*)(ctx_ws(lds) + WS_X), nullptr, nullptr, nullptr, opq(G));
            SEAM(pb + 6);
        }
        if (PHM(8) && IN(pb + 7)) { phase_norm(lds, opq(G), ctx_in(lds, I_NORM2) + opq(l) * 2048, false); SEAM(pb + 7); }
        if (PHM(9) && IN(pb + 8)) {
            pg8::Gemm g{(const bf16_t*)(ctx_ws(lds) + WS_H), (const bf16_t*)(ctx_ws(lds) + WS_W + (size_t)opq(l) * LW_BYTES + LW_WGU), MPAD, 11264, 2048, 2048, 2048};
            pg8::StaticOrder S; S.init(MPAD, 11264, opq(G), (int)blockIdx.x);
            pg8::EpiSwiGLU E{(bf16_t*)(ctx_ws(lds) + WS_PROJ), DFF};
            pg8::gemm_phase(lds, g, S, E);
            SEAM(pb + 8);
        }
        if (PHM(10) && IN(pb + 9)) {
            pg8::Gemm g{(const bf16_t*)(ctx_ws(lds) + WS_PROJ), (const bf16_t*)(ctx_ws(lds) + WS_W + (size_t)opq(l) * LW_BYTES + LW_WDN), MP, 2048, DFF, DFF, DFF};
            pg8::StaticOrder S; S.init(MP, 2048, opq(G), (int)blockIdx.x);
            pg8::EpiResid E{(float*)(ctx_ws(lds) + WS_X), 2048};
            pg8::gemm_phase(lds, g, S, E);
            skinny_phase<0>(lds, g.A, DFF, g.Bt, DFF, DFF, (float*)(ctx_ws(lds) + WS_X), nullptr, nullptr, nullptr, opq(G));
            SEAM(pb + 9);
        }
    }
    if (PHM(11) && IN(21)) phase_final(lds, opq(G));
    if (IN(22)) phase_dump(lds, G);
#undef IN
#undef SEAM
}

extern "C" void kernel_launch(void* const* d_in, const int* in_sizes, int n_in, void* d_out, int out_size, void* d_ws, size_t ws_size, hipStream_t stream) {
    static int grid = 0;
    if (grid == 0) {
        if (n_in != 37 || ws_size < WS_END) { fprintf(stderr, "kernel_launch: expected 37 inputs and >= %zu bytes of workspace; got %d, %zu\n", (size_t)WS_END, n_in, ws_size); grid = -1; return; }
        int dev = 0, cus = 0, per_cu = 0;
        if (hipGetDevice(&dev) != hipSuccess || hipDeviceGetAttribute(&cus, hipDeviceAttributeMultiprocessorCount, dev) != hipSuccess) { grid = -1; return; }
        if (hipFuncSetAttribute((const void*)fwd_kernel, hipFuncAttributeMaxDynamicSharedMemorySize, LDS_BYTES) != hipSuccess) { fprintf(stderr, "kernel_launch: hipFuncSetAttribute failed\n"); grid = -1; return; }
        if (hipOccupancyMaxActiveBlocksPerMultiprocessor(&per_cu, (const void*)fwd_kernel, NTHREADS, LDS_BYTES) != hipSuccess || per_cu < 1) { fprintf(stderr, "kernel_launch: occupancy query says %d\n", per_cu); }
        (void)hipGetLastError();
        grid = cus;
    }
    if (grid < 0) return;
    (void)hipMemsetAsync((char*)d_ws + WS_CTL, 0, CTL_BYTES, stream);
    Args a{};
    for (int i = 0; i < 37; ++i) a.in[i] = (const float*)d_in[i];
    a.out = (float*)d_out; a.ws = (unsigned char*)d_ws;
    if (MK_N_LAUNCHES == 1) { a.ph_lo = 0; a.ph_hi = N_PHASES; hipLaunchKernelGGL(fwd_kernel, dim3(grid), dim3(NTHREADS), LDS_BYTES, stream, a); }
    else { for (int p = 0; p < DBG_LIM; ++p) { a.ph_lo = p; a.ph_hi = p + 1; hipLaunchKernelGGL(fwd_kernel, dim3(grid), dim3(NTHREADS), LDS_BYTES, stream, a);
            const int kind = p == 0 ? 0 : (p == 21 ? 11 : 1 + (p - 1) % 10);
            if ((DBG_REP_MASK >> kind) & 1) { a.ph_hi = (p + 1) | (DBG_ROLE_MASK << 8); hipLaunchKernelGGL(fwd_kernel, dim3(grid), dim3(NTHREADS), LDS_BYTES, stream, a); } }
        if (DBG_LIM < 22) { a.ph_lo = 22; a.ph_hi = 23; hipLaunchKernelGGL(fwd_kernel, dim3(grid), dim3(NTHREADS), LDS_BYTES, stream, a); } }
}
```

```cpp
#include <hip/hip_runtime.h>
#include <cstdio>
#include <cstdint>

#ifndef MK_N_LAUNCHES
#define MK_N_LAUNCHES 1
#endif

#ifndef DBG_LIM
#define DBG_LIM 22
#ifndef DBG_ROLE_MASK
#define DBG_ROLE_MASK 0
#endif
#ifndef DBG_REP_MASK
#define DBG_REP_MASK 0
#endif
#define DBG_SEL 2
#endif
#define LAS __attribute__((address_space(3)))
typedef unsigned short bf16_t;
typedef short bf16x8 __attribute__((ext_vector_type(8)));
typedef float f32x4 __attribute__((ext_vector_type(4)));
typedef unsigned u32x4 __attribute__((ext_vector_type(4)));
typedef unsigned u32x2 __attribute__((ext_vector_type(2)));

constexpr int DM = 2048, MP = 8192, MT = 8320, MPAD = 8448, NINP = 16640, NIN = 16600;
constexpr int RC = 3264, M0 = 3264, G0 = 7368, GT0 = 10456, DFF = 5632;
constexpr int NTHREADS = 512;
constexpr size_t O_YP = 0, O_YS = 16777216, O_PSHIFT = 17039360, O_PWKV = 17065472, O_PCONV = 17589760, O_PC = 17638912, O_PN = 19736064, O_PM = 19744256,
                 O_PGLA = 19744288, O_SSHIFT = 20792864, O_SWKV = 21628448, O_SCONV = 38405664, O_SC = 39978528, O_SN = 107087392, O_SM = 107349536, O_SGLA = 107350560;
constexpr size_t AL(size_t x) { return (x + 255) & ~(size_t)255; }
constexpr size_t WS_CTL = 0, CTL_BYTES = 1u << 20;
constexpr size_t LW_WIN = 0, LW_WBR = LW_WIN + (size_t)NINP * 2048 * 2, LW_WOUT = LW_WBR + (size_t)3 * 2048 * 1024 * 2, LW_WGU = LW_WOUT + (size_t)2048 * 2048 * 2,
                 LW_WDN = LW_WGU + (size_t)11264 * 2048 * 2, LW_LORA = LW_WDN + (size_t)2048 * 5632 * 2, LW_GA2 = LW_LORA + (size_t)3 * 1024 * 64 * 2, LW_BYTES = LW_GA2 + (size_t)512 * 32 * 2;
constexpr size_t WS_W = CTL_BYTES;
constexpr size_t WS_X = AL(WS_W + 2 * LW_BYTES);
constexpr size_t WS_H = AL(WS_X + (size_t)MPAD * 2048 * 4);
constexpr size_t WS_PROJ = AL(WS_H + (size_t)MPAD * 2048 * 2);
constexpr size_t ARR = (size_t)MT * 1024;
constexpr size_t WS_RPRE = AL(WS_PROJ + (size_t)MPAD * NINP * 2);
constexpr size_t WS_ROUT = AL(WS_RPRE + 7 * ARR * 4);
constexpr size_t WS_QM = AL(WS_ROUT + ARR * 4);
constexpr size_t WS_KM = WS_QM + ARR * 2, WS_GQ = WS_KM + ARR * 2, WS_GK = WS_GQ + ARR, WS_GKH = WS_GK + ARR;
constexpr size_t WS_GATES = AL(WS_GKH + ARR);
constexpr size_t WS_EGL = AL(WS_GATES + (size_t)MT * 8 * 4);
constexpr size_t WS_HM = AL(WS_EGL + (size_t)256 * 512 * 4);
constexpr size_t WS_OG = AL(WS_HM + ARR * 4);
constexpr size_t WS_END = AL(WS_OG + ARR * 4);
static_assert((size_t)MPAD * 3072 * 2 <= WS_GATES - WS_QM, "obr alias");
static_assert((size_t)MPAD * 2048 * 4 <= 7 * ARR * 4, "macc alias");

__device__ __forceinline__ float bf2f(bf16_t b) { return __uint_as_float(((unsigned)b) << 16); }
typedef __bf16 bf16x2_t __attribute__((ext_vector_type(2)));
typedef float f32x2_t __attribute__((ext_vector_type(2)));
__device__ __forceinline__ unsigned pk2(float lo, float hi) { const f32x2_t v = {lo, hi}; return __builtin_bit_cast(unsigned, __builtin_convertvector(v, bf16x2_t)); }
__device__ __forceinline__ bf16_t f2bf(float f) { return (bf16_t)(pk2(f, 0.f) & 0xffffu); }
__device__ __forceinline__ void unpack8(const u32x4 w, float (&f)[8]) {
    f[0] = __uint_as_float(w.x << 16); f[1] = __uint_as_float(w.x & 0xffff0000u); f[2] = __uint_as_float(w.y << 16); f[3] = __uint_as_float(w.y & 0xffff0000u);
    f[4] = __uint_as_float(w.z << 16); f[5] = __uint_as_float(w.z & 0xffff0000u); f[6] = __uint_as_float(w.w << 16); f[7] = __uint_as_float(w.w & 0xffff0000u);
}
__device__ __forceinline__ u32x4 pack8(const float (&f)[8]) { u32x4 w; w.x = pk2(f[0], f[1]); w.y = pk2(f[2], f[3]); w.z = pk2(f[4], f[5]); w.w = pk2(f[6], f[7]); return w; }
__device__ __forceinline__ void ld8f(const float* p, float (&f)[8]) { const f32x4 a = *(const f32x4*)p, b = *(const f32x4*)(p + 4); f[0] = a.x; f[1] = a.y; f[2] = a.z; f[3] = a.w; f[4] = b.x; f[5] = b.y; f[6] = b.z; f[7] = b.w; }
__device__ __forceinline__ void st8f(float* p, const float (&f)[8]) { *(f32x4*)p = (f32x4){f[0], f[1], f[2], f[3]}; *(f32x4*)(p + 4) = (f32x4){f[4], f[5], f[6], f[7]}; }
__device__ __forceinline__ void ld8b(const bf16_t* p, float (&f)[8]) { unpack8(*(const u32x4*)p, f); }
__device__ __forceinline__ float sigm(float x) { return 1.f / (1.f + __expf(-x)); }
__device__ __forceinline__ float siluf(float x) { return x / (1.f + __expf(-x)); }
__device__ __forceinline__ float tanh_fast(float x) { const float e = __expf(2.f * x); return 1.f - 2.f / (e + 1.f); }
__device__ __forceinline__ float logsig_fast(float x) { return fminf(x, 0.f) - __logf(1.f + __expf(-fabsf(x))); }
__device__ __forceinline__ float wave_sum(float v) {
#pragma unroll
    for (int o = 1; o < 64; o <<= 1) v += __shfl_xor(v, o);
    return v;
}
template <int CTRL> __device__ __forceinline__ float dppf(float v) { return __int_as_float(__builtin_amdgcn_update_dpp(0, __float_as_int(v), CTRL, 0xF, 0xF, true)); }
__device__ __forceinline__ float row16_sum(float x) { x += dppf<0xB1>(x); x += dppf<0x4E>(x); x += dppf<0x141>(x); x += dppf<0x140>(x); return x; }
__device__ __forceinline__ float row8_sum(float x) { x += dppf<0xB1>(x); x += dppf<0x4E>(x); x += dppf<0x141>(x); return x; }
__device__ __forceinline__ float quad_sum(float x) { x += dppf<0xB1>(x); x += dppf<0x4E>(x); return x; }
__device__ __forceinline__ int opq(int x) { asm volatile("" : "+s"(x)); return x; }
__device__ __forceinline__ int opaque_tid() { int t = threadIdx.x; asm volatile("" : "+v"(t)); return t; }
__device__ __forceinline__ f32x4 mfma16_safe(const bf16x8 a, const bf16x8 b, const f32x4 c) { f32x4 d = __builtin_amdgcn_mfma_f32_16x16x32_bf16(a, b, c, 0, 0, 0); asm volatile("" : "+v"(d) : "v"(a), "v"(b)); return d; }
#define MFMA16(a, b, c) mfma16_safe((a), (b), (c))
#define LDS_WAIT() asm volatile("s_waitcnt lgkmcnt(0)" ::: "memory")

#define XB_TMO      128
#define XB_XCNT(j)  (256  + 64 * (j))
#define XB_XSUB(j)  (1280 + 64 * (j))
#define XB_XGEN(j)  (2304 + 64 * (j))
#define XB_TOP      3328
#define XB_TOPGEN   3392
#define XCD_BAR_WORDS 3456
#define XB_SPIN_CAP (1u << 18)
__device__ __forceinline__ unsigned xb_ld(unsigned* p)              { return __hip_atomic_load(p, __ATOMIC_RELAXED, __HIP_MEMORY_SCOPE_AGENT); }
__device__ __forceinline__ unsigned xb_add(unsigned* p, unsigned v) { return __hip_atomic_fetch_add(p, v, __ATOMIC_RELAXED, __HIP_MEMORY_SCOPE_AGENT); }
__device__ __forceinline__ unsigned xb_xcc_id() { return (unsigned)__builtin_amdgcn_s_getreg((3 << 11) | 20) & 0xFu; }
#define XB_SPIN(cond, bar) do { unsigned _sp = 0; while (cond) { __builtin_amdgcn_s_sleep(1); \
    if ((++_sp & 255u) == 0u) { if (xb_ld(&(bar)[XB_TMO])) break; if (_sp > XB_SPIN_CAP) { atomicAdd(&(bar)[XB_TMO], 1u); break; } } } } while (0)
struct XcdBarrier { unsigned* bar; unsigned x; volatile LAS unsigned* st; };
__device__ __forceinline__ XcdBarrier xcd_barrier_post(unsigned* bar, volatile LAS unsigned* st) {
    XcdBarrier b; b.bar = bar; b.x = xb_xcc_id(); b.st = st;
    if (threadIdx.x == 0) (void)xb_add(&bar[XB_XCNT(b.x)], 1u);
    return b;
}
__device__ __forceinline__ void xcd_barrier_complete(unsigned* bar, unsigned x, unsigned& nloc, unsigned& nx) {
    const unsigned G = gridDim.x * gridDim.y * gridDim.z;
    unsigned sum, cnt, mine, sp = 0u;
    for (;;) {
        sum = 0u; cnt = 0u; mine = 0u;
#pragma unroll
        for (unsigned j = 0; j < 16; ++j) { const unsigned c = xb_ld(&bar[XB_XCNT(j)]); sum += c; cnt += (c > 0u) ? 1u : 0u; mine = (j == x) ? c : mine; }
        if (sum == G) break;
        __builtin_amdgcn_s_sleep(1);
        if ((++sp & 255u) == 0u) { if (xb_ld(&bar[XB_TMO])) break; if (sp > XB_SPIN_CAP) { atomicAdd(&bar[XB_TMO], 1u); break; } }
    }
    nloc = mine > 0u ? mine : 1u; nx = cnt > 0u ? cnt : 1u;
}
__device__ __forceinline__ void xcd_barrier(const XcdBarrier& b) {
    asm volatile("s_waitcnt vmcnt(0)" ::: "memory");
    __syncthreads();
    if (threadIdx.x == 0) {
        unsigned* bar = b.bar;
        __builtin_amdgcn_s_waitcnt(0);
        unsigned nloc = b.st[0], nx = b.st[1];
        if (nloc == 0u) { xcd_barrier_complete(bar, b.x, nloc, nx); b.st[0] = nloc; b.st[1] = nx; }
        const unsigned old = xb_add(&bar[XB_XSUB(b.x)], 1u);
        const unsigned gen = old / nloc;
        if (old + 1u == (gen + 1u) * nloc) {
            __builtin_amdgcn_fence(__ATOMIC_RELEASE, "agent");
            asm volatile("s_waitcnt vmcnt(0)" ::: "memory");
            const unsigned og = xb_add(&bar[XB_TOP], 1u);
            const unsigned tg = og / nx;
            if (og + 1u == (tg + 1u) * nx) xb_add(&bar[XB_TOPGEN], 1u);
            else XB_SPIN(xb_ld(&bar[XB_TOPGEN]) == tg, bar);
            __builtin_amdgcn_fence(__ATOMIC_ACQUIRE, "agent");
            xb_add(&bar[XB_XGEN(b.x)], 1u);
            asm volatile("s_waitcnt vmcnt(0)" ::: "memory");
        } else {
            XB_SPIN(xb_ld(&bar[XB_XGEN(b.x)]) == gen, bar);
            __builtin_amdgcn_fence(__ATOMIC_ACQUIRE, "agent");
            asm volatile("s_waitcnt vmcnt(0)" ::: "memory");
        }
    }
    __syncthreads();
}

namespace pg8 {
constexpr int BM = 256, BK = 64, HALF = 128, HTB = HALF * BK * 2, STAGE_BYTES = 8 * HTB, NXCD = 8, WGM = 8;
__host__ __device__ __forceinline__ int lds_byte(int r, int c) { const int st = (r >> 4) * 2 + (c >> 5), rr = r & 15, cc = c & 31, ob = rr * 64 + cc * 2; return st * 1024 + (ob ^ (((ob >> 9) & 1) << 5)); }
__host__ __device__ __forceinline__ void stage_rc(int b, int& R, int& C) { const int st = b / 1024, sb = b % 1024, swz = sb ^ (((sb >> 9) & 1) << 5); R = (st >> 1) * 16 + swz / 64; C = (st & 1) * 32 + (swz % 64) / 2; }
__host__ __device__ __forceinline__ int perm32(int rho) { const int n = rho >> 4, i = rho & 15; return 8 * (i >> 2) + 4 * n + (i & 3); }
struct Unit { int pm, pn; };
struct Gemm { const bf16_t* A; const bf16_t* Bt; int M, N, K, lda, ldb; };
struct StaticOrder {
    int nM, nN, nwg, G, c;
    __device__ void init(int M, int N, int G_, int c_) { nM = M / BM; nN = N / BM; nwg = nM * nN; G = G_; c = c_; }
    __device__ bool next(int i, Unit& u) const {
        const long L = (long)i * G + c; if (L >= nwg) return false;
        int wgid = (int)L; { const int q = nwg / NXCD, r = nwg % NXCD, xcd = wgid % NXCD, off = wgid / NXCD; wgid = (xcd < r ? xcd * (q + 1) : r * (q + 1) + (xcd - r) * q) + off; }
        const int nig = WGM * nN, gid = wgid / nig, fm = gid * WGM, gsz = (nM - fm) < WGM ? (nM - fm) : WGM;
        u.pm = fm + ((wgid % nig) % gsz); u.pn = (wgid % nig) / gsz; return true;
    }
};
struct EpiProj {
    static constexpr bool PERM = true, HOOK = false;
    bf16_t* O; int ldc;
    __device__ __forceinline__ void operator()(const f32x4 (&acc)[2][2][4][2], const Unit& u, int wr, int wc, int fr, int fq) const {
        const int row0 = u.pm * BM + wr * 64 + fr, col0 = u.pn * BM + wc * 32 + 8 * fq;
#pragma unroll
        for (int ai = 0; ai < 2; ++ai)
#pragma unroll
            for (int m = 0; m < 4; ++m) { bf16_t* rowp = O + (size_t)(row0 + ai * HALF + m * 16) * ldc + col0;
#pragma unroll
                for (int bj = 0; bj < 2; ++bj) { const f32x4 v0 = acc[ai][bj][m][0], v1 = acc[ai][bj][m][1];
                    u32x4 w; w.x = pk2(v0[0], v0[1]); w.y = pk2(v0[2], v0[3]); w.z = pk2(v1[0], v1[1]); w.w = pk2(v1[2], v1[3]);
                    *(u32x4*)(rowp + bj * HALF) = w; } }
    }
};
struct EpiSwiGLU {
    static constexpr bool PERM = true, HOOK = false;
    bf16_t* O; int ldc;
    __device__ __forceinline__ void operator()(const f32x4 (&acc)[2][2][4][2], const Unit& u, int wr, int wc, int fr, int fq) const {
        const int row0 = u.pm * BM + wr * 64 + fr, col0 = u.pn * HALF + wc * 32 + 8 * fq;
#pragma unroll
        for (int ai = 0; ai < 2; ++ai)
#pragma unroll
            for (int m = 0; m < 4; ++m) { bf16_t* rowp = O + (size_t)(row0 + ai * HALF + m * 16) * ldc + col0;
                float o[8];
#pragma unroll
                for (int n = 0; n < 2; ++n)
#pragma unroll
                    for (int j = 0; j < 4; ++j) o[n * 4 + j] = siluf(acc[ai][0][m][n][j]) * acc[ai][1][m][n][j];
                *(u32x4*)rowp = pack8(o); }
    }
};
struct EpiResid {
    static constexpr bool PERM = false, HOOK = false;
    float* X; int ldc;
    __device__ __forceinline__ void operator()(const f32x4 (&acc)[2][2][4][2], const Unit& u, int wr, int wc, int fr, int fq) const {
        const int row0 = u.pm * BM + wr * 64 + fr, col0 = u.pn * BM + wc * 32 + 4 * fq;
#pragma unroll
        for (int ai = 0; ai < 2; ++ai) {
            f32x4 xv[4][2][2];
#pragma unroll
            for (int m = 0; m < 4; ++m)
#pragma unroll
                for (int bj = 0; bj < 2; ++bj)
#pragma unroll
                    for (int n = 0; n < 2; ++n) xv[m][bj][n] = *(const f32x4*)(X + (size_t)(row0 + ai * HALF + m * 16) * ldc + col0 + bj * HALF + n * 16);
#pragma unroll
            for (int m = 0; m < 4; ++m) asm volatile("" : "+v"(xv[m][0][0]), "+v"(xv[m][0][1]), "+v"(xv[m][1][0]), "+v"(xv[m][1][1]));
#pragma unroll
            for (int m = 0; m < 4; ++m)
#pragma unroll
                for (int bj = 0; bj < 2; ++bj)
#pragma unroll
                    for (int n = 0; n < 2; ++n) *(f32x4*)(X + (size_t)(row0 + ai * HALF + m * 16) * ldc + col0 + bj * HALF + n * 16) = xv[m][bj][n] + acc[ai][bj][m][n];
        }
    }
};
struct EpiBranchK {
    static constexpr bool PERM = true, HOOK = true;
    bf16_t* merged; const bf16_t* gr;
    __device__ __forceinline__ void hook(f32x4 (&acc)[2][2][4][2], const Unit& u, int jn, int wr, int wc, int fr, int fq) const {
        int row0 = u.pm * BM + wr * 64 + fr, col0 = u.pn * BM + wc * 32 + 8 * fq;
        asm volatile("" : "+v"(row0), "+v"(col0));
        u32x4 rv[2][4][2];
#pragma unroll
        for (int ai = 0; ai < 2; ++ai)
#pragma unroll
            for (int m = 0; m < 4; ++m)
#pragma unroll
                for (int bj = 0; bj < 2; ++bj) rv[ai][m][bj] = *(const u32x4*)(gr + (size_t)(row0 + ai * HALF + m * 16) * 6144 + (jn - 1) * 2048 + col0 + bj * HALF);
#pragma unroll
        for (int ai = 0; ai < 2; ++ai)
#pragma unroll
            for (int m = 0; m < 4; ++m)
#pragma unroll
                for (int bj = 0; bj < 2; ++bj) { float r[8]; unpack8(rv[ai][m][bj], r);
#pragma unroll
                    for (int i = 0; i < 8; ++i) acc[ai][bj][m][i >> 2][i & 3] *= r[i]; }
    }
    __device__ __forceinline__ void operator()(const f32x4 (&acc)[2][2][4][2], const Unit& u, int wr, int wc, int fr, int fq) const {
        const int row0 = u.pm * BM + wr * 64 + fr, col0 = u.pn * BM + wc * 32 + 8 * fq;
        u32x4 rv[2][4][2];
#pragma unroll
        for (int ai = 0; ai < 2; ++ai)
#pragma unroll
            for (int m = 0; m < 4; ++m)
#pragma unroll
                for (int bj = 0; bj < 2; ++bj) rv[ai][m][bj] = *(const u32x4*)(gr + (size_t)(row0 + ai * HALF + m * 16) * 6144 + 4096 + col0 + bj * HALF);
#pragma unroll
        for (int ai = 0; ai < 2; ++ai)
#pragma unroll
            for (int m = 0; m < 4; ++m) asm volatile("" : "+v"(rv[ai][m][0]), "+v"(rv[ai][m][1]));
#pragma unroll
        for (int ai = 0; ai < 2; ++ai)
#pragma unroll
            for (int m = 0; m < 4; ++m) { const int row = row0 + ai * HALF + m * 16;
#pragma unroll
                for (int bj = 0; bj < 2; ++bj) { float r[8], o[8]; unpack8(rv[ai][m][bj], r);
#pragma unroll
                    for (int i = 0; i < 8; ++i) o[i] = acc[ai][bj][m][i >> 2][i & 3] * r[i];
                    *(u32x4*)(merged + (size_t)row * 2048 + col0 + bj * HALF) = pack8(o); } }
    }
};

template <class Epi>
__device__ __forceinline__ void gemm_phase(LAS unsigned char* lds, const Gemm g, const StaticOrder& S, const Epi& E) {
    const int tid = opaque_tid(), wid = __builtin_amdgcn_readfirstlane(tid >> 6), lane = tid & 63, wr = wid >> 2, wc = wid & 3, fr = lane & 15, fq = lane >> 4;
    const int K = g.K, nt = K / BK;
    unsigned voffA[2], voffB[2];
#pragma unroll
    for (int i = 0; i < 2; ++i) { int R, C; stage_rc(tid * 16 + i * 8192, R, C); const int Rb = Epi::PERM ? ((R & ~31) + perm32(R & 31)) : R;
        voffA[i] = (unsigned)(R * g.lda + C) * 2u; voffB[i] = (unsigned)(Rb * g.ldb + C) * 2u; }
    const size_t kstep = (size_t)(BK * 2);
    const size_t hstepA = (size_t)HALF * g.lda * 2, hstepB = (size_t)HALF * g.ldb * 2;
    const size_t tstepA = 2 * hstepA, tstepB = 2 * hstepB;
    const unsigned ldsw = (unsigned)wid * 1024u;
    const int aoff = lds_byte(wr * 64 + fr, fq * 8), boff = lds_byte(wc * 32 + fr, fq * 8);
#define PG8_SA(b, h) (((b) * 2 + (h)) * HTB)
#define PG8_SB(b, h) ((4 + (b) * 2 + (h)) * HTB)
#define PG8_STAGE(bufoff, gbase, voff) do { _Pragma("unroll") for (int _i = 0; _i < 2; ++_i) \
        __builtin_amdgcn_global_load_lds((const unsigned*)((const char*)(gbase) + (voff)[_i]), (LAS unsigned*)(lds + (bufoff) + ldsw + _i * 8192), 16, 0, 0); } while (0)
#define PG8_LDA(dst, b, h) do { _Pragma("unroll") for (int m = 0; m < 4; ++m) _Pragma("unroll") for (int k = 0; k < 2; ++k) dst[m][k] = *(const LAS bf16x8*)(lds + PG8_SA(b, h) + aoff + m * 2048 + k * 1024); } while (0)
#define PG8_LDB(dst, b, h) do { _Pragma("unroll") for (int n = 0; n < 2; ++n) _Pragma("unroll") for (int k = 0; k < 2; ++k) dst[n][k] = *(const LAS bf16x8*)(lds + PG8_SB(b, h) + boff + n * 2048 + k * 1024); } while (0)
#define PG8_MMA(ai, bj, At, Bt) do { __builtin_amdgcn_s_setprio(1); _Pragma("unroll") for (int m = 0; m < 4; ++m) _Pragma("unroll") for (int n = 0; n < 2; ++n) _Pragma("unroll") for (int k = 0; k < 2; ++k) \
        acc[ai][bj][m][n] = __builtin_amdgcn_mfma_f32_16x16x32_bf16(Bt[n][k], At[m][k], acc[ai][bj][m][n], 0, 0, 0); __builtin_amdgcn_s_setprio(0); } while (0)
#define PG8_WAIT_V(n) asm volatile("s_waitcnt vmcnt(" #n ")" ::: "memory")
#define PG8_WAIT_L(n) asm volatile("s_waitcnt lgkmcnt(" #n ")" ::: "memory")
#define PG8_BAR __builtin_amdgcn_s_barrier()
#define PG8_SCHED __builtin_amdgcn_sched_barrier(0)
    Unit cur, nxt; int ui = 0;
    if (!S.next(0, cur)) return;
    f32x4 acc[2][2][4][2];
#pragma unroll
    for (int a = 0; a < 2; ++a)
#pragma unroll
        for (int b = 0; b < 2; ++b)
#pragma unroll
            for (int m = 0; m < 4; ++m)
#pragma unroll
                for (int n = 0; n < 2; ++n) acc[a][b][m][n] = (f32x4){0.f, 0.f, 0.f, 0.f};
    bf16x8 At[4][2], B0[2][2], B1[2][2];
    const char* cA = (const char*)g.A + (size_t)cur.pm * tstepA; const char* cB = (const char*)g.Bt + (size_t)cur.pn * tstepB;
    PG8_STAGE(PG8_SB(0, 0), cB, voffB); PG8_STAGE(PG8_SA(0, 0), cA, voffA); PG8_STAGE(PG8_SB(0, 1), cB + hstepB, voffB); PG8_STAGE(PG8_SA(0, 1), cA + hstepA, voffA);
    if (wr == 1) PG8_BAR;
    PG8_WAIT_V(4); PG8_BAR;
    PG8_STAGE(PG8_SB(1, 0), cB + kstep, voffB); PG8_STAGE(PG8_SA(1, 0), cA + kstep, voffA); PG8_STAGE(PG8_SB(1, 1), cB + hstepB + kstep, voffB);
    PG8_WAIT_V(6); PG8_BAR;
    for (;;) {
        const bool has_next = S.next(ui + 1, nxt);
        const char* nA = has_next ? (const char*)g.A + (size_t)nxt.pm * tstepA : cA; const char* nB = has_next ? (const char*)g.Bt + (size_t)nxt.pn * tstepB : cB;
        for (int t = 0; t < nt; t += 2) {
            const bool last = (t == nt - 2);
            const char* a1 = cA + (size_t)(t + 1) * kstep;
            const char* a2 = last ? nA : cA + (size_t)(t + 2) * kstep; const char* b2 = last ? nB : cB + (size_t)(t + 2) * kstep;
            const char* a3 = a2 + kstep; const char* b3 = b2 + kstep;
            if constexpr (Epi::HOOK) { if (t == 16 || t == 32) E.hook(acc, cur, t >> 4, wr, wc, fr, fq); }
            PG8_LDB(B0, 0, 0); PG8_SCHED; PG8_LDA(At, 0, 0); PG8_STAGE(PG8_SA(1, 1), a1 + hstepA, voffA);
            PG8_WAIT_L(8); PG8_BAR; PG8_WAIT_L(0); PG8_MMA(0, 0, At, B0); PG8_BAR; PG8_SCHED;
            PG8_LDB(B1, 0, 1); PG8_STAGE(PG8_SB(0, 0), b2, voffB);
            PG8_BAR; PG8_WAIT_L(0); PG8_MMA(0, 1, At, B1); PG8_BAR;
            PG8_LDA(At, 0, 1); PG8_STAGE(PG8_SA(0, 0), a2, voffA);
            PG8_BAR; PG8_WAIT_L(0); PG8_MMA(1, 0, At, B0); PG8_BAR; PG8_SCHED;
            PG8_STAGE(PG8_SB(0, 1), b2 + hstepB, voffB);
            PG8_WAIT_V(6); PG8_BAR; PG8_MMA(1, 1, At, B1); PG8_BAR;
            PG8_LDB(B0, 1, 0); PG8_SCHED; PG8_LDA(At, 1, 0); PG8_STAGE(PG8_SA(0, 1), a2 + hstepA, voffA);
            PG8_WAIT_L(8); PG8_BAR; PG8_WAIT_L(0); PG8_MMA(0, 0, At, B0); PG8_BAR; PG8_SCHED;
            PG8_LDB(B1, 1, 1); PG8_STAGE(PG8_SB(1, 0), b3, voffB);
            PG8_BAR; PG8_WAIT_L(0); PG8_MMA(0, 1, At, B1); PG8_BAR;
            PG8_LDA(At, 1, 1); PG8_STAGE(PG8_SA(1, 0), a3, voffA);
            PG8_BAR; PG8_WAIT_L(0); PG8_MMA(1, 0, At, B0); PG8_BAR; PG8_SCHED;
            PG8_STAGE(PG8_SB(1, 1), b3 + hstepB, voffB);
            PG8_WAIT_V(6); PG8_BAR; PG8_MMA(1, 1, At, B1); PG8_BAR;
        }
        E(acc, cur, wr, wc, fr, fq);
        if (!has_next) break;
#pragma unroll
        for (int a = 0; a < 2; ++a)
#pragma unroll
            for (int b = 0; b < 2; ++b)
#pragma unroll
                for (int m = 0; m < 4; ++m)
#pragma unroll
                    for (int n = 0; n < 2; ++n) acc[a][b][m][n] = (f32x4){0.f, 0.f, 0.f, 0.f};
        cur = nxt; cA = nA; cB = nB; ++ui;
    }
    PG8_WAIT_V(0);
    if (wr == 0) PG8_BAR;
    PG8_BAR;
#undef PG8_SA
#undef PG8_SB
#undef PG8_STAGE
#undef PG8_LDA
#undef PG8_LDB
#undef PG8_MMA
#undef PG8_WAIT_V
#undef PG8_WAIT_L
#undef PG8_BAR
#undef PG8_SCHED
}
}

constexpr size_t RP_W = 6 * ARR * 2, RP_GR = RP_W + ARR * 4;
static_assert(RP_GR + (size_t)MT * 6144 * 2 <= 7 * ARR * 4, "RPRE region");
struct Args { const float* in[37]; float* out; unsigned char* ws; int ph_lo, ph_hi; };
enum { I_XP = 0, I_XS, I_SSHIFT, I_SWKV, I_SCONV, I_SC, I_SN, I_SM, I_SGLA, I_NORM1, I_WIN, I_GATEB, I_MU, I_W0, I_W2, I_A0, I_A2, I_G2, I_KK, I_KA, I_RK, I_LNG, I_LNB,
       I_CONVW, I_CONVB, I_IB, I_FB, I_MNORM, I_GA2, I_GAB, I_GNORM, I_WBR, I_WOUT, I_NORM2, I_WGU, I_WDN, I_FNORM };

constexpr int LDS_BYTES = 147456;
constexpr int PTAB_OFF = LDS_BYTES - 1024;
__device__ __forceinline__ unsigned long long ctx_raw(LAS unsigned char* lds, int i) {
    const unsigned long long v = ((const LAS unsigned long long*)(lds + PTAB_OFF))[i];
    const unsigned lo = __builtin_amdgcn_readfirstlane((unsigned)v), hi = __builtin_amdgcn_readfirstlane((unsigned)(v >> 32));
    return ((unsigned long long)hi << 32) | lo;
}
#define GAS __attribute__((address_space(1)))
__device__ __forceinline__ const float* ctx_in(LAS unsigned char* lds, int i) { return (const float*)(const GAS float*)ctx_raw(lds, i); }
__device__ __forceinline__ float* ctx_out(LAS unsigned char* lds) { return (float*)(GAS float*)ctx_raw(lds, 37); }
__device__ __forceinline__ unsigned char* ctx_ws(LAS unsigned char* lds) { return (unsigned char*)(GAS unsigned char*)ctx_raw(lds, 38); }

struct TrD { const float* p; bf16_t* dst; int ldw, K; bool ok; };
__device__ __forceinline__ TrD tr_decode(LAS unsigned char* lds, int it, int lane) {
    constexpr int I_IN = 32 * 519, I_BR = 3 * 16 * 64, I_OUT = 32 * 64, I_GU = 32 * 352, I_DN = 88 * 64, I_LO = 3 * 32, PER_L = I_IN + I_BR + I_OUT + I_GU + I_DN + I_LO;
    const int l = it / PER_L; int r = it % PER_L;
    unsigned char* wl = ctx_ws(lds) + WS_W + (size_t)l * LW_BYTES;
    const float* W; bf16_t* WT; int ldw, K, k0, n0, nv = 32, drow0, dk = 0;
    if (r < I_IN) { const int kb = r / 519, nb = r % 519; nv = (NIN - nb * 32) < 32 ? (NIN - nb * 32) : 32;
        W = ctx_in(lds, I_WIN) + (size_t)l * 2048 * NIN; ldw = NIN; k0 = kb * 64; n0 = nb * 32; WT = (bf16_t*)(wl + LW_WIN); K = 2048; drow0 = nb * 32; }
    else if ((r -= I_IN) < I_BR) { const int j = r / 1024, q = r % 1024, kb = q / 64, nb = q % 64;
        W = ctx_in(lds, I_WBR) + (size_t)(l * 3 + j) * 1024 * 2048; ldw = 2048; k0 = kb * 64; n0 = nb * 32; WT = (bf16_t*)(wl + LW_WBR); K = 3072; drow0 = nb * 32; dk = j * 1024; }
    else if ((r -= I_BR) < I_OUT) { const int kb = r / 64, nb = r % 64;
        W = ctx_in(lds, I_WOUT) + (size_t)l * 2048 * 2048; ldw = 2048; k0 = kb * 64; n0 = nb * 32; WT = (bf16_t*)(wl + LW_WOUT); K = 2048; drow0 = nb * 32; }
    else if ((r -= I_OUT) < I_GU) { const int kb = r / 352, nb = r % 352; n0 = nb * 32; const int np = n0 < DFF ? n0 : n0 - DFF;
        W = ctx_in(lds, I_WGU) + (size_t)l * 2048 * 11264; ldw = 11264; k0 = kb * 64; WT = (bf16_t*)(wl + LW_WGU); K = 2048; drow0 = 256 * (np / 128) + (np % 128) + (n0 < DFF ? 0 : 128); }
    else if ((r -= I_GU) < I_DN) { const int kb = r / 64, nb = r % 64;
        W = ctx_in(lds, I_WDN) + (size_t)l * DFF * 2048; ldw = 2048; k0 = kb * 64; n0 = nb * 32; WT = (bf16_t*)(wl + LW_WDN); K = DFF; drow0 = nb * 32; }
    else { r -= I_DN; const int mat = r / 32, nb = r % 32;
        W = (mat == 0 ? ctx_in(lds, I_W2) : (mat == 1 ? ctx_in(lds, I_A2) : ctx_in(lds, I_G2))) + (size_t)l * 64 * 1024; ldw = 1024; k0 = 0; n0 = nb * 32; WT = (bf16_t*)(wl + LW_LORA) + (size_t)mat * 1024 * 64; K = 64; drow0 = nb * 32; }
    TrD t; const int n = lane & 31; t.ok = n < nv; t.ldw = ldw; t.K = K;
    t.p = W + (size_t)(k0 + (lane >> 5)) * ldw + n0 + (t.ok ? n : 0); t.dst = WT + (size_t)drow0 * K + dk + k0; return t;
}
#define TR_PIN16(v, o) asm volatile("" : "+v"(v[o]), "+v"(v[o + 1]), "+v"(v[o + 2]), "+v"(v[o + 3]), "+v"(v[o + 4]), "+v"(v[o + 5]), "+v"(v[o + 6]), "+v"(v[o + 7]), "+v"(v[o + 8]), "+v"(v[o + 9]), "+v"(v[o + 10]), "+v"(v[o + 11]), "+v"(v[o + 12]), "+v"(v[o + 13]), "+v"(v[o + 14]), "+v"(v[o + 15]))
__device__ __forceinline__ void tr_load(const TrD& t, float (&v)[32]) {
#pragma unroll
    for (int i = 0; i < 32; ++i) v[i] = __builtin_nontemporal_load(t.p + (size_t)(2 * i) * t.ldw);
}
__device__ __forceinline__ void tr_store(const TrD& t, const float (&v)[32], LAS float* scr, int lane) {
    const int n = lane & 31;
#pragma unroll
    for (int i = 0; i < 32; ++i) scr[(2 * i + (lane >> 5)) * 33 + n] = t.ok ? v[i] : 0.f;
    LDS_WAIT();
    const int c = lane & 7;
#pragma unroll
    for (int j = 0; j < 4; ++j) { const int nn = (lane >> 3) + 8 * j; const LAS float* s = scr + (8 * c) * 33 + nn;
        u32x4 o; o.x = pk2(s[0 * 33], s[1 * 33]); o.y = pk2(s[2 * 33], s[3 * 33]); o.z = pk2(s[4 * 33], s[5 * 33]); o.w = pk2(s[6 * 33], s[7 * 33]);
        *(u32x4*)(t.dst + (size_t)nn * t.K + 8 * c) = o; }
    LDS_WAIT();
}
__device__ __forceinline__ void phase_prologue(LAS unsigned char* lds, int G) {
    const int tid = opaque_tid(), lane = tid & 63, wave = tid >> 6;
    LAS float* scr = (LAS float*)(lds + wave * 8704);
    const int gw = blockIdx.x * 8 + wave, NGW = G * 8;
    constexpr int NITEMS = 2 * (32 * 519 + 3 * 16 * 64 + 32 * 64 + 32 * 352 + 88 * 64 + 3 * 32);
    if (gw < NITEMS) {
        const int last = gw + ((NITEMS - 1 - gw) / NGW) * NGW;
        TrD ta = tr_decode(lds, gw, lane); float va[32]; tr_load(ta, va);
        for (int it = gw; it < NITEMS; it += 2 * NGW) {
            const int i1 = it + NGW <= last ? it + NGW : last, i2 = it + 2 * NGW <= last ? it + 2 * NGW : last;
            const TrD tb = tr_decode(lds, i1, lane); float vb[32]; tr_load(tb, vb);
            TR_PIN16(va, 0); TR_PIN16(va, 16);
            tr_store(ta, va, scr, lane);
            ta = tr_decode(lds, i2, lane); tr_load(ta, va);
            TR_PIN16(vb, 0); TR_PIN16(vb, 16);
            if (it + NGW < NITEMS) tr_store(tb, vb, scr, lane);
        }
    }
    const int gt = blockIdx.x * NTHREADS + tid, NGT = G * NTHREADS;
    for (int i = gt; i < 2 * 32 * 2048 / 8; i += NGT) { const int l = i / (32 * 256), q = i % (32 * 256);
        *(u32x4*)((bf16_t*)(ctx_ws(lds) + WS_W + (size_t)l * LW_BYTES + LW_WIN) + (size_t)16608 * 2048 + (size_t)q * 8) = (u32x4){0u, 0u, 0u, 0u}; }
    for (int i = gt; i < 2 * 512 * 32; i += NGT) { const int l = i / (512 * 32), q = i % (512 * 32), c = q / 32, k = q % 32;
        ((bf16_t*)(ctx_ws(lds) + WS_W + (size_t)l * LW_BYTES + LW_GA2))[q] = k < 16 ? f2bf(ctx_in(lds, I_GA2)[(size_t)l * 16 * 512 + k * 512 + c]) : (bf16_t)0; }
}

__device__ __forceinline__ void phase_norm(LAS unsigned char* lds, int G, const float* gvec, bool from_input) {
    const int tid = opaque_tid(), lane = tid & 63, wave = tid >> 6;
    float* __restrict__ xbuf = (float*)(ctx_ws(lds) + WS_X); bf16_t* __restrict__ hb = (bf16_t*)(ctx_ws(lds) + WS_H);
    f32x4 gg[8];
#pragma unroll
    for (int j = 0; j < 8; ++j) gg[j] = *(const f32x4*)(gvec + (lane + 64 * j) * 4);
    for (int m = blockIdx.x * 8 + wave; m < MPAD; m += G * 8) {
        if (m >= MT) { if (from_input) {
#pragma unroll
            for (int j = 0; j < 4; ++j) *(u32x4*)(hb + (size_t)m * 2048 + (lane + 64 * j) * 8) = (u32x4){0u, 0u, 0u, 0u}; } continue; }
        const float* src = from_input ? (m < MP ? ctx_in(lds, I_XP) + (size_t)m * 2048 : ctx_in(lds, I_XS) + (size_t)(m - MP) * 2048) : xbuf + (size_t)m * 2048;
        f32x4 v[8]; float s = 0.f;
#pragma unroll
        for (int j = 0; j < 8; ++j) v[j] = *(const f32x4*)(src + (lane + 64 * j) * 4);
#pragma unroll
        for (int j = 0; j < 8; ++j) s += (v[j].x * v[j].x + v[j].y * v[j].y) + (v[j].z * v[j].z + v[j].w * v[j].w);
        const float rs = rsqrtf(wave_sum(s) * (1.f / 2048.f) + 1e-6f);
#pragma unroll
        for (int j = 0; j < 8; ++j) { const int c = (lane + 64 * j) * 4;
            if (from_input) *(f32x4*)(xbuf + (size_t)m * 2048 + c) = v[j];
            u32x2 w; w.x = pk2(v[j].x * rs * gg[j].x, v[j].y * rs * gg[j].y); w.y = pk2(v[j].z * rs * gg[j].z, v[j].w * rs * gg[j].w);
            *(u32x2*)(hb + (size_t)m * 2048 + c) = w; }
    }
}
__device__ __forceinline__ void dump_words(const unsigned* src, unsigned* dst, size_t n, int G) {
    for (size_t i = (size_t)blockIdx.x * NTHREADS + threadIdx.x; i < n; i += (size_t)G * NTHREADS) dst[i] = src[i];
}
__device__ __forceinline__ void phase_dump(LAS unsigned char* lds, int G) {
    unsigned char* ws = ctx_ws(lds); unsigned* out = (unsigned*)ctx_out(lds);
    if (DBG_LIM == 5) { if (DBG_SEL == 0) dump_words((const unsigned*)(ws + WS_ROUT), out + O_YP, ARR, G); if (DBG_SEL == 1) dump_words((const unsigned*)(ws + WS_HM), out + O_YP, ARR, G); if (DBG_SEL == 2) { dump_words((const unsigned*)(ws + WS_OG), out + O_YP, ARR, G); dump_words((const unsigned*)(ws + WS_HM), out + O_SC, ARR, G); } if (DBG_SEL == 3) dump_words((const unsigned*)(ws + WS_QM), out + O_YP, ARR, G); if (DBG_SEL == 4) dump_words((const unsigned*)(ws + WS_HM), out + O_YP, (size_t)MP * 1024, G); }
    else if (DBG_LIM == 6) { dump_words((const unsigned*)(ws + WS_QM), out + O_YP, (size_t)MT * 3072 / 2, G); }
    else if (DBG_LIM == 7) { dump_words((const unsigned*)(ws + WS_H), out + O_YP, (size_t)MT * 2048 / 2, G); }
    else { dump_words((const unsigned*)(ws + WS_X), out + O_YP, (size_t)MP * 2048, G); }
}
__device__ __forceinline__ void phase_final(LAS unsigned char* lds, int G) {
    const int tid = opaque_tid(), lane = tid & 63, wave = tid >> 6;
    const float* __restrict__ xbuf = (const float*)(ctx_ws(lds) + WS_X); const float* __restrict__ gvec = ctx_in(lds, I_FNORM);
    f32x4 gg[8];
#pragma unroll
    for (int j = 0; j < 8; ++j) gg[j] = *(const f32x4*)(gvec + (lane + 64 * j) * 4);
    for (int m = blockIdx.x * 8 + wave; m < MT; m += G * 8) {
        const float* src = xbuf + (size_t)m * 2048; float* __restrict__ dst = ctx_out(lds) + (m < MP ? O_YP + (size_t)m * 2048 : O_YS + (size_t)(m - MP) * 2048);
        f32x4 v[8]; float s = 0.f;
#pragma unroll
        for (int j = 0; j < 8; ++j) v[j] = *(const f32x4*)(src + (lane + 64 * j) * 4);
#pragma unroll
        for (int j = 0; j < 8; ++j) s += (v[j].x * v[j].x + v[j].y * v[j].y) + (v[j].z * v[j].z + v[j].w * v[j].w);
        const float rs = rsqrtf(wave_sum(s) * (1.f / 2048.f) + 1e-6f);
#pragma unroll
        for (int j = 0; j < 8; ++j) { const int c = (lane + 64 * j) * 4;
            *(f32x4*)(dst + c) = (f32x4){v[j].x * rs * gg[j].x, v[j].y * rs * gg[j].y, v[j].z * rs * gg[j].z, v[j].w * rs * gg[j].w}; }
    }
}

__device__ __forceinline__ void load_prev8(const bf16_t* proj, const float* shift_l, int m, int col, float (&o)[8]) {
    if (m >= MP) ld8f(shift_l + (size_t)(m - MP) * RC + col, o);
    else if ((m & 2047) == 0) {
#pragma unroll
        for (int i = 0; i < 8; ++i) o[i] = 0.f; }
    else ld8b(proj + (size_t)(m - 1) * NINP + col, o);
}
__device__ __forceinline__ void ld16b(const bf16_t* p, float (&f)[16]) { ld8b(p, *(float(*)[8])&f[0]); ld8b(p + 8, *(float(*)[8])&f[8]); }
__device__ __forceinline__ void ld16f(const float* p, float (&f)[16]) { ld8f(p, *(float(*)[8])&f[0]); ld8f(p + 8, *(float(*)[8])&f[8]); }
__device__ __forceinline__ void st16f(float* p, const float (&f)[16]) { st8f(p, *(const float(*)[8])&f[0]); st8f(p + 8, *(const float(*)[8])&f[8]); }
__device__ __forceinline__ void st16b(bf16_t* p, const float (&f)[16]) { *(u32x4*)p = pack8(*(const float(*)[8])&f[0]); *(u32x4*)(p + 8) = pack8(*(const float(*)[8])&f[8]); }
__device__ __forceinline__ void pre_rwkv_item(LAS unsigned char* lds, int l, int cidx, int tt, int h0, int nh, int wave, int lane) {
    const int lr = lane & 15, lq = lane >> 4;
    const int m0 = cidx * 64 + tt * 16;
    const bf16_t* __restrict__ proj = (const bf16_t*)(ctx_ws(lds) + WS_PROJ);
    const float* __restrict__ shift_l = ctx_in(lds, I_SSHIFT) + (size_t)l * 128 * RC;
    const float* __restrict__ mu = ctx_in(lds, I_MU) + (size_t)l * RC;
    const bf16_t* __restrict__ loraT = (const bf16_t*)(ctx_ws(lds) + WS_W + (size_t)l * LW_BYTES + LW_LORA);
    bf16_t* __restrict__ rb = (bf16_t*)(ctx_ws(lds) + WS_RPRE); float* __restrict__ rw = (float*)(ctx_ws(lds) + WS_RPRE + RP_W);
    LAS bf16_t* loraA = (LAS bf16_t*)(lds + wave * 14336);
    LAS bf16_t* loraO = (LAS bf16_t*)(lds + wave * 14336 + 7168);
    const int tok = lane >> 2, c4 = lane & 3, m = m0 + tok;
    {
#pragma unroll
        for (int i = 0; i < 6; ++i) {
            const int cgp = c4 + 4 * i, col = 3072 + cgp * 8, mat = cgp >> 3, kc = (cgp & 7) * 8;
            float p[8], pv[8], mm[8], x[8];
            ld8b(proj + (size_t)m * NINP + col, p); load_prev8(proj, shift_l, m, col, pv); ld8f(mu + col, mm);
#pragma unroll
            for (int j = 0; j < 8; ++j) { const float xs = p[j] + (pv[j] - p[j]) * mm[j]; x[j] = mat == 0 ? tanh_fast(xs) : (mat == 1 ? xs : sigm(xs)); }
            *(LAS u32x4*)(loraA + (mat * 16 + tok) * 72 + kc) = pack8(x);
        }
    }
    LDS_WAIT();
    const bool samp = m >= MP, first = !samp && ((m & 2047) == 0);
    const bf16_t* prow = proj + (size_t)m * NINP;
    const bf16_t* qrow = proj + (size_t)((samp || first) ? m : m - 1) * NINP;
    const float* srow = shift_l + (size_t)(samp ? m - MP : 0) * RC;
#pragma unroll 1
    for (int hh = 0; hh < nh; ++hh) {
        const int h = h0 + hh, c0 = h * 64 + c4 * 16;
        bf16x8 bfr[3][4][2];
#pragma unroll
        for (int mat = 0; mat < 3; ++mat)
#pragma unroll
            for (int tc = 0; tc < 4; ++tc)
#pragma unroll
                for (int ks = 0; ks < 2; ++ks) bfr[mat][tc][ks] = *(const bf16x8*)(loraT + (size_t)(mat * 1024 + h * 64 + tc * 16 + lr) * 64 + ks * 32 + lq * 8);
        u32x4 pw[3][2], qw[3][2]; f32x4 qs[3][4];
#pragma unroll
        for (int g = 0; g < 3; ++g) { pw[g][0] = *(const u32x4*)(prow + g * 1024 + c0); pw[g][1] = *(const u32x4*)(prow + g * 1024 + c0 + 8);
            if (samp) {
#pragma unroll
                for (int k = 0; k < 4; ++k) qs[g][k] = *(const f32x4*)(srow + g * 1024 + c0 + 4 * k); }
            else { qw[g][0] = *(const u32x4*)(qrow + g * 1024 + c0); qw[g][1] = *(const u32x4*)(qrow + g * 1024 + c0 + 8); } }
#pragma unroll
        for (int mat = 0; mat < 3; ++mat)
#pragma unroll
            for (int tc = 0; tc < 4; ++tc) { f32x4 acc = {0.f, 0.f, 0.f, 0.f};
#pragma unroll
                for (int ks = 0; ks < 2; ++ks) {
                    const bf16x8 av = *(const LAS bf16x8*)(loraA + (mat * 16 + lr) * 72 + ks * 32 + lq * 8);
                    acc = MFMA16(av, bfr[mat][tc][ks], acc); }
#pragma unroll
                for (int r = 0; r < 4; ++r) loraO[(mat * 16 + lq * 4 + r) * 72 + tc * 16 + lr] = f2bf(acc[r]); }
        LDS_WAIT();
        float xr[16], xk[16], xv[16];
#pragma unroll
        for (int g = 0; g < 3; ++g) { float p[16], q[16], mm[16];
            unpack8(pw[g][0], *(float(*)[8])&p[0]); unpack8(pw[g][1], *(float(*)[8])&p[8]); ld16f(mu + g * 1024 + c0, mm);
            if (samp) {
#pragma unroll
                for (int j = 0; j < 16; ++j) q[j] = qs[g][j >> 2][j & 3]; }
            else { unpack8(qw[g][0], *(float(*)[8])&q[0]); unpack8(qw[g][1], *(float(*)[8])&q[8]);
                if (first) {
#pragma unroll
                    for (int j = 0; j < 16; ++j) q[j] = 0.f; } }
#pragma unroll
            for (int j = 0; j < 16; ++j) { const float x = p[j] + (q[j] - p[j]) * mm[j]; if (g == 0) xr[j] = x; else if (g == 1) xk[j] = x; else xv[j] = x; } }
        const size_t o = (size_t)m * 1024 + c0;
        st16b(rb + 3 * ARR + o, xr); st16b(rb + 4 * ARR + o, xv);
        float lw[16], la[16], lg[16];
        { const LAS bf16_t* lo = loraO + tok * 72 + c4 * 16;
          unpack8(*(const LAS u32x4*)(lo), *(float(*)[8])&lw[0]); unpack8(*(const LAS u32x4*)(lo + 8), *(float(*)[8])&lw[8]);
          unpack8(*(const LAS u32x4*)(lo + 16 * 72), *(float(*)[8])&la[0]); unpack8(*(const LAS u32x4*)(lo + 16 * 72 + 8), *(float(*)[8])&la[8]);
          unpack8(*(const LAS u32x4*)(lo + 32 * 72), *(float(*)[8])&lg[0]); unpack8(*(const LAS u32x4*)(lo + 32 * 72 + 8), *(float(*)[8])&lg[8]); }
        st16b(rb + 5 * ARR + o, lg);
        float pa[16], pb[16], kkr[16], av[16]; float ss = 0.f;
        ld16f(ctx_in(lds, I_KK) + l * 1024 + c0, pa); ld16f(ctx_in(lds, I_A0) + l * 1024 + c0, pb);
#pragma unroll
        for (int j = 0; j < 16; ++j) { kkr[j] = xk[j] * pa[j]; ss += kkr[j] * kkr[j]; av[j] = sigm(pb[j] + la[j]); }
        ss = quad_sum(ss);
        const float inv = 1.f / fmaxf(sqrtf(ss), 1e-12f);
#pragma unroll
        for (int j = 0; j < 16; ++j) { kkr[j] *= inv; pa[j] = kkr[j] * av[j]; }
        st16b(rb + 0 * ARR + o, kkr); st16b(rb + 1 * ARR + o, pa);
        ld16f(ctx_in(lds, I_KA) + l * 1024 + c0, pa); ld16f(ctx_in(lds, I_W0) + l * 1024 + c0, pb);
#pragma unroll
        for (int j = 0; j < 16; ++j) { pa[j] = xk[j] * (1.f + (av[j] - 1.f) * pa[j]);
            const float wp = -(pb[j] + lw[j]); const float sp = fmaxf(wp, 0.f) + __logf(1.f + __expf(-fabsf(wp))); pb[j] = __expf(-__expf(-sp - 0.5f)); }
        st16b(rb + 2 * ARR + o, pa); st16f(rw + o, pb);
        LDS_WAIT();
    }
}
__device__ __forceinline__ void pre_mlstm(LAS unsigned char* lds, int l, int cidx, int m0, int ntok) {
    const int tid = opaque_tid();
    const bf16_t* __restrict__ proj = (const bf16_t*)(ctx_ws(lds) + WS_PROJ);
    bf16_t* __restrict__ qm = (bf16_t*)(ctx_ws(lds) + WS_QM); bf16_t* __restrict__ km = (bf16_t*)(ctx_ws(lds) + WS_KM); float* __restrict__ gates = (float*)(ctx_ws(lds) + WS_GATES);
    const int cgp = tid & 255, th = tid >> 8, c0 = cgp * 8;
    float w0[8], w1[8], w2[8], w3[8], cb[8];
    ld8f(ctx_in(lds, I_CONVW) + (size_t)(l * 4 + 0) * 2048 + c0, w0); ld8f(ctx_in(lds, I_CONVW) + (size_t)(l * 4 + 1) * 2048 + c0, w1);
    ld8f(ctx_in(lds, I_CONVW) + (size_t)(l * 4 + 2) * 2048 + c0, w2); ld8f(ctx_in(lds, I_CONVW) + (size_t)(l * 4 + 3) * 2048 + c0, w3);
    ld8f(ctx_in(lds, I_CONVB) + (size_t)l * 2048 + c0, cb);
    bf16_t* dst = cgp < 128 ? qm + c0 : km + (c0 - 1024); const float sc = cgp < 128 ? 1.f : 0.0625f;
    if (cidx < 128) {
        float x3[8], x2[8], x1[8];
        const int t0 = th * 32, ts0 = (m0 & 2047) + t0;
#pragma unroll
        for (int j = 0; j < 8; ++j) { x3[j] = 0.f; x2[j] = 0.f; x1[j] = 0.f; }
        if (ts0 >= 3) { ld8b(proj + (size_t)(m0 + t0 - 3) * NINP + M0 + c0, x3); ld8b(proj + (size_t)(m0 + t0 - 2) * NINP + M0 + c0, x2); ld8b(proj + (size_t)(m0 + t0 - 1) * NINP + M0 + c0, x1); }
        const bool lastc = (cidx & 31) == 31; const int b = cidx >> 5;
#pragma unroll 1
        for (int tb = t0; tb < t0 + 32; tb += 8) {
            u32x4 xb[8];
#pragma unroll
            for (int i = 0; i < 8; ++i) xb[i] = *(const u32x4*)(proj + (size_t)(m0 + tb + i) * NINP + M0 + c0);
#pragma unroll
            for (int i = 0; i < 8; ++i) { const int m = m0 + tb + i; float x0[8], y[8]; unpack8(xb[i], x0);
#pragma unroll
                for (int j = 0; j < 8; ++j) { const float cv = cb[j] + w0[j] * x3[j] + w1[j] * x2[j] + w2[j] * x1[j] + w3[j] * x0[j]; y[j] = siluf(cv) * sc; x3[j] = x2[j]; x2[j] = x1[j]; x1[j] = x0[j]; }
                *(u32x4*)(dst + (size_t)m * 1024) = pack8(y);
                if (lastc && tb + i >= 61) st8f(ctx_out(lds) + O_PCONV + (size_t)((l * 4 + b) * 3 + (tb + i - 61)) * 2048 + c0, x0); }
        }
    } else {
#pragma unroll 1
        for (int tb = th * (ntok >> 1); tb < (th + 1) * (ntok >> 1); tb += 4) {
            u32x4 xb[4]; f32x4 sa[4][6];
#pragma unroll
            for (int i = 0; i < 4; ++i) { const int m = m0 + tb + i, s = m - MP; const float* __restrict__ cs = ctx_in(lds, I_SCONV) + (size_t)((l * 128 + s) * 3) * 2048 + c0;
                xb[i] = *(const u32x4*)(proj + (size_t)m * NINP + M0 + c0);
#pragma unroll
                for (int k = 0; k < 3; ++k) { sa[i][2 * k] = *(const f32x4*)(cs + k * 2048); sa[i][2 * k + 1] = *(const f32x4*)(cs + k * 2048 + 4); } }
#pragma unroll
            for (int i = 0; i < 4; ++i) { const int m = m0 + tb + i, s = m - MP; float x0[8], y[8]; unpack8(xb[i], x0);
#pragma unroll
                for (int j = 0; j < 8; ++j) { const float x3 = sa[i][0 + (j >> 2)][j & 3], x2 = sa[i][2 + (j >> 2)][j & 3], x1 = sa[i][4 + (j >> 2)][j & 3];
                    const float cv = cb[j] + w0[j] * x3 + w1[j] * x2 + w2[j] * x1 + w3[j] * x0[j]; y[j] = siluf(cv) * sc; }
                *(u32x4*)(dst + (size_t)m * 1024) = pack8(y);
                float* co = ctx_out(lds) + O_SCONV + (size_t)((l * 128 + s) * 3) * 2048 + c0;
                *(f32x4*)co = sa[i][2]; *(f32x4*)(co + 4) = sa[i][3]; *(f32x4*)(co + 2048) = sa[i][4]; *(f32x4*)(co + 2052) = sa[i][5]; st8f(co + 4096, x0); }
        }
    }
    if (tid < ntok * 4) { const int t = tid >> 2, hh = tid & 3, m = m0 + t;
        const float ip = bf2f(proj[(size_t)m * NINP + M0 + 3072 + hh]), fp = bf2f(proj[(size_t)m * NINP + M0 + 3076 + hh]);
        const float xf = fp + ctx_in(lds, I_FB)[l * 4 + hh];
        gates[(size_t)m * 8 + hh] = ip + ctx_in(lds, I_IB)[l * 4 + hh];
        gates[(size_t)m * 8 + 4 + hh] = fminf(xf, 0.f) - log1pf(__expf(-fabsf(xf))); }
}
__device__ __forceinline__ void pre_gla(LAS unsigned char* lds, int l, int cidx, int m0, int ntok) {
    const int tid = opaque_tid(), lane = tid & 63, wave = tid >> 6, lr = lane & 15, lq = lane >> 4;
    const bf16_t* __restrict__ proj = (const bf16_t*)(ctx_ws(lds) + WS_PROJ);
    bf16_t* __restrict__ gq = (bf16_t*)(ctx_ws(lds) + WS_GQ); bf16_t* __restrict__ gk = (bf16_t*)(ctx_ws(lds) + WS_GK); bf16_t* __restrict__ gkh = (bf16_t*)(ctx_ws(lds) + WS_GKH); float* __restrict__ egl = (float*)(ctx_ws(lds) + WS_EGL);
    const bf16_t* __restrict__ a2T = (const bf16_t*)(ctx_ws(lds) + WS_W + (size_t)l * LW_BYTES + LW_GA2);
    LAS float* bb = (LAS float*)lds;
    LAS bf16_t* xa = (LAS bf16_t*)(lds + 64 * 516 * 4);
    const bool samp = cidx >= 128;
    __syncthreads();
    for (int i = tid; i < ntok * 32; i += NTHREADS) { const int t = i >> 5, k = i & 31; xa[t * 40 + k] = k < 16 ? proj[(size_t)(m0 + t) * NINP + G0 + 2048 + k] : (bf16_t)0; }
    __syncthreads();
#pragma unroll
    for (int q = 0; q < 4; ++q) { const int tc = wave * 4 + q;
        const bf16x8 bv = *(const bf16x8*)(a2T + (size_t)(tc * 16 + lr) * 32 + lq * 8);
        const float ab = ctx_in(lds, I_GAB)[l * 512 + tc * 16 + lr];
#pragma unroll
        for (int tt = 0; tt < 4; ++tt) { if (tt * 16 >= ntok) break; const bf16x8 av = *(const LAS bf16x8*)(xa + (tt * 16 + lr) * 40 + lq * 8);
            f32x4 acc = {0.f, 0.f, 0.f, 0.f}; acc = MFMA16(av, bv, acc);
#pragma unroll
            for (int r = 0; r < 4; ++r) bb[(tt * 16 + lq * 4 + r) * 516 + tc * 16 + lr] = logsig_fast(acc[r] + ab) * 0.0625f; } }
    __syncthreads();
    if (!samp) { const int c = tid; float run = 0.f;
#pragma unroll 8
        for (int t = 0; t < 64; ++t) { run += bb[t * 516 + c]; bb[t * 516 + c] = run; }
        egl[(size_t)cidx * 512 + c] = __expf(run); }
    __syncthreads();
    const float scale = 0.08838834764831845f;
    for (int i = tid; i < ntok * 64; i += NTHREADS) { const int t = i >> 6, cg = i & 63, c = cg * 8; const size_t m = m0 + t;
        float q[8], k[8], b8[8], bl[8], oq[8], ok[8], oh[8];
        ld8b(proj + m * NINP + G0 + c, q); ld8b(proj + m * NINP + G0 + 512 + c, k);
#pragma unroll
        for (int j = 0; j < 8; ++j) { b8[j] = bb[t * 516 + c + j]; bl[j] = samp ? b8[j] : bb[63 * 516 + c + j]; }
#pragma unroll
        for (int j = 0; j < 8; ++j) { oq[j] = q[j] * __expf(b8[j]) * scale; ok[j] = k[j] * __expf(-b8[j]); oh[j] = k[j] * __expf(bl[j] - b8[j]); }
        *(u32x4*)(gq + m * 512 + c) = pack8(oq); *(u32x4*)(gk + m * 512 + c) = pack8(ok); *(u32x4*)(gkh + m * 512 + c) = pack8(oh);
        if (samp) { float e[8];
#pragma unroll
            for (int j = 0; j < 8; ++j) e[j] = __expf(b8[j]);
            st8f(egl + (size_t)(128 + (m - MP)) * 512 + c, e); } }
}
__device__ __forceinline__ void phase_pre(LAS unsigned char* lds, int l, int G) {
    { const int tid = opaque_tid(), wave = tid >> 6, lane = tid & 63;
      for (int it = blockIdx.x * 8 + wave; it < 2048 + G * 8; it += G * 8) {
          int cidx, tt, h0, nh;
          if (it < 2048) { cidx = it >> 4; tt = (it >> 2) & 3; h0 = (it & 3) * 4; nh = 4; }
          else { const int j = G * 8 - 1 - (it - 2048); if (j >= 128) continue; cidx = 128 + (j >> 6); tt = (j >> 4) & 3; h0 = j & 15; nh = 1; }
          pre_rwkv_item(lds, l, cidx, tt, h0, nh, wave, lane); } }
    for (int u = blockIdx.x; u < 272; u += G) {
        if (u < 128) pre_gla(lds, l, u, u * 64, 64);
        else if (u < 256) pre_mlstm(lds, l, u - 128, (u - 128) * 64, 64);
        else if (u < 264) pre_gla(lds, l, 128, MP + (u - 256) * 16, 16);
        else pre_mlstm(lds, l, 128, MP + (u - 264) * 16, 16);
    }
    {
        const bf16_t* __restrict__ proj = (const bf16_t*)(ctx_ws(lds) + WS_PROJ);
        for (int i = blockIdx.x * NTHREADS + opaque_tid(); i < 132 * (RC / 8); i += G * NTHREADS) { const int sq = i / (RC / 8), cg8 = i % (RC / 8); float p[8];
            const int m = sq < 4 ? sq * 2048 + 2047 : MP + (sq - 4);
            ld8b(proj + (size_t)m * NINP + cg8 * 8, p);
            st8f(ctx_out(lds) + (sq < 4 ? O_PSHIFT + (size_t)(l * 4 + sq) * RC : O_SSHIFT + (size_t)(l * 128 + (sq - 4)) * RC) + cg8 * 8, p); }
    }
}

__device__ __forceinline__ void scan_rwkv(LAS unsigned char* lds, int l, int u) {
    const int tid = opaque_tid(), bh = u >> 1, half = u & 1, b = bh >> 4, h = bh & 15;
    const int row2 = (tid >> 3) & 31, jg = tid & 7;
    const float* __restrict__ rpre = (const float*)(ctx_ws(lds) + WS_RPRE); bf16_t* __restrict__ rout = (bf16_t*)(ctx_ws(lds) + WS_ROUT);
    LAS float* stage = (LAS float*)lds;
    LAS float* obuf = (LAS float*)(lds + 64 * 352 * 4);
    f32x4 Sa = {0.f, 0.f, 0.f, 0.f}, Sb = {0.f, 0.f, 0.f, 0.f};
    const size_t mb = (size_t)b * 2048;
    const unsigned char* rbase = (const unsigned char*)rpre;
    unsigned off[7], inc[7]; int lo[7];
#pragma unroll
    for (int q = 0; q < 7; ++q) { int i = tid + 512 * q; i = i < 3328 ? i : 3327; const int tok = i / 52, j = i % 52;
        if (j < 32) { const int arr = j >> 3, pc = j & 7; off[q] = (unsigned)(arr * (int)ARR + tok * 1024 + h * 64 + pc * 8) * 2u; inc[q] = 64u * 1024u * 2u; lo[q] = tok * 352 + (arr == 0 ? 0 : arr == 1 ? 64 : arr == 2 ? 192 : 256) + pc * 8; }
        else if (j < 48) { const int pc = j - 32; off[q] = (unsigned)RP_W + (unsigned)(tok * 1024 + h * 64 + pc * 4) * 4u; inc[q] = 64u * 1024u * 4u; lo[q] = -(tok * 352 + 128 + pc * 4) - 1; }
        else { const int pc = j - 48; off[q] = (unsigned)(4 * (int)ARR + tok * 1024 + h * 64 + half * 32 + pc * 8) * 2u; inc[q] = 64u * 1024u * 2u; lo[q] = tok * 352 + 320 + pc * 8; } }
    u32x4 pf[7];
    const size_t cb0 = mb / 64;
#pragma unroll
    for (int q = 0; q < 7; ++q) pf[q] = *(const u32x4*)(rbase + off[q] + cb0 * inc[q]);
    __syncthreads();
    for (int ch = 0; ch < 32; ++ch) {
#pragma unroll
        for (int q = 0; q < 7; ++q) {
            if (lo[q] < 0) *(LAS u32x4*)(stage + (-lo[q] - 1)) = pf[q];
            else { float f[8]; unpack8(pf[q], f); *(LAS f32x4*)(stage + lo[q]) = (f32x4){f[0], f[1], f[2], f[3]}; *(LAS f32x4*)(stage + lo[q] + 4) = (f32x4){f[4], f[5], f[6], f[7]}; } }
        __syncthreads();
        { const size_t chn = cb0 + (ch + 1 < 32 ? ch + 1 : 31);
#pragma unroll
          for (int q = 0; q < 7; ++q) pf[q] = *(const u32x4*)(rbase + off[q] + chn * inc[q]); }
        if (tid < 256) {
        f32x4 B5[2][10]; float Bv[2];
#define RW_LD(slot, t) do { const LAS float* sp_ = stage + (t) * 352 + jg * 8; _Pragma("unroll") for (int v_ = 0; v_ < 5; ++v_) { B5[slot][2 * v_] = *(const LAS f32x4*)(sp_ + 64 * v_); B5[slot][2 * v_ + 1] = *(const LAS f32x4*)(sp_ + 64 * v_ + 4); } \
            Bv[slot] = stage[(t) * 352 + 320 + row2]; } while (0)
        RW_LD(0, 0);
        float os[8] = {0.f, 0.f, 0.f, 0.f, 0.f, 0.f, 0.f, 0.f};
#pragma unroll
        for (int t = 0; t < 64; ++t) {
            if (t + 1 < 64) RW_LD((t + 1) & 1, t + 1);
            const int sl = t & 1; const float vv = Bv[sl];
            f32x4 p = Sa * B5[sl][0]; p = Sb * B5[sl][1] + p;
            float sa = (p.x + p.y) + (p.z + p.w);
            sa = row8_sum(sa);
            Sa = Sa * B5[sl][4] - sa * B5[sl][2] + vv * B5[sl][6];
            Sb = Sb * B5[sl][5] - sa * B5[sl][3] + vv * B5[sl][7];
            f32x4 q = Sa * B5[sl][8]; q = Sb * B5[sl][9] + q;
            float o = (q.x + q.y) + (q.z + q.w);
            o = row8_sum(o);
            if ((t & 7) == jg) os[t >> 3] = o;
        }
#undef RW_LD
#pragma unroll
        for (int i = 0; i < 8; ++i) obuf[(i * 8 + jg) * 32 + row2] = os[i];
        }
        __syncthreads();
        for (int i = tid; i < 1024; i += NTHREADS) *(unsigned*)(rout + (mb + ch * 64 + (i >> 4)) * 1024 + h * 64 + half * 32 + (i & 15) * 2) = pk2(obuf[i * 2], obuf[i * 2 + 1]);
    }
    if (tid < 256) { float* sp = ctx_out(lds) + O_PWKV + ((size_t)((l * 4 + b) * 16 + h) * 64 + half * 32 + row2) * 64 + jg * 8; *(f32x4*)sp = Sa; *(f32x4*)(sp + 4) = Sb; }
    __syncthreads();
}
__device__ __forceinline__ void scan_mlstm(LAS unsigned char* lds, int l, int u) {
    const int tid = opaque_tid(), lane = tid & 63, wave = tid >> 6, lr = lane & 15, lq = lane >> 4;
    const int bh = u >> 2, sl = u & 3, b = bh >> 2, h = bh & 3;
    const bf16_t* __restrict__ proj = (const bf16_t*)(ctx_ws(lds) + WS_PROJ); const bf16_t* __restrict__ qm = (const bf16_t*)(ctx_ws(lds) + WS_QM); const bf16_t* __restrict__ km = (const bf16_t*)(ctx_ws(lds) + WS_KM);
    const float* __restrict__ gates = (const float*)(ctx_ws(lds) + WS_GATES); bf16_t* __restrict__ hm = (bf16_t*)(ctx_ws(lds) + WS_HM);
    LAS bf16_t* kS = (LAS bf16_t*)lds;
    LAS bf16_t* kwT = (LAS bf16_t*)(lds + 33792);
    LAS bf16_t* vT = (LAS bf16_t*)(lds + 33792 + 36864);
    LAS bf16_t* Sp = (LAS bf16_t*)(lds + 33792 + 36864 + 11520);
    LAS bf16_t* CT = (LAS bf16_t*)(lds + 33792 + 36864 + 11520 + 9216);
    LAS float* gF = (LAS float*)(lds + 33792 + 36864 + 11520 + 9216 + 42240);
    LAS float* gU = gF + 64; LAS float* gM = gF + 128; LAS float* gS = gF + 192; LAS float* gD = gF + 196;
    __syncthreads();
    for (int i = tid; i < 80 * 264 / 2; i += NTHREADS) ((LAS unsigned*)CT)[i] = 0u;
    for (int i = tid; i < 16 * 72; i += NTHREADS) vT[64 * 72 + i] = (i < 72) ? (bf16_t)0x3F80 : (bf16_t)0;
    f32x4 acc[2][5];
#pragma unroll
    for (int i = 0; i < 2; ++i)
#pragma unroll
        for (int j = 0; j < 5; ++j) acc[i][j] = (f32x4){0.f, 0.f, 0.f, 0.f};
    float m_prev = 0.f;
    const int tt = wave >> 1, wodd = wave & 1, s = tid & 63, eg = tid >> 6;
    const size_t mb = (size_t)b * 2048;
    u32x4 pv = *(const u32x4*)(proj + (mb + s) * NINP + M0 + 2048 + h * 256 + sl * 64 + eg * 8);
    u32x4 pk[4];
#pragma unroll
    for (int j = 0; j < 4; ++j) pk[j] = *(const u32x4*)(km + (mb + s) * 1024 + h * 256 + (eg + 8 * j) * 8);
    bf16x8 qf[8];
#pragma unroll
    for (int ks = 0; ks < 8; ++ks) qf[ks] = *(const bf16x8*)(qm + (mb + tt * 16 + lr) * 1024 + h * 256 + ks * 32 + lq * 8);
    float pig = gates[(mb + lane) * 8 + h], plf = gates[(mb + lane) * 8 + 4 + h];
    for (int c = 0; c < 32; ++c) {
        const size_t m0 = mb + c * 64;
        if (wave == 0) {
            float F = plf;
#pragma unroll
            for (int o = 1; o < 64; o <<= 1) { const float t = __shfl_up(F, o); if (lane >= o) F += t; }
            const float uu = pig - F; float am = uu;
#pragma unroll
            for (int o = 1; o < 64; o <<= 1) { const float t = __shfl_up(am, o); if (lane >= o) am = fmaxf(am, t); }
            const float Mt = fmaxf(m_prev, am);
            gF[lane] = F; gU[lane] = uu; gM[lane] = Mt;
            if (lane == 63) { gS[0] = __expf(m_prev - Mt); gS[1] = Mt; gS[2] = F + Mt; }
        }
        { vT[(eg * 8 + 0) * 72 + s] = (bf16_t)(pv.x & 0xffffu); vT[(eg * 8 + 1) * 72 + s] = (bf16_t)(pv.x >> 16); vT[(eg * 8 + 2) * 72 + s] = (bf16_t)(pv.y & 0xffffu); vT[(eg * 8 + 3) * 72 + s] = (bf16_t)(pv.y >> 16);
          vT[(eg * 8 + 4) * 72 + s] = (bf16_t)(pv.z & 0xffffu); vT[(eg * 8 + 5) * 72 + s] = (bf16_t)(pv.z >> 16); vT[(eg * 8 + 6) * 72 + s] = (bf16_t)(pv.w & 0xffffu); vT[(eg * 8 + 7) * 72 + s] = (bf16_t)(pv.w >> 16);
#pragma unroll
          for (int j = 0; j < 4; ++j) *(LAS u32x4*)(kS + s * 264 + (eg + 8 * j) * 8) = pk[j]; }
        __syncthreads();
        const float a_c = gS[0], ML = gS[1], m_new = gS[2];
        { const float ws = __expf(gU[s] - ML);
#pragma unroll
          for (int j = 0; j < 4; ++j) { const int d0 = (eg + 8 * j) * 8; float k[8]; unpack8(pk[j], k);
#pragma unroll
              for (int i = 0; i < 8; ++i) kwT[(d0 + i) * 72 + s] = f2bf(k[i] * ws); } }
        const size_t m1 = mb + (size_t)(c + 1 < 32 ? c + 1 : 31) * 64;
        pig = gates[(m1 + lane) * 8 + h]; plf = gates[(m1 + lane) * 8 + 4 + h];
        pv = *(const u32x4*)(proj + (m1 + s) * NINP + M0 + 2048 + h * 256 + sl * 64 + eg * 8);
#pragma unroll
        for (int j = 0; j < 4; ++j) pk[j] = *(const u32x4*)(km + (m1 + s) * 1024 + h * 256 + (eg + 8 * j) * 8);
#pragma unroll
        for (int q = 0; q < 2; ++q) { const int ts = 2 * wodd + q;
            f32x4 sacc = {0.f, 0.f, 0.f, 0.f};
            if (ts <= tt) {
#pragma unroll
                for (int ks = 0; ks < 8; ++ks) { const bf16x8 kf = *(const LAS bf16x8*)(kS + (ts * 16 + lr) * 264 + ks * 32 + lq * 8); sacc = MFMA16(qf[ks], kf, sacc); }
            }
            const int sc = ts * 16 + lr; const float us = gU[sc];
#pragma unroll
            for (int r = 0; r < 4; ++r) { const int t = tt * 16 + lq * 4 + r; const float v = (sc <= t) ? sacc[r] * __expf(us - gM[t]) : 0.f; Sp[t * 72 + sc] = f2bf(v); }
        }
        __syncthreads();
        f32x4 hn[3];
#pragma unroll
        for (int q = 0; q < 3; ++q) { const int te = wodd ? 3 + q : q; hn[q] = (f32x4){0.f, 0.f, 0.f, 0.f}; if (te < 5) {
            f32x4 aq = {0.f, 0.f, 0.f, 0.f}, as = {0.f, 0.f, 0.f, 0.f};
#pragma unroll
            for (int ks = 0; ks < 8; ++ks) { const bf16x8 cf = *(const LAS bf16x8*)(CT + (te * 16 + lr) * 264 + ks * 32 + lq * 8); aq = MFMA16(qf[ks], cf, aq); }
#pragma unroll
            for (int ks = 0; ks < 2; ++ks) { const bf16x8 sf = *(const LAS bf16x8*)(Sp + (tt * 16 + lr) * 72 + ks * 32 + lq * 8); const bf16x8 vf = *(const LAS bf16x8*)(vT + (te * 16 + lr) * 72 + ks * 32 + lq * 8); as = MFMA16(sf, vf, as); }
#pragma unroll
            for (int r = 0; r < 4; ++r) { const int t = tt * 16 + lq * 4 + r; hn[q][r] = __expf(m_prev - gM[t]) * aq[r] + as[r]; }
            if (te == 4 && lr == 0) {
#pragma unroll
                for (int r = 0; r < 4; ++r) gD[tt * 16 + lq * 4 + r] = hn[q][r]; }
        } }
#pragma unroll
        for (int ks = 0; ks < 8; ++ks) qf[ks] = *(const bf16x8*)(qm + (m1 + tt * 16 + lr) * 1024 + h * 256 + ks * 32 + lq * 8);
#pragma unroll
        for (int i = 0; i < 2; ++i) { const int dt = wave * 2 + i;
            bf16x8 kf[2];
#pragma unroll
            for (int ks = 0; ks < 2; ++ks) kf[ks] = *(const LAS bf16x8*)(kwT + (dt * 16 + lr) * 72 + ks * 32 + lq * 8);
#pragma unroll
            for (int et = 0; et < 5; ++et) { acc[i][et] = acc[i][et] * a_c;
#pragma unroll
                for (int ks = 0; ks < 2; ++ks) { const bf16x8 vf = *(const LAS bf16x8*)(vT + (et * 16 + lr) * 72 + ks * 32 + lq * 8); acc[i][et] = MFMA16(kf[ks], vf, acc[i][et]); } } }
        __syncthreads();
#pragma unroll
        for (int i = 0; i < 2; ++i) { const int dt = wave * 2 + i;
#pragma unroll
            for (int et = 0; et < 5; ++et) { u32x2 w; w.x = pk2(acc[i][et][0], acc[i][et][1]); w.y = pk2(acc[i][et][2], acc[i][et][3]);
                *(LAS u32x2*)(CT + (et * 16 + lr) * 264 + dt * 16 + lq * 4) = w; } }
        { float dd[4];
#pragma unroll
          for (int r = 0; r < 4; ++r) { const int t = tt * 16 + lq * 4 + r; dd[r] = 1.f / fmaxf(fabsf(gD[t]), __expf(-(gF[t] + gM[t]))); }
#pragma unroll
          for (int q = 0; q < 3; ++q) { const int te = wodd ? 3 + q : q; if (te < 4) {
#pragma unroll
              for (int r = 0; r < 4; ++r) hm[(m0 + tt * 16 + lq * 4 + r) * 1024 + h * 256 + sl * 64 + te * 16 + lr] = f2bf(hn[q][r] * dd[r]); } } }
        m_prev = m_new;
        __syncthreads();
    }
#pragma unroll
    for (int i = 0; i < 2; ++i) { const int dt = wave * 2 + i;
#pragma unroll
        for (int et = 0; et < 5; ++et)
#pragma unroll
            for (int r = 0; r < 4; ++r) { const int d = dt * 16 + lq * 4 + r;
                if (et < 4) ctx_out(lds)[O_PC + ((size_t)((l * 4 + b) * 4 + h) * 256 + d) * 256 + sl * 64 + et * 16 + lr] = acc[i][et][r];
                else if (sl == 0 && lr == 0) ctx_out(lds)[O_PN + (size_t)((l * 4 + b) * 4 + h) * 256 + d] = acc[i][et][r]; } }
    if (sl == 0 && tid == 0) ctx_out(lds)[O_PM + (l * 4 + b) * 4 + h] = m_prev;
    __syncthreads();
}
__device__ __forceinline__ void scan_gla(LAS unsigned char* lds, int l, int u) {
    const int tid = opaque_tid(), lane = tid & 63, wave = tid >> 6, lr = lane & 15, lq = lane >> 4;
    const int bh = u >> 2, sl = u & 3, b = bh >> 2, h = bh & 3;
    const bf16_t* __restrict__ proj = (const bf16_t*)(ctx_ws(lds) + WS_PROJ); const bf16_t* __restrict__ gq = (const bf16_t*)(ctx_ws(lds) + WS_GQ); const bf16_t* __restrict__ gk = (const bf16_t*)(ctx_ws(lds) + WS_GK); const bf16_t* __restrict__ gkh = (const bf16_t*)(ctx_ws(lds) + WS_GKH);
    const float* __restrict__ egl = (const float*)(ctx_ws(lds) + WS_EGL); bf16_t* __restrict__ og = (bf16_t*)(ctx_ws(lds) + WS_OG);
    LAS bf16_t* khT = (LAS bf16_t*)lds;
    LAS bf16_t* vT = (LAS bf16_t*)(lds + 18432);
    LAS bf16_t* Ap = (LAS bf16_t*)(lds + 18432 + 9216);
    LAS bf16_t* ST = (LAS bf16_t*)(lds + 36864);
    LAS bf16_t* kS = (LAS bf16_t*)(lds + 36864 + 17408);
    __syncthreads();
    for (int i = tid; i < 64 * 136 / 2; i += NTHREADS) ((LAS unsigned*)ST)[i] = 0u;
    f32x4 acc[4];
#pragma unroll
    for (int j = 0; j < 4; ++j) acc[j] = (f32x4){0.f, 0.f, 0.f, 0.f};
    const int tt = wave >> 1, wodd = wave & 1, s = tid & 63, eg = tid >> 6;
    const size_t mb = (size_t)b * 2048;
    u32x4 pv = *(const u32x4*)(proj + (mb + s) * NINP + G0 + 1024 + h * 256 + sl * 64 + eg * 8);
    u32x4 pkh[2], pgk[2];
#pragma unroll
    for (int j = 0; j < 2; ++j) { pkh[j] = *(const u32x4*)(gkh + (mb + s) * 512 + h * 128 + (eg + 8 * j) * 8); pgk[j] = *(const u32x4*)(gk + (mb + s) * 512 + h * 128 + (eg + 8 * j) * 8); }
    bf16x8 qf[4];
#pragma unroll
    for (int ks = 0; ks < 4; ++ks) qf[ks] = *(const bf16x8*)(gq + (mb + tt * 16 + lr) * 512 + h * 128 + ks * 32 + lq * 8);
    float eg4[4];
#pragma unroll
    for (int r = 0; r < 4; ++r) eg4[r] = egl[(size_t)(b * 32) * 512 + h * 128 + wave * 16 + lq * 4 + r];
    for (int c = 0; c < 32; ++c) {
        const int cidx = b * 32 + c; const size_t m0 = (size_t)cidx * 64;
        { vT[(eg * 8 + 0) * 72 + s] = (bf16_t)(pv.x & 0xffffu); vT[(eg * 8 + 1) * 72 + s] = (bf16_t)(pv.x >> 16); vT[(eg * 8 + 2) * 72 + s] = (bf16_t)(pv.y & 0xffffu); vT[(eg * 8 + 3) * 72 + s] = (bf16_t)(pv.y >> 16);
          vT[(eg * 8 + 4) * 72 + s] = (bf16_t)(pv.z & 0xffffu); vT[(eg * 8 + 5) * 72 + s] = (bf16_t)(pv.z >> 16); vT[(eg * 8 + 6) * 72 + s] = (bf16_t)(pv.w & 0xffffu); vT[(eg * 8 + 7) * 72 + s] = (bf16_t)(pv.w >> 16);
#pragma unroll
          for (int j = 0; j < 2; ++j) { const int d0 = (eg + 8 * j) * 8; const u32x4 w = pkh[j];
              khT[(d0 + 0) * 72 + s] = (bf16_t)(w.x & 0xffffu); khT[(d0 + 1) * 72 + s] = (bf16_t)(w.x >> 16); khT[(d0 + 2) * 72 + s] = (bf16_t)(w.y & 0xffffu); khT[(d0 + 3) * 72 + s] = (bf16_t)(w.y >> 16);
              khT[(d0 + 4) * 72 + s] = (bf16_t)(w.z & 0xffffu); khT[(d0 + 5) * 72 + s] = (bf16_t)(w.z >> 16); khT[(d0 + 6) * 72 + s] = (bf16_t)(w.w & 0xffffu); khT[(d0 + 7) * 72 + s] = (bf16_t)(w.w >> 16);
              *(LAS u32x4*)(kS + s * 136 + d0) = pgk[j]; } }
        __syncthreads();
        const float e0 = eg4[0], e1 = eg4[1], e2 = eg4[2], e3 = eg4[3];
        const int cn = c + 1 < 32 ? cidx + 1 : cidx; const size_t m1 = (size_t)cn * 64;
        pv = *(const u32x4*)(proj + (m1 + s) * NINP + G0 + 1024 + h * 256 + sl * 64 + eg * 8);
#pragma unroll
        for (int j = 0; j < 2; ++j) { pkh[j] = *(const u32x4*)(gkh + (m1 + s) * 512 + h * 128 + (eg + 8 * j) * 8); pgk[j] = *(const u32x4*)(gk + (m1 + s) * 512 + h * 128 + (eg + 8 * j) * 8); }
#pragma unroll
        for (int r = 0; r < 4; ++r) eg4[r] = egl[(size_t)cn * 512 + h * 128 + wave * 16 + lq * 4 + r];
#pragma unroll
        for (int q = 0; q < 2; ++q) { const int ts = 2 * wodd + q;
            f32x4 sacc = {0.f, 0.f, 0.f, 0.f};
            if (ts <= tt) {
#pragma unroll
                for (int ks = 0; ks < 4; ++ks) { const bf16x8 kf = *(const LAS bf16x8*)(kS + (ts * 16 + lr) * 136 + ks * 32 + lq * 8); sacc = MFMA16(qf[ks], kf, sacc); }
            }
            const int sc = ts * 16 + lr;
#pragma unroll
            for (int r = 0; r < 4; ++r) { const int t = tt * 16 + lq * 4 + r; Ap[t * 72 + sc] = f2bf((sc <= t) ? sacc[r] : 0.f); }
        }
        __syncthreads();
#pragma unroll
        for (int q = 0; q < 2; ++q) { const int te = 2 * wodd + q;
            f32x4 ao = {0.f, 0.f, 0.f, 0.f};
#pragma unroll
            for (int ks = 0; ks < 4; ++ks) { const bf16x8 sf = *(const LAS bf16x8*)(ST + (te * 16 + lr) * 136 + ks * 32 + lq * 8); ao = MFMA16(qf[ks], sf, ao); }
#pragma unroll
            for (int ks = 0; ks < 2; ++ks) { const bf16x8 af = *(const LAS bf16x8*)(Ap + (tt * 16 + lr) * 72 + ks * 32 + lq * 8); const bf16x8 vf = *(const LAS bf16x8*)(vT + (te * 16 + lr) * 72 + ks * 32 + lq * 8); ao = MFMA16(af, vf, ao); }
#pragma unroll
            for (int r = 0; r < 4; ++r) og[(m0 + tt * 16 + lq * 4 + r) * 1024 + h * 256 + sl * 64 + te * 16 + lr] = f2bf(ao[r]);
        }
#pragma unroll
        for (int ks = 0; ks < 4; ++ks) qf[ks] = *(const bf16x8*)(gq + (m1 + tt * 16 + lr) * 512 + h * 128 + ks * 32 + lq * 8);
        { const int dt = wave;
          bf16x8 kf[2];
#pragma unroll
          for (int ks = 0; ks < 2; ++ks) kf[ks] = *(const LAS bf16x8*)(khT + (dt * 16 + lr) * 72 + ks * 32 + lq * 8);
#pragma unroll
          for (int et = 0; et < 4; ++et) {
              acc[et][0] *= e0; acc[et][1] *= e1; acc[et][2] *= e2; acc[et][3] *= e3;
#pragma unroll
              for (int ks = 0; ks < 2; ++ks) { const bf16x8 vf = *(const LAS bf16x8*)(vT + (et * 16 + lr) * 72 + ks * 32 + lq * 8); acc[et] = MFMA16(kf[ks], vf, acc[et]); } } }
        __syncthreads();
#pragma unroll
        for (int et = 0; et < 4; ++et) { u32x2 w; w.x = pk2(acc[et][0], acc[et][1]); w.y = pk2(acc[et][2], acc[et][3]);
            *(LAS u32x2*)(ST + (et * 16 + lr) * 136 + wave * 16 + lq * 4) = w; }
        __syncthreads();
    }
#pragma unroll
    for (int et = 0; et < 4; ++et)
#pragma unroll
        for (int r = 0; r < 4; ++r) ctx_out(lds)[O_PGLA + ((size_t)((l * 4 + b) * 4 + h) * 128 + wave * 16 + lq * 4 + r) * 256 + sl * 64 + et * 16 + lr] = acc[et][r];
    __syncthreads();
}
__device__ __forceinline__ void samp_rwkv(LAS unsigned char* lds, int l, int u) {
    const int tid = opaque_tid(), s = u >> 3, h = (u & 7) * 2 + (tid >> 8), row = (tid & 255) >> 2, kq = tid & 3;
    const float* __restrict__ rpre = (const float*)(ctx_ws(lds) + WS_RPRE); bf16_t* __restrict__ rout = (bf16_t*)(ctx_ws(lds) + WS_ROUT);
    const size_t m = MP + s, po = m * 1024 + h * 64 + kq * 16;
    const size_t so = ((size_t)((l * 128 + s) * 16 + h) * 64 + row) * 64 + kq * 16;
    const float* __restrict__ sp = ctx_in(lds, I_SWKV) + so;
    f32x4 S[4], kk[4], bb[4], ww[4], k2[4], rr[4];
    const bf16_t* rb = (const bf16_t*)rpre; const float* rw = (const float*)((const unsigned char*)rpre + RP_W);
    { float t0[16], t1[16], t2[16], t3[16];
      ld16b(rb + po, t0); ld16b(rb + ARR + po, t1); ld16b(rb + 2 * ARR + po, t2); ld16b(rb + 3 * ARR + po, t3);
#pragma unroll
      for (int j = 0; j < 4; ++j) { S[j] = *(const f32x4*)(sp + j * 4); ww[j] = *(const f32x4*)(rw + po + j * 4);
          kk[j] = (f32x4){t0[4 * j], t0[4 * j + 1], t0[4 * j + 2], t0[4 * j + 3]}; bb[j] = (f32x4){t1[4 * j], t1[4 * j + 1], t1[4 * j + 2], t1[4 * j + 3]};
          k2[j] = (f32x4){t2[4 * j], t2[4 * j + 1], t2[4 * j + 2], t2[4 * j + 3]}; rr[j] = (f32x4){t3[4 * j], t3[4 * j + 1], t3[4 * j + 2], t3[4 * j + 3]}; } }
    const float vv = bf2f(rb[4 * ARR + m * 1024 + h * 64 + row]);
    float sa = 0.f;
#pragma unroll
    for (int j = 0; j < 4; ++j) sa += (S[j].x * kk[j].x + S[j].y * kk[j].y) + (S[j].z * kk[j].z + S[j].w * kk[j].w);
    sa = quad_sum(sa);
    float o = 0.f;
#pragma unroll
    for (int j = 0; j < 4; ++j) { S[j] = S[j] * ww[j] - sa * bb[j] + vv * k2[j]; o += (S[j].x * rr[j].x + S[j].y * rr[j].y) + (S[j].z * rr[j].z + S[j].w * rr[j].w);
        *(f32x4*)(ctx_out(lds) + O_SWKV + so + j * 4) = S[j]; }
    o = quad_sum(o);
    if (kq == 0) rout[m * 1024 + h * 64 + row] = f2bf(o);
}
__device__ __forceinline__ float block_sum2(LAS float* red, float v, int tid) {
    v = wave_sum(v);
    __syncthreads();
    if ((tid & 63) == 0) red[tid >> 6] = v;
    __syncthreads();
    return ((red[0] + red[1]) + (red[2] + red[3])) + ((red[4] + red[5]) + (red[6] + red[7]));
}
__device__ __forceinline__ void samp_mlstm(LAS unsigned char* lds, int l, int u) {
    const int tid = opaque_tid(), s = u >> 2, h = u & 3;
    const bf16_t* __restrict__ proj = (const bf16_t*)(ctx_ws(lds) + WS_PROJ); const bf16_t* __restrict__ qm = (const bf16_t*)(ctx_ws(lds) + WS_QM); const bf16_t* __restrict__ km = (const bf16_t*)(ctx_ws(lds) + WS_KM);
    const float* __restrict__ gates = (const float*)(ctx_ws(lds) + WS_GATES); bf16_t* __restrict__ hm = (bf16_t*)(ctx_ws(lds) + WS_HM);
    LAS float* qs = (LAS float*)lds; LAS float* ks = qs + 256; LAS float* red = ks + 256; LAS float* rs = red + 8 * 256;
    const size_t m = MP + s; const size_t sb = (size_t)(l * 128 + s) * 4 + h;
    __syncthreads();
    float pq = 0.f, pn = 0.f;
    if (tid < 256) { const float q = bf2f(qm[m * 1024 + h * 256 + tid]), k = bf2f(km[m * 1024 + h * 256 + tid]); qs[tid] = q; ks[tid] = k; pq = q * k; pn = q * ctx_in(lds, I_SN)[sb * 256 + tid]; }
    const float qk = block_sum2(rs, pq, tid);
    const float qn = block_sum2(rs + 8, pn, tid);
    const float ig = gates[m * 8 + h], lf = gates[m * 8 + 4 + h], m_prev = ctx_in(lds, I_SM)[sb];
    const float uu = ig - lf, Mx = fmaxf(m_prev, uu), m_t = lf + Mx, w_inter = __expf(m_prev - Mx), ws = __expf(uu - Mx), Sv = qk * ws;
    const int eg = tid & 63, dp = tid >> 6;
    const u32x2 vw = *(const u32x2*)(proj + m * NINP + M0 + 2048 + h * 256 + eg * 4);
    const f32x4 v4 = {__uint_as_float(vw.x << 16), __uint_as_float(vw.x & 0xffff0000u), __uint_as_float(vw.y << 16), __uint_as_float(vw.y & 0xffff0000u)};
    f32x4 num = {0.f, 0.f, 0.f, 0.f};
    const float* __restrict__ Cs = ctx_in(lds, I_SC) + sb * 65536 + eg * 4; float* Co = ctx_out(lds) + O_SC + sb * 65536 + eg * 4;
#pragma unroll 1
    for (int i0 = 0; i0 < 32; i0 += 16) {
        f32x4 cb[16];
#pragma unroll
        for (int i = 0; i < 16; ++i) cb[i] = *(const f32x4*)(Cs + (size_t)(dp + 8 * (i0 + i)) * 256);
        asm volatile("" : "+v"(cb[0]), "+v"(cb[1]), "+v"(cb[2]), "+v"(cb[3]), "+v"(cb[4]), "+v"(cb[5]), "+v"(cb[6]), "+v"(cb[7]));
        asm volatile("" : "+v"(cb[8]), "+v"(cb[9]), "+v"(cb[10]), "+v"(cb[11]), "+v"(cb[12]), "+v"(cb[13]), "+v"(cb[14]), "+v"(cb[15]));
#pragma unroll
        for (int i = 0; i < 16; ++i) { const int d = dp + 8 * (i0 + i); const f32x4 c4 = cb[i];
            num = num + qs[d] * c4; *(f32x4*)(Co + (size_t)d * 256) = w_inter * c4 + (ws * ks[d]) * v4; } }
    *(LAS f32x4*)(red + dp * 256 + eg * 4) = num;
    __syncthreads();
    if (tid < 256) {
        float nsum = 0.f;
#pragma unroll
        for (int j = 0; j < 8; ++j) nsum += red[j * 256 + tid];
        const float ve = bf2f(proj[m * NINP + M0 + 2048 + h * 256 + tid]);
        const float nm = w_inter * nsum + Sv * ve, den = w_inter * qn + Sv;
        hm[m * 1024 + h * 256 + tid] = f2bf(nm / fmaxf(fabsf(den), __expf(-m_t)));
        ctx_out(lds)[O_SN + sb * 256 + tid] = w_inter * ctx_in(lds, I_SN)[sb * 256 + tid] + ws * ks[tid];
        if (tid == 0) ctx_out(lds)[O_SM + sb] = m_t;
    }
}
__device__ __forceinline__ void samp_gla(LAS unsigned char* lds, int l, int u) {
    const int tid = opaque_tid(), s = u >> 2, h = u & 3;
    const bf16_t* __restrict__ proj = (const bf16_t*)(ctx_ws(lds) + WS_PROJ); const bf16_t* __restrict__ gq = (const bf16_t*)(ctx_ws(lds) + WS_GQ); const bf16_t* __restrict__ gk = (const bf16_t*)(ctx_ws(lds) + WS_GK); const bf16_t* __restrict__ gkh = (const bf16_t*)(ctx_ws(lds) + WS_GKH);
    const float* __restrict__ egl = (const float*)(ctx_ws(lds) + WS_EGL); bf16_t* __restrict__ og = (bf16_t*)(ctx_ws(lds) + WS_OG);
    LAS float* qs = (LAS float*)lds; LAS float* ks = qs + 128; LAS float* es = ks + 128; LAS float* red = es + 128; LAS float* rs = red + 8 * 256;
    const size_t m = MP + s; const size_t sb = (size_t)(l * 128 + s) * 4 + h;
    __syncthreads();
    float pa = 0.f;
    if (tid < 128) { const float q = bf2f(gq[m * 512 + h * 128 + tid]), k = bf2f(gk[m * 512 + h * 128 + tid]); qs[tid] = q; ks[tid] = bf2f(gkh[m * 512 + h * 128 + tid]); es[tid] = egl[(size_t)(128 + s) * 512 + h * 128 + tid]; pa = q * k; }
    const float A = block_sum2(rs, pa, tid);
    const int eg = tid & 63, dp = tid >> 6;
    const u32x2 vw = *(const u32x2*)(proj + m * NINP + G0 + 1024 + h * 256 + eg * 4);
    const f32x4 v4 = {__uint_as_float(vw.x << 16), __uint_as_float(vw.x & 0xffff0000u), __uint_as_float(vw.y << 16), __uint_as_float(vw.y & 0xffff0000u)};
    f32x4 o4 = {0.f, 0.f, 0.f, 0.f};
    const float* __restrict__ Ss = ctx_in(lds, I_SGLA) + sb * 32768 + eg * 4; float* So = ctx_out(lds) + O_SGLA + sb * 32768 + eg * 4;
    { f32x4 sb[16];
#pragma unroll
      for (int i = 0; i < 16; ++i) sb[i] = *(const f32x4*)(Ss + (size_t)(dp + 8 * i) * 256);
      asm volatile("" : "+v"(sb[0]), "+v"(sb[1]), "+v"(sb[2]), "+v"(sb[3]), "+v"(sb[4]), "+v"(sb[5]), "+v"(sb[6]), "+v"(sb[7]));
      asm volatile("" : "+v"(sb[8]), "+v"(sb[9]), "+v"(sb[10]), "+v"(sb[11]), "+v"(sb[12]), "+v"(sb[13]), "+v"(sb[14]), "+v"(sb[15]));
#pragma unroll
      for (int i = 0; i < 16; ++i) { const int d = dp + 8 * i; const f32x4 s4 = sb[i];
          o4 = o4 + qs[d] * s4; *(f32x4*)(So + (size_t)d * 256) = es[d] * s4 + ks[d] * v4; } }
    *(LAS f32x4*)(red + dp * 256 + eg * 4) = o4;
    __syncthreads();
    if (tid < 256) { float osum = 0.f;
#pragma unroll
        for (int j = 0; j < 8; ++j) osum += red[j * 256 + tid];
        og[m * 1024 + h * 256 + tid] = f2bf(osum + A * bf2f(proj[m * NINP + G0 + 1024 + h * 256 + tid])); }
}
__device__ __forceinline__ void phase_scan(LAS unsigned char* lds, int l, int G, unsigned* queue, int rmask) {
    for (int u = blockIdx.x; u < 256; u += G) {
        const int slot = u >> 3, x = u & 7, role = slot & 3, s2 = slot >> 2;
        const int idx = role < 2 ? (s2 * 8 + x) : ((x * 2 + (s2 >> 2)) * 4 + (s2 & 3));
#ifndef SC_MASK
#define SC_MASK 63
#endif
        if (rmask && !((rmask >> (role < 2 ? 0 : role - 1)) & 1)) continue;
        if (role < 2) { if (SC_MASK & 1) scan_rwkv(lds, l, idx * 2 + role); }
        else if (role == 2) { if (SC_MASK & 2) scan_mlstm(lds, l, idx); }
        else { if (SC_MASK & 4) scan_gla(lds, l, idx); }
    }
    LAS unsigned* qw = (LAS unsigned*)(lds + 140000);
    for (;;) {
        __syncthreads();
        if (threadIdx.x == 0) *qw = __hip_atomic_fetch_add(queue, 1u, __ATOMIC_RELAXED, __HIP_MEMORY_SCOPE_AGENT);
        __syncthreads();
        const unsigned u = *qw;
        if (u >= 2048u) break;
        if (u < 512u) { if (SC_MASK & 16) samp_mlstm(lds, l, (int)u); }
        else if (u < 1024u) { if (SC_MASK & 32) samp_gla(lds, l, (int)u - 512); }
        else { if (SC_MASK & 8) samp_rwkv(lds, l, (int)u - 1024); }
    }
}

__device__ __forceinline__ void ld16l(const LAS float* p, float (&f)[16]) {
#pragma unroll
    for (int k = 0; k < 4; ++k) { const f32x4 t = *(const LAS f32x4*)(p + 4 * k); f[4 * k] = t.x; f[4 * k + 1] = t.y; f[4 * k + 2] = t.z; f[4 * k + 3] = t.w; }
}
__device__ __forceinline__ void phase_post(LAS unsigned char* lds, int l, int G) {
    const int tid = opaque_tid(), lane = tid & 63, wave = tid >> 6, c0 = lane * 16;
    const bf16_t* __restrict__ proj = (const bf16_t*)(ctx_ws(lds) + WS_PROJ); const float* __restrict__ rpre = (const float*)(ctx_ws(lds) + WS_RPRE); const bf16_t* __restrict__ rout = (const bf16_t*)(ctx_ws(lds) + WS_ROUT);
    const bf16_t* __restrict__ hm = (const bf16_t*)(ctx_ws(lds) + WS_HM); const bf16_t* __restrict__ og = (const bf16_t*)(ctx_ws(lds) + WS_OG); bf16_t* __restrict__ obr = (bf16_t*)(ctx_ws(lds) + WS_QM);
    LAS float* pl = (LAS float*)lds;
    __syncthreads();
    for (int i = tid; i < 11264; i += NTHREADS) { float v;
        if (i < 1024) v = ctx_in(lds, I_RK)[l * 1024 + i]; else if (i < 2048) v = ctx_in(lds, I_LNG)[l * 1024 + i - 1024]; else if (i < 3072) v = ctx_in(lds, I_LNB)[l * 1024 + i - 2048];
        else if (i < 4096) v = ctx_in(lds, I_MNORM)[l * 1024 + i - 3072]; else if (i < 5120) v = ctx_in(lds, I_GNORM)[l * 1024 + i - 4096]; else v = ctx_in(lds, I_GATEB)[(size_t)l * 6144 + i - 5120];
        pl[i] = v; }
    __syncthreads();
    for (int it = blockIdx.x * 8 + wave; it < MP + 512; it += G * 8) {
        const int m = it < MP ? it : MP + ((it - MP) >> 2); const int part = it < MP ? -1 : (it - MP) & 3;
        const size_t o = (size_t)m * 1024 + c0;
        const bf16_t* prow = proj + (size_t)m * NINP;
        u32x4 L[30];
#define POST_LD(slot, ptr) do { L[slot] = *(const u32x4*)(ptr); L[(slot) + 1] = *(const u32x4*)((ptr) + 8); } while (0)
        if (part < 0 || part == 0) { POST_LD(0, rout + o); POST_LD(2, (const bf16_t*)rpre + 3 * ARR + o); POST_LD(4, (const bf16_t*)rpre + 2 * ARR + o); POST_LD(6, (const bf16_t*)rpre + 4 * ARR + o); POST_LD(8, (const bf16_t*)rpre + 5 * ARR + o); }
        if (part < 0 || part == 1) { POST_LD(10, hm + o); POST_LD(12, prow + M0 + 3080 + c0); }
        if (part < 0 || part == 2) { POST_LD(14, og + o); POST_LD(16, prow + G0 + 2064 + c0); }
        if (part < 0 || part == 3) {
#pragma unroll
            for (int q = 0; q < 2; ++q)
#pragma unroll
                for (int j = 0; j < 3; ++j) POST_LD(18 + (q * 3 + j) * 2, prow + GT0 + j * 2048 + q * 1024 + c0); }
#undef POST_LD
#define POST_UP(slot, arr) do { unpack8(L[slot], *(float(*)[8])&arr[0]); unpack8(L[(slot) + 1], *(float(*)[8])&arr[8]); } while (0)
        if (part < 0 || part == 0) {
            float x[16], r[16], k2[16], v[16], g[16], rk[16], lg[16], lb[16];
            POST_UP(0, x); POST_UP(2, r); POST_UP(4, k2); POST_UP(6, v); POST_UP(8, g);
            ld16l(pl + c0, rk); ld16l(pl + 1024 + c0, lg); ld16l(pl + 2048 + c0, lb);
            float s = 0.f, bs = 0.f;
#pragma unroll
            for (int j = 0; j < 16; ++j) { s += x[j]; bs += r[j] * k2[j] * rk[j]; }
            s += __shfl_xor(s, 1); s += __shfl_xor(s, 2); bs += __shfl_xor(bs, 1); bs += __shfl_xor(bs, 2);
            const float mean = s * (1.f / 64.f); float q = 0.f;
#pragma unroll
            for (int j = 0; j < 16; ++j) { const float d = x[j] - mean; q += d * d; }
            q += __shfl_xor(q, 1); q += __shfl_xor(q, 2);
            const float rstd = rsqrtf(q * (1.f / 64.f) + 64e-5f);
            float y[16];
#pragma unroll
            for (int j = 0; j < 16; ++j) y[j] = ((x[j] - mean) * rstd * lg[j] + lb[j] + bs * v[j]) * g[j];
            st16b(obr + (size_t)m * 3072 + c0, y);
        }
        if (part < 0 || part == 1) {
            float x[16], ng[16], go[16];
            POST_UP(10, x); POST_UP(12, go); ld16l(pl + 3072 + c0, ng);
            float q = 0.f;
#pragma unroll
            for (int j = 0; j < 16; ++j) q += x[j] * x[j];
            q += __shfl_xor(q, 1); q += __shfl_xor(q, 2); q += __shfl_xor(q, 4); q += __shfl_xor(q, 8);
            const float rs = rsqrtf(q * (1.f / 256.f) + 1e-6f);
            float y[16];
#pragma unroll
            for (int j = 0; j < 16; ++j) y[j] = x[j] * rs * ng[j] * sigm(go[j]);
            st16b(obr + (size_t)m * 3072 + 1024 + c0, y);
        }
        if (part < 0 || part == 2) {
            float x[16], ng[16], go[16];
            POST_UP(14, x); POST_UP(16, go); ld16l(pl + 4096 + c0, ng);
            float q = 0.f;
#pragma unroll
            for (int j = 0; j < 16; ++j) q += x[j] * x[j];
            q += __shfl_xor(q, 1); q += __shfl_xor(q, 2); q += __shfl_xor(q, 4); q += __shfl_xor(q, 8);
            const float rs = rsqrtf(q * (1.f / 256.f) + 1e-6f);
            float y[16];
#pragma unroll
            for (int j = 0; j < 16; ++j) y[j] = x[j] * rs * ng[j] * siluf(go[j]);
            st16b(obr + (size_t)m * 3072 + 2048 + c0, y);
        }
        if (part < 0 || part == 3) {
            bf16_t* __restrict__ gr = (bf16_t*)(ctx_ws(lds) + WS_RPRE + RP_GR) + (size_t)m * 6144; const float* __restrict__ gbv = ctx_in(lds, I_GATEB) + (size_t)l * 3 * 2048;
#pragma unroll
            for (int q = 0; q < 2; ++q) { const int d0 = q * 1024 + c0;
                float e0[16], e1[16], e2[16], gb[16];
                POST_UP(18 + (q * 3 + 0) * 2, e0); POST_UP(18 + (q * 3 + 1) * 2, e1); POST_UP(18 + (q * 3 + 2) * 2, e2);
                ld16l(pl + 5120 + d0, gb);
#pragma unroll
                for (int j = 0; j < 16; ++j) e0[j] = 1.f + __expf(-(e0[j] + gb[j]));
                ld16l(pl + 5120 + 2048 + d0, gb);
#pragma unroll
                for (int j = 0; j < 16; ++j) e1[j] = 1.f + __expf(-(e1[j] + gb[j]));
                ld16l(pl + 5120 + 4096 + d0, gb);
#pragma unroll
                for (int j = 0; j < 16; ++j) { e2[j] = 1.f + __expf(-(e2[j] + gb[j])); const float i0 = __builtin_amdgcn_rcpf(e0[j]), i1 = __builtin_amdgcn_rcpf(e1[j]), i2 = __builtin_amdgcn_rcpf(e2[j]);
                    e0[j] = e1[j] * i0; e1[j] = e2[j] * i1; e2[j] = i2; }
                st16b(gr + d0, e0); st16b(gr + 2048 + d0, e1); st16b(gr + 4096 + d0, e2); }
        }
#undef POST_UP
    }
}

template <int MODE>
__device__ __forceinline__ void skinny_phase(LAS unsigned char* lds, const bf16_t* A, int lda, const bf16_t* Bt, int ldb, int K, float* X, bf16_t* merged, const bf16_t* gr, const float* unused, int G) {
    const int tid = opaque_tid(), lane = tid & 63, wave = tid >> 6, lr = lane & 15, lq = lane >> 4, rt = wave & 3, kh = wave >> 2;
    LAS float* xch = (LAS float*)lds;
    for (int u = blockIdx.x; u < 256; u += G) {
        const int cg = u >> 1, rh = u & 1;
        const bf16_t* ap = A + (size_t)(MP + rh * 64 + rt * 16 + lr) * lda + lq * 8;
        const bf16_t* bp = Bt + (size_t)(cg * 16 + lr) * ldb + lq * 8;
        const int row0 = MP + rh * 64 + rt * 16 + lq * 4, col = cg * 16 + lr;
        constexpr int NJ = MODE == 0 ? 1 : 3;
        const int Kj = MODE == 0 ? K : 1024, Kh = Kj / 2;
        f32x4 acc[NJ];
#pragma unroll
        for (int j = 0; j < NJ; ++j) {
            f32x4 a0c = {0.f, 0.f, 0.f, 0.f}, a1c = {0.f, 0.f, 0.f, 0.f};
            const bf16_t* aj = ap + j * 1024 + kh * Kh; const bf16_t* bj = bp + j * 1024 + kh * Kh;
            bf16x8 av[8], bv[8], an[8], bn[8];
#pragma unroll
            for (int i = 0; i < 8; ++i) { av[i] = *(const bf16x8*)(aj + i * 32); bv[i] = *(const bf16x8*)(bj + i * 32); }
            for (int k0 = 0; k0 < Kh; k0 += 256) {
                const int kn = k0 + 256 < Kh ? k0 + 256 : k0;
#pragma unroll
                for (int i = 0; i < 8; ++i) { an[i] = *(const bf16x8*)(aj + kn + i * 32); bn[i] = *(const bf16x8*)(bj + kn + i * 32); }
#pragma unroll
                for (int i = 0; i < 8; i += 2) { a0c = MFMA16(av[i], bv[i], a0c); a1c = MFMA16(av[i + 1], bv[i + 1], a1c); }
#pragma unroll
                for (int i = 0; i < 8; ++i) { av[i] = an[i]; bv[i] = bn[i]; }
            }
            acc[j] = a0c + a1c;
        }
        __syncthreads();
        if (kh == 1) {
#pragma unroll
            for (int j = 0; j < NJ; ++j) *(LAS f32x4*)(xch + ((j * 4 + rt) * 64 + lane) * 4) = acc[j]; }
        __syncthreads();
        if (kh == 0) {
#pragma unroll
            for (int j = 0; j < NJ; ++j) acc[j] = acc[j] + *(const LAS f32x4*)(xch + ((j * 4 + rt) * 64 + lane) * 4);
            if (MODE == 0) {
                { float xo[4];
#pragma unroll
                  for (int r = 0; r < 4; ++r) xo[r] = X[(size_t)(row0 + r) * 2048 + col];
                  asm volatile("" : "+v"(xo[0]), "+v"(xo[1]), "+v"(xo[2]), "+v"(xo[3]));
#pragma unroll
                  for (int r = 0; r < 4; ++r) X[(size_t)(row0 + r) * 2048 + col] = xo[r] + acc[0][r]; }
            } else {
#pragma unroll
                for (int r = 0; r < 4; ++r) { float o = 0.f;
#pragma unroll
                    for (int j = 0; j < NJ; ++j) o = (o + acc[j][r]) * bf2f(gr[(size_t)(row0 + r) * 6144 + j * 2048 + col]);
                    merged[(size_t)(row0 + r) * 2048 + col] = f2bf(o); }
            }
        }
    }
}

constexpr int N_PHASES = 22;
constexpr int CW_BAR = 1024, CW_QUEUE = 8192;

__global__ void __launch_bounds__(NTHREADS, 2) fwd_kernel(Args a) {
    extern __shared__ __attribute__((aligned(16))) unsigned char lds_raw[];
    LAS unsigned char* lds = (LAS unsigned char*)lds_raw;
    const int tid = opaque_tid(), G = gridDim.x;
    volatile LAS unsigned* misc = (volatile LAS unsigned*)(lds + 147456 - 64);
    if (tid < 16) misc[tid] = 0u;
    if (tid < 39) ((LAS unsigned long long*)(lds + PTAB_OFF))[tid] = ((const unsigned long long*)&a)[tid];
    __syncthreads();
    unsigned* ctl = (unsigned*)(ctx_ws(lds) + WS_CTL);
    XcdBarrier bar; bar.bar = ctl + CW_BAR; bar.x = 0; bar.st = misc;
    if (MK_N_LAUNCHES == 1) bar = xcd_barrier_post(ctl + CW_BAR, misc);
    const int lo = a.ph_lo, hi = a.ph_hi & 0xff, rmask = (a.ph_hi >> 8) & 0xff;
#ifndef PH_MASK
#define PH_MASK 0xFFFu
#endif
#define PHM(b) ((PH_MASK >> (b)) & 1u)
#define IN(k) (lo <= (k) && (k) < hi)
#define SEAM(k) do { if (MK_N_LAUNCHES == 1 && IN(k) && IN((k) + 1)) xcd_barrier(bar); } while (0)
    if (PHM(0) && IN(0)) { phase_prologue(lds, opq(G)); SEAM(0); }
#pragma nounroll
    for (int l = 0; l < 2; ++l) {
        const int pb = 1 + 10 * l;
        if (PHM(1) && IN(pb + 0)) { phase_norm(lds, opq(G), ctx_in(lds, I_NORM1) + opq(l) * 2048, opq(l) == 0); SEAM(pb + 0); }
        if (PHM(2) && IN(pb + 1)) {
            pg8::Gemm g{(const bf16_t*)(ctx_ws(lds) + WS_H), (const bf16_t*)(ctx_ws(lds) + WS_W + (size_t)opq(l) * LW_BYTES + LW_WIN), MPAD, NINP, 2048, 2048, 2048};
            pg8::StaticOrder S; S.init(MPAD, NINP, opq(G), (int)blockIdx.x);
            pg8::EpiProj E{(bf16_t*)(ctx_ws(lds) + WS_PROJ), NINP};
            pg8::gemm_phase(lds, g, S, E);
            SEAM(pb + 1);
        }
        if (PHM(3) && IN(pb + 2)) { phase_pre(lds, opq(l), opq(G)); SEAM(pb + 2); }
        if (PHM(4) && IN(pb + 3)) { phase_scan(lds, opq(l), opq(G), (unsigned*)(ctx_ws(lds) + WS_CTL) + CW_QUEUE + 64 * opq(l), rmask); SEAM(pb + 3); }
        if (PHM(5) && IN(pb + 4)) { phase_post(lds, opq(l), opq(G)); SEAM(pb + 4); }
        if (PHM(6) && IN(pb + 5)) {
            pg8::StaticOrder S; S.init(MP, 2048, opq(G), (int)blockIdx.x);
            const bf16_t* obr = (const bf16_t*)(ctx_ws(lds) + WS_QM); const bf16_t* wbr = (const bf16_t*)(ctx_ws(lds) + WS_W + (size_t)opq(l) * LW_BYTES + LW_WBR);
            bf16_t* merged = (bf16_t*)(ctx_ws(lds) + WS_H); const bf16_t* gr = (const bf16_t*)(ctx_ws(lds) + WS_RPRE + RP_GR);
            { pg8::Gemm g{obr, wbr, MP, 2048, 3072, 3072, 3072}; pg8::EpiBranchK E{merged, gr}; pg8::gemm_phase(lds, g, S, E); }
            skinny_phase<1>(lds, obr, 3072, wbr, 3072, 3072, nullptr, merged, gr, nullptr, opq(G));
            SEAM(pb + 5);
        }
        if (PHM(7) && IN(pb + 6)) {
            pg8::Gemm g{(const bf16_t*)(ctx_ws(lds) + WS_H), (const bf16_t*)(ctx_ws(lds) + WS_W + (size_t)opq(l) * LW_BYTES + LW_WOUT), MP, 2048, 2048, 2048, 2048};
            pg8::StaticOrder S; S.init(MP, 2048, opq(G), (int)blockIdx.x);
            pg8::EpiResid E{(float*)(ctx_ws(lds) + WS_X), 2048};
            pg8::gemm_phase(lds, g, S, E);
            skinny_phase<0>(lds, g.A, 2048, g.Bt, 2048, 2048, (float*)(ctx_ws(lds) + WS_X), nullptr, nullptr, nullptr, opq(G));
            SEAM(pb + 6);
        }
        if (PHM(8) && IN(pb + 7)) { phase_norm(lds, opq(G), ctx_in(lds, I_NORM2) + opq(l) * 2048, false); SEAM(pb + 7); }
        if (PHM(9) && IN(pb + 8)) {
            pg8::Gemm g{(const bf16_t*)(ctx_ws(lds) + WS_H), (const bf16_t*)(ctx_ws(lds) + WS_W + (size_t)opq(l) * LW_BYTES + LW_WGU), MPAD, 11264, 2048, 2048, 2048};
            pg8::StaticOrder S; S.init(MPAD, 11264, opq(G), (int)blockIdx.x);
            pg8::EpiSwiGLU E{(bf16_t*)(ctx_ws(lds) + WS_PROJ), DFF};
            pg8::gemm_phase(lds, g, S, E);
            SEAM(pb + 8);
        }
        if (PHM(10) && IN(pb + 9)) {
            pg8::Gemm g{(const bf16_t*)(ctx_ws(lds) + WS_PROJ), (const bf16_t*)(ctx_ws(lds) + WS_W + (size_t)opq(l) * LW_BYTES + LW_WDN), MP, 2048, DFF, DFF, DFF};
            pg8::StaticOrder S; S.init(MP, 2048, opq(G), (int)blockIdx.x);
            pg8::EpiResid E{(float*)(ctx_ws(lds) + WS_X), 2048};
            pg8::gemm_phase(lds, g, S, E);
            skinny_phase<0>(lds, g.A, DFF, g.Bt, DFF, DFF, (float*)(ctx_ws(lds) + WS_X), nullptr, nullptr, nullptr, opq(G));
            SEAM(pb + 9);
        }
    }
    if (PHM(11) && IN(21)) phase_final(lds, opq(G));
    if (IN(22)) phase_dump(lds, G);
#undef IN
#undef SEAM
}

extern "C" void kernel_launch(void* const* d_in, const int* in_sizes, int n_in, void* d_out, int out_size, void* d_ws, size_t ws_size, hipStream_t stream) {
    static int grid = 0;
    if (grid == 0) {
        if (n_in != 37 || ws_size < WS_END) { fprintf(stderr, "kernel_launch: expected 37 inputs and >= %zu bytes of workspace; got %d, %zu\n", (size_t)WS_END, n_in, ws_size); grid = -1; return; }
        int dev = 0, cus = 0, per_cu = 0;
        if (hipGetDevice(&dev) != hipSuccess || hipDeviceGetAttribute(&cus, hipDeviceAttributeMultiprocessorCount, dev) != hipSuccess) { grid = -1; return; }
        if (hipFuncSetAttribute((const void*)fwd_kernel, hipFuncAttributeMaxDynamicSharedMemorySize, LDS_BYTES) != hipSuccess) { fprintf(stderr, "kernel_launch: hipFuncSetAttribute failed\n"); grid = -1; return; }
        if (hipOccupancyMaxActiveBlocksPerMultiprocessor(&per_cu, (const void*)fwd_kernel, NTHREADS, LDS_BYTES) != hipSuccess || per_cu < 1) { fprintf(stderr, "kernel_launch: occupancy query says %d\n", per_cu); }
        (void)hipGetLastError();
        grid = cus;
    }
    if (grid < 0) return;
    (void)hipMemsetAsync((char*)d_ws + WS_CTL, 0, CTL_BYTES, stream);
    Args a{};
    for (int i = 0; i < 37; ++i) a.in[i] = (const float*)d_in[i];
    a.out = (float*)d_out; a.ws = (unsigned char*)d_ws;
    if (MK_N_LAUNCHES == 1) { a.ph_lo = 0; a.ph_hi = N_PHASES; hipLaunchKernelGGL(fwd_kernel, dim3(grid), dim3(NTHREADS), LDS_BYTES, stream, a); }
    else { for (int p = 0; p < DBG_LIM; ++p) { a.ph_lo = p; a.ph_hi = p + 1; hipLaunchKernelGGL(fwd_kernel, dim3(grid), dim3(NTHREADS), LDS_BYTES, stream, a);
            const int kind = p == 0 ? 0 : (p == 21 ? 11 : 1 + (p - 1) % 10);
            if ((DBG_REP_MASK >> kind) & 1) { a.ph_hi = (p + 1) | (DBG_ROLE_MASK << 8); hipLaunchKernelGGL(fwd_kernel, dim3(grid), dim3(NTHREADS), LDS_BYTES, stream, a); } }
        if (DBG_LIM < 22) { a.ph_lo = 22; a.ph_hi = 23; hipLaunchKernelGGL(fwd_kernel, dim3(grid), dim3(NTHREADS), LDS_BYTES, stream, a); } }
}
```

```cpp
#include <hip/hip_runtime.h>
#include <cstdio>
#include <cstdint>

#ifndef MK_N_LAUNCHES
#define MK_N_LAUNCHES 1
#endif

#ifndef DBG_LIM
#define DBG_LIM 22
#ifndef DBG_ROLE_MASK
#define DBG_ROLE_MASK 0
#endif
#ifndef DBG_REP_MASK
#define DBG_REP_MASK 0
#endif
#define DBG_SEL 2
#endif
#define LAS __attribute__((address_space(3)))
typedef unsigned short bf16_t;
typedef short bf16x8 __attribute__((ext_vector_type(8)));
typedef float f32x4 __attribute__((ext_vector_type(4)));
typedef unsigned u32x4 __attribute__((ext_vector_type(4)));
typedef unsigned u32x2 __attribute__((ext_vector_type(2)));

constexpr int DM = 2048, MP = 8192, MT = 8320, MPAD = 8448, NINP = 16640, NIN = 16600;
constexpr int RC = 3264, M0 = 3264, G0 = 7368, GT0 = 10456, DFF = 5632;
constexpr int NTHREADS = 512;
constexpr size_t O_YP = 0, O_YS = 16777216, O_PSHIFT = 17039360, O_PWKV = 17065472, O_PCONV = 17589760, O_PC = 17638912, O_PN = 19736064, O_PM = 19744256,
                 O_PGLA = 19744288, O_SSHIFT = 20792864, O_SWKV = 21628448, O_SCONV = 38405664, O_SC = 39978528, O_SN = 107087392, O_SM = 107349536, O_SGLA = 107350560;
constexpr size_t AL(size_t x) { return (x + 255) & ~(size_t)255; }
constexpr size_t WS_CTL = 0, CTL_BYTES = 1u << 20;
constexpr size_t LW_WIN = 0, LW_WBR = LW_WIN + (size_t)NINP * 2048 * 2, LW_WOUT = LW_WBR + (size_t)3 * 2048 * 1024 * 2, LW_WGU = LW_WOUT + (size_t)2048 * 2048 * 2,
                 LW_WDN = LW_WGU + (size_t)11264 * 2048 * 2, LW_LORA = LW_WDN + (size_t)2048 * 5632 * 2, LW_GA2 = LW_LORA + (size_t)3 * 1024 * 64 * 2, LW_BYTES = LW_GA2 + (size_t)512 * 32 * 2;
constexpr size_t WS_W = CTL_BYTES;
constexpr size_t WS_X = AL(WS_W + 2 * LW_BYTES);
constexpr size_t WS_H = AL(WS_X + (size_t)MPAD * 2048 * 4);
constexpr size_t WS_PROJ = AL(WS_H + (size_t)MPAD * 2048 * 2);
constexpr size_t ARR = (size_t)MT * 1024;
constexpr size_t WS_RPRE = AL(WS_PROJ + (size_t)MPAD * NINP * 2);
constexpr size_t WS_ROUT = AL(WS_RPRE + 7 * ARR * 4);
constexpr size_t WS_QM = AL(WS_ROUT + ARR * 4);
constexpr size_t WS_KM = WS_QM + ARR * 2, WS_GQ = WS_KM + ARR * 2, WS_GK = WS_GQ + ARR, WS_GKH = WS_GK + ARR;
constexpr size_t WS_GATES = AL(WS_GKH + ARR);
constexpr size_t WS_EGL = AL(WS_GATES + (size_t)MT * 8 * 4);
constexpr size_t WS_HM = AL(WS_EGL + (size_t)256 * 512 * 4);
constexpr size_t WS_OG = AL(WS_HM + ARR * 4);
constexpr size_t WS_END = AL(WS_OG + ARR * 4);
static_assert((size_t)MPAD * 3072 * 2 <= WS_GATES - WS_QM, "obr alias");
static_assert((size_t)MPAD * 2048 * 4 <= 7 * ARR * 4, "macc alias");

__device__ __forceinline__ float bf2f(bf16_t b) { return __uint_as_float(((unsigned)b) << 16); }
typedef __bf16 bf16x2_t __attribute__((ext_vector_type(2)));
typedef float f32x2_t __attribute__((ext_vector_type(2)));
__device__ __forceinline__ unsigned pk2(float lo, float hi) { const f32x2_t v = {lo, hi}; return __builtin_bit_cast(unsigned, __builtin_convertvector(v, bf16x2_t)); }
__device__ __forceinline__ bf16_t f2bf(float f) { return (bf16_t)(pk2(f, 0.f) & 0xffffu); }
__device__ __forceinline__ void unpack8(const u32x4 w, float (&f)[8]) {
    f[0] = __uint_as_float(w.x << 16); f[1] = __uint_as_float(w.x & 0xffff0000u); f[2] = __uint_as_float(w.y << 16); f[3] = __uint_as_float(w.y & 0xffff0000u);
    f[4] = __uint_as_float(w.z << 16); f[5] = __uint_as_float(w.z & 0xffff0000u); f[6] = __uint_as_float(w.w << 16); f[7] = __uint_as_float(w.w & 0xffff0000u);
}
__device__ __forceinline__ u32x4 pack8(const float (&f)[8]) { u32x4 w; w.x = pk2(f[0], f[1]); w.y = pk2(f[2], f[3]); w.z = pk2(f[4], f[5]); w.w = pk2(f[6], f[7]); return w; }
__device__ __forceinline__ void ld8f(const float* p, float (&f)[8]) { const f32x4 a = *(const f32x4*)p, b = *(const f32x4*)(p + 4); f[0] = a.x; f[1] = a.y; f[2] = a.z; f[3] = a.w; f[4] = b.x; f[5] = b.y; f[6] = b.z; f[7] = b.w; }
__device__ __forceinline__ void st8f(float* p, const float (&f)[8]) { *(f32x4*)p = (f32x4){f[0], f[1], f[2], f[3]}; *(f32x4*)(p + 4) = (f32x4){f[4], f[5], f[6], f[7]}; }
__device__ __forceinline__ void ld8b(const bf16_t* p, float (&f)[8]) { unpack8(*(const u32x4*)p, f); }
__device__ __forceinline__ float sigm(float x) { return 1.f / (1.f + __expf(-x)); }
__device__ __forceinline__ float siluf(float x) { return x / (1.f + __expf(-x)); }
__device__ __forceinline__ float tanh_fast(float x) { const float e = __expf(2.f * x); return 1.f - 2.f / (e + 1.f); }
__device__ __forceinline__ float logsig_fast(float x) { return fminf(x, 0.f) - __logf(1.f + __expf(-fabsf(x))); }
__device__ __forceinline__ float wave_sum(float v) {
#pragma unroll
    for (int o = 1; o < 64; o <<= 1) v += __shfl_xor(v, o);
    return v;
}
template <int CTRL> __device__ __forceinline__ float dppf(float v) { return __int_as_float(__builtin_amdgcn_update_dpp(0, __float_as_int(v), CTRL, 0xF, 0xF, true)); }
__device__ __forceinline__ float row16_sum(float x) { x += dppf<0xB1>(x); x += dppf<0x4E>(x); x += dppf<0x141>(x); x += dppf<0x140>(x); return x; }
__device__ __forceinline__ float row8_sum(float x) { x += dppf<0xB1>(x); x += dppf<0x4E>(x); x += dppf<0x141>(x); return x; }
__device__ __forceinline__ float quad_sum(float x) { x += dppf<0xB1>(x); x += dppf<0x4E>(x); return x; }
__device__ __forceinline__ int opq(int x) { asm volatile("" : "+s"(x)); return x; }
__device__ __forceinline__ int opaque_tid() { int t = threadIdx.x; asm volatile("" : "+v"(t)); return t; }
__device__ __forceinline__ f32x4 mfma16_safe(const bf16x8 a, const bf16x8 b, const f32x4 c) { f32x4 d = __builtin_amdgcn_mfma_f32_16x16x32_bf16(a, b, c, 0, 0, 0); asm volatile("" : "+v"(d) : "v"(a), "v"(b)); return d; }
#define MFMA16(a, b, c) mfma16_safe((a), (b), (c))
#define LDS_WAIT() asm volatile("s_waitcnt lgkmcnt(0)" ::: "memory")

#define XB_TMO      128
#define XB_XCNT(j)  (256  + 64 * (j))
#define XB_XSUB(j)  (1280 + 64 * (j))
#define XB_XGEN(j)  (2304 + 64 * (j))
#define XB_TOP      3328
#define XB_TOPGEN   3392
#define XCD_BAR_WORDS 3456
#define XB_SPIN_CAP (1u << 18)
__device__ __forceinline__ unsigned xb_ld(unsigned* p)              { return __hip_atomic_load(p, __ATOMIC_RELAXED, __HIP_MEMORY_SCOPE_AGENT); }
__device__ __forceinline__ unsigned xb_add(unsigned* p, unsigned v) { return __hip_atomic_fetch_add(p, v, __ATOMIC_RELAXED, __HIP_MEMORY_SCOPE_AGENT); }
__device__ __forceinline__ unsigned xb_xcc_id() { return (unsigned)__builtin_amdgcn_s_getreg((3 << 11) | 20) & 0xFu; }
#define XB_SPIN(cond, bar) do { unsigned _sp = 0; while (cond) { __builtin_amdgcn_s_sleep(1); \
    if ((++_sp & 255u) == 0u) { if (xb_ld(&(bar)[XB_TMO])) break; if (_sp > XB_SPIN_CAP) { atomicAdd(&(bar)[XB_TMO], 1u); break; } } } } while (0)
struct XcdBarrier { unsigned* bar; unsigned x; volatile LAS unsigned* st; };
__device__ __forceinline__ XcdBarrier xcd_barrier_post(unsigned* bar, volatile LAS unsigned* st) {
    XcdBarrier b; b.bar = bar; b.x = xb_xcc_id(); b.st = st;
    if (threadIdx.x == 0) (void)xb_add(&bar[XB_XCNT(b.x)], 1u);
    return b;
}
__device__ __forceinline__ void xcd_barrier_complete(unsigned* bar, unsigned x, unsigned& nloc, unsigned& nx) {
    const unsigned G = gridDim.x * gridDim.y * gridDim.z;
    unsigned sum, cnt, mine, sp = 0u;
    for (;;) {
        sum = 0u; cnt = 0u; mine = 0u;
#pragma unroll
        for (unsigned j = 0; j < 16; ++j) { const unsigned c = xb_ld(&bar[XB_XCNT(j)]); sum += c; cnt += (c > 0u) ? 1u : 0u; mine = (j == x) ? c : mine; }
        if (sum == G) break;
        __builtin_amdgcn_s_sleep(1);
        if ((++sp & 255u) == 0u) { if (xb_ld(&bar[XB_TMO])) break; if (sp > XB_SPIN_CAP) { atomicAdd(&bar[XB_TMO], 1u); break; } }
    }
    nloc = mine > 0u ? mine : 1u; nx = cnt > 0u ? cnt : 1u;
}
__device__ __forceinline__ void xcd_barrier(const XcdBarrier& b) {
    asm volatile("s_waitcnt vmcnt(0)" ::: "memory");
    __syncthreads();
    if (threadIdx.x == 0) {
        unsigned* bar = b.bar;
        __builtin_amdgcn_s_waitcnt(0);
        unsigned nloc = b.st[0], nx = b.st[1];
        if (nloc == 0u) { xcd_barrier_complete(bar, b.x, nloc, nx); b.st[0] = nloc; b.st[1] = nx; }
        const unsigned old = xb_add(&bar[XB_XSUB(b.x)], 1u);
        const unsigned gen = old / nloc;
        if (old + 1u == (gen + 1u) * nloc) {
            __builtin_amdgcn_fence(__ATOMIC_RELEASE, "agent");
            asm volatile("s_waitcnt vmcnt(0)" ::: "memory");
            const unsigned og = xb_add(&bar[XB_TOP], 1u);
            const unsigned tg = og / nx;
            if (og + 1u == (tg + 1u) * nx) xb_add(&bar[XB_TOPGEN], 1u);
            else XB_SPIN(xb_ld(&bar[XB_TOPGEN]) == tg, bar);
            __builtin_amdgcn_fence(__ATOMIC_ACQUIRE, "agent");
            xb_add(&bar[XB_XGEN(b.x)], 1u);
            asm volatile("s_waitcnt vmcnt(0)" ::: "memory");
        } else {
            XB_SPIN(xb_ld(&bar[XB_XGEN(b.x)]) == gen, bar);
            __builtin_amdgcn_fence(__ATOMIC_ACQUIRE, "agent");
            asm volatile("s_waitcnt vmcnt(0)" ::: "memory");
        }
    }
    __syncthreads();
}

namespace pg8 {
constexpr int BM = 256, BK = 64, HALF = 128, HTB = HALF * BK * 2, STAGE_BYTES = 8 * HTB, NXCD = 8, WGM = 8;
__host__ __device__ __forceinline__ int lds_byte(int r, int c) { const int st = (r >> 4) * 2 + (c >> 5), rr = r & 15, cc = c & 31, ob = rr * 64 + cc * 2; return st * 1024 + (ob ^ (((ob >> 9) & 1) << 5)); }
__host__ __device__ __forceinline__ void stage_rc(int b, int& R, int& C) { const int st = b / 1024, sb = b % 1024, swz = sb ^ (((sb >> 9) & 1) << 5); R = (st >> 1) * 16 + swz / 64; C = (st & 1) * 32 + (swz % 64) / 2; }
__host__ __device__ __forceinline__ int perm32(int rho) { const int n = rho >> 4, i = rho & 15; return 8 * (i >> 2) + 4 * n + (i & 3); }
struct Unit { int pm, pn; };
struct Gemm { const bf16_t* A; const bf16_t* Bt; int M, N, K, lda, ldb; };
struct StaticOrder {
    int nM, nN, nwg, G, c;
    __device__ void init(int M, int N, int G_, int c_) { nM = M / BM; nN = N / BM; nwg = nM * nN; G = G_; c = c_; }
    __device__ bool next(int i, Unit& u) const {
        const long L = (long)i * G + c; if (L >= nwg) return false;
        int wgid = (int)L; { const int q = nwg / NXCD, r = nwg % NXCD, xcd = wgid % NXCD, off = wgid / NXCD; wgid = (xcd < r ? xcd * (q + 1) : r * (q + 1) + (xcd - r) * q) + off; }
        const int nig = WGM * nN, gid = wgid / nig, fm = gid * WGM, gsz = (nM - fm) < WGM ? (nM - fm) : WGM;
        u.pm = fm + ((wgid % nig) % gsz); u.pn = (wgid % nig) / gsz; return true;
    }
};
struct EpiProj {
    static constexpr bool PERM = true, HOOK = false;
    bf16_t* O; int ldc;
    __device__ __forceinline__ void operator()(const f32x4 (&acc)[2][2][4][2], const Unit& u, int wr, int wc, int fr, int fq) const {
        const int row0 = u.pm * BM + wr * 64 + fr, col0 = u.pn * BM + wc * 32 + 8 * fq;
#pragma unroll
        for (int ai = 0; ai < 2; ++ai)
#pragma unroll
            for (int m = 0; m < 4; ++m) { bf16_t* rowp = O + (size_t)(row0 + ai * HALF + m * 16) * ldc + col0;
#pragma unroll
                for (int bj = 0; bj < 2; ++bj) { const f32x4 v0 = acc[ai][bj][m][0], v1 = acc[ai][bj][m][1];
                    u32x4 w; w.x = pk2(v0[0], v0[1]); w.y = pk2(v0[2], v0[3]); w.z = pk2(v1[0], v1[1]); w.w = pk2(v1[2], v1[3]);
                    *(u32x4*)(rowp + bj * HALF) = w; } }
    }
};
struct EpiSwiGLU {
    static constexpr bool PERM = true, HOOK = false;
    bf16_t* O; int ldc;
    __device__ __forceinline__ void operator()(const f32x4 (&acc)[2][2][4][2], const Unit& u, int wr, int wc, int fr, int fq) const {
        const int row0 = u.pm * BM + wr * 64 + fr, col0 = u.pn * HALF + wc * 32 + 8 * fq;
#pragma unroll
        for (int ai = 0; ai < 2; ++ai)
#pragma unroll
            for (int m = 0; m < 4; ++m) { bf16_t* rowp = O + (size_t)(row0 + ai * HALF + m * 16) * ldc + col0;
                float o[8];
#pragma unroll
                for (int n = 0; n < 2; ++n)
#pragma unroll
                    for (int j = 0; j < 4; ++j) o[n * 4 + j] = siluf(acc[ai][0][m][n][j]) * acc[ai][1][m][n][j];
                *(u32x4*)rowp = pack8(o); }
    }
};
struct EpiResid {
    static constexpr bool PERM = false, HOOK = false;
    float* X; int ldc;
    __device__ __forceinline__ void operator()(const f32x4 (&acc)[2][2][4][2], const Unit& u, int wr, int wc, int fr, int fq) const {
        const int row0 = u.pm * BM + wr * 64 + fr, col0 = u.pn * BM + wc * 32 + 4 * fq;
#pragma unroll
        for (int ai = 0; ai < 2; ++ai) {
            f32x4 xv[4][2][2];
#pragma unroll
            for (int m = 0; m < 4; ++m)
#pragma unroll
                for (int bj = 0; bj < 2; ++bj)
#pragma unroll
                    for (int n = 0; n < 2; ++n) xv[m][bj][n] = *(const f32x4*)(X + (size_t)(row0 + ai * HALF + m * 16) * ldc + col0 + bj * HALF + n * 16);
#pragma unroll
            for (int m = 0; m < 4; ++m) asm volatile("" : "+v"(xv[m][0][0]), "+v"(xv[m][0][1]), "+v"(xv[m][1][0]), "+v"(xv[m][1][1]));
#pragma unroll
            for (int m = 0; m < 4; ++m)
#pragma unroll
                for (int bj = 0; bj < 2; ++bj)
#pragma unroll
                    for (int n = 0; n < 2; ++n) *(f32x4*)(X + (size_t)(row0 + ai * HALF + m * 16) * ldc + col0 + bj * HALF + n * 16) = xv[m][bj][n] + acc[ai][bj][m][n];
        }
    }
};
struct EpiBranchK {
    static constexpr bool PERM = true, HOOK = true;
    bf16_t* merged; const bf16_t* gr;
    __device__ __forceinline__ void hook(f32x4 (&acc)[2][2][4][2], const Unit& u, int jn, int wr, int wc, int fr, int fq) const {
        int row0 = u.pm * BM + wr * 64 + fr, col0 = u.pn * BM + wc * 32 + 8 * fq;
        asm volatile("" : "+v"(row0), "+v"(col0));
        u32x4 rv[2][4][2];
#pragma unroll
        for (int ai = 0; ai < 2; ++ai)
#pragma unroll
            for (int m = 0; m < 4; ++m)
#pragma unroll
                for (int bj = 0; bj < 2; ++bj) rv[ai][m][bj] = *(const u32x4*)(gr + (size_t)(row0 + ai * HALF + m * 16) * 6144 + (jn - 1) * 2048 + col0 + bj * HALF);
#pragma unroll
        for (int ai = 0; ai < 2; ++ai)
#pragma unroll
            for (int m = 0; m < 4; ++m)
#pragma unroll
                for (int bj = 0; bj < 2; ++bj) { float r[8]; unpack8(rv[ai][m][bj], r);
#pragma unroll
                    for (int i = 0; i < 8; ++i) acc[ai][bj][m][i >> 2][i & 3] *= r[i]; }
    }
    __device__ __forceinline__ void operator()(const f32x4 (&acc)[2][2][4][2], const Unit& u, int wr, int wc, int fr, int fq) const {
        const int row0 = u.pm * BM + wr * 64 + fr, col0 = u.pn * BM + wc * 32 + 8 * fq;
        u32x4 rv[2][4][2];
#pragma unroll
        for (int ai = 0; ai < 2; ++ai)
#pragma unroll
            for (int m = 0; m < 4; ++m)
#pragma unroll
                for (int bj = 0; bj < 2; ++bj) rv[ai][m][bj] = *(const u32x4*)(gr + (size_t)(row0 + ai * HALF + m * 16) * 6144 + 4096 + col0 + bj * HALF);
#pragma unroll
        for (int ai = 0; ai < 2; ++ai)
#pragma unroll
            for (int m = 0; m < 4; ++m) asm volatile("" : "+v"(rv[ai][m][0]), "+v"(rv[ai][m][1]));
#pragma unroll
        for (int ai = 0; ai < 2; ++ai)
#pragma unroll
            for (int m = 0; m < 4; ++m) { const int row = row0 + ai * HALF + m * 16;
#pragma unroll
                for (int bj = 0; bj < 2; ++bj) { float r[8], o[8]; unpack8(rv[ai][m][bj], r);
#pragma unroll
                    for (int i = 0; i < 8; ++i) o[i] = acc[ai][bj][m][i >> 2][i & 3] * r[i];
                    *(u32x4*)(merged + (size_t)row * 2048 + col0 + bj * HALF) = pack8(o); } }
    }
};

template <class Epi>
__device__ __forceinline__ void gemm_phase(LAS unsigned char* lds, const Gemm g, const StaticOrder& S, const Epi& E) {
    const int tid = opaque_tid(), wid = __builtin_amdgcn_readfirstlane(tid >> 6), lane = tid & 63, wr = wid >> 2, wc = wid & 3, fr = lane & 15, fq = lane >> 4;
    const int K = g.K, nt = K / BK;
    unsigned voffA[2], voffB[2];
#pragma unroll
    for (int i = 0; i < 2; ++i) { int R, C; stage_rc(tid * 16 + i * 8192, R, C); const int Rb = Epi::PERM ? ((R & ~31) + perm32(R & 31)) : R;
        voffA[i] = (unsigned)(R * g.lda + C) * 2u; voffB[i] = (unsigned)(Rb * g.ldb + C) * 2u; }
    const size_t kstep = (size_t)(BK * 2);
    const size_t hstepA = (size_t)HALF * g.lda * 2, hstepB = (size_t)HALF * g.ldb * 2;
    const size_t tstepA = 2 * hstepA, tstepB = 2 * hstepB;
    const unsigned ldsw = (unsigned)wid * 1024u;
    const int aoff = lds_byte(wr * 64 + fr, fq * 8), boff = lds_byte(wc * 32 + fr, fq * 8);
#define PG8_SA(b, h) (((b) * 2 + (h)) * HTB)
#define PG8_SB(b, h) ((4 + (b) * 2 + (h)) * HTB)
#define PG8_STAGE(bufoff, gbase, voff) do { _Pragma("unroll") for (int _i = 0; _i < 2; ++_i) \
        __builtin_amdgcn_global_load_lds((const unsigned*)((const char*)(gbase) + (voff)[_i]), (LAS unsigned*)(lds + (bufoff) + ldsw + _i * 8192), 16, 0, 0); } while (0)
#define PG8_LDA(dst, b, h) do { _Pragma("unroll") for (int m = 0; m < 4; ++m) _Pragma("unroll") for (int k = 0; k < 2; ++k) dst[m][k] = *(const LAS bf16x8*)(lds + PG8_SA(b, h) + aoff + m * 2048 + k * 1024); } while (0)
#define PG8_LDB(dst, b, h) do { _Pragma("unroll") for (int n = 0; n < 2; ++n) _Pragma("unroll") for (int k = 0; k < 2; ++k) dst[n][k] = *(const LAS bf16x8*)(lds + PG8_SB(b, h) + boff + n * 2048 + k * 1024); } while (0)
#define PG8_MMA(ai, bj, At, Bt) do { __builtin_amdgcn_s_setprio(1); _Pragma("unroll") for (int m = 0; m < 4; ++m) _Pragma("unroll") for (int n = 0; n < 2; ++n) _Pragma("unroll") for (int k = 0; k < 2; ++k) \
        acc[ai][bj][m][n] = __builtin_amdgcn_mfma_f32_16x16x32_bf16(Bt[n][k], At[m][k], acc[ai][bj][m][n], 0, 0, 0); __builtin_amdgcn_s_setprio(0); } while (0)
#define PG8_WAIT_V(n) asm volatile("s_waitcnt vmcnt(" #n ")" ::: "memory")
#define PG8_WAIT_L(n) asm volatile("s_waitcnt lgkmcnt(" #n ")" ::: "memory")
#define PG8_BAR __builtin_amdgcn_s_barrier()
#define PG8_SCHED __builtin_amdgcn_sched_barrier(0)
    Unit cur, nxt; int ui = 0;
    if (!S.next(0, cur)) return;
    f32x4 acc[2][2][4][2];
#pragma unroll
    for (int a = 0; a < 2; ++a)
#pragma unroll
        for (int b = 0; b < 2; ++b)
#pragma unroll
            for (int m = 0; m < 4; ++m)
#pragma unroll
                for (int n = 0; n < 2; ++n) acc[a][b][m][n] = (f32x4){0.f, 0.f, 0.f, 0.f};
    bf16x8 At[4][2], B0[2][2], B1[2][2];
    const char* cA = (const char*)g.A + (size_t)cur.pm * tstepA; const char* cB = (const char*)g.Bt + (size_t)cur.pn * tstepB;
    PG8_STAGE(PG8_SB(0, 0), cB, voffB); PG8_STAGE(PG8_SA(0, 0), cA, voffA); PG8_STAGE(PG8_SB(0, 1), cB + hstepB, voffB); PG8_STAGE(PG8_SA(0, 1), cA + hstepA, voffA);
    if (wr == 1) PG8_BAR;
    PG8_WAIT_V(4); PG8_BAR;
    PG8_STAGE(PG8_SB(1, 0), cB + kstep, voffB); PG8_STAGE(PG8_SA(1, 0), cA + kstep, voffA); PG8_STAGE(PG8_SB(1, 1), cB + hstepB + kstep, voffB);
    PG8_WAIT_V(6); PG8_BAR;
    for (;;) {
        const bool has_next = S.next(ui + 1, nxt);
        const char* nA = has_next ? (const char*)g.A + (size_t)nxt.pm * tstepA : cA; const char* nB = has_next ? (const char*)g.Bt + (size_t)nxt.pn * tstepB : cB;
        for (int t = 0; t < nt; t += 2) {
            const bool last = (t == nt - 2);
            const char* a1 = cA + (size_t)(t + 1) * kstep;
            const char* a2 = last ? nA : cA + (size_t)(t + 2) * kstep; const char* b2 = last ? nB : cB + (size_t)(t + 2) * kstep;
            const char* a3 = a2 + kstep; const char* b3 = b2 + kstep;
            if constexpr (Epi::HOOK) { if (t == 16 || t == 32) E.hook(acc, cur, t >> 4, wr, wc, fr, fq); }
            PG8_LDB(B0, 0, 0); PG8_SCHED; PG8_LDA(At, 0, 0); PG8_STAGE(PG8_SA(1, 1), a1 + hstepA, voffA);
            PG8_WAIT_L(8); PG8_BAR; PG8_WAIT_L(0); PG8_MMA(0, 0, At, B0); PG8_BAR; PG8_SCHED;
            PG8_LDB(B1, 0, 1); PG8_STAGE(PG8_SB(0, 0), b2, voffB);
            PG8_BAR; PG8_WAIT_L(0); PG8_MMA(0, 1, At, B1); PG8_BAR;
            PG8_LDA(At, 0, 1); PG8_STAGE(PG8_SA(0, 0), a2, voffA);
            PG8_BAR; PG8_WAIT_L(0); PG8_MMA(1, 0, At, B0); PG8_BAR; PG8_SCHED;
            PG8_STAGE(PG8_SB(0, 1), b2 + hstepB, voffB);
            PG8_WAIT_V(6); PG8_BAR; PG8_MMA(1, 1, At, B1); PG8_BAR;
            PG8_LDB(B0, 1, 0); PG8_SCHED; PG8_LDA(At, 1, 0); PG8_STAGE(PG8_SA(0, 1), a2 + hstepA, voffA);
            PG8_WAIT_L(8); PG8_BAR; PG8_WAIT_L(0); PG8_MMA(0, 0, At, B0); PG8_BAR; PG8_SCHED;
            PG8_LDB(B1, 1, 1); PG8_STAGE(PG8_SB(1, 0), b3, voffB);
            PG8_BAR; PG8_WAIT_L(0); PG8_MMA(0, 1, At, B1); PG8_BAR;
            PG8_LDA(At, 1, 1); PG8_STAGE(PG8_SA(1, 0), a3, voffA);
            PG8_BAR; PG8_WAIT_L(0); PG8_MMA(1, 0, At, B0); PG8_BAR; PG8_SCHED;
            PG8_STAGE(PG8_SB(1, 1), b3 + hstepB, voffB);
            PG8_WAIT_V(6); PG8_BAR; PG8_MMA(1, 1, At, B1); PG8_BAR;
        }
        E(acc, cur, wr, wc, fr, fq);
        if (!has_next) break;
#pragma unroll
        for (int a = 0; a < 2; ++a)
#pragma unroll
            for (int b = 0; b < 2; ++b)
#pragma unroll
                for (int m = 0; m < 4; ++m)
#pragma unroll
                    for (int n = 0; n < 2; ++n) acc[a][b][m][n] = (f32x4){0.f, 0.f, 0.f, 0.f};
        cur = nxt; cA = nA; cB = nB; ++ui;
    }
    PG8_WAIT_V(0);
    if (wr == 0) PG8_BAR;
    PG8_BAR;
#undef PG8_SA
#undef PG8_SB
#undef PG8_STAGE
#undef PG8_LDA
#undef PG8_LDB
#undef PG8_MMA
#undef PG8_WAIT_V
#undef PG8_WAIT_L
#undef PG8_BAR
#undef PG8_SCHED
}
}

constexpr size_t RP_W = 6 * ARR * 2, RP_GR = RP_W + ARR * 4;
static_assert(RP_GR + (size_t)MT * 6144 * 2 <= 7 * ARR * 4, "RPRE region");
struct Args { const float* in[37]; float* out; unsigned char* ws; int ph_lo, ph_hi; };
enum { I_XP = 0, I_XS, I_SSHIFT, I_SWKV, I_SCONV, I_SC, I_SN, I_SM, I_SGLA, I_NORM1, I_WIN, I_GATEB, I_MU, I_W0, I_W2, I_A0, I_A2, I_G2, I_KK, I_KA, I_RK, I_LNG, I_LNB,
       I_CONVW, I_CONVB, I_IB, I_FB, I_MNORM, I_GA2, I_GAB, I_GNORM, I_WBR, I_WOUT, I_NORM2, I_WGU, I_WDN, I_FNORM };

constexpr int LDS_BYTES = 147456;
constexpr int PTAB_OFF = LDS_BYTES - 1024;
__device__ __forceinline__ unsigned long long ctx_raw(LAS unsigned char* lds, int i) {
    const unsigned long long v = ((const LAS unsigned long long*)(lds + PTAB_OFF))[i];
    const unsigned lo = __builtin_amdgcn_readfirstlane((unsigned)v), hi = __builtin_amdgcn_readfirstlane((unsigned)(v >> 32));
    return ((unsigned long long)hi << 32) | lo;
}
#define GAS __attribute__((address_space(1)))
__device__ __forceinline__ const float* ctx_in(LAS unsigned char* lds, int i) { return (const float*)(const GAS float*)ctx_raw(lds, i); }
__device__ __forceinline__ float* ctx_out(LAS unsigned char* lds) { return (float*)(GAS float*)ctx_raw(lds, 37); }
__device__ __forceinline__ unsigned char* ctx_ws(LAS unsigned char* lds) { return (unsigned char*)(GAS unsigned char*)ctx_raw(lds, 38); }

struct TrD { const float* p; bf16_t* dst; int ldw, K; bool ok; };
__device__ __forceinline__ TrD tr_decode(LAS unsigned char* lds, int it, int lane) {
    constexpr int I_IN = 32 * 519, I_BR = 3 * 16 * 64, I_OUT = 32 * 64, I_GU = 32 * 352, I_DN = 88 * 64, I_LO = 3 * 32, PER_L = I_IN + I_BR + I_OUT + I_GU + I_DN + I_LO;
    const int l = it / PER_L; int r = it % PER_L;
    unsigned char* wl = ctx_ws(lds) + WS_W + (size_t)l * LW_BYTES;
    const float* W; bf16_t* WT; int ldw, K, k0, n0, nv = 32, drow0, dk = 0;
    if (r < I_IN) { const int kb = r / 519, nb = r % 519; nv = (NIN - nb * 32) < 32 ? (NIN - nb * 32) : 32;
        W = ctx_in(lds, I_WIN) + (size_t)l * 2048 * NIN; ldw = NIN; k0 = kb * 64; n0 = nb * 32; WT = (bf16_t*)(wl + LW_WIN); K = 2048; drow0 = nb * 32; }
    else if ((r -= I_IN) < I_BR) { const int j = r / 1024, q = r % 1024, kb = q / 64, nb = q % 64;
        W = ctx_in(lds, I_WBR) + (size_t)(l * 3 + j) * 1024 * 2048; ldw = 2048; k0 = kb * 64; n0 = nb * 32; WT = (bf16_t*)(wl + LW_WBR); K = 3072; drow0 = nb * 32; dk = j * 1024; }
    else if ((r -= I_BR) < I_OUT) { const int kb = r / 64, nb = r % 64;
        W = ctx_in(lds, I_WOUT) + (size_t)l * 2048 * 2048; ldw = 2048; k0 = kb * 64; n0 = nb * 32; WT = (bf16_t*)(wl + LW_WOUT); K = 2048; drow0 = nb * 32; }
    else if ((r -= I_OUT) < I_GU) { const int kb = r / 352, nb = r % 352; n0 = nb * 32; const int np = n0 < DFF ? n0 : n0 - DFF;
        W = ctx_in(lds, I_WGU) + (size_t)l * 2048 * 11264; ldw = 11264; k0 = kb * 64; WT = (bf16_t*)(wl + LW_WGU); K = 2048; drow0 = 256 * (np / 128) + (np % 128) + (n0 < DFF ? 0 : 128); }
    else if ((r -= I_GU) < I_DN) { const int kb = r / 64, nb = r % 64;
        W = ctx_in(lds, I_WDN) + (size_t)l * DFF * 2048; ldw = 2048; k0 = kb * 64; n0 = nb * 32; WT = (bf16_t*)(wl + LW_WDN); K = DFF; drow0 = nb * 32; }
    else { r -= I_DN; const int mat = r / 32, nb = r % 32;
        W = (mat == 0 ? ctx_in(lds, I_W2) : (mat == 1 ? ctx_in(lds, I_A2) : ctx_in(lds, I_G2))) + (size_t)l * 64 * 1024; ldw = 1024; k0 = 0; n0 = nb * 32; WT = (bf16_t*)(wl + LW_LORA) + (size_t)mat * 1024 * 64; K = 64; drow0 = nb * 32; }
    TrD t; const int n = lane & 31; t.ok = n < nv; t.ldw = ldw; t.K = K;
    t.p = W + (size_t)(k0 + (lane >> 5)) * ldw + n0 + (t.ok ? n : 0); t.dst = WT + (size_t)drow0 * K + dk + k0; return t;
}
#define TR_PIN16(v, o) asm volatile("" : "+v"(v[o]), "+v"(v[o + 1]), "+v"(v[o + 2]), "+v"(v[o + 3]), "+v"(v[o + 4]), "+v"(v[o + 5]), "+v"(v[o + 6]), "+v"(v[o + 7]), "+v"(v[o + 8]), "+v"(v[o + 9]), "+v"(v[o + 10]), "+v"(v[o + 11]), "+v"(v[o + 12]), "+v"(v[o + 13]), "+v"(v[o + 14]), "+v"(v[o + 15]))
__device__ __forceinline__ void tr_load(const TrD& t, float (&v)[32]) {
#pragma unroll
    for (int i = 0; i < 32; ++i) v[i] = __builtin_nontemporal_load(t.p + (size_t)(2 * i) * t.ldw);
}
__device__ __forceinline__ void tr_store(const TrD& t, const float (&v)[32], LAS float* scr, int lane) {
    const int n = lane & 31;
#pragma unroll
    for (int i = 0; i < 32; ++i) scr[(2 * i + (lane >> 5)) * 33 + n] = t.ok ? v[i] : 0.f;
    LDS_WAIT();
    const int c = lane & 7;
#pragma unroll
    for (int j = 0; j < 4; ++j) { const int nn = (lane >> 3) + 8 * j; const LAS float* s = scr + (8 * c) * 33 + nn;
        u32x4 o; o.x = pk2(s[0 * 33], s[1 * 33]); o.y = pk2(s[2 * 33], s[3 * 33]); o.z = pk2(s[4 * 33], s[5 * 33]); o.w = pk2(s[6 * 33], s[7 * 33]);
        *(u32x4*)(t.dst + (size_t)nn * t.K + 8 * c) = o; }
    LDS_WAIT();
}
__device__ __forceinline__ void phase_prologue(LAS unsigned char* lds, int G) {
    const int tid = opaque_tid(), lane = tid & 63, wave = tid >> 6;
    LAS float* scr = (LAS float*)(lds + wave * 8704);
    const int gw = blockIdx.x * 8 + wave, NGW = G * 8;
    constexpr int NITEMS = 2 * (32 * 519 + 3 * 16 * 64 + 32 * 64 + 32 * 352 + 88 * 64 + 3 * 32);
    if (gw < NITEMS) {
        const int last = gw + ((NITEMS - 1 - gw) / NGW) * NGW;
        TrD ta = tr_decode(lds, gw, lane); float va[32]; tr_load(ta, va);
        for (int it = gw; it < NITEMS; it += 2 * NGW) {
            const int i1 = it + NGW <= last ? it + NGW : last, i2 = it + 2 * NGW <= last ? it + 2 * NGW : last;
            const TrD tb = tr_decode(lds, i1, lane); float vb[32]; tr_load(tb, vb);
            TR_PIN16(va, 0); TR_PIN16(va, 16);
            tr_store(ta, va, scr, lane);
            ta = tr_decode(lds, i2, lane); tr_load(ta, va);
            TR_PIN16(vb, 0); TR_PIN16(vb, 16);
            if (it + NGW < NITEMS) tr_store(tb, vb, scr, lane);
        }
    }
    const int gt = blockIdx.x * NTHREADS + tid, NGT = G * NTHREADS;
    for (int i = gt; i < 2 * 32 * 2048 / 8; i += NGT) { const int l = i / (32 * 256), q = i % (32 * 256);
        *(u32x4*)((bf16_t*)(ctx_ws(lds) + WS_W + (size_t)l * LW_BYTES + LW_WIN) + (size_t)16608 * 2048 + (size_t)q * 8) = (u32x4){0u, 0u, 0u, 0u}; }
    for (int i = gt; i < 2 * 512 * 32; i += NGT) { const int l = i / (512 * 32), q = i % (512 * 32), c = q / 32, k = q % 32;
        ((bf16_t*)(ctx_ws(lds) + WS_W + (size_t)l * LW_BYTES + LW_GA2))[q] = k < 16 ? f2bf(ctx_in(lds, I_GA2)[(size_t)l * 16 * 512 + k * 512 + c]) : (bf16_t)0; }
}

__device__ __forceinline__ void phase_norm(LAS unsigned char* lds, int G, const float* gvec, bool from_input) {
    const int tid = opaque_tid(), lane = tid & 63, wave = tid >> 6;
    float* __restrict__ xbuf = (float*)(ctx_ws(lds) + WS_X); bf16_t* __restrict__ hb = (bf16_t*)(ctx_ws(lds) + WS_H);
    f32x4 gg[8];
#pragma unroll
    for (int j = 0; j < 8; ++j) gg[j] = *(const f32x4*)(gvec + (lane + 64 * j) * 4);
    for (int m = blockIdx.x * 8 + wave; m < MPAD; m += G * 8) {
        if (m >= MT) { if (from_input) {
#pragma unroll
            for (int j = 0; j < 4; ++j) *(u32x4*)(hb + (size_t)m * 2048 + (lane + 64 * j) * 8) = (u32x4){0u, 0u, 0u, 0u}; } continue; }
        const float* src = from_input ? (m < MP ? ctx_in(lds, I_XP) + (size_t)m * 2048 : ctx_in(lds, I_XS) + (size_t)(m - MP) * 2048) : xbuf + (size_t)m * 2048;
        f32x4 v[8]; float s = 0.f;
#pragma unroll
        for (int j = 0; j < 8; ++j) v[j] = *(const f32x4*)(src + (lane + 64 * j) * 4);
#pragma unroll
        for (int j = 0; j < 8; ++j) s += (v[j].x * v[j].x + v[j].y * v[j].y) + (v[j].z * v[j].z + v[j].w * v[j].w);
        const float rs = rsqrtf(wave_sum(s) * (1.f / 2048.f) + 1e-6f);
#pragma unroll
        for (int j = 0; j < 8; ++j) { const int c = (lane + 64 * j) * 4;
            if (from_input) *(f32x4*)(xbuf + (size_t)m * 2048 + c) = v[j];
            u32x2 w; w.x = pk2(v[j].x * rs * gg[j].x, v[j].y * rs * gg[j].y); w.y = pk2(v[j].z * rs * gg[j].z, v[j].w * rs * gg[j].w);
            *(u32x2*)(hb + (size_t)m * 2048 + c) = w; }
    }
}
__device__ __forceinline__ void dump_words(const unsigned* src, unsigned* dst, size_t n, int G) {
    for (size_t i = (size_t)blockIdx.x * NTHREADS + threadIdx.x; i < n; i += (size_t)G * NTHREADS) dst[i] = src[i];
}
__device__ __forceinline__ void phase_dump(LAS unsigned char* lds, int G) {
    unsigned char* ws = ctx_ws(lds); unsigned* out = (unsigned*)ctx_out(lds);
    if (DBG_LIM == 5) { if (DBG_SEL == 0) dump_words((const unsigned*)(ws + WS_ROUT), out + O_YP, ARR, G); if (DBG_SEL == 1) dump_words((const unsigned*)(ws + WS_HM), out + O_YP, ARR, G); if (DBG_SEL == 2) { dump_words((const unsigned*)(ws + WS_OG), out + O_YP, ARR, G); dump_words((const unsigned*)(ws + WS_HM), out + O_SC, ARR, G); } if (DBG_SEL == 3) dump_words((const unsigned*)(ws + WS_QM), out + O_YP, ARR, G); if (DBG_SEL == 4) dump_words((const unsigned*)(ws + WS_HM), out + O_YP, (size_t)MP * 1024, G); }
    else if (DBG_LIM == 6) { dump_words((const unsigned*)(ws + WS_QM), out + O_YP, (size_t)MT * 3072 / 2, G); }
    else if (DBG_LIM == 7) { dump_words((const unsigned*)(ws + WS_H), out + O_YP, (size_t)MT * 2048 / 2, G); }
    else { dump_words((const unsigned*)(ws + WS_X), out + O_YP, (size_t)MP * 2048, G); }
}
__device__ __forceinline__ void phase_final(LAS unsigned char* lds, int G) {
    const int tid = opaque_tid(), lane = tid & 63, wave = tid >> 6;
    const float* __restrict__ xbuf = (const float*)(ctx_ws(lds) + WS_X); const float* __restrict__ gvec = ctx_in(lds, I_FNORM);
    f32x4 gg[8];
#pragma unroll
    for (int j = 0; j < 8; ++j) gg[j] = *(const f32x4*)(gvec + (lane + 64 * j) * 4);
    for (int m = blockIdx.x * 8 + wave; m < MT; m += G * 8) {
        const float* src = xbuf + (size_t)m * 2048; float* __restrict__ dst = ctx_out(lds) + (m < MP ? O_YP + (size_t)m * 2048 : O_YS + (size_t)(m - MP) * 2048);
        f32x4 v[8]; float s = 0.f;
#pragma unroll
        for (int j = 0; j < 8; ++j) v[j] = *(const f32x4*)(src + (lane + 64 * j) * 4);
#pragma unroll
        for (int j = 0; j < 8; ++j) s += (v[j].x * v[j].x + v[j].y * v[j].y) + (v[j].z * v[j].z + v[j].w * v[j].w);
        const float rs = rsqrtf(wave_sum(s) * (1.f / 2048.f) + 1e-6f);
#pragma unroll
        for (int j = 0; j < 8; ++j) { const int c = (lane + 64 * j) * 4;
            *(f32x4*)(dst + c) = (f32x4){v[j].x * rs * gg[j].x, v[j].y * rs * gg[j].y, v[j].z * rs * gg[j].z, v[j].w * rs * gg[j].w}; }
    }
}

__device__ __forceinline__ void load_prev8(const bf16_t* proj, const float* shift_l, int m, int col, float (&o)[8]) {
    if (m >= MP) ld8f(shift_l + (size_t)(m - MP) * RC + col, o);
    else if ((m & 2047) == 0) {
#pragma unroll
        for (int i = 0; i < 8; ++i) o[i] = 0.f; }
    else ld8b(proj + (size_t)(m - 1) * NINP + col, o);
}
__device__ __forceinline__ void ld16b(const bf16_t* p, float (&f)[16]) { ld8b(p, *(float(*)[8])&f[0]); ld8b(p + 8, *(float(*)[8])&f[8]); }
__device__ __forceinline__ void ld16f(const float* p, float (&f)[16]) { ld8f(p, *(float(*)[8])&f[0]); ld8f(p + 8, *(float(*)[8])&f[8]); }
__device__ __forceinline__ void st16f(float* p, const float (&f)[16]) { st8f(p, *(const float(*)[8])&f[0]); st8f(p + 8, *(const float(*)[8])&f[8]); }
__device__ __forceinline__ void st16b(bf16_t* p, const float (&f)[16]) { *(u32x4*)p = pack8(*(const float(*)[8])&f[0]); *(u32x4*)(p + 8) = pack8(*(const float(*)[8])&f[8]); }
__device__ __forceinline__ void pre_rwkv_item(LAS unsigned char* lds, int l, int cidx, int tt, int h0, int nh, int wave, int lane) {
    const int lr = lane & 15, lq = lane >> 4;
    const int m0 = cidx * 64 + tt * 16;
    const bf16_t* __restrict__ proj = (const bf16_t*)(ctx_ws(lds) + WS_PROJ);
    const float* __restrict__ shift_l = ctx_in(lds, I_SSHIFT) + (size_t)l * 128 * RC;
    const float* __restrict__ mu = ctx_in(lds, I_MU) + (size_t)l * RC;
    const bf16_t* __restrict__ loraT = (const bf16_t*)(ctx_ws(lds) + WS_W + (size_t)l * LW_BYTES + LW_LORA);
    bf16_t* __restrict__ rb = (bf16_t*)(ctx_ws(lds) + WS_RPRE); float* __restrict__ rw = (float*)(ctx_ws(lds) + WS_RPRE + RP_W);
    LAS bf16_t* loraA = (LAS bf16_t*)(lds + wave * 14336);
    LAS bf16_t* loraO = (LAS bf16_t*)(lds + wave * 14336 + 7168);
    const int tok = lane >> 2, c4 = lane & 3, m = m0 + tok;
    {
#pragma unroll
        for (int i = 0; i < 6; ++i) {
            const int cgp = c4 + 4 * i, col = 3072 + cgp * 8, mat = cgp >> 3, kc = (cgp & 7) * 8;
            float p[8], pv[8], mm[8], x[8];
            ld8b(proj + (size_t)m * NINP + col, p); load_prev8(proj, shift_l, m, col, pv); ld8f(mu + col, mm);
#pragma unroll
            for (int j = 0; j < 8; ++j) { const float xs = p[j] + (pv[j] - p[j]) * mm[j]; x[j] = mat == 0 ? tanh_fast(xs) : (mat == 1 ? xs : sigm(xs)); }
            *(LAS u32x4*)(loraA + (mat * 16 + tok) * 72 + kc) = pack8(x);
        }
    }
    LDS_WAIT();
    const bool samp = m >= MP, first = !samp && ((m & 2047) == 0);
    const bf16_t* prow = proj + (size_t)m * NINP;
    const bf16_t* qrow = proj + (size_t)((samp || first) ? m : m - 1) * NINP;
    const float* srow = shift_l + (size_t)(samp ? m - MP : 0) * RC;
#pragma unroll 1
    for (int hh = 0; hh < nh; ++hh) {
        const int h = h0 + hh, c0 = h * 64 + c4 * 16;
        bf16x8 bfr[3][4][2];
#pragma unroll
        for (int mat = 0; mat < 3; ++mat)
#pragma unroll
            for (int tc = 0; tc < 4; ++tc)
#pragma unroll
                for (int ks = 0; ks < 2; ++ks) bfr[mat][tc][ks] = *(const bf16x8*)(loraT + (size_t)(mat * 1024 + h * 64 + tc * 16 + lr) * 64 + ks * 32 + lq * 8);
        u32x4 pw[3][2], qw[3][2]; f32x4 qs[3][4];
#pragma unroll
        for (int g = 0; g < 3; ++g) { pw[g][0] = *(const u32x4*)(prow + g * 1024 + c0); pw[g][1] = *(const u32x4*)(prow + g * 1024 + c0 + 8);
            if (samp) {
#pragma unroll
                for (int k = 0; k < 4; ++k) qs[g][k] = *(const f32x4*)(srow + g * 1024 + c0 + 4 * k); }
            else { qw[g][0] = *(const u32x4*)(qrow + g * 1024 + c0); qw[g][1] = *(const u32x4*)(qrow + g * 1024 + c0 + 8); } }
#pragma unroll
        for (int mat = 0; mat < 3; ++mat)
#pragma unroll
            for (int tc = 0; tc < 4; ++tc) { f32x4 acc = {0.f, 0.f, 0.f, 0.f};
#pragma unroll
                for (int ks = 0; ks < 2; ++ks) {
                    const bf16x8 av = *(const LAS bf16x8*)(loraA + (mat * 16 + lr) * 72 + ks * 32 + lq * 8);
                    acc = MFMA16(av, bfr[mat][tc][ks], acc); }
#pragma unroll
                for (int r = 0; r < 4; ++r) loraO[(mat * 16 + lq * 4 + r) * 72 + tc * 16 + lr] = f2bf(acc[r]); }
        LDS_WAIT();
        float xr[16], xk[16], xv[16];
#pragma unroll
        for (int g = 0; g < 3; ++g) { float p[16], q[16], mm[16];
            unpack8(pw[g][0], *(float(*)[8])&p[0]); unpack8(pw[g][1], *(float(*)[8])&p[8]); ld16f(mu + g * 1024 + c0, mm);
            if (samp) {
#pragma unroll
                for (int j = 0; j < 16; ++j) q[j] = qs[g][j >> 2][j & 3]; }
            else { unpack8(qw[g][0], *(float(*)[8])&q[0]); unpack8(qw[g][1], *(float(*)[8])&q[8]);
                if (first) {
#pragma unroll
                    for (int j = 0; j < 16; ++j) q[j] = 0.f; } }
#pragma unroll
            for (int j = 0; j < 16; ++j) { const float x = p[j] + (q[j] - p[j]) * mm[j]; if (g == 0) xr[j] = x; else if (g == 1) xk[j] = x; else xv[j] = x; } }
        const size_t o = (size_t)m * 1024 + c0;
        st16b(rb + 3 * ARR + o, xr); st16b(rb + 4 * ARR + o, xv);
        float lw[16], la[16], lg[16];
        { const LAS bf16_t* lo = loraO + tok * 72 + c4 * 16;
          unpack8(*(const LAS u32x4*)(lo), *(float(*)[8])&lw[0]); unpack8(*(const LAS u32x4*)(lo + 8), *(float(*)[8])&lw[8]);
          unpack8(*(const LAS u32x4*)(lo + 16 * 72), *(float(*)[8])&la[0]); unpack8(*(const LAS u32x4*)(lo + 16 * 72 + 8), *(float(*)[8])&la[8]);
          unpack8(*(const LAS u32x4*)(lo + 32 * 72), *(float(*)[8])&lg[0]); unpack8(*(const LAS u32x4*)(lo + 32 * 72 + 8), *(float(*)[8])&lg[8]); }
        st16b(rb + 5 * ARR + o, lg);
        float pa[16], pb[16], kkr[16], av[16]; float ss = 0.f;
        ld16f(ctx_in(lds, I_KK) + l * 1024 + c0, pa); ld16f(ctx_in(lds, I_A0) + l * 1024 + c0, pb);
#pragma unroll
        for (int j = 0; j < 16; ++j) { kkr[j] = xk[j] * pa[j]; ss += kkr[j] * kkr[j]; av[j] = sigm(pb[j] + la[j]); }
        ss = quad_sum(ss);
        const float inv = 1.f / fmaxf(sqrtf(ss), 1e-12f);
#pragma unroll
        for (int j = 0; j < 16; ++j) { kkr[j] *= inv; pa[j] = kkr[j] * av[j]; }
        st16b(rb + 0 * ARR + o, kkr); st16b(rb + 1 * ARR + o, pa);
        ld16f(ctx_in(lds, I_KA) + l * 1024 + c0, pa); ld16f(ctx_in(lds, I_W0) + l * 1024 + c0, pb);
#pragma unroll
        for (int j = 0; j < 16; ++j) { pa[j] = xk[j] * (1.f + (av[j] - 1.f) * pa[j]);
            const float wp = -(pb[j] + lw[j]); const float sp = fmaxf(wp, 0.f) + __logf(1.f + __expf(-fabsf(wp))); pb[j] = __expf(-__expf(-sp - 0.5f)); }
        st16b(rb + 2 * ARR + o, pa); st16f(rw + o, pb);
        LDS_WAIT();
    }
}
__device__ __forceinline__ void pre_mlstm(LAS unsigned char* lds, int l, int cidx, int m0, int ntok) {
    const int tid = opaque_tid();
    const bf16_t* __restrict__ proj = (const bf16_t*)(ctx_ws(lds) + WS_PROJ);
    bf16_t* __restrict__ qm = (bf16_t*)(ctx_ws(lds) + WS_QM); bf16_t* __restrict__ km = (bf16_t*)(ctx_ws(lds) + WS_KM); float* __restrict__ gates = (float*)(ctx_ws(lds) + WS_GATES);
    const int cgp = tid & 255, th = tid >> 8, c0 = cgp * 8;
    float w0[8], w1[8], w2[8], w3[8], cb[8];
    ld8f(ctx_in(lds, I_CONVW) + (size_t)(l * 4 + 0) * 2048 + c0, w0); ld8f(ctx_in(lds, I_CONVW) + (size_t)(l * 4 + 1) * 2048 + c0, w1);
    ld8f(ctx_in(lds, I_CONVW) + (size_t)(l * 4 + 2) * 2048 + c0, w2); ld8f(ctx_in(lds, I_CONVW) + (size_t)(l * 4 + 3) * 2048 + c0, w3);
    ld8f(ctx_in(lds, I_CONVB) + (size_t)l * 2048 + c0, cb);
    bf16_t* dst = cgp < 128 ? qm + c0 : km + (c0 - 1024); const float sc = cgp < 128 ? 1.f : 0.0625f;
    if (cidx < 128) {
        float x3[8], x2[8], x1[8];
        const int t0 = th * 32, ts0 = (m0 & 2047) + t0;
#pragma unroll
        for (int j = 0; j < 8; ++j) { x3[j] = 0.f; x2[j] = 0.f; x1[j] = 0.f; }
        if (ts0 >= 3) { ld8b(proj + (size_t)(m0 + t0 - 3) * NINP + M0 + c0, x3); ld8b(proj + (size_t)(m0 + t0 - 2) * NINP + M0 + c0, x2); ld8b(proj + (size_t)(m0 + t0 - 1) * NINP + M0 + c0, x1); }
        const bool lastc = (cidx & 31) == 31; const int b = cidx >> 5;
#pragma unroll 1
        for (int tb = t0; tb < t0 + 32; tb += 8) {
            u32x4 xb[8];
#pragma unroll
            for (int i = 0; i < 8; ++i) xb[i] = *(const u32x4*)(proj + (size_t)(m0 + tb + i) * NINP + M0 + c0);
#pragma unroll
            for (int i = 0; i < 8; ++i) { const int m = m0 + tb + i; float x0[8], y[8]; unpack8(xb[i], x0);
#pragma unroll
                for (int j = 0; j < 8; ++j) { const float cv = cb[j] + w0[j] * x3[j] + w1[j] * x2[j] + w2[j] * x1[j] + w3[j] * x0[j]; y[j] = siluf(cv) * sc; x3[j] = x2[j]; x2[j] = x1[j]; x1[j] = x0[j]; }
                *(u32x4*)(dst + (size_t)m * 1024) = pack8(y);
                if (lastc && tb + i >= 61) st8f(ctx_out(lds) + O_PCONV + (size_t)((l * 4 + b) * 3 + (tb + i - 61)) * 2048 + c0, x0); }
        }
    } else {
#pragma unroll 1
        for (int tb = th * (ntok >> 1); tb < (th + 1) * (ntok >> 1); tb += 4) {
            u32x4 xb[4]; f32x4 sa[4][6];
#pragma unroll
            for (int i = 0; i < 4; ++i) { const int m = m0 + tb + i, s = m - MP; const float* __restrict__ cs = ctx_in(lds, I_SCONV) + (size_t)((l * 128 + s) * 3) * 2048 + c0;
                xb[i] = *(const u32x4*)(proj + (size_t)m * NINP + M0 + c0);
#pragma unroll
                for (int k = 0; k < 3; ++k) { sa[i][2 * k] = *(const f32x4*)(cs + k * 2048); sa[i][2 * k + 1] = *(const f32x4*)(cs + k * 2048 + 4); } }
#pragma unroll
            for (int i = 0; i < 4; ++i) { const int m = m0 + tb + i, s = m - MP; float x0[8], y[8]; unpack8(xb[i], x0);
#pragma unroll
                for (int j = 0; j < 8; ++j) { const float x3 = sa[i][0 + (j >> 2)][j & 3], x2 = sa[i][2 + (j >> 2)][j & 3], x1 = sa[i][4 + (j >> 2)][j & 3];
                    const float cv = cb[j] + w0[j] * x3 + w1[j] * x2 + w2[j] * x1 + w3[j] * x0[j]; y[j] = siluf(cv) * sc; }
                *(u32x4*)(dst + (size_t)m * 1024) = pack8(y);
                float* co = ctx_out(lds) + O_SCONV + (size_t)((l * 128 + s) * 3) * 2048 + c0;
                *(f32x4*)co = sa[i][2]; *(f32x4*)(co + 4) = sa[i][3]; *(f32x4*)(co + 2048) = sa[i][4]; *(f32x4*)(co + 2052) = sa[i][5]; st8f(co + 4096, x0); }
        }
    }
    if (tid < ntok * 4) { const int t = tid >> 2, hh = tid & 3, m = m0 + t;
        const float ip = bf2f(proj[(size_t)m * NINP + M0 + 3072 + hh]), fp = bf2f(proj[(size_t)m * NINP + M0 + 3076 + hh]);
        const float xf = fp + ctx_in(lds, I_FB)[l * 4 + hh];
        gates[(size_t)m * 8 + hh] = ip + ctx_in(lds, I_IB)[l * 4 + hh];
        gates[(size_t)m * 8 + 4 + hh] = fminf(xf, 0.f) - log1pf(__expf(-fabsf(xf))); }
}
__device__ __forceinline__ void pre_gla(LAS unsigned char* lds, int l, int cidx, int m0, int ntok) {
    const int tid = opaque_tid(), lane = tid & 63, wave = tid >> 6, lr = lane & 15, lq = lane >> 4;
    const bf16_t* __restrict__ proj = (const bf16_t*)(ctx_ws(lds) + WS_PROJ);
    bf16_t* __restrict__ gq = (bf16_t*)(ctx_ws(lds) + WS_GQ); bf16_t* __restrict__ gk = (bf16_t*)(ctx_ws(lds) + WS_GK); bf16_t* __restrict__ gkh = (bf16_t*)(ctx_ws(lds) + WS_GKH); float* __restrict__ egl = (float*)(ctx_ws(lds) + WS_EGL);
    const bf16_t* __restrict__ a2T = (const bf16_t*)(ctx_ws(lds) + WS_W + (size_t)l * LW_BYTES + LW_GA2);
    LAS float* bb = (LAS float*)lds;
    LAS bf16_t* xa = (LAS bf16_t*)(lds + 64 * 516 * 4);
    const bool samp = cidx >= 128;
    __syncthreads();
    for (int i = tid; i < ntok * 32; i += NTHREADS) { const int t = i >> 5, k = i & 31; xa[t * 40 + k] = k < 16 ? proj[(size_t)(m0 + t) * NINP + G0 + 2048 + k] : (bf16_t)0; }
    __syncthreads();
#pragma unroll
    for (int q = 0; q < 4; ++q) { const int tc = wave * 4 + q;
        const bf16x8 bv = *(const bf16x8*)(a2T + (size_t)(tc * 16 + lr) * 32 + lq * 8);
        const float ab = ctx_in(lds, I_GAB)[l * 512 + tc * 16 + lr];
#pragma unroll
        for (int tt = 0; tt < 4; ++tt) { if (tt * 16 >= ntok) break; const bf16x8 av = *(const LAS bf16x8*)(xa + (tt * 16 + lr) * 40 + lq * 8);
            f32x4 acc = {0.f, 0.f, 0.f, 0.f}; acc = MFMA16(av, bv, acc);
#pragma unroll
            for (int r = 0; r < 4; ++r) bb[(tt * 16 + lq * 4 + r) * 516 + tc * 16 + lr] = logsig_fast(acc[r] + ab) * 0.0625f; } }
    __syncthreads();
    if (!samp) { const int c = tid; float run = 0.f;
#pragma unroll 8
        for (int t = 0; t < 64; ++t) { run += bb[t * 516 + c]; bb[t * 516 + c] = run; }
        egl[(size_t)cidx * 512 + c] = __expf(run); }
    __syncthreads();
    const float scale = 0.08838834764831845f;
    for (int i = tid; i < ntok * 64; i += NTHREADS) { const int t = i >> 6, cg = i & 63, c = cg * 8; const size_t m = m0 + t;
        float q[8], k[8], b8[8], bl[8], oq[8], ok[8], oh[8];
        ld8b(proj + m * NINP + G0 + c, q); ld8b(proj + m * NINP + G0 + 512 + c, k);
#pragma unroll
        for (int j = 0; j < 8; ++j) { b8[j] = bb[t * 516 + c + j]; bl[j] = samp ? b8[j] : bb[63 * 516 + c + j]; }
#pragma unroll
        for (int j = 0; j < 8; ++j) { oq[j] = q[j] * __expf(b8[j]) * scale; ok[j] = k[j] * __expf(-b8[j]); oh[j] = k[j] * __expf(bl[j] - b8[j]); }
        *(u32x4*)(gq + m * 512 + c) = pack8(oq); *(u32x4*)(gk + m * 512 + c) = pack8(ok); *(u32x4*)(gkh + m * 512 + c) = pack8(oh);
        if (samp) { float e[8];
#pragma unroll
            for (int j = 0; j < 8; ++j) e[j] = __expf(b8[j]);
            st8f(egl + (size_t)(128 + (m - MP)) * 512 + c, e); } }
}
__device__ __forceinline__ void phase_pre(LAS unsigned char* lds, int l, int G) {
    { const int tid = opaque_tid(), wave = tid >> 6, lane = tid & 63;
      for (int it = blockIdx.x * 8 + wave; it < 2048 + G * 8; it += G * 8) {
          int cidx, tt, h0, nh;
          if (it < 2048) { cidx = it >> 4; tt = (it >> 2) & 3; h0 = (it & 3) * 4; nh = 4; }
          else { const int j = G * 8 - 1 - (it - 2048); if (j >= 128) continue; cidx = 128 + (j >> 6); tt = (j >> 4) & 3; h0 = j & 15; nh = 1; }
          pre_rwkv_item(lds, l, cidx, tt, h0, nh, wave, lane); } }
    for (int u = blockIdx.x; u < 272; u += G) {
        if (u < 128) pre_gla(lds, l, u, u * 64, 64);
        else if (u < 256) pre_mlstm(lds, l, u - 128, (u - 128) * 64, 64);
        else if (u < 264) pre_gla(lds, l, 128, MP + (u - 256) * 16, 16);
        else pre_mlstm(lds, l, 128, MP + (u - 264) * 16, 16);
    }
    {
        const bf16_t* __restrict__ proj = (const bf16_t*)(ctx_ws(lds) + WS_PROJ);
        for (int i = blockIdx.x * NTHREADS + opaque_tid(); i < 132 * (RC / 8); i += G * NTHREADS) { const int sq = i / (RC / 8), cg8 = i % (RC / 8); float p[8];
            const int m = sq < 4 ? sq * 2048 + 2047 : MP + (sq - 4);
            ld8b(proj + (size_t)m * NINP + cg8 * 8, p);
            st8f(ctx_out(lds) + (sq < 4 ? O_PSHIFT + (size_t)(l * 4 + sq) * RC : O_SSHIFT + (size_t)(l * 128 + (sq - 4)) * RC) + cg8 * 8, p); }
    }
}

__device__ __forceinline__ void scan_rwkv(LAS unsigned char* lds, int l, int u) {
    const int tid = opaque_tid(), bh = u >> 1, half = u & 1, b = bh >> 4, h = bh & 15;
    const int row2 = (tid >> 3) & 31, jg = tid & 7;
    const float* __restrict__ rpre = (const float*)(ctx_ws(lds) + WS_RPRE); bf16_t* __restrict__ rout = (bf16_t*)(ctx_ws(lds) + WS_ROUT);
    LAS float* stage = (LAS float*)lds;
    LAS float* obuf = (LAS float*)(lds + 64 * 352 * 4);
    f32x4 Sa = {0.f, 0.f, 0.f, 0.f}, Sb = {0.f, 0.f, 0.f, 0.f};
    const size_t mb = (size_t)b * 2048;
    const unsigned char* rbase = (const unsigned char*)rpre;
    unsigned off[7], inc[7]; int lo[7];
#pragma unroll
    for (int q = 0; q < 7; ++q) { int i = tid + 512 * q; i = i < 3328 ? i : 3327; const int tok = i / 52, j = i % 52;
        if (j < 32) { const int arr = j >> 3, pc = j & 7; off[q] = (unsigned)(arr * (int)ARR + tok * 1024 + h * 64 + pc * 8) * 2u; inc[q] = 64u * 1024u * 2u; lo[q] = tok * 352 + (arr == 0 ? 0 : arr == 1 ? 64 : arr == 2 ? 192 : 256) + pc * 8; }
        else if (j < 48) { const int pc = j - 32; off[q] = (unsigned)RP_W + (unsigned)(tok * 1024 + h * 64 + pc * 4) * 4u; inc[q] = 64u * 1024u * 4u; lo[q] = -(tok * 352 + 128 + pc * 4) - 1; }
        else { const int pc = j - 48; off[q] = (unsigned)(4 * (int)ARR + tok * 1024 + h * 64 + half * 32 + pc * 8) * 2u; inc[q] = 64u * 1024u * 2u; lo[q] = tok * 352 + 320 + pc * 8; } }
    u32x4 pf[7];
    const size_t cb0 = mb / 64;
#pragma unroll
    for (int q = 0; q < 7; ++q) pf[q] = *(const u32x4*)(rbase + off[q] + cb0 * inc[q]);
    __syncthreads();
    for (int ch = 0; ch < 32; ++ch) {
#pragma unroll
        for (int q = 0; q < 7; ++q) {
            if (lo[q] < 0) *(LAS u32x4*)(stage + (-lo[q] - 1)) = pf[q];
            else { float f[8]; unpack8(pf[q], f); *(LAS f32x4*)(stage + lo[q]) = (f32x4){f[0], f[1], f[2], f[3]}; *(LAS f32x4*)(stage + lo[q] + 4) = (f32x4){f[4], f[5], f[6], f[7]}; } }
        __syncthreads();
        { const size_t chn = cb0 + (ch + 1 < 32 ? ch + 1 : 31);
#pragma unroll
          for (int q = 0; q < 7; ++q) pf[q] = *(const u32x4*)(rbase + off[q] + chn * inc[q]); }
        if (tid < 256) {
        f32x4 B5[2][10]; float Bv[2];
#define RW_LD(slot, t) do { const LAS float* sp_ = stage + (t) * 352 + jg * 8; _Pragma("unroll") for (int v_ = 0; v_ < 5; ++v_) { B5[slot][2 * v_] = *(const LAS f32x4*)(sp_ + 64 * v_); B5[slot][2 * v_ + 1] = *(const LAS f32x4*)(sp_ + 64 * v_ + 4); } \
            Bv[slot] = stage[(t) * 352 + 320 + row2]; } while (0)
        RW_LD(0, 0);
        float os[8] = {0.f, 0.f, 0.f, 0.f, 0.f, 0.f, 0.f, 0.f};
        f32x4 q = {0.f, 0.f, 0.f, 0.f};
#define RW_OSUM(t) do { float o = (q.x + q.y) + (q.z + q.w); o = row8_sum(o); if (((t) & 7) == jg) os[(t) >> 3] = o; } while (0)
#pragma unroll
        for (int t = 0; t < 64; ++t) {
            if (t + 1 < 64) RW_LD((t + 1) & 1, t + 1);
            __builtin_amdgcn_sched_barrier(0);
            const int sl = t & 1; const float vv = Bv[sl];
            f32x4 p = Sa * B5[sl][0]; p = Sb * B5[sl][1] + p;
            float sa = (p.x + p.y) + (p.z + p.w);
            if (t > 0) RW_OSUM(t - 1);
            sa = row8_sum(sa);
            Sa = Sa * B5[sl][4] - sa * B5[sl][2] + vv * B5[sl][6];
            Sb = Sb * B5[sl][5] - sa * B5[sl][3] + vv * B5[sl][7];
            q = Sa * B5[sl][8]; q = Sb * B5[sl][9] + q;
        }
        RW_OSUM(63);
#undef RW_OSUM
#undef RW_LD
#pragma unroll
        for (int i = 0; i < 8; ++i) obuf[(i * 8 + jg) * 32 + row2] = os[i];
        }
        __syncthreads();
        for (int i = tid; i < 1024; i += NTHREADS) *(unsigned*)(rout + (mb + ch * 64 + (i >> 4)) * 1024 + h * 64 + half * 32 + (i & 15) * 2) = pk2(obuf[i * 2], obuf[i * 2 + 1]);
    }
    if (tid < 256) { float* sp = ctx_out(lds) + O_PWKV + ((size_t)((l * 4 + b) * 16 + h) * 64 + half * 32 + row2) * 64 + jg * 8; *(f32x4*)sp = Sa; *(f32x4*)(sp + 4) = Sb; }
    __syncthreads();
}
__device__ __forceinline__ void scan_mlstm(LAS unsigned char* lds, int l, int u) {
    const int tid = opaque_tid(), lane = tid & 63, wave = tid >> 6, lr = lane & 15, lq = lane >> 4;
    const int bh = u >> 2, sl = u & 3, b = bh >> 2, h = bh & 3;
    const bf16_t* __restrict__ proj = (const bf16_t*)(ctx_ws(lds) + WS_PROJ); const bf16_t* __restrict__ qm = (const bf16_t*)(ctx_ws(lds) + WS_QM); const bf16_t* __restrict__ km = (const bf16_t*)(ctx_ws(lds) + WS_KM);
    const float* __restrict__ gates = (const float*)(ctx_ws(lds) + WS_GATES); bf16_t* __restrict__ hm = (bf16_t*)(ctx_ws(lds) + WS_HM);
    LAS bf16_t* kS = (LAS bf16_t*)lds;
    LAS bf16_t* kwT = (LAS bf16_t*)(lds + 33792);
    LAS bf16_t* vT = (LAS bf16_t*)(lds + 33792 + 36864);
    LAS bf16_t* Sp = (LAS bf16_t*)(lds + 33792 + 36864 + 11520);
    LAS bf16_t* CT = (LAS bf16_t*)(lds + 33792 + 36864 + 11520 + 9216);
    LAS float* gF = (LAS float*)(lds + 33792 + 36864 + 11520 + 9216 + 42240);
    LAS float* gU = gF + 64; LAS float* gM = gF + 128; LAS float* gS = gF + 192; LAS float* gD = gF + 196;
    __syncthreads();
    for (int i = tid; i < 80 * 264 / 2; i += NTHREADS) ((LAS unsigned*)CT)[i] = 0u;
    for (int i = tid; i < 16 * 72; i += NTHREADS) vT[64 * 72 + i] = (i < 72) ? (bf16_t)0x3F80 : (bf16_t)0;
    f32x4 acc[2][5];
#pragma unroll
    for (int i = 0; i < 2; ++i)
#pragma unroll
        for (int j = 0; j < 5; ++j) acc[i][j] = (f32x4){0.f, 0.f, 0.f, 0.f};
    float m_prev = 0.f;
    const int tt = wave >> 1, wodd = wave & 1, s = tid & 63, eg = tid >> 6;
    const size_t mb = (size_t)b * 2048;
    u32x4 pv = *(const u32x4*)(proj + (mb + s) * NINP + M0 + 2048 + h * 256 + sl * 64 + eg * 8);
    u32x4 pk[4];
#pragma unroll
    for (int j = 0; j < 4; ++j) pk[j] = *(const u32x4*)(km + (mb + s) * 1024 + h * 256 + (eg + 8 * j) * 8);
    bf16x8 qf[8];
#pragma unroll
    for (int ks = 0; ks < 8; ++ks) qf[ks] = *(const bf16x8*)(qm + (mb + tt * 16 + lr) * 1024 + h * 256 + ks * 32 + lq * 8);
    float pig = gates[(mb + lane) * 8 + h], plf = gates[(mb + lane) * 8 + 4 + h];
    for (int c = 0; c < 32; ++c) {
        const size_t m0 = mb + c * 64;
        if (wave == 0) {
            float F = plf;
#pragma unroll
            for (int o = 1; o < 64; o <<= 1) { const float t = __shfl_up(F, o); if (lane >= o) F += t; }
            const float uu = pig - F; float am = uu;
#pragma unroll
            for (int o = 1; o < 64; o <<= 1) { const float t = __shfl_up(am, o); if (lane >= o) am = fmaxf(am, t); }
            const float Mt = fmaxf(m_prev, am);
            gF[lane] = F; gU[lane] = uu; gM[lane] = Mt;
            if (lane == 63) { gS[0] = __expf(m_prev - Mt); gS[1] = Mt; gS[2] = F + Mt; }
        }
        { vT[(eg * 8 + 0) * 72 + s] = (bf16_t)(pv.x & 0xffffu); vT[(eg * 8 + 1) * 72 + s] = (bf16_t)(pv.x >> 16); vT[(eg * 8 + 2) * 72 + s] = (bf16_t)(pv.y & 0xffffu); vT[(eg * 8 + 3) * 72 + s] = (bf16_t)(pv.y >> 16);
          vT[(eg * 8 + 4) * 72 + s] = (bf16_t)(pv.z & 0xffffu); vT[(eg * 8 + 5) * 72 + s] = (bf16_t)(pv.z >> 16); vT[(eg * 8 + 6) * 72 + s] = (bf16_t)(pv.w & 0xffffu); vT[(eg * 8 + 7) * 72 + s] = (bf16_t)(pv.w >> 16);
#pragma unroll
          for (int j = 0; j < 4; ++j) *(LAS u32x4*)(kS + s * 264 + (eg + 8 * j) * 8) = pk[j]; }
        __syncthreads();
        const float a_c = gS[0], ML = gS[1], m_new = gS[2];
        { const float ws = __expf(gU[s] - ML);
#pragma unroll
          for (int j = 0; j < 4; ++j) { const int d0 = (eg + 8 * j) * 8; float k[8]; unpack8(pk[j], k);
#pragma unroll
              for (int i = 0; i < 8; ++i) kwT[(d0 + i) * 72 + s] = f2bf(k[i] * ws); } }
        const size_t m1 = mb + (size_t)(c + 1 < 32 ? c + 1 : 31) * 64;
        pig = gates[(m1 + lane) * 8 + h]; plf = gates[(m1 + lane) * 8 + 4 + h];
        pv = *(const u32x4*)(proj + (m1 + s) * NINP + M0 + 2048 + h * 256 + sl * 64 + eg * 8);
#pragma unroll
        for (int j = 0; j < 4; ++j) pk[j] = *(const u32x4*)(km + (m1 + s) * 1024 + h * 256 + (eg + 8 * j) * 8);
#pragma unroll
        for (int q = 0; q < 2; ++q) { const int ts = 2 * wodd + q;
            f32x4 sacc = {0.f, 0.f, 0.f, 0.f};
            if (ts <= tt) {
#pragma unroll
                for (int ks = 0; ks < 8; ++ks) { const bf16x8 kf = *(const LAS bf16x8*)(kS + (ts * 16 + lr) * 264 + ks * 32 + lq * 8); sacc = MFMA16(qf[ks], kf, sacc); }
            }
            const int sc = ts * 16 + lr; const float us = gU[sc];
#pragma unroll
            for (int r = 0; r < 4; ++r) { const int t = tt * 16 + lq * 4 + r; const float v = (sc <= t) ? sacc[r] * __expf(us - gM[t]) : 0.f; Sp[t * 72 + sc] = f2bf(v); }
        }
        __syncthreads();
        f32x4 hn[3];
#pragma unroll
        for (int q = 0; q < 3; ++q) { const int te = wodd ? 3 + q : q; hn[q] = (f32x4){0.f, 0.f, 0.f, 0.f}; if (te < 5) {
            f32x4 aq = {0.f, 0.f, 0.f, 0.f}, as = {0.f, 0.f, 0.f, 0.f};
#pragma unroll
            for (int ks = 0; ks < 8; ++ks) { const bf16x8 cf = *(const LAS bf16x8*)(CT + (te * 16 + lr) * 264 + ks * 32 + lq * 8); aq = MFMA16(qf[ks], cf, aq); }
#pragma unroll
            for (int ks = 0; ks < 2; ++ks) { const bf16x8 sf = *(const LAS bf16x8*)(Sp + (tt * 16 + lr) * 72 + ks * 32 + lq * 8); const bf16x8 vf = *(const LAS bf16x8*)(vT + (te * 16 + lr) * 72 + ks * 32 + lq * 8); as = MFMA16(sf, vf, as); }
#pragma unroll
            for (int r = 0; r < 4; ++r) { const int t = tt * 16 + lq * 4 + r; hn[q][r] = __expf(m_prev - gM[t]) * aq[r] + as[r]; }
            if (te == 4 && lr == 0) {
#pragma unroll
                for (int r = 0; r < 4; ++r) gD[tt * 16 + lq * 4 + r] = hn[q][r]; }
        } }
#pragma unroll
        for (int ks = 0; ks < 8; ++ks) qf[ks] = *(const bf16x8*)(qm + (m1 + tt * 16 + lr) * 1024 + h * 256 + ks * 32 + lq * 8);
#pragma unroll
        for (int i = 0; i < 2; ++i) { const int dt = wave * 2 + i;
            bf16x8 kf[2];
#pragma unroll
            for (int ks = 0; ks < 2; ++ks) kf[ks] = *(const LAS bf16x8*)(kwT + (dt * 16 + lr) * 72 + ks * 32 + lq * 8);
#pragma unroll
            for (int et = 0; et < 5; ++et) { acc[i][et] = acc[i][et] * a_c;
#pragma unroll
                for (int ks = 0; ks < 2; ++ks) { const bf16x8 vf = *(const LAS bf16x8*)(vT + (et * 16 + lr) * 72 + ks * 32 + lq * 8); acc[i][et] = MFMA16(kf[ks], vf, acc[i][et]); } } }
        __syncthreads();
#pragma unroll
        for (int i = 0; i < 2; ++i) { const int dt = wave * 2 + i;
#pragma unroll
            for (int et = 0; et < 5; ++et) { u32x2 w; w.x = pk2(acc[i][et][0], acc[i][et][1]); w.y = pk2(acc[i][et][2], acc[i][et][3]);
                *(LAS u32x2*)(CT + (et * 16 + lr) * 264 + dt * 16 + lq * 4) = w; } }
        { float dd[4];
#pragma unroll
          for (int r = 0; r < 4; ++r) { const int t = tt * 16 + lq * 4 + r; dd[r] = 1.f / fmaxf(fabsf(gD[t]), __expf(-(gF[t] + gM[t]))); }
#pragma unroll
          for (int q = 0; q < 3; ++q) { const int te = wodd ? 3 + q : q; if (te < 4) {
#pragma unroll
              for (int r = 0; r < 4; ++r) hm[(m0 + tt * 16 + lq * 4 + r) * 1024 + h * 256 + sl * 64 + te * 16 + lr] = f2bf(hn[q][r] * dd[r]); } } }
        m_prev = m_new;
        __syncthreads();
    }
#pragma unroll
    for (int i = 0; i < 2; ++i) { const int dt = wave * 2 + i;
#pragma unroll
        for (int et = 0; et < 5; ++et)
#pragma unroll
            for (int r = 0; r < 4; ++r) { const int d = dt * 16 + lq * 4 + r;
                if (et < 4) ctx_out(lds)[O_PC + ((size_t)((l * 4 + b) * 4 + h) * 256 + d) * 256 + sl * 64 + et * 16 + lr] = acc[i][et][r];
                else if (sl == 0 && lr == 0) ctx_out(lds)[O_PN + (size_t)((l * 4 + b) * 4 + h) * 256 + d] = acc[i][et][r]; } }
    if (sl == 0 && tid == 0) ctx_out(lds)[O_PM + (l * 4 + b) * 4 + h] = m_prev;
    __syncthreads();
}
__device__ __forceinline__ void scan_gla(LAS unsigned char* lds, int l, int u) {
    const int tid = opaque_tid(), lane = tid & 63, wave = tid >> 6, lr = lane & 15, lq = lane >> 4;
    const int bh = u >> 2, sl = u & 3, b = bh >> 2, h = bh & 3;
    const bf16_t* __restrict__ proj = (const bf16_t*)(ctx_ws(lds) + WS_PROJ); const bf16_t* __restrict__ gq = (const bf16_t*)(ctx_ws(lds) + WS_GQ); const bf16_t* __restrict__ gk = (const bf16_t*)(ctx_ws(lds) + WS_GK); const bf16_t* __restrict__ gkh = (const bf16_t*)(ctx_ws(lds) + WS_GKH);
    const float* __restrict__ egl = (const float*)(ctx_ws(lds) + WS_EGL); bf16_t* __restrict__ og = (bf16_t*)(ctx_ws(lds) + WS_OG);
    LAS bf16_t* khT = (LAS bf16_t*)lds;
    LAS bf16_t* vT = (LAS bf16_t*)(lds + 18432);
    LAS bf16_t* Ap = (LAS bf16_t*)(lds + 18432 + 9216);
    LAS bf16_t* ST = (LAS bf16_t*)(lds + 36864);
    LAS bf16_t* kS = (LAS bf16_t*)(lds + 36864 + 17408);
    __syncthreads();
    for (int i = tid; i < 64 * 136 / 2; i += NTHREADS) ((LAS unsigned*)ST)[i] = 0u;
    f32x4 acc[4];
#pragma unroll
    for (int j = 0; j < 4; ++j) acc[j] = (f32x4){0.f, 0.f, 0.f, 0.f};
    const int tt = wave >> 1, wodd = wave & 1, s = tid & 63, eg = tid >> 6;
    const size_t mb = (size_t)b * 2048;
    u32x4 pv = *(const u32x4*)(proj + (mb + s) * NINP + G0 + 1024 + h * 256 + sl * 64 + eg * 8);
    u32x4 pkh[2], pgk[2];
#pragma unroll
    for (int j = 0; j < 2; ++j) { pkh[j] = *(const u32x4*)(gkh + (mb + s) * 512 + h * 128 + (eg + 8 * j) * 8); pgk[j] = *(const u32x4*)(gk + (mb + s) * 512 + h * 128 + (eg + 8 * j) * 8); }
    bf16x8 qf[4];
#pragma unroll
    for (int ks = 0; ks < 4; ++ks) qf[ks] = *(const bf16x8*)(gq + (mb + tt * 16 + lr) * 512 + h * 128 + ks * 32 + lq * 8);
    float eg4[4];
#pragma unroll
    for (int r = 0; r < 4; ++r) eg4[r] = egl[(size_t)(b * 32) * 512 + h * 128 + wave * 16 + lq * 4 + r];
    for (int c = 0; c < 32; ++c) {
        const int cidx = b * 32 + c; const size_t m0 = (size_t)cidx * 64;
        { vT[(eg * 8 + 0) * 72 + s] = (bf16_t)(pv.x & 0xffffu); vT[(eg * 8 + 1) * 72 + s] = (bf16_t)(pv.x >> 16); vT[(eg * 8 + 2) * 72 + s] = (bf16_t)(pv.y & 0xffffu); vT[(eg * 8 + 3) * 72 + s] = (bf16_t)(pv.y >> 16);
          vT[(eg * 8 + 4) * 72 + s] = (bf16_t)(pv.z & 0xffffu); vT[(eg * 8 + 5) * 72 + s] = (bf16_t)(pv.z >> 16); vT[(eg * 8 + 6) * 72 + s] = (bf16_t)(pv.w & 0xffffu); vT[(eg * 8 + 7) * 72 + s] = (bf16_t)(pv.w >> 16);
#pragma unroll
          for (int j = 0; j < 2; ++j) { const int d0 = (eg + 8 * j) * 8; const u32x4 w = pkh[j];
              khT[(d0 + 0) * 72 + s] = (bf16_t)(w.x & 0xffffu); khT[(d0 + 1) * 72 + s] = (bf16_t)(w.x >> 16); khT[(d0 + 2) * 72 + s] = (bf16_t)(w.y & 0xffffu); khT[(d0 + 3) * 72 + s] = (bf16_t)(w.y >> 16);
              khT[(d0 + 4) * 72 + s] = (bf16_t)(w.z & 0xffffu); khT[(d0 + 5) * 72 + s] = (bf16_t)(w.z >> 16); khT[(d0 + 6) * 72 + s] = (bf16_t)(w.w & 0xffffu); khT[(d0 + 7) * 72 + s] = (bf16_t)(w.w >> 16);
              *(LAS u32x4*)(kS + s * 136 + d0) = pgk[j]; } }
        __syncthreads();
        const float e0 = eg4[0], e1 = eg4[1], e2 = eg4[2], e3 = eg4[3];
        const int cn = c + 1 < 32 ? cidx + 1 : cidx; const size_t m1 = (size_t)cn * 64;
        pv = *(const u32x4*)(proj + (m1 + s) * NINP + G0 + 1024 + h * 256 + sl * 64 + eg * 8);
#pragma unroll
        for (int j = 0; j < 2; ++j) { pkh[j] = *(const u32x4*)(gkh + (m1 + s) * 512 + h * 128 + (eg + 8 * j) * 8); pgk[j] = *(const u32x4*)(gk + (m1 + s) * 512 + h * 128 + (eg + 8 * j) * 8); }
#pragma unroll
        for (int r = 0; r < 4; ++r) eg4[r] = egl[(size_t)cn * 512 + h * 128 + wave * 16 + lq * 4 + r];
#pragma unroll
        for (int q = 0; q < 2; ++q) { const int ts = 2 * wodd + q;
            f32x4 sacc = {0.f, 0.f, 0.f, 0.f};
            if (ts <= tt) {
#pragma unroll
                for (int ks = 0; ks < 4; ++ks) { const bf16x8 kf = *(const LAS bf16x8*)(kS + (ts * 16 + lr) * 136 + ks * 32 + lq * 8); sacc = MFMA16(qf[ks], kf, sacc); }
            }
            const int sc = ts * 16 + lr;
#pragma unroll
            for (int r = 0; r < 4; ++r) { const int t = tt * 16 + lq * 4 + r; Ap[t * 72 + sc] = f2bf((sc <= t) ? sacc[r] : 0.f); }
        }
        __syncthreads();
#pragma unroll
        for (int q = 0; q < 2; ++q) { const int te = 2 * wodd + q;
            f32x4 ao = {0.f, 0.f, 0.f, 0.f};
#pragma unroll
            for (int ks = 0; ks < 4; ++ks) { const bf16x8 sf = *(const LAS bf16x8*)(ST + (te * 16 + lr) * 136 + ks * 32 + lq * 8); ao = MFMA16(qf[ks], sf, ao); }
#pragma unroll
            for (int ks = 0; ks < 2; ++ks) { const bf16x8 af = *(const LAS bf16x8*)(Ap + (tt * 16 + lr) * 72 + ks * 32 + lq * 8); const bf16x8 vf = *(const LAS bf16x8*)(vT + (te * 16 + lr) * 72 + ks * 32 + lq * 8); ao = MFMA16(af, vf, ao); }
#pragma unroll
            for (int r = 0; r < 4; ++r) og[(m0 + tt * 16 + lq * 4 + r) * 1024 + h * 256 + sl * 64 + te * 16 + lr] = f2bf(ao[r]);
        }
#pragma unroll
        for (int ks = 0; ks < 4; ++ks) qf[ks] = *(const bf16x8*)(gq + (m1 + tt * 16 + lr) * 512 + h * 128 + ks * 32 + lq * 8);
        { const int dt = wave;
          bf16x8 kf[2];
#pragma unroll
          for (int ks = 0; ks < 2; ++ks) kf[ks] = *(const LAS bf16x8*)(khT + (dt * 16 + lr) * 72 + ks * 32 + lq * 8);
#pragma unroll
          for (int et = 0; et < 4; ++et) {
              acc[et][0] *= e0; acc[et][1] *= e1; acc[et][2] *= e2; acc[et][3] *= e3;
#pragma unroll
              for (int ks = 0; ks < 2; ++ks) { const bf16x8 vf = *(const LAS bf16x8*)(vT + (et * 16 + lr) * 72 + ks * 32 + lq * 8); acc[et] = MFMA16(kf[ks], vf, acc[et]); } } }
        __syncthreads();
#pragma unroll
        for (int et = 0; et < 4; ++et) { u32x2 w; w.x = pk2(acc[et][0], acc[et][1]); w.y = pk2(acc[et][2], acc[et][3]);
            *(LAS u32x2*)(ST + (et * 16 + lr) * 136 + wave * 16 + lq * 4) = w; }
        __syncthreads();
    }
#pragma unroll
    for (int et = 0; et < 4; ++et)
#pragma unroll
        for (int r = 0; r < 4; ++r) ctx_out(lds)[O_PGLA + ((size_t)((l * 4 + b) * 4 + h) * 128 + wave * 16 + lq * 4 + r) * 256 + sl * 64 + et * 16 + lr] = acc[et][r];
    __syncthreads();
}
__device__ __forceinline__ void samp_rwkv(LAS unsigned char* lds, int l, int u) {
    const int tid = opaque_tid(), s = u >> 1, hb = (u & 1) * 8 + (tid >> 8), row = (tid & 255) >> 2, kq = tid & 3;
    const float* __restrict__ rpre = (const float*)(ctx_ws(lds) + WS_RPRE); bf16_t* __restrict__ rout = (bf16_t*)(ctx_ws(lds) + WS_ROUT);
    const size_t m = MP + s;
    const float* __restrict__ sp = ctx_in(lds, I_SWKV);
    const bf16_t* rb = (const bf16_t*)rpre; const float* rw = (const float*)((const unsigned char*)rpre + RP_W);
    f32x4 S[4][4];
#pragma unroll
    for (int j = 0; j < 4; ++j) { const size_t so = ((size_t)((l * 128 + s) * 16 + hb + 2 * j) * 64 + row) * 64 + kq * 16;
#pragma unroll
        for (int k = 0; k < 4; ++k) S[j][k] = *(const f32x4*)(sp + so + k * 4); }
#pragma unroll
    for (int j = 0; j < 4; ++j) { const int h = hb + 2 * j; const size_t po = m * 1024 + h * 64 + kq * 16;
        const size_t so = ((size_t)((l * 128 + s) * 16 + h) * 64 + row) * 64 + kq * 16;
        f32x4 kk[4], bb[4], ww[4], k2[4], rr[4];
        { float t0[16], t1[16], t2[16], t3[16];
          ld16b(rb + po, t0); ld16b(rb + ARR + po, t1); ld16b(rb + 2 * ARR + po, t2); ld16b(rb + 3 * ARR + po, t3);
#pragma unroll
          for (int k = 0; k < 4; ++k) { ww[k] = *(const f32x4*)(rw + po + k * 4);
              kk[k] = (f32x4){t0[4 * k], t0[4 * k + 1], t0[4 * k + 2], t0[4 * k + 3]}; bb[k] = (f32x4){t1[4 * k], t1[4 * k + 1], t1[4 * k + 2], t1[4 * k + 3]};
              k2[k] = (f32x4){t2[4 * k], t2[4 * k + 1], t2[4 * k + 2], t2[4 * k + 3]}; rr[k] = (f32x4){t3[4 * k], t3[4 * k + 1], t3[4 * k + 2], t3[4 * k + 3]}; } }
        const float vv = bf2f(rb[4 * ARR + m * 1024 + h * 64 + row]);
        float sa = 0.f;
#pragma unroll
        for (int k = 0; k < 4; ++k) sa += (S[j][k].x * kk[k].x + S[j][k].y * kk[k].y) + (S[j][k].z * kk[k].z + S[j][k].w * kk[k].w);
        sa = quad_sum(sa);
        float o = 0.f;
#pragma unroll
        for (int k = 0; k < 4; ++k) { const f32x4 n4 = S[j][k] * ww[k] - sa * bb[k] + vv * k2[k]; o += (n4.x * rr[k].x + n4.y * rr[k].y) + (n4.z * rr[k].z + n4.w * rr[k].w);
            *(f32x4*)(ctx_out(lds) + O_SWKV + so + k * 4) = n4; }
        o = quad_sum(o);
        if (kq == 0) rout[m * 1024 + h * 64 + row] = f2bf(o);
    }
}
__device__ __forceinline__ float block_sum2(LAS float* red, float v, int tid) {
    v = wave_sum(v);
    __syncthreads();
    if ((tid & 63) == 0) red[tid >> 6] = v;
    __syncthreads();
    return ((red[0] + red[1]) + (red[2] + red[3])) + ((red[4] + red[5]) + (red[6] + red[7]));
}
__device__ __forceinline__ void samp_mlstm(LAS unsigned char* lds, int l, int u) {
    const int tid = opaque_tid(), s = u >> 2, h = u & 3;
    const bf16_t* __restrict__ proj = (const bf16_t*)(ctx_ws(lds) + WS_PROJ); const bf16_t* __restrict__ qm = (const bf16_t*)(ctx_ws(lds) + WS_QM); const bf16_t* __restrict__ km = (const bf16_t*)(ctx_ws(lds) + WS_KM);
    const float* __restrict__ gates = (const float*)(ctx_ws(lds) + WS_GATES); bf16_t* __restrict__ hm = (bf16_t*)(ctx_ws(lds) + WS_HM);
    LAS float* qs = (LAS float*)lds; LAS float* ks = qs + 256; LAS float* red = ks + 256; LAS float* rs = red + 8 * 256;
    const size_t m = MP + s; const size_t sb = (size_t)(l * 128 + s) * 4 + h;
    const int eg = tid & 63, dp = tid >> 6;
    const float* __restrict__ Cs = ctx_in(lds, I_SC) + sb * 65536 + eg * 4; float* Co = ctx_out(lds) + O_SC + sb * 65536 + eg * 4;
    f32x4 cb[32];
#pragma unroll
    for (int i = 0; i < 32; ++i) cb[i] = *(const f32x4*)(Cs + (size_t)(dp + 8 * i) * 256);
    __syncthreads();
    float pq = 0.f, pn = 0.f;
    if (tid < 256) { const float q = bf2f(qm[m * 1024 + h * 256 + tid]), k = bf2f(km[m * 1024 + h * 256 + tid]); qs[tid] = q; ks[tid] = k; pq = q * k; pn = q * ctx_in(lds, I_SN)[sb * 256 + tid]; }
    const float qk = block_sum2(rs, pq, tid);
    const float qn = block_sum2(rs + 8, pn, tid);
    const float ig = gates[m * 8 + h], lf = gates[m * 8 + 4 + h], m_prev = ctx_in(lds, I_SM)[sb];
    const float uu = ig - lf, Mx = fmaxf(m_prev, uu), m_t = lf + Mx, w_inter = __expf(m_prev - Mx), ws = __expf(uu - Mx), Sv = qk * ws;
    const u32x2 vw = *(const u32x2*)(proj + m * NINP + M0 + 2048 + h * 256 + eg * 4);
    const f32x4 v4 = {__uint_as_float(vw.x << 16), __uint_as_float(vw.x & 0xffff0000u), __uint_as_float(vw.y << 16), __uint_as_float(vw.y & 0xffff0000u)};
    f32x4 num = {0.f, 0.f, 0.f, 0.f};
#pragma unroll
    for (int i0 = 0; i0 < 32; i0 += 8)
        asm volatile("" : "+v"(cb[i0]), "+v"(cb[i0 + 1]), "+v"(cb[i0 + 2]), "+v"(cb[i0 + 3]), "+v"(cb[i0 + 4]), "+v"(cb[i0 + 5]), "+v"(cb[i0 + 6]), "+v"(cb[i0 + 7]));
#pragma unroll
    for (int i = 0; i < 32; ++i) { const int d = dp + 8 * i; const f32x4 c4 = cb[i];
        num = num + qs[d] * c4; *(f32x4*)(Co + (size_t)d * 256) = w_inter * c4 + (ws * ks[d]) * v4; }
    *(LAS f32x4*)(red + dp * 256 + eg * 4) = num;
    __syncthreads();
    if (tid < 256) {
        float nsum = 0.f;
#pragma unroll
        for (int j = 0; j < 8; ++j) nsum += red[j * 256 + tid];
        const float ve = bf2f(proj[m * NINP + M0 + 2048 + h * 256 + tid]);
        const float nm = w_inter * nsum + Sv * ve, den = w_inter * qn + Sv;
        hm[m * 1024 + h * 256 + tid] = f2bf(nm / fmaxf(fabsf(den), __expf(-m_t)));
        ctx_out(lds)[O_SN + sb * 256 + tid] = w_inter * ctx_in(lds, I_SN)[sb * 256 + tid] + ws * ks[tid];
        if (tid == 0) ctx_out(lds)[O_SM + sb] = m_t;
    }
}
__device__ __forceinline__ void samp_gla(LAS unsigned char* lds, int l, int u) {
    const int tid = opaque_tid(), s = u >> 2, h = u & 3;
    const bf16_t* __restrict__ proj = (const bf16_t*)(ctx_ws(lds) + WS_PROJ); const bf16_t* __restrict__ gq = (const bf16_t*)(ctx_ws(lds) + WS_GQ); const bf16_t* __restrict__ gk = (const bf16_t*)(ctx_ws(lds) + WS_GK); const bf16_t* __restrict__ gkh = (const bf16_t*)(ctx_ws(lds) + WS_GKH);
    const float* __restrict__ egl = (const float*)(ctx_ws(lds) + WS_EGL); bf16_t* __restrict__ og = (bf16_t*)(ctx_ws(lds) + WS_OG);
    LAS float* qs = (LAS float*)lds; LAS float* ks = qs + 128; LAS float* es = ks + 128; LAS float* red = es + 128; LAS float* rs = red + 8 * 256;
    const size_t m = MP + s; const size_t sb = (size_t)(l * 128 + s) * 4 + h;
    const int eg = tid & 63, dp = tid >> 6;
    const float* __restrict__ Ss = ctx_in(lds, I_SGLA) + sb * 32768 + eg * 4; float* So = ctx_out(lds) + O_SGLA + sb * 32768 + eg * 4;
    f32x4 st[16];
#pragma unroll
    for (int i = 0; i < 16; ++i) st[i] = *(const f32x4*)(Ss + (size_t)(dp + 8 * i) * 256);
    __syncthreads();
    float pa = 0.f;
    if (tid < 128) { const float q = bf2f(gq[m * 512 + h * 128 + tid]), k = bf2f(gk[m * 512 + h * 128 + tid]); qs[tid] = q; ks[tid] = bf2f(gkh[m * 512 + h * 128 + tid]); es[tid] = egl[(size_t)(128 + s) * 512 + h * 128 + tid]; pa = q * k; }
    const float A = block_sum2(rs, pa, tid);
    const u32x2 vw = *(const u32x2*)(proj + m * NINP + G0 + 1024 + h * 256 + eg * 4);
    const f32x4 v4 = {__uint_as_float(vw.x << 16), __uint_as_float(vw.x & 0xffff0000u), __uint_as_float(vw.y << 16), __uint_as_float(vw.y & 0xffff0000u)};
    f32x4 o4 = {0.f, 0.f, 0.f, 0.f};
    asm volatile("" : "+v"(st[0]), "+v"(st[1]), "+v"(st[2]), "+v"(st[3]), "+v"(st[4]), "+v"(st[5]), "+v"(st[6]), "+v"(st[7]));
    asm volatile("" : "+v"(st[8]), "+v"(st[9]), "+v"(st[10]), "+v"(st[11]), "+v"(st[12]), "+v"(st[13]), "+v"(st[14]), "+v"(st[15]));
#pragma unroll
    for (int i = 0; i < 16; ++i) { const int d = dp + 8 * i; const f32x4 s4 = st[i];
        o4 = o4 + qs[d] * s4; *(f32x4*)(So + (size_t)d * 256) = es[d] * s4 + ks[d] * v4; }
    *(LAS f32x4*)(red + dp * 256 + eg * 4) = o4;
    __syncthreads();
    if (tid < 256) { float osum = 0.f;
#pragma unroll
        for (int j = 0; j < 8; ++j) osum += red[j * 256 + tid];
        og[m * 1024 + h * 256 + tid] = f2bf(osum + A * bf2f(proj[m * NINP + G0 + 1024 + h * 256 + tid])); }
}
__device__ __forceinline__ void phase_scan(LAS unsigned char* lds, int l, int G, unsigned* queue, int rmask) {
    for (int u = blockIdx.x; u < 256; u += G) {
        const int slot = u >> 3, x = u & 7, role = slot & 3, s2 = slot >> 2;
        const int idx = role < 2 ? (s2 * 8 + x) : ((x * 2 + (s2 >> 2)) * 4 + (s2 & 3));
#ifndef SC_MASK
#define SC_MASK 63
#endif
        if (rmask && !((rmask >> (role < 2 ? 0 : role - 1)) & 1)) continue;
        if (role < 2) { if (SC_MASK & 1) scan_rwkv(lds, l, idx * 2 + role); }
        else if (role == 2) { if (SC_MASK & 2) scan_mlstm(lds, l, idx); }
        else { if (SC_MASK & 4) scan_gla(lds, l, idx); }
    }
    LAS unsigned* qw = (LAS unsigned*)(lds + 140000);
    __syncthreads();
    if (threadIdx.x == 0) *qw = __hip_atomic_fetch_add(queue, 1u, __ATOMIC_RELAXED, __HIP_MEMORY_SCOPE_AGENT);
    __syncthreads();
    unsigned u = *qw;
    while (u < 1280u) {
        unsigned nxt;
        if (threadIdx.x == 0) { unsigned z = 0u; asm volatile("" : "+v"(z));
            nxt = __hip_atomic_fetch_add(queue + z, 1u, __ATOMIC_RELAXED, __HIP_MEMORY_SCOPE_AGENT); }
        if (u < 512u) { if (SC_MASK & 16) samp_mlstm(lds, l, (int)u); }
        else if (u < 1024u) { if (SC_MASK & 32) samp_gla(lds, l, (int)u - 512); }
        else { if (SC_MASK & 8) samp_rwkv(lds, l, (int)u - 1024); }
        __syncthreads();
        if (threadIdx.x == 0) *qw = nxt;
        __syncthreads();
        u = *qw;
    }
}

__device__ __forceinline__ void ld16l(const LAS float* p, float (&f)[16]) {
#pragma unroll
    for (int k = 0; k < 4; ++k) { const f32x4 t = *(const LAS f32x4*)(p + 4 * k); f[4 * k] = t.x; f[4 * k + 1] = t.y; f[4 * k + 2] = t.z; f[4 * k + 3] = t.w; }
}
__device__ __forceinline__ void phase_post(LAS unsigned char* lds, int l, int G) {
    const int tid = opaque_tid(), lane = tid & 63, wave = tid >> 6, c0 = lane * 16;
    const bf16_t* __restrict__ proj = (const bf16_t*)(ctx_ws(lds) + WS_PROJ); const float* __restrict__ rpre = (const float*)(ctx_ws(lds) + WS_RPRE); const bf16_t* __restrict__ rout = (const bf16_t*)(ctx_ws(lds) + WS_ROUT);
    const bf16_t* __restrict__ hm = (const bf16_t*)(ctx_ws(lds) + WS_HM); const bf16_t* __restrict__ og = (const bf16_t*)(ctx_ws(lds) + WS_OG); bf16_t* __restrict__ obr = (bf16_t*)(ctx_ws(lds) + WS_QM);
    LAS float* pl = (LAS float*)lds;
    __syncthreads();
    for (int i = tid; i < 11264; i += NTHREADS) { float v;
        if (i < 1024) v = ctx_in(lds, I_RK)[l * 1024 + i]; else if (i < 2048) v = ctx_in(lds, I_LNG)[l * 1024 + i - 1024]; else if (i < 3072) v = ctx_in(lds, I_LNB)[l * 1024 + i - 2048];
        else if (i < 4096) v = ctx_in(lds, I_MNORM)[l * 1024 + i - 3072]; else if (i < 5120) v = ctx_in(lds, I_GNORM)[l * 1024 + i - 4096]; else v = ctx_in(lds, I_GATEB)[(size_t)l * 6144 + i - 5120];
        pl[i] = v; }
    __syncthreads();
    for (int it = blockIdx.x * 8 + wave; it < MP + 512; it += G * 8) {
        const int m = it < MP ? it : MP + ((it - MP) >> 2); const int part = it < MP ? -1 : (it - MP) & 3;
        const size_t o = (size_t)m * 1024 + c0;
        const bf16_t* prow = proj + (size_t)m * NINP;
        u32x4 L[30];
#define POST_LD(slot, ptr) do { L[slot] = *(const u32x4*)(ptr); L[(slot) + 1] = *(const u32x4*)((ptr) + 8); } while (0)
        if (part < 0 || part == 0) { POST_LD(0, rout + o); POST_LD(2, (const bf16_t*)rpre + 3 * ARR + o); POST_LD(4, (const bf16_t*)rpre + 2 * ARR + o); POST_LD(6, (const bf16_t*)rpre + 4 * ARR + o); POST_LD(8, (const bf16_t*)rpre + 5 * ARR + o); }
        if (part < 0 || part == 1) { POST_LD(10, hm + o); POST_LD(12, prow + M0 + 3080 + c0); }
        if (part < 0 || part == 2) { POST_LD(14, og + o); POST_LD(16, prow + G0 + 2064 + c0); }
        if (part < 0 || part == 3) {
#pragma unroll
            for (int q = 0; q < 2; ++q)
#pragma unroll
                for (int j = 0; j < 3; ++j) POST_LD(18 + (q * 3 + j) * 2, prow + GT0 + j * 2048 + q * 1024 + c0); }
#undef POST_LD
#define POST_UP(slot, arr) do { unpack8(L[slot], *(float(*)[8])&arr[0]); unpack8(L[(slot) + 1], *(float(*)[8])&arr[8]); } while (0)
        if (part < 0 || part == 0) {
            float x[16], r[16], k2[16], v[16], g[16], rk[16], lg[16], lb[16];
            POST_UP(0, x); POST_UP(2, r); POST_UP(4, k2); POST_UP(6, v); POST_UP(8, g);
            ld16l(pl + c0, rk); ld16l(pl + 1024 + c0, lg); ld16l(pl + 2048 + c0, lb);
            float s = 0.f, bs = 0.f;
#pragma unroll
            for (int j = 0; j < 16; ++j) { s += x[j]; bs += r[j] * k2[j] * rk[j]; }
            s += __shfl_xor(s, 1); s += __shfl_xor(s, 2); bs += __shfl_xor(bs, 1); bs += __shfl_xor(bs, 2);
            const float mean = s * (1.f / 64.f); float q = 0.f;
#pragma unroll
            for (int j = 0; j < 16; ++j) { const float d = x[j] - mean; q += d * d; }
            q += __shfl_xor(q, 1); q += __shfl_xor(q, 2);
            const float rstd = rsqrtf(q * (1.f / 64.f) + 64e-5f);
            float y[16];
#pragma unroll
            for (int j = 0; j < 16; ++j) y[j] = ((x[j] - mean) * rstd * lg[j] + lb[j] + bs * v[j]) * g[j];
            st16b(obr + (size_t)m * 3072 + c0, y);
        }
        if (part < 0 || part == 1) {
            float x[16], ng[16], go[16];
            POST_UP(10, x); POST_UP(12, go); ld16l(pl + 3072 + c0, ng);
            float q = 0.f;
#pragma unroll
            for (int j = 0; j < 16; ++j) q += x[j] * x[j];
            q += __shfl_xor(q, 1); q += __shfl_xor(q, 2); q += __shfl_xor(q, 4); q += __shfl_xor(q, 8);
            const float rs = rsqrtf(q * (1.f / 256.f) + 1e-6f);
            float y[16];
#pragma unroll
            for (int j = 0; j < 16; ++j) y[j] = x[j] * rs * ng[j] * sigm(go[j]);
            st16b(obr + (size_t)m * 3072 + 1024 + c0, y);
        }
        if (part < 0 || part == 2) {
            float x[16], ng[16], go[16];
            POST_UP(14, x); POST_UP(16, go); ld16l(pl + 4096 + c0, ng);
            float q = 0.f;
#pragma unroll
            for (int j = 0; j < 16; ++j) q += x[j] * x[j];
            q += __shfl_xor(q, 1); q += __shfl_xor(q, 2); q += __shfl_xor(q, 4); q += __shfl_xor(q, 8);
            const float rs = rsqrtf(q * (1.f / 256.f) + 1e-6f);
            float y[16];
#pragma unroll
            for (int j = 0; j < 16; ++j) y[j] = x[j] * rs * ng[j] * siluf(go[j]);
            st16b(obr + (size_t)m * 3072 + 2048 + c0, y);
        }
        if (part < 0 || part == 3) {
            bf16_t* __restrict__ gr = (bf16_t*)(ctx_ws(lds) + WS_RPRE + RP_GR) + (size_t)m * 6144; const float* __restrict__ gbv = ctx_in(lds, I_GATEB) + (size_t)l * 3 * 2048;
#pragma unroll
            for (int q = 0; q < 2; ++q) { const int d0 = q * 1024 + c0;
                float e0[16], e1[16], e2[16], gb[16];
                POST_UP(18 + (q * 3 + 0) * 2, e0); POST_UP(18 + (q * 3 + 1) * 2, e1); POST_UP(18 + (q * 3 + 2) * 2, e2);
                ld16l(pl + 5120 + d0, gb);
#pragma unroll
                for (int j = 0; j < 16; ++j) e0[j] = 1.f + __expf(-(e0[j] + gb[j]));
                ld16l(pl + 5120 + 2048 + d0, gb);
#pragma unroll
                for (int j = 0; j < 16; ++j) e1[j] = 1.f + __expf(-(e1[j] + gb[j]));
                ld16l(pl + 5120 + 4096 + d0, gb);
#pragma unroll
                for (int j = 0; j < 16; ++j) { e2[j] = 1.f + __expf(-(e2[j] + gb[j])); const float i0 = __builtin_amdgcn_rcpf(e0[j]), i1 = __builtin_amdgcn_rcpf(e1[j]), i2 = __builtin_amdgcn_rcpf(e2[j]);
                    e0[j] = e1[j] * i0; e1[j] = e2[j] * i1; e2[j] = i2; }
                st16b(gr + d0, e0); st16b(gr + 2048 + d0, e1); st16b(gr + 4096 + d0, e2); }
        }
#undef POST_UP
    }
}

template <int MODE>
__device__ __forceinline__ void skinny_phase(LAS unsigned char* lds, const bf16_t* A, int lda, const bf16_t* Bt, int ldb, int K, float* X, bf16_t* merged, const bf16_t* gr, const float* unused, int G) {
    const int tid = opaque_tid(), lane = tid & 63, wave = tid >> 6, lr = lane & 15, lq = lane >> 4, rt = wave & 3, kh = wave >> 2;
    LAS float* xch = (LAS float*)lds;
    for (int u = blockIdx.x; u < 256; u += G) {
        const int cg = u >> 1, rh = u & 1;
        const bf16_t* ap = A + (size_t)(MP + rh * 64 + rt * 16 + lr) * lda + lq * 8;
        const bf16_t* bp = Bt + (size_t)(cg * 16 + lr) * ldb + lq * 8;
        const int row0 = MP + rh * 64 + rt * 16 + lq * 4, col = cg * 16 + lr;
        constexpr int NJ = MODE == 0 ? 1 : 3;
        const int Kj = MODE == 0 ? K : 1024, Kh = Kj / 2;
        f32x4 acc[NJ];
#pragma unroll
        for (int j = 0; j < NJ; ++j) {
            f32x4 a0c = {0.f, 0.f, 0.f, 0.f}, a1c = {0.f, 0.f, 0.f, 0.f};
            const bf16_t* aj = ap + j * 1024 + kh * Kh; const bf16_t* bj = bp + j * 1024 + kh * Kh;
            bf16x8 av[8], bv[8], an[8], bn[8];
#pragma unroll
            for (int i = 0; i < 8; ++i) { av[i] = *(const bf16x8*)(aj + i * 32); bv[i] = *(const bf16x8*)(bj + i * 32); }
            for (int k0 = 0; k0 < Kh; k0 += 256) {
                const int kn = k0 + 256 < Kh ? k0 + 256 : k0;
#pragma unroll
                for (int i = 0; i < 8; ++i) { an[i] = *(const bf16x8*)(aj + kn + i * 32); bn[i] = *(const bf16x8*)(bj + kn + i * 32); }
#pragma unroll
                for (int i = 0; i < 8; i += 2) { a0c = MFMA16(av[i], bv[i], a0c); a1c = MFMA16(av[i + 1], bv[i + 1], a1c); }
#pragma unroll
                for (int i = 0; i < 8; ++i) { av[i] = an[i]; bv[i] = bn[i]; }
            }
            acc[j] = a0c + a1c;
        }
        __syncthreads();
        if (kh == 1) {
#pragma unroll
            for (int j = 0; j < NJ; ++j) *(LAS f32x4*)(xch + ((j * 4 + rt) * 64 + lane) * 4) = acc[j]; }
        __syncthreads();
        if (kh == 0) {
#pragma unroll
            for (int j = 0; j < NJ; ++j) acc[j] = acc[j] + *(const LAS f32x4*)(xch + ((j * 4 + rt) * 64 + lane) * 4);
            if (MODE == 0) {
                { float xo[4];
#pragma unroll
                  for (int r = 0; r < 4; ++r) xo[r] = X[(size_t)(row0 + r) * 2048 + col];
                  asm volatile("" : "+v"(xo[0]), "+v"(xo[1]), "+v"(xo[2]), "+v"(xo[3]));
#pragma unroll
                  for (int r = 0; r < 4; ++r) X[(size_t)(row0 + r) * 2048 + col] = xo[r] + acc[0][r]; }
            } else {
#pragma unroll
                for (int r = 0; r < 4; ++r) { float o = 0.f;
#pragma unroll
                    for (int j = 0; j < NJ; ++j) o = (o + acc[j][r]) * bf2f(gr[(size_t)(row0 + r) * 6144 + j * 2048 + col]);
                    merged[(size_t)(row0 + r) * 2048 + col] = f2bf(o); }
            }
        }
    }
}

constexpr int N_PHASES = 22;
constexpr int CW_BAR = 1024, CW_QUEUE = 8192;

__global__ void __launch_bounds__(NTHREADS, 2) fwd_kernel(Args a) {
    extern __shared__ __attribute__((aligned(16))) unsigned char lds_raw[];
    LAS unsigned char* lds = (LAS unsigned char*)lds_raw;
    const int tid = opaque_tid(), G = gridDim.x;
    volatile LAS unsigned* misc = (volatile LAS unsigned*)(lds + 147456 - 64);
    if (tid < 16) misc[tid] = 0u;
    if (tid < 39) ((LAS unsigned long long*)(lds + PTAB_OFF))[tid] = ((const unsigned long long*)&a)[tid];
    __syncthreads();
    unsigned* ctl = (unsigned*)(ctx_ws(lds) + WS_CTL);
    XcdBarrier bar; bar.bar = ctl + CW_BAR; bar.x = 0; bar.st = misc;
    if (MK_N_LAUNCHES == 1) bar = xcd_barrier_post(ctl + CW_BAR, misc);
    const int lo = a.ph_lo, hi = a.ph_hi & 0xff, rmask = (a.ph_hi >> 8) & 0xff;
#ifndef PH_MASK
#define PH_MASK 0xFFFu
#endif
#define PHM(b) ((PH_MASK >> (b)) & 1u)
#define IN(k) (lo <= (k) && (k) < hi)
#define SEAM(k) do { if (MK_N_LAUNCHES == 1 && IN(k) && IN((k) + 1)) xcd_barrier(bar); } while (0)
    if (PHM(0) && IN(0)) { phase_prologue(lds, opq(G)); SEAM(0); }
#pragma nounroll
    for (int l = 0; l < 2; ++l) {
        const int pb = 1 + 10 * l;
        if (PHM(1) && IN(pb + 0)) { phase_norm(lds, opq(G), ctx_in(lds, I_NORM1) + opq(l) * 2048, opq(l) == 0); SEAM(pb + 0); }
        if (PHM(2) && IN(pb + 1)) {
            pg8::Gemm g{(const bf16_t*)(ctx_ws(lds) + WS_H), (const bf16_t*)(ctx_ws(lds) + WS_W + (size_t)opq(l) * LW_BYTES + LW_WIN), MPAD, NINP, 2048, 2048, 2048};
            pg8::StaticOrder S; S.init(MPAD, NINP, opq(G), (int)blockIdx.x);
            pg8::EpiProj E{(bf16_t*)(ctx_ws(lds) + WS_PROJ), NINP};
            pg8::gemm_phase(lds, g, S, E);
            SEAM(pb + 1);
        }
        if (PHM(3) && IN(pb + 2)) { phase_pre(lds, opq(l), opq(G)); SEAM(pb + 2); }
        if (PHM(4) && IN(pb + 3)) { phase_scan(lds, opq(l), opq(G), (unsigned*)(ctx_ws(lds) + WS_CTL) + CW_QUEUE + 64 * opq(l), rmask); SEAM(pb + 3); }
        if (PHM(5) && IN(pb + 4)) { phase_post(lds, opq(l), opq(G)); SEAM(pb + 4); }
        if (PHM(6) && IN(pb + 5)) {
            pg8::StaticOrder S; S.init(MP, 2048, opq(G), (int)blockIdx.x);
            const bf16_t* obr = (const bf16_t*)(ctx_ws(lds) + WS_QM); const bf16_t* wbr = (const bf16_t*)(ctx_ws(lds) + WS_W + (size_t)opq(l) * LW_BYTES + LW_WBR);
            bf16_t* merged = (bf16_t*)(ctx_ws(lds) + WS_H); const bf16_t* gr = (const bf16_t*)(ctx_ws(lds) + WS_RPRE + RP_GR);
            { pg8::Gemm g{obr, wbr, MP, 2048, 3072, 3072, 3072}; pg8::EpiBranchK E{merged, gr}; pg8::gemm_phase(lds, g, S, E); }
            skinny_phase<1>(lds, obr, 3072, wbr, 3072, 3072, nullptr, merged, gr, nullptr, opq(G));
            SEAM(pb + 5);
        }
        if (PHM(7) && IN(pb + 6)) {
            pg8::Gemm g{(const bf16_t*)(ctx_ws(lds) + WS_H), (const bf16_t*)(ctx_ws(lds) + WS_W + (size_t)opq(l) * LW_BYTES + LW_WOUT), MP, 2048, 2048, 2048, 2048};
            pg8::StaticOrder S; S.init(MP, 2048, opq(G), (int)blockIdx.x);
            pg8::EpiResid E{(float*)(ctx_ws(lds) + WS_X), 2048};
            pg8::gemm_phase(lds, g, S, E);
            skinny_phase<0>(lds, g.A, 2048, g.Bt, 2048, 2048, (float*)(ctx_ws(lds) + WS_X), nullptr, nullptr, nullptr, opq(G));
            SEAM(pb + 6);
        }
        if (PHM(8) && IN(pb + 7)) { phase_norm(lds, opq(G), ctx_in(lds, I_NORM2) + opq(l) * 2048, false); SEAM(pb + 7); }
        if (PHM(9) && IN(pb + 8)) {
            pg8::Gemm g{(const bf16_t*)(ctx_ws(lds) + WS_H), (const bf16_t*)(ctx_ws(lds) + WS_W + (size_t)opq(l) * LW_BYTES + LW_WGU), MPAD, 11264, 2048, 2048, 2048};
            pg8::StaticOrder S; S.init(MPAD, 11264, opq(G), (int)blockIdx.x);
            pg8::EpiSwiGLU E{(bf16_t*)(ctx_ws(lds) + WS_PROJ), DFF};
            pg8::gemm_phase(lds, g, S, E);
            SEAM(pb + 8);
        }
        if (PHM(10) && IN(pb + 9)) {
            pg8::Gemm g{(const bf16_t*)(ctx_ws(lds) + WS_PROJ), (const bf16_t*)(ctx_ws(lds) + WS_W + (size_t)opq(l) * LW_BYTES + LW_WDN), MP, 2048, DFF, DFF, DFF};
            pg8::StaticOrder S; S.init(MP, 2048, opq(G), (int)blockIdx.x);
            pg8::EpiResid E{(float*)(ctx_ws(lds) + WS_X), 2048};
            pg8::gemm_phase(lds, g, S, E);
            skinny_phase<0>(lds, g.A, DFF, g.Bt, DFF, DFF, (float*)(ctx_ws(lds) + WS_X), nullptr, nullptr, nullptr, opq(G));
            SEAM(pb + 9);
        }
    }
    if (PHM(11) && IN(21)) phase_final(lds, opq(G));
    if (IN(22)) phase_dump(lds, G);
#undef IN
#undef SEAM
}

extern "C" void kernel_launch(void* const* d_in, const int* in_sizes, int n_in, void* d_out, int out_size, void* d_ws, size_t ws_size, hipStream_t stream) {
    static int grid = 0;
    if (grid == 0) {
        if (n_in != 37 || ws_size < WS_END) { fprintf(stderr, "kernel_launch: expected 37 inputs and >= %zu bytes of workspace; got %d, %zu\n", (size_t)WS_END, n_in, ws_size); grid = -1; return; }
        int dev = 0, cus = 0, per_cu = 0;
        if (hipGetDevice(&dev) != hipSuccess || hipDeviceGetAttribute(&cus, hipDeviceAttributeMultiprocessorCount, dev) != hipSuccess) { grid = -1; return; }
        if (hipFuncSetAttribute((const void*)fwd_kernel, hipFuncAttributeMaxDynamicSharedMemorySize, LDS_BYTES) != hipSuccess) { fprintf(stderr, "kernel_launch: hipFuncSetAttribute failed\n"); grid = -1; return; }
        if (hipOccupancyMaxActiveBlocksPerMultiprocessor(&per_cu, (const void*)fwd_kernel, NTHREADS, LDS_BYTES) != hipSuccess || per_cu < 1) { fprintf(stderr, "kernel_launch: occupancy query says %d\n", per_cu); }
        (void)hipGetLastError();
        grid = cus;
    }
    if (grid < 0) return;
    (void)hipMemsetAsync((char*)d_ws + WS_CTL, 0, CTL_BYTES, stream);
    Args a{};
    for (int i = 0; i < 37; ++i) a.in[i] = (const float*)d_in[i];
    a.out = (float*)d_out; a.ws = (unsigned char*)d_ws;
    if (MK_N_LAUNCHES == 1) { a.ph_lo = 0; a.ph_hi = N_PHASES; hipLaunchKernelGGL(fwd_kernel, dim3(grid), dim3(NTHREADS), LDS_BYTES, stream, a); }
    else { for (int p = 0; p < DBG_LIM; ++p) { a.ph_lo = p; a.ph_hi = p + 1; hipLaunchKernelGGL(fwd_kernel, dim3(grid), dim3(NTHREADS), LDS_BYTES, stream, a);
            const int kind = p == 0 ? 0 : (p == 21 ? 11 : 1 + (p - 1) % 10);
            if ((DBG_REP_MASK >> kind) & 1) { a.ph_hi = (p + 1) | (DBG_ROLE_MASK << 8); hipLaunchKernelGGL(fwd_kernel, dim3(grid), dim3(NTHREADS), LDS_BYTES, stream, a); } }
        if (DBG_LIM < 22) { a.ph_lo = 22; a.ph_hi = 23; hipLaunchKernelGGL(fwd_kernel, dim3(grid), dim3(NTHREADS), LDS_BYTES, stream, a); } }
}
```

```cpp
#include <hip/hip_runtime.h>
#include <cstdio>
#include <cstdint>

#ifndef MK_N_LAUNCHES
#define MK_N_LAUNCHES 1
#endif

#ifndef DBG_LIM
#define DBG_LIM 22
#ifndef DBG_ROLE_MASK
#define DBG_ROLE_MASK 0
#endif
#ifndef DBG_REP_MASK
#define DBG_REP_MASK 0
#endif
#define DBG_SEL 2
#endif
#define LAS __attribute__((address_space(3)))
typedef unsigned short bf16_t;
typedef short bf16x8 __attribute__((ext_vector_type(8)));
typedef float f32x4 __attribute__((ext_vector_type(4)));
typedef unsigned u32x4 __attribute__((ext_vector_type(4)));
typedef unsigned u32x2 __attribute__((ext_vector_type(2)));

constexpr int DM = 2048, MP = 8192, MT = 8320, MPAD = 8448, NINP = 16640, NIN = 16600;
constexpr int RC = 3264, M0 = 3264, G0 = 7368, GT0 = 10456, DFF = 5632;
constexpr int NTHREADS = 512;
constexpr size_t O_YP = 0, O_YS = 16777216, O_PSHIFT = 17039360, O_PWKV = 17065472, O_PCONV = 17589760, O_PC = 17638912, O_PN = 19736064, O_PM = 19744256,
                 O_PGLA = 19744288, O_SSHIFT = 20792864, O_SWKV = 21628448, O_SCONV = 38405664, O_SC = 39978528, O_SN = 107087392, O_SM = 107349536, O_SGLA = 107350560;
constexpr size_t AL(size_t x) { return (x + 255) & ~(size_t)255; }
constexpr size_t WS_CTL = 0, CTL_BYTES = 1u << 20;
constexpr size_t LW_WIN = 0, LW_WBR = LW_WIN + (size_t)NINP * 2048 * 2, LW_WOUT = LW_WBR + (size_t)3 * 2048 * 1024 * 2, LW_WGU = LW_WOUT + (size_t)2048 * 2048 * 2,
                 LW_WDN = LW_WGU + (size_t)11264 * 2048 * 2, LW_LORA = LW_WDN + (size_t)2048 * 5632 * 2, LW_GA2 = LW_LORA + (size_t)3 * 1024 * 64 * 2, LW_BYTES = LW_GA2 + (size_t)512 * 32 * 2;
constexpr size_t WS_W = CTL_BYTES;
constexpr size_t WS_X = AL(WS_W + 2 * LW_BYTES);
constexpr size_t WS_H = AL(WS_X + (size_t)MPAD * 2048 * 4);
constexpr size_t WS_PROJ = AL(WS_H + (size_t)MPAD * 2048 * 2);
constexpr size_t ARR = (size_t)MT * 1024;
constexpr size_t WS_RPRE = AL(WS_PROJ + (size_t)MPAD * NINP * 2);
constexpr size_t WS_ROUT = AL(WS_RPRE + 7 * ARR * 4);
constexpr size_t WS_QM = AL(WS_ROUT + ARR * 4);
constexpr size_t WS_KM = WS_QM + ARR * 2, WS_GQ = WS_KM + ARR * 2, WS_GK = WS_GQ + ARR, WS_GKH = WS_GK + ARR;
constexpr size_t WS_GATES = AL(WS_GKH + ARR);
constexpr size_t WS_EGL = AL(WS_GATES + (size_t)MT * 8 * 4);
constexpr size_t WS_HM = AL(WS_EGL + (size_t)256 * 512 * 4);
constexpr size_t WS_OG = AL(WS_HM + ARR * 4);
constexpr size_t WS_END = AL(WS_OG + ARR * 4);
static_assert((size_t)MPAD * 3072 * 2 <= WS_GATES - WS_QM, "obr alias");
static_assert((size_t)MPAD * 2048 * 4 <= 7 * ARR * 4, "macc alias");

__device__ __forceinline__ float bf2f(bf16_t b) { return __uint_as_float(((unsigned)b) << 16); }
typedef __bf16 bf16x2_t __attribute__((ext_vector_type(2)));
typedef float f32x2_t __attribute__((ext_vector_type(2)));
__device__ __forceinline__ unsigned pk2(float lo, float hi) { const f32x2_t v = {lo, hi}; return __builtin_bit_cast(unsigned, __builtin_convertvector(v, bf16x2_t)); }
__device__ __forceinline__ bf16_t f2bf(float f) { return (bf16_t)(pk2(f, 0.f) & 0xffffu); }
__device__ __forceinline__ void unpack8(const u32x4 w, float (&f)[8]) {
    f[0] = __uint_as_float(w.x << 16); f[1] = __uint_as_float(w.x & 0xffff0000u); f[2] = __uint_as_float(w.y << 16); f[3] = __uint_as_float(w.y & 0xffff0000u);
    f[4] = __uint_as_float(w.z << 16); f[5] = __uint_as_float(w.z & 0xffff0000u); f[6] = __uint_as_float(w.w << 16); f[7] = __uint_as_float(w.w & 0xffff0000u);
}
__device__ __forceinline__ u32x4 pack8(const float (&f)[8]) { u32x4 w; w.x = pk2(f[0], f[1]); w.y = pk2(f[2], f[3]); w.z = pk2(f[4], f[5]); w.w = pk2(f[6], f[7]); return w; }
__device__ __forceinline__ void ld8f(const float* p, float (&f)[8]) { const f32x4 a = *(const f32x4*)p, b = *(const f32x4*)(p + 4); f[0] = a.x; f[1] = a.y; f[2] = a.z; f[3] = a.w; f[4] = b.x; f[5] = b.y; f[6] = b.z; f[7] = b.w; }
__device__ __forceinline__ void st8f(float* p, const float (&f)[8]) { *(f32x4*)p = (f32x4){f[0], f[1], f[2], f[3]}; *(f32x4*)(p + 4) = (f32x4){f[4], f[5], f[6], f[7]}; }
__device__ __forceinline__ void ld8b(const bf16_t* p, float (&f)[8]) { unpack8(*(const u32x4*)p, f); }
__device__ __forceinline__ float sigm(float x) { return 1.f / (1.f + __expf(-x)); }
__device__ __forceinline__ float siluf(float x) { return x / (1.f + __expf(-x)); }
__device__ __forceinline__ float tanh_fast(float x) { const float e = __expf(2.f * x); return 1.f - 2.f / (e + 1.f); }
__device__ __forceinline__ float logsig_fast(float x) { return fminf(x, 0.f) - __logf(1.f + __expf(-fabsf(x))); }
__device__ __forceinline__ float wave_sum(float v) {
#pragma unroll
    for (int o = 1; o < 64; o <<= 1) v += __shfl_xor(v, o);
    return v;
}
template <int CTRL> __device__ __forceinline__ float dppf(float v) { return __int_as_float(__builtin_amdgcn_update_dpp(0, __float_as_int(v), CTRL, 0xF, 0xF, true)); }
__device__ __forceinline__ float row16_sum(float x) { x += dppf<0xB1>(x); x += dppf<0x4E>(x); x += dppf<0x141>(x); x += dppf<0x140>(x); return x; }
__device__ __forceinline__ float row8_sum(float x) { x += dppf<0xB1>(x); x += dppf<0x4E>(x); x += dppf<0x141>(x); return x; }
__device__ __forceinline__ float quad_sum(float x) { x += dppf<0xB1>(x); x += dppf<0x4E>(x); return x; }
__device__ __forceinline__ int opq(int x) { asm volatile("" : "+s"(x)); return x; }
__device__ __forceinline__ int opaque_tid() { int t = threadIdx.x; asm volatile("" : "+v"(t)); return t; }
__device__ __forceinline__ f32x4 mfma16_safe(const bf16x8 a, const bf16x8 b, const f32x4 c) { f32x4 d = __builtin_amdgcn_mfma_f32_16x16x32_bf16(a, b, c, 0, 0, 0); asm volatile("" : "+v"(d) : "v"(a), "v"(b)); return d; }
#define MFMA16(a, b, c) mfma16_safe((a), (b), (c))
#define LDS_WAIT() asm volatile("s_waitcnt lgkmcnt(0)" ::: "memory")

#define XB_TMO      128
#define XB_XCNT(j)  (256  + 64 * (j))
#define XB_XSUB(j)  (1280 + 64 * (j))
#define XB_XGEN(j)  (2304 + 64 * (j))
#define XB_TOP      3328
#define XB_TOPGEN   3392
#define XCD_BAR_WORDS 3456
#define XB_SPIN_CAP (1u << 18)
__device__ __forceinline__ unsigned xb_ld(unsigned* p)              { return __hip_atomic_load(p, __ATOMIC_RELAXED, __HIP_MEMORY_SCOPE_AGENT); }
__device__ __forceinline__ unsigned xb_add(unsigned* p, unsigned v) { return __hip_atomic_fetch_add(p, v, __ATOMIC_RELAXED, __HIP_MEMORY_SCOPE_AGENT); }
__device__ __forceinline__ unsigned xb_xcc_id() { return (unsigned)__builtin_amdgcn_s_getreg((3 << 11) | 20) & 0xFu; }
#define XB_SPIN(cond, bar) do { unsigned _sp = 0; while (cond) { __builtin_amdgcn_s_sleep(1); \
    if ((++_sp & 255u) == 0u) { if (xb_ld(&(bar)[XB_TMO])) break; if (_sp > XB_SPIN_CAP) { atomicAdd(&(bar)[XB_TMO], 1u); break; } } } } while (0)
struct XcdBarrier { unsigned* bar; unsigned x; volatile LAS unsigned* st; };
__device__ __forceinline__ XcdBarrier xcd_barrier_post(unsigned* bar, volatile LAS unsigned* st) {
    XcdBarrier b; b.bar = bar; b.x = xb_xcc_id(); b.st = st;
    if (threadIdx.x == 0) (void)xb_add(&bar[XB_XCNT(b.x)], 1u);
    return b;
}
__device__ __forceinline__ void xcd_barrier_complete(unsigned* bar, unsigned x, unsigned& nloc, unsigned& nx) {
    const unsigned G = gridDim.x * gridDim.y * gridDim.z;
    unsigned sum, cnt, mine, sp = 0u;
    for (;;) {
        sum = 0u; cnt = 0u; mine = 0u;
#pragma unroll
        for (unsigned j = 0; j < 16; ++j) { const unsigned c = xb_ld(&bar[XB_XCNT(j)]); sum += c; cnt += (c > 0u) ? 1u : 0u; mine = (j == x) ? c : mine; }
        if (sum == G) break;
        __builtin_amdgcn_s_sleep(1);
        if ((++sp & 255u) == 0u) { if (xb_ld(&bar[XB_TMO])) break; if (sp > XB_SPIN_CAP) { atomicAdd(&bar[XB_TMO], 1u); break; } }
    }
    nloc = mine > 0u ? mine : 1u; nx = cnt > 0u ? cnt : 1u;
}
__device__ __forceinline__ void xcd_barrier(const XcdBarrier& b) {
    asm volatile("s_waitcnt vmcnt(0)" ::: "memory");
    __syncthreads();
    if (threadIdx.x == 0) {
        unsigned* bar = b.bar;
        __builtin_amdgcn_s_waitcnt(0);
        unsigned nloc = b.st[0], nx = b.st[1];
        if (nloc == 0u) { xcd_barrier_complete(bar, b.x, nloc, nx); b.st[0] = nloc; b.st[1] = nx; }
        const unsigned old = xb_add(&bar[XB_XSUB(b.x)], 1u);
        const unsigned gen = old / nloc;
        if (old + 1u == (gen + 1u) * nloc) {
            __builtin_amdgcn_fence(__ATOMIC_RELEASE, "agent");
            asm volatile("s_waitcnt vmcnt(0)" ::: "memory");
            const unsigned og = xb_add(&bar[XB_TOP], 1u);
            const unsigned tg = og / nx;
            if (og + 1u == (tg + 1u) * nx) xb_add(&bar[XB_TOPGEN], 1u);
            else XB_SPIN(xb_ld(&bar[XB_TOPGEN]) == tg, bar);
            __builtin_amdgcn_fence(__ATOMIC_ACQUIRE, "agent");
            xb_add(&bar[XB_XGEN(b.x)], 1u);
            asm volatile("s_waitcnt vmcnt(0)" ::: "memory");
        } else {
            XB_SPIN(xb_ld(&bar[XB_XGEN(b.x)]) == gen, bar);
            __builtin_amdgcn_fence(__ATOMIC_ACQUIRE, "agent");
            asm volatile("s_waitcnt vmcnt(0)" ::: "memory");
        }
    }
    __syncthreads();
}

namespace pg8 {
constexpr int BM = 256, BK = 64, HALF = 128, HTB = HALF * BK * 2, STAGE_BYTES = 8 * HTB, NXCD = 8, WGM = 8;
__host__ __device__ __forceinline__ int lds_byte(int r, int c) { const int st = (r >> 4) * 2 + (c >> 5), rr = r & 15, cc = c & 31, ob = rr * 64 + cc * 2; return st * 1024 + (ob ^ (((ob >> 9) & 1) << 5)); }
__host__ __device__ __forceinline__ void stage_rc(int b, int& R, int& C) { const int st = b / 1024, sb = b % 1024, swz = sb ^ (((sb >> 9) & 1) << 5); R = (st >> 1) * 16 + swz / 64; C = (st & 1) * 32 + (swz % 64) / 2; }
__host__ __device__ __forceinline__ int perm32(int rho) { const int n = rho >> 4, i = rho & 15; return 8 * (i >> 2) + 4 * n + (i & 3); }
struct Unit { int pm, pn; };
struct Gemm { const bf16_t* A; const bf16_t* Bt; int M, N, K, lda, ldb; };
struct StaticOrder {
    int nM, nN, nwg, G, c;
    __device__ void init(int M, int N, int G_, int c_) { nM = M / BM; nN = N / BM; nwg = nM * nN; G = G_; c = c_; }
    __device__ bool next(int i, Unit& u) const {
        const long L = (long)i * G + c; if (L >= nwg) return false;
        int wgid = (int)L; { const int q = nwg / NXCD, r = nwg % NXCD, xcd = wgid % NXCD, off = wgid / NXCD; wgid = (xcd < r ? xcd * (q + 1) : r * (q + 1) + (xcd - r) * q) + off; }
        const int nig = WGM * nN, gid = wgid / nig, fm = gid * WGM, gsz = (nM - fm) < WGM ? (nM - fm) : WGM;
        u.pm = fm + ((wgid % nig) % gsz); u.pn = (wgid % nig) / gsz; return true;
    }
};
struct EpiProj {
    static constexpr bool PERM = true, HOOK = false;
    bf16_t* O; int ldc;
    __device__ __forceinline__ void operator()(const f32x4 (&acc)[2][2][4][2], const Unit& u, int wr, int wc, int fr, int fq) const {
        const int row0 = u.pm * BM + wr * 64 + fr, col0 = u.pn * BM + wc * 32 + 8 * fq;
#pragma unroll
        for (int ai = 0; ai < 2; ++ai)
#pragma unroll
            for (int m = 0; m < 4; ++m) { bf16_t* rowp = O + (size_t)(row0 + ai * HALF + m * 16) * ldc + col0;
#pragma unroll
                for (int bj = 0; bj < 2; ++bj) { const f32x4 v0 = acc[ai][bj][m][0], v1 = acc[ai][bj][m][1];
                    u32x4 w; w.x = pk2(v0[0], v0[1]); w.y = pk2(v0[2], v0[3]); w.z = pk2(v1[0], v1[1]); w.w = pk2(v1[2], v1[3]);
                    *(u32x4*)(rowp + bj * HALF) = w; } }
    }
};
struct EpiSwiGLU {
    static constexpr bool PERM = true, HOOK = false;
    bf16_t* O; int ldc;
    __device__ __forceinline__ void operator()(const f32x4 (&acc)[2][2][4][2], const Unit& u, int wr, int wc, int fr, int fq) const {
        const int row0 = u.pm * BM + wr * 64 + fr, col0 = u.pn * HALF + wc * 32 + 8 * fq;
#pragma unroll
        for (int ai = 0; ai < 2; ++ai)
#pragma unroll
            for (int m = 0; m < 4; ++m) { bf16_t* rowp = O + (size_t)(row0 + ai * HALF + m * 16) * ldc + col0;
                float o[8];
#pragma unroll
                for (int n = 0; n < 2; ++n)
#pragma unroll
                    for (int j = 0; j < 4; ++j) o[n * 4 + j] = siluf(acc[ai][0][m][n][j]) * acc[ai][1][m][n][j];
                *(u32x4*)rowp = pack8(o); }
    }
};
struct EpiResid {
    static constexpr bool PERM = false, HOOK = false;
    float* X; int ldc;
    __device__ __forceinline__ void operator()(const f32x4 (&acc)[2][2][4][2], const Unit& u, int wr, int wc, int fr, int fq) const {
        const int row0 = u.pm * BM + wr * 64 + fr, col0 = u.pn * BM + wc * 32 + 4 * fq;
#pragma unroll
        for (int ai = 0; ai < 2; ++ai) {
            f32x4 xv[4][2][2];
#pragma unroll
            for (int m = 0; m < 4; ++m)
#pragma unroll
                for (int bj = 0; bj < 2; ++bj)
#pragma unroll
                    for (int n = 0; n < 2; ++n) xv[m][bj][n] = *(const f32x4*)(X + (size_t)(row0 + ai * HALF + m * 16) * ldc + col0 + bj * HALF + n * 16);
#pragma unroll
            for (int m = 0; m < 4; ++m) asm volatile("" : "+v"(xv[m][0][0]), "+v"(xv[m][0][1]), "+v"(xv[m][1][0]), "+v"(xv[m][1][1]));
#pragma unroll
            for (int m = 0; m < 4; ++m)
#pragma unroll
                for (int bj = 0; bj < 2; ++bj)
#pragma unroll
                    for (int n = 0; n < 2; ++n) *(f32x4*)(X + (size_t)(row0 + ai * HALF + m * 16) * ldc + col0 + bj * HALF + n * 16) = xv[m][bj][n] + acc[ai][bj][m][n];
        }
    }
};
struct EpiBranchK {
    static constexpr bool PERM = true, HOOK = true;
    bf16_t* merged; const bf16_t* gr;
    __device__ __forceinline__ void hook(f32x4 (&acc)[2][2][4][2], const Unit& u, int jn, int wr, int wc, int fr, int fq) const {
        int row0 = u.pm * BM + wr * 64 + fr, col0 = u.pn * BM + wc * 32 + 8 * fq;
        asm volatile("" : "+v"(row0), "+v"(col0));
        u32x4 rv[2][4][2];
#pragma unroll
        for (int ai = 0; ai < 2; ++ai)
#pragma unroll
            for (int m = 0; m < 4; ++m)
#pragma unroll
                for (int bj = 0; bj < 2; ++bj) rv[ai][m][bj] = *(const u32x4*)(gr + (size_t)(row0 + ai * HALF + m * 16) * 6144 + (jn - 1) * 2048 + col0 + bj * HALF);
#pragma unroll
        for (int ai = 0; ai < 2; ++ai)
#pragma unroll
            for (int m = 0; m < 4; ++m)
#pragma unroll
                for (int bj = 0; bj < 2; ++bj) { float r[8]; unpack8(rv[ai][m][bj], r);
#pragma unroll
                    for (int i = 0; i < 8; ++i) acc[ai][bj][m][i >> 2][i & 3] *= r[i]; }
    }
    __device__ __forceinline__ void operator()(const f32x4 (&acc)[2][2][4][2], const Unit& u, int wr, int wc, int fr, int fq) const {
        const int row0 = u.pm * BM + wr * 64 + fr, col0 = u.pn * BM + wc * 32 + 8 * fq;
        u32x4 rv[2][4][2];
#pragma unroll
        for (int ai = 0; ai < 2; ++ai)
#pragma unroll
            for (int m = 0; m < 4; ++m)
#pragma unroll
                for (int bj = 0; bj < 2; ++bj) rv[ai][m][bj] = *(const u32x4*)(gr + (size_t)(row0 + ai * HALF + m * 16) * 6144 + 4096 + col0 + bj * HALF);
#pragma unroll
        for (int ai = 0; ai < 2; ++ai)
#pragma unroll
            for (int m = 0; m < 4; ++m) asm volatile("" : "+v"(rv[ai][m][0]), "+v"(rv[ai][m][1]));
#pragma unroll
        for (int ai = 0; ai < 2; ++ai)
#pragma unroll
            for (int m = 0; m < 4; ++m) { const int row = row0 + ai * HALF + m * 16;
#pragma unroll
                for (int bj = 0; bj < 2; ++bj) { float r[8], o[8]; unpack8(rv[ai][m][bj], r);
#pragma unroll
                    for (int i = 0; i < 8; ++i) o[i] = acc[ai][bj][m][i >> 2][i & 3] * r[i];
                    *(u32x4*)(merged + (size_t)row * 2048 + col0 + bj * HALF) = pack8(o); } }
    }
};

template <class Epi>
__device__ __forceinline__ void gemm_phase(LAS unsigned char* lds, const Gemm g, const StaticOrder& S, const Epi& E) {
    const int tid = opaque_tid(), wid = __builtin_amdgcn_readfirstlane(tid >> 6), lane = tid & 63, wr = wid >> 2, wc = wid & 3, fr = lane & 15, fq = lane >> 4;
    const int K = g.K, nt = K / BK;
    unsigned voffA[2], voffB[2];
#pragma unroll
    for (int i = 0; i < 2; ++i) { int R, C; stage_rc(tid * 16 + i * 8192, R, C); const int Rb = Epi::PERM ? ((R & ~31) + perm32(R & 31)) : R;
        voffA[i] = (unsigned)(R * g.lda + C) * 2u; voffB[i] = (unsigned)(Rb * g.ldb + C) * 2u; }
    const size_t kstep = (size_t)(BK * 2);
    const size_t hstepA = (size_t)HALF * g.lda * 2, hstepB = (size_t)HALF * g.ldb * 2;
    const size_t tstepA = 2 * hstepA, tstepB = 2 * hstepB;
    const unsigned ldsw = (unsigned)wid * 1024u;
    const int aoff = lds_byte(wr * 64 + fr, fq * 8), boff = lds_byte(wc * 32 + fr, fq * 8);
#define PG8_SA(b, h) (((b) * 2 + (h)) * HTB)
#define PG8_SB(b, h) ((4 + (b) * 2 + (h)) * HTB)
#define PG8_STAGE(bufoff, gbase, voff) do { _Pragma("unroll") for (int _i = 0; _i < 2; ++_i) \
        __builtin_amdgcn_global_load_lds((const unsigned*)((const char*)(gbase) + (voff)[_i]), (LAS unsigned*)(lds + (bufoff) + ldsw + _i * 8192), 16, 0, 0); } while (0)
#define PG8_LDA(dst, b, h) do { _Pragma("unroll") for (int m = 0; m < 4; ++m) _Pragma("unroll") for (int k = 0; k < 2; ++k) dst[m][k] = *(const LAS bf16x8*)(lds + PG8_SA(b, h) + aoff + m * 2048 + k * 1024); } while (0)
#define PG8_LDB(dst, b, h) do { _Pragma("unroll") for (int n = 0; n < 2; ++n) _Pragma("unroll") for (int k = 0; k < 2; ++k) dst[n][k] = *(const LAS bf16x8*)(lds + PG8_SB(b, h) + boff + n * 2048 + k * 1024); } while (0)
#define PG8_MMA(ai, bj, At, Bt) do { __builtin_amdgcn_s_setprio(1); _Pragma("unroll") for (int m = 0; m < 4; ++m) _Pragma("unroll") for (int n = 0; n < 2; ++n) _Pragma("unroll") for (int k = 0; k < 2; ++k) \
        acc[ai][bj][m][n] = __builtin_amdgcn_mfma_f32_16x16x32_bf16(Bt[n][k], At[m][k], acc[ai][bj][m][n], 0, 0, 0); __builtin_amdgcn_s_setprio(0); } while (0)
#define PG8_WAIT_V(n) asm volatile("s_waitcnt vmcnt(" #n ")" ::: "memory")
#define PG8_WAIT_L(n) asm volatile("s_waitcnt lgkmcnt(" #n ")" ::: "memory")
#define PG8_BAR __builtin_amdgcn_s_barrier()
#define PG8_SCHED __builtin_amdgcn_sched_barrier(0)
    Unit cur, nxt; int ui = 0;
    if (!S.next(0, cur)) return;
    f32x4 acc[2][2][4][2];
#pragma unroll
    for (int a = 0; a < 2; ++a)
#pragma unroll
        for (int b = 0; b < 2; ++b)
#pragma unroll
            for (int m = 0; m < 4; ++m)
#pragma unroll
                for (int n = 0; n < 2; ++n) acc[a][b][m][n] = (f32x4){0.f, 0.f, 0.f, 0.f};
    bf16x8 At[4][2], B0[2][2], B1[2][2];
    const char* cA = (const char*)g.A + (size_t)cur.pm * tstepA; const char* cB = (const char*)g.Bt + (size_t)cur.pn * tstepB;
    PG8_STAGE(PG8_SB(0, 0), cB, voffB); PG8_STAGE(PG8_SA(0, 0), cA, voffA); PG8_STAGE(PG8_SB(0, 1), cB + hstepB, voffB); PG8_STAGE(PG8_SA(0, 1), cA + hstepA, voffA);
    if (wr == 1) PG8_BAR;
    PG8_WAIT_V(4); PG8_BAR;
    PG8_STAGE(PG8_SB(1, 0), cB + kstep, voffB); PG8_STAGE(PG8_SA(1, 0), cA + kstep, voffA); PG8_STAGE(PG8_SB(1, 1), cB + hstepB + kstep, voffB);
    PG8_WAIT_V(6); PG8_BAR;
    for (;;) {
        const bool has_next = S.next(ui + 1, nxt);
        const char* nA = has_next ? (const char*)g.A + (size_t)nxt.pm * tstepA : cA; const char* nB = has_next ? (const char*)g.Bt + (size_t)nxt.pn * tstepB : cB;
        for (int t = 0; t < nt; t += 2) {
            const bool last = (t == nt - 2);
            const char* a1 = cA + (size_t)(t + 1) * kstep;
            const char* a2 = last ? nA : cA + (size_t)(t + 2) * kstep; const char* b2 = last ? nB : cB + (size_t)(t + 2) * kstep;
            const char* a3 = a2 + kstep; const char* b3 = b2 + kstep;
            if constexpr (Epi::HOOK) { if (t == 16 || t == 32) E.hook(acc, cur, t >> 4, wr, wc, fr, fq); }
            PG8_LDB(B0, 0, 0); PG8_SCHED; PG8_LDA(At, 0, 0); PG8_STAGE(PG8_SA(1, 1), a1 + hstepA, voffA);
            PG8_WAIT_L(8); PG8_BAR; PG8_WAIT_L(0); PG8_MMA(0, 0, At, B0); PG8_BAR; PG8_SCHED;
            PG8_LDB(B1, 0, 1); PG8_STAGE(PG8_SB(0, 0), b2, voffB);
            PG8_BAR; PG8_WAIT_L(0); PG8_MMA(0, 1, At, B1); PG8_BAR;
            PG8_LDA(At, 0, 1); PG8_STAGE(PG8_SA(0, 0), a2, voffA);
            PG8_BAR; PG8_WAIT_L(0); PG8_MMA(1, 0, At, B0); PG8_BAR; PG8_SCHED;
            PG8_STAGE(PG8_SB(0, 1), b2 + hstepB, voffB);
            PG8_WAIT_V(6); PG8_BAR; PG8_MMA(1, 1, At, B1); PG8_BAR;
            PG8_LDB(B0, 1, 0); PG8_SCHED; PG8_LDA(At, 1, 0); PG8_STAGE(PG8_SA(0, 1), a2 + hstepA, voffA);
            PG8_WAIT_L(8); PG8_BAR; PG8_WAIT_L(0); PG8_MMA(0, 0, At, B0); PG8_BAR; PG8_SCHED;
            PG8_LDB(B1, 1, 1); PG8_STAGE(PG8_SB(1, 0), b3, voffB);
            PG8_BAR; PG8_WAIT_L(0); PG8_MMA(0, 1, At, B1); PG8_BAR;
            PG8_LDA(At, 1, 1); PG8_STAGE(PG8_SA(1, 0), a3, voffA);
            PG8_BAR; PG8_WAIT_L(0); PG8_MMA(1, 0, At, B0); PG8_BAR; PG8_SCHED;
            PG8_STAGE(PG8_SB(1, 1), b3 + hstepB, voffB);
            PG8_WAIT_V(6); PG8_BAR; PG8_MMA(1, 1, At, B1); PG8_BAR;
        }
        E(acc, cur, wr, wc, fr, fq);
        if (!has_next) break;
#pragma unroll
        for (int a = 0; a < 2; ++a)
#pragma unroll
            for (int b = 0; b < 2; ++b)
#pragma unroll
                for (int m = 0; m < 4; ++m)
#pragma unroll
                    for (int n = 0; n < 2; ++n) acc[a][b][m][n] = (f32x4){0.f, 0.f, 0.f, 0.f};
        cur = nxt; cA = nA; cB = nB; ++ui;
    }
    PG8_WAIT_V(0);
    if (wr == 0) PG8_BAR;
    PG8_BAR;
#undef PG8_SA
#undef PG8_SB
#undef PG8_STAGE
#undef PG8_LDA
#undef PG8_LDB
#undef PG8_MMA
#undef PG8_WAIT_V
#undef PG8_WAIT_L
#undef PG8_BAR
#undef PG8_SCHED
}
}

constexpr size_t RP_W = 6 * ARR * 2, RP_GR = RP_W + ARR * 4;
static_assert(RP_GR + (size_t)MT * 6144 * 2 <= 7 * ARR * 4, "RPRE region");
struct Args { const float* in[37]; float* out; unsigned char* ws; int ph_lo, ph_hi; };
enum { I_XP = 0, I_XS, I_SSHIFT, I_SWKV, I_SCONV, I_SC, I_SN, I_SM, I_SGLA, I_NORM1, I_WIN, I_GATEB, I_MU, I_W0, I_W2, I_A0, I_A2, I_G2, I_KK, I_KA, I_RK, I_LNG, I_LNB,
       I_CONVW, I_CONVB, I_IB, I_FB, I_MNORM, I_GA2, I_GAB, I_GNORM, I_WBR, I_WOUT, I_NORM2, I_WGU, I_WDN, I_FNORM };

constexpr int LDS_BYTES = 147456;
constexpr int PTAB_OFF = LDS_BYTES - 1024;
__device__ __forceinline__ unsigned long long ctx_raw(LAS unsigned char* lds, int i) {
    const unsigned long long v = ((const LAS unsigned long long*)(lds + PTAB_OFF))[i];
    const unsigned lo = __builtin_amdgcn_readfirstlane((unsigned)v), hi = __builtin_amdgcn_readfirstlane((unsigned)(v >> 32));
    return ((unsigned long long)hi << 32) | lo;
}
#define GAS __attribute__((address_space(1)))
__device__ __forceinline__ const float* ctx_in(LAS unsigned char* lds, int i) { return (const float*)(const GAS float*)ctx_raw(lds, i); }
__device__ __forceinline__ float* ctx_out(LAS unsigned char* lds) { return (float*)(GAS float*)ctx_raw(lds, 37); }
__device__ __forceinline__ unsigned char* ctx_ws(LAS unsigned char* lds) { return (unsigned char*)(GAS unsigned char*)ctx_raw(lds, 38); }

struct TrD { const float* p; bf16_t* dst; int ldw, K; bool ok; };
__device__ __forceinline__ TrD tr_decode(LAS unsigned char* lds, int it, int lane) {
    constexpr int I_IN = 32 * 519, I_BR = 3 * 16 * 64, I_OUT = 32 * 64, I_GU = 32 * 352, I_DN = 88 * 64, I_LO = 3 * 32, PER_L = I_IN + I_BR + I_OUT + I_GU + I_DN + I_LO;
    const int l = it / PER_L; int r = it % PER_L;
    unsigned char* wl = ctx_ws(lds) + WS_W + (size_t)l * LW_BYTES;
    const float* W; bf16_t* WT; int ldw, K, k0, n0, nv = 32, drow0, dk = 0;
    if (r < I_IN) { const int kb = r / 519, nb = r % 519; nv = (NIN - nb * 32) < 32 ? (NIN - nb * 32) : 32;
        W = ctx_in(lds, I_WIN) + (size_t)l * 2048 * NIN; ldw = NIN; k0 = kb * 64; n0 = nb * 32; WT = (bf16_t*)(wl + LW_WIN); K = 2048; drow0 = nb * 32; }
    else if ((r -= I_IN) < I_BR) { const int j = r / 1024, q = r % 1024, kb = q / 64, nb = q % 64;
        W = ctx_in(lds, I_WBR) + (size_t)(l * 3 + j) * 1024 * 2048; ldw = 2048; k0 = kb * 64; n0 = nb * 32; WT = (bf16_t*)(wl + LW_WBR); K = 3072; drow0 = nb * 32; dk = j * 1024; }
    else if ((r -= I_BR) < I_OUT) { const int kb = r / 64, nb = r % 64;
        W = ctx_in(lds, I_WOUT) + (size_t)l * 2048 * 2048; ldw = 2048; k0 = kb * 64; n0 = nb * 32; WT = (bf16_t*)(wl + LW_WOUT); K = 2048; drow0 = nb * 32; }
    else if ((r -= I_OUT) < I_GU) { const int kb = r / 352, nb = r % 352; n0 = nb * 32; const int np = n0 < DFF ? n0 : n0 - DFF;
        W = ctx_in(lds, I_WGU) + (size_t)l * 2048 * 11264; ldw = 11264; k0 = kb * 64; WT = (bf16_t*)(wl + LW_WGU); K = 2048; drow0 = 256 * (np / 128) + (np % 128) + (n0 < DFF ? 0 : 128); }
    else if ((r -= I_GU) < I_DN) { const int kb = r / 64, nb = r % 64;
        W = ctx_in(lds, I_WDN) + (size_t)l * DFF * 2048; ldw = 2048; k0 = kb * 64; n0 = nb * 32; WT = (bf16_t*)(wl + LW_WDN); K = DFF; drow0 = nb * 32; }
    else { r -= I_DN; const int mat = r / 32, nb = r % 32;
        W = (mat == 0 ? ctx_in(lds, I_W2) : (mat == 1 ? ctx_in(lds, I_A2) : ctx_in(lds, I_G2))) + (size_t)l * 64 * 1024; ldw = 1024; k0 = 0; n0 = nb * 32; WT = (bf16_t*)(wl + LW_LORA) + (size_t)mat * 1024 * 64; K = 64; drow0 = nb * 32; }
    TrD t; const int n = lane & 31; t.ok = n < nv; t.ldw = ldw; t.K = K;
    t.p = W + (size_t)(k0 + (lane >> 5)) * ldw + n0 + (t.ok ? n : 0); t.dst = WT + (size_t)drow0 * K + dk + k0; return t;
}
#define TR_PIN16(v, o) asm volatile("" : "+v"(v[o]), "+v"(v[o + 1]), "+v"(v[o + 2]), "+v"(v[o + 3]), "+v"(v[o + 4]), "+v"(v[o + 5]), "+v"(v[o + 6]), "+v"(v[o + 7]), "+v"(v[o + 8]), "+v"(v[o + 9]), "+v"(v[o + 10]), "+v"(v[o + 11]), "+v"(v[o + 12]), "+v"(v[o + 13]), "+v"(v[o + 14]), "+v"(v[o + 15]))
__device__ __forceinline__ void tr_load(const TrD& t, float (&v)[32]) {
#pragma unroll
    for (int i = 0; i < 32; ++i) v[i] = __builtin_nontemporal_load(t.p + (size_t)(2 * i) * t.ldw);
}
__device__ __forceinline__ void tr_store(const TrD& t, const float (&v)[32], LAS float* scr, int lane) {
    const int n = lane & 31;
#pragma unroll
    for (int i = 0; i < 32; ++i) scr[(2 * i + (lane >> 5)) * 33 + n] = t.ok ? v[i] : 0.f;
    LDS_WAIT();
    const int c = lane & 7;
#pragma unroll
    for (int j = 0; j < 4; ++j) { const int nn = (lane >> 3) + 8 * j; const LAS float* s = scr + (8 * c) * 33 + nn;
        u32x4 o; o.x = pk2(s[0 * 33], s[1 * 33]); o.y = pk2(s[2 * 33], s[3 * 33]); o.z = pk2(s[4 * 33], s[5 * 33]); o.w = pk2(s[6 * 33], s[7 * 33]);
        *(u32x4*)(t.dst + (size_t)nn * t.K + 8 * c) = o; }
    LDS_WAIT();
}
__device__ __forceinline__ void phase_prologue(LAS unsigned char* lds, int G) {
    const int tid = opaque_tid(), lane = tid & 63, wave = tid >> 6;
    LAS float* scr = (LAS float*)(lds + wave * 8704);
    const int gw = blockIdx.x * 8 + wave, NGW = G * 8;
    constexpr int NITEMS = 2 * (32 * 519 + 3 * 16 * 64 + 32 * 64 + 32 * 352 + 88 * 64 + 3 * 32);
    if (gw < NITEMS) {
        const int last = gw + ((NITEMS - 1 - gw) / NGW) * NGW;
        TrD ta = tr_decode(lds, gw, lane); float va[32]; tr_load(ta, va);
        for (int it = gw; it < NITEMS; it += 2 * NGW) {
            const int i1 = it + NGW <= last ? it + NGW : last, i2 = it + 2 * NGW <= last ? it + 2 * NGW : last;
            const TrD tb = tr_decode(lds, i1, lane); float vb[32]; tr_load(tb, vb);
            TR_PIN16(va, 0); TR_PIN16(va, 16);
            tr_store(ta, va, scr, lane);
            ta = tr_decode(lds, i2, lane); tr_load(ta, va);
            TR_PIN16(vb, 0); TR_PIN16(vb, 16);
            if (it + NGW < NITEMS) tr_store(tb, vb, scr, lane);
        }
    }
    const int gt = blockIdx.x * NTHREADS + tid, NGT = G * NTHREADS;
    for (int i = gt; i < 2 * 32 * 2048 / 8; i += NGT) { const int l = i / (32 * 256), q = i % (32 * 256);
        *(u32x4*)((bf16_t*)(ctx_ws(lds) + WS_W + (size_t)l * LW_BYTES + LW_WIN) + (size_t)16608 * 2048 + (size_t)q * 8) = (u32x4){0u, 0u, 0u, 0u}; }
    for (int i = gt; i < 2 * 512 * 32; i += NGT) { const int l = i / (512 * 32), q = i % (512 * 32), c = q / 32, k = q % 32;
        ((bf16_t*)(ctx_ws(lds) + WS_W + (size_t)l * LW_BYTES + LW_GA2))[q] = k < 16 ? f2bf(ctx_in(lds, I_GA2)[(size_t)l * 16 * 512 + k * 512 + c]) : (bf16_t)0; }
}

__device__ __forceinline__ void phase_norm(LAS unsigned char* lds, int G, const float* gvec, bool from_input) {
    const int tid = opaque_tid(), lane = tid & 63, wave = tid >> 6;
    float* __restrict__ xbuf = (float*)(ctx_ws(lds) + WS_X); bf16_t* __restrict__ hb = (bf16_t*)(ctx_ws(lds) + WS_H);
    f32x4 gg[8];
#pragma unroll
    for (int j = 0; j < 8; ++j) gg[j] = *(const f32x4*)(gvec + (lane + 64 * j) * 4);
    for (int m = blockIdx.x * 8 + wave; m < MPAD; m += G * 8) {
        if (m >= MT) { if (from_input) {
#pragma unroll
            for (int j = 0; j < 4; ++j) *(u32x4*)(hb + (size_t)m * 2048 + (lane + 64 * j) * 8) = (u32x4){0u, 0u, 0u, 0u}; } continue; }
        const float* src = from_input ? (m < MP ? ctx_in(lds, I_XP) + (size_t)m * 2048 : ctx_in(lds, I_XS) + (size_t)(m - MP) * 2048) : xbuf + (size_t)m * 2048;
        f32x4 v[8]; float s = 0.f;
#pragma unroll
        for (int j = 0; j < 8; ++j) v[j] = *(const f32x4*)(src + (lane + 64 * j) * 4);
#pragma unroll
        for (int j = 0; j < 8; ++j) s += (v[j].x * v[j].x + v[j].y * v[j].y) + (v[j].z * v[j].z + v[j].w * v[j].w);
        const float rs = rsqrtf(wave_sum(s) * (1.f / 2048.f) + 1e-6f);
#pragma unroll
        for (int j = 0; j < 8; ++j) { const int c = (lane + 64 * j) * 4;
            if (from_input) *(f32x4*)(xbuf + (size_t)m * 2048 + c) = v[j];
            u32x2 w; w.x = pk2(v[j].x * rs * gg[j].x, v[j].y * rs * gg[j].y); w.y = pk2(v[j].z * rs * gg[j].z, v[j].w * rs * gg[j].w);
            *(u32x2*)(hb + (size_t)m * 2048 + c) = w; }
    }
}
__device__ __forceinline__ void dump_words(const unsigned* src, unsigned* dst, size_t n, int G) {
    for (size_t i = (size_t)blockIdx.x * NTHREADS + threadIdx.x; i < n; i += (size_t)G * NTHREADS) dst[i] = src[i];
}
__device__ __forceinline__ void phase_dump(LAS unsigned char* lds, int G) {
    unsigned char* ws = ctx_ws(lds); unsigned* out = (unsigned*)ctx_out(lds);
    if (DBG_LIM == 5) { if (DBG_SEL == 0) dump_words((const unsigned*)(ws + WS_ROUT), out + O_YP, ARR, G); if (DBG_SEL == 1) dump_words((const unsigned*)(ws + WS_HM), out + O_YP, ARR, G); if (DBG_SEL == 2) { dump_words((const unsigned*)(ws + WS_OG), out + O_YP, ARR, G); dump_words((const unsigned*)(ws + WS_HM), out + O_SC, ARR, G); } if (DBG_SEL == 3) dump_words((const unsigned*)(ws + WS_QM), out + O_YP, ARR, G); if (DBG_SEL == 4) dump_words((const unsigned*)(ws + WS_HM), out + O_YP, (size_t)MP * 1024, G); }
    else if (DBG_LIM == 6) { dump_words((const unsigned*)(ws + WS_QM), out + O_YP, (size_t)MT * 3072 / 2, G); }
    else if (DBG_LIM == 7) { dump_words((const unsigned*)(ws + WS_H), out + O_YP, (size_t)MT * 2048 / 2, G); }
    else { dump_words((const unsigned*)(ws + WS_X), out + O_YP, (size_t)MP * 2048, G); }
}
__device__ __forceinline__ void phase_final(LAS unsigned char* lds, int G) {
    const int tid = opaque_tid(), lane = tid & 63, wave = tid >> 6;
    const float* __restrict__ xbuf = (const float*)(ctx_ws(lds) + WS_X); const float* __restrict__ gvec = ctx_in(lds, I_FNORM);
    f32x4 gg[8];
#pragma unroll
    for (int j = 0; j < 8; ++j) gg[j] = *(const f32x4*)(gvec + (lane + 64 * j) * 4);
    for (int m = blockIdx.x * 8 + wave; m < MT; m += G * 8) {
        const float* src = xbuf + (size_t)m * 2048; float* __restrict__ dst = ctx_out(lds) + (m < MP ? O_YP + (size_t)m * 2048 : O_YS + (size_t)(m - MP) * 2048);
        f32x4 v[8]; float s = 0.f;
#pragma unroll
        for (int j = 0; j < 8; ++j) v[j] = *(const f32x4*)(src + (lane + 64 * j) * 4);
#pragma unroll
        for (int j = 0; j < 8; ++j) s += (v[j].x * v[j].x + v[j].y * v[j].y) + (v[j].z * v[j].z + v[j].w * v[j].w);
        const float rs = rsqrtf(wave_sum(s) * (1.f / 2048.f) + 1e-6f);
#pragma unroll
        for (int j = 0; j < 8; ++j) { const int c = (lane + 64 * j) * 4;
            *(f32x4*)(dst + c) = (f32x4){v[j].x * rs * gg[j].x, v[j].y * rs * gg[j].y, v[j].z * rs * gg[j].z, v[j].w * rs * gg[j].w}; }
    }
}

__device__ __forceinline__ void load_prev8(const bf16_t* proj, const float* shift_l, int m, int col, float (&o)[8]) {
    if (m >= MP) ld8f(shift_l + (size_t)(m - MP) * RC + col, o);
    else if ((m & 2047) == 0) {
#pragma unroll
        for (int i = 0; i < 8; ++i) o[i] = 0.f; }
    else ld8b(proj + (size_t)(m - 1) * NINP + col, o);
}
__device__ __forceinline__ void ld16b(const bf16_t* p, float (&f)[16]) { ld8b(p, *(float(*)[8])&f[0]); ld8b(p + 8, *(float(*)[8])&f[8]); }
__device__ __forceinline__ void ld16f(const float* p, float (&f)[16]) { ld8f(p, *(float(*)[8])&f[0]); ld8f(p + 8, *(float(*)[8])&f[8]); }
__device__ __forceinline__ void st16f(float* p, const float (&f)[16]) { st8f(p, *(const float(*)[8])&f[0]); st8f(p + 8, *(const float(*)[8])&f[8]); }
__device__ __forceinline__ void st16b(bf16_t* p, const float (&f)[16]) { *(u32x4*)p = pack8(*(const float(*)[8])&f[0]); *(u32x4*)(p + 8) = pack8(*(const float(*)[8])&f[8]); }
__device__ __forceinline__ void pre_rwkv_item(LAS unsigned char* lds, int l, int cidx, int tt, int h0, int nh, int wave, int lane) {
    const int lr = lane & 15, lq = lane >> 4;
    const int m0 = cidx * 64 + tt * 16;
    const bf16_t* __restrict__ proj = (const bf16_t*)(ctx_ws(lds) + WS_PROJ);
    const float* __restrict__ shift_l = ctx_in(lds, I_SSHIFT) + (size_t)l * 128 * RC;
    const float* __restrict__ mu = ctx_in(lds, I_MU) + (size_t)l * RC;
    const bf16_t* __restrict__ loraT = (const bf16_t*)(ctx_ws(lds) + WS_W + (size_t)l * LW_BYTES + LW_LORA);
    bf16_t* __restrict__ rb = (bf16_t*)(ctx_ws(lds) + WS_RPRE); float* __restrict__ rw = (float*)(ctx_ws(lds) + WS_RPRE + RP_W);
    LAS bf16_t* loraA = (LAS bf16_t*)(lds + wave * 14336);
    LAS bf16_t* loraO = (LAS bf16_t*)(lds + wave * 14336 + 7168);
    const int tok = lane >> 2, c4 = lane & 3, m = m0 + tok;
    {
#pragma unroll
        for (int i = 0; i < 6; ++i) {
            const int cgp = c4 + 4 * i, col = 3072 + cgp * 8, mat = cgp >> 3, kc = (cgp & 7) * 8;
            float p[8], pv[8], mm[8], x[8];
            ld8b(proj + (size_t)m * NINP + col, p); load_prev8(proj, shift_l, m, col, pv); ld8f(mu + col, mm);
#pragma unroll
            for (int j = 0; j < 8; ++j) { const float xs = p[j] + (pv[j] - p[j]) * mm[j]; x[j] = mat == 0 ? tanh_fast(xs) : (mat == 1 ? xs : sigm(xs)); }
            *(LAS u32x4*)(loraA + (mat * 16 + tok) * 72 + kc) = pack8(x);
        }
    }
    LDS_WAIT();
    const bool samp = m >= MP, first = !samp && ((m & 2047) == 0);
    const bf16_t* prow = proj + (size_t)m * NINP;
    const bf16_t* qrow = proj + (size_t)((samp || first) ? m : m - 1) * NINP;
    const float* srow = shift_l + (size_t)(samp ? m - MP : 0) * RC;
#pragma unroll 1
    for (int hh = 0; hh < nh; ++hh) {
        const int h = h0 + hh, c0 = h * 64 + c4 * 16;
        bf16x8 bfr[3][4][2];
#pragma unroll
        for (int mat = 0; mat < 3; ++mat)
#pragma unroll
            for (int tc = 0; tc < 4; ++tc)
#pragma unroll
                for (int ks = 0; ks < 2; ++ks) bfr[mat][tc][ks] = *(const bf16x8*)(loraT + (size_t)(mat * 1024 + h * 64 + tc * 16 + lr) * 64 + ks * 32 + lq * 8);
        u32x4 pw[3][2], qw[3][2]; f32x4 qs[3][4];
#pragma unroll
        for (int g = 0; g < 3; ++g) { pw[g][0] = *(const u32x4*)(prow + g * 1024 + c0); pw[g][1] = *(const u32x4*)(prow + g * 1024 + c0 + 8);
            if (samp) {
#pragma unroll
                for (int k = 0; k < 4; ++k) qs[g][k] = *(const f32x4*)(srow + g * 1024 + c0 + 4 * k); }
            else { qw[g][0] = *(const u32x4*)(qrow + g * 1024 + c0); qw[g][1] = *(const u32x4*)(qrow + g * 1024 + c0 + 8); } }
#pragma unroll
        for (int mat = 0; mat < 3; ++mat)
#pragma unroll
            for (int tc = 0; tc < 4; ++tc) { f32x4 acc = {0.f, 0.f, 0.f, 0.f};
#pragma unroll
                for (int ks = 0; ks < 2; ++ks) {
                    const bf16x8 av = *(const LAS bf16x8*)(loraA + (mat * 16 + lr) * 72 + ks * 32 + lq * 8);
                    acc = MFMA16(av, bfr[mat][tc][ks], acc); }
#pragma unroll
                for (int r = 0; r < 4; ++r) loraO[(mat * 16 + lq * 4 + r) * 72 + tc * 16 + lr] = f2bf(acc[r]); }
        LDS_WAIT();
        float xr[16], xk[16], xv[16];
#pragma unroll
        for (int g = 0; g < 3; ++g) { float p[16], q[16], mm[16];
            unpack8(pw[g][0], *(float(*)[8])&p[0]); unpack8(pw[g][1], *(float(*)[8])&p[8]); ld16f(mu + g * 1024 + c0, mm);
            if (samp) {
#pragma unroll
                for (int j = 0; j < 16; ++j) q[j] = qs[g][j >> 2][j & 3]; }
            else { unpack8(qw[g][0], *(float(*)[8])&q[0]); unpack8(qw[g][1], *(float(*)[8])&q[8]);
                if (first) {
#pragma unroll
                    for (int j = 0; j < 16; ++j) q[j] = 0.f; } }
#pragma unroll
            for (int j = 0; j < 16; ++j) { const float x = p[j] + (q[j] - p[j]) * mm[j]; if (g == 0) xr[j] = x; else if (g == 1) xk[j] = x; else xv[j] = x; } }
        const size_t o = (size_t)m * 1024 + c0;
        st16b(rb + 3 * ARR + o, xr); st16b(rb + 4 * ARR + o, xv);
        float lw[16], la[16], lg[16];
        { const LAS bf16_t* lo = loraO + tok * 72 + c4 * 16;
          unpack8(*(const LAS u32x4*)(lo), *(float(*)[8])&lw[0]); unpack8(*(const LAS u32x4*)(lo + 8), *(float(*)[8])&lw[8]);
          unpack8(*(const LAS u32x4*)(lo + 16 * 72), *(float(*)[8])&la[0]); unpack8(*(const LAS u32x4*)(lo + 16 * 72 + 8), *(float(*)[8])&la[8]);
          unpack8(*(const LAS u32x4*)(lo + 32 * 72), *(float(*)[8])&lg[0]); unpack8(*(const LAS u32x4*)(lo + 32 * 72 + 8), *(float(*)[8])&lg[8]); }
        st16b(rb + 5 * ARR + o, lg);
        float pa[16], pb[16], kkr[16], av[16]; float ss = 0.f;
        ld16f(ctx_in(lds, I_KK) + l * 1024 + c0, pa); ld16f(ctx_in(lds, I_A0) + l * 1024 + c0, pb);
#pragma unroll
        for (int j = 0; j < 16; ++j) { kkr[j] = xk[j] * pa[j]; ss += kkr[j] * kkr[j]; av[j] = sigm(pb[j] + la[j]); }
        ss = quad_sum(ss);
        const float inv = 1.f / fmaxf(sqrtf(ss), 1e-12f);
#pragma unroll
        for (int j = 0; j < 16; ++j) { kkr[j] *= inv; pa[j] = kkr[j] * av[j]; }
        st16b(rb + 0 * ARR + o, kkr); st16b(rb + 1 * ARR + o, pa);
        ld16f(ctx_in(lds, I_KA) + l * 1024 + c0, pa); ld16f(ctx_in(lds, I_W0) + l * 1024 + c0, pb);
#pragma unroll
        for (int j = 0; j < 16; ++j) { pa[j] = xk[j] * (1.f + (av[j] - 1.f) * pa[j]);
            const float wp = -(pb[j] + lw[j]); const float sp = fmaxf(wp, 0.f) + __logf(1.f + __expf(-fabsf(wp))); pb[j] = __expf(-__expf(-sp - 0.5f)); }
        st16b(rb + 2 * ARR + o, pa); st16f(rw + o, pb);
        LDS_WAIT();
    }
}
__device__ __forceinline__ void pre_mlstm(LAS unsigned char* lds, int l, int cidx, int m0, int ntok) {
    const int tid = opaque_tid();
    const bf16_t* __restrict__ proj = (const bf16_t*)(ctx_ws(lds) + WS_PROJ);
    bf16_t* __restrict__ qm = (bf16_t*)(ctx_ws(lds) + WS_QM); bf16_t* __restrict__ km = (bf16_t*)(ctx_ws(lds) + WS_KM); float* __restrict__ gates = (float*)(ctx_ws(lds) + WS_GATES);
    const int cgp = tid & 255, th = tid >> 8, c0 = cgp * 8;
    float w0[8], w1[8], w2[8], w3[8], cb[8];
    ld8f(ctx_in(lds, I_CONVW) + (size_t)(l * 4 + 0) * 2048 + c0, w0); ld8f(ctx_in(lds, I_CONVW) + (size_t)(l * 4 + 1) * 2048 + c0, w1);
    ld8f(ctx_in(lds, I_CONVW) + (size_t)(l * 4 + 2) * 2048 + c0, w2); ld8f(ctx_in(lds, I_CONVW) + (size_t)(l * 4 + 3) * 2048 + c0, w3);
    ld8f(ctx_in(lds, I_CONVB) + (size_t)l * 2048 + c0, cb);
    bf16_t* dst = cgp < 128 ? qm + c0 : km + (c0 - 1024); const float sc = cgp < 128 ? 1.f : 0.0625f;
    if (cidx < 128) {
        float x3[8], x2[8], x1[8];
        const int t0 = th * 32, ts0 = (m0 & 2047) + t0;
#pragma unroll
        for (int j = 0; j < 8; ++j) { x3[j] = 0.f; x2[j] = 0.f; x1[j] = 0.f; }
        if (ts0 >= 3) { ld8b(proj + (size_t)(m0 + t0 - 3) * NINP + M0 + c0, x3); ld8b(proj + (size_t)(m0 + t0 - 2) * NINP + M0 + c0, x2); ld8b(proj + (size_t)(m0 + t0 - 1) * NINP + M0 + c0, x1); }
        const bool lastc = (cidx & 31) == 31; const int b = cidx >> 5;
#pragma unroll 1
        for (int tb = t0; tb < t0 + 32; tb += 8) {
            u32x4 xb[8];
#pragma unroll
            for (int i = 0; i < 8; ++i) xb[i] = *(const u32x4*)(proj + (size_t)(m0 + tb + i) * NINP + M0 + c0);
#pragma unroll
            for (int i = 0; i < 8; ++i) { const int m = m0 + tb + i; float x0[8], y[8]; unpack8(xb[i], x0);
#pragma unroll
                for (int j = 0; j < 8; ++j) { const float cv = cb[j] + w0[j] * x3[j] + w1[j] * x2[j] + w2[j] * x1[j] + w3[j] * x0[j]; y[j] = siluf(cv) * sc; x3[j] = x2[j]; x2[j] = x1[j]; x1[j] = x0[j]; }
                *(u32x4*)(dst + (size_t)m * 1024) = pack8(y);
                if (lastc && tb + i >= 61) st8f(ctx_out(lds) + O_PCONV + (size_t)((l * 4 + b) * 3 + (tb + i - 61)) * 2048 + c0, x0); }
        }
    } else {
#pragma unroll 1
        for (int tb = th * (ntok >> 1); tb < (th + 1) * (ntok >> 1); tb += 4) {
            u32x4 xb[4]; f32x4 sa[4][6];
#pragma unroll
            for (int i = 0; i < 4; ++i) { const int m = m0 + tb + i, s = m - MP; const float* __restrict__ cs = ctx_in(lds, I_SCONV) + (size_t)((l * 128 + s) * 3) * 2048 + c0;
                xb[i] = *(const u32x4*)(proj + (size_t)m * NINP + M0 + c0);
#pragma unroll
                for (int k = 0; k < 3; ++k) { sa[i][2 * k] = *(const f32x4*)(cs + k * 2048); sa[i][2 * k + 1] = *(const f32x4*)(cs + k * 2048 + 4); } }
#pragma unroll
            for (int i = 0; i < 4; ++i) { const int m = m0 + tb + i, s = m - MP; float x0[8], y[8]; unpack8(xb[i], x0);
#pragma unroll
                for (int j = 0; j < 8; ++j) { const float x3 = sa[i][0 + (j >> 2)][j & 3], x2 = sa[i][2 + (j >> 2)][j & 3], x1 = sa[i][4 + (j >> 2)][j & 3];
                    const float cv = cb[j] + w0[j] * x3 + w1[j] * x2 + w2[j] * x1 + w3[j] * x0[j]; y[j] = siluf(cv) * sc; }
                *(u32x4*)(dst + (size_t)m * 1024) = pack8(y);
                float* co = ctx_out(lds) + O_SCONV + (size_t)((l * 128 + s) * 3) * 2048 + c0;
                *(f32x4*)co = sa[i][2]; *(f32x4*)(co + 4) = sa[i][3]; *(f32x4*)(co + 2048) = sa[i][4]; *(f32x4*)(co + 2052) = sa[i][5]; st8f(co + 4096, x0); }
        }
    }
    if (tid < ntok * 4) { const int t = tid >> 2, hh = tid & 3, m = m0 + t;
        const float ip = bf2f(proj[(size_t)m * NINP + M0 + 3072 + hh]), fp = bf2f(proj[(size_t)m * NINP + M0 + 3076 + hh]);
        const float xf = fp + ctx_in(lds, I_FB)[l * 4 + hh];
        gates[(size_t)m * 8 + hh] = ip + ctx_in(lds, I_IB)[l * 4 + hh];
        gates[(size_t)m * 8 + 4 + hh] = fminf(xf, 0.f) - log1pf(__expf(-fabsf(xf))); }
}
__device__ __forceinline__ void pre_gla(LAS unsigned char* lds, int l, int cidx, int m0, int ntok) {
    const int tid = opaque_tid(), lane = tid & 63, wave = tid >> 6, lr = lane & 15, lq = lane >> 4;
    const bf16_t* __restrict__ proj = (const bf16_t*)(ctx_ws(lds) + WS_PROJ);
    bf16_t* __restrict__ gq = (bf16_t*)(ctx_ws(lds) + WS_GQ); bf16_t* __restrict__ gk = (bf16_t*)(ctx_ws(lds) + WS_GK); bf16_t* __restrict__ gkh = (bf16_t*)(ctx_ws(lds) + WS_GKH); float* __restrict__ egl = (float*)(ctx_ws(lds) + WS_EGL);
    const bf16_t* __restrict__ a2T = (const bf16_t*)(ctx_ws(lds) + WS_W + (size_t)l * LW_BYTES + LW_GA2);
    LAS float* bb = (LAS float*)lds;
    LAS bf16_t* xa = (LAS bf16_t*)(lds + 64 * 516 * 4);
    const bool samp = cidx >= 128;
    __syncthreads();
    for (int i = tid; i < ntok * 32; i += NTHREADS) { const int t = i >> 5, k = i & 31; xa[t * 40 + k] = k < 16 ? proj[(size_t)(m0 + t) * NINP + G0 + 2048 + k] : (bf16_t)0; }
    __syncthreads();
#pragma unroll
    for (int q = 0; q < 4; ++q) { const int tc = wave * 4 + q;
        const bf16x8 bv = *(const bf16x8*)(a2T + (size_t)(tc * 16 + lr) * 32 + lq * 8);
        const float ab = ctx_in(lds, I_GAB)[l * 512 + tc * 16 + lr];
#pragma unroll
        for (int tt = 0; tt < 4; ++tt) { if (tt * 16 >= ntok) break; const bf16x8 av = *(const LAS bf16x8*)(xa + (tt * 16 + lr) * 40 + lq * 8);
            f32x4 acc = {0.f, 0.f, 0.f, 0.f}; acc = MFMA16(av, bv, acc);
#pragma unroll
            for (int r = 0; r < 4; ++r) bb[(tt * 16 + lq * 4 + r) * 516 + tc * 16 + lr] = logsig_fast(acc[r] + ab) * 0.0625f; } }
    __syncthreads();
    if (!samp) { const int c = tid; float run = 0.f;
#pragma unroll 8
        for (int t = 0; t < 64; ++t) { run += bb[t * 516 + c]; bb[t * 516 + c] = run; }
        egl[(size_t)cidx * 512 + c] = __expf(run); }
    __syncthreads();
    const float scale = 0.08838834764831845f;
    for (int i = tid; i < ntok * 64; i += NTHREADS) { const int t = i >> 6, cg = i & 63, c = cg * 8; const size_t m = m0 + t;
        float q[8], k[8], b8[8], bl[8], oq[8], ok[8], oh[8];
        ld8b(proj + m * NINP + G0 + c, q); ld8b(proj + m * NINP + G0 + 512 + c, k);
#pragma unroll
        for (int j = 0; j < 8; ++j) { b8[j] = bb[t * 516 + c + j]; bl[j] = samp ? b8[j] : bb[63 * 516 + c + j]; }
#pragma unroll
        for (int j = 0; j < 8; ++j) { oq[j] = q[j] * __expf(b8[j]) * scale; ok[j] = k[j] * __expf(-b8[j]); oh[j] = k[j] * __expf(bl[j] - b8[j]); }
        *(u32x4*)(gq + m * 512 + c) = pack8(oq); *(u32x4*)(gk + m * 512 + c) = pack8(ok); *(u32x4*)(gkh + m * 512 + c) = pack8(oh);
        if (samp) { float e[8];
#pragma unroll
            for (int j = 0; j < 8; ++j) e[j] = __expf(b8[j]);
            st8f(egl + (size_t)(128 + (m - MP)) * 512 + c, e); } }
}
__device__ __forceinline__ void phase_pre(LAS unsigned char* lds, int l, int G) {
    { const int tid = opaque_tid(), wave = tid >> 6, lane = tid & 63;
      for (int it = blockIdx.x * 8 + wave; it < 2048 + G * 8; it += G * 8) {
          int cidx, tt, h0, nh;
          if (it < 2048) { cidx = it >> 4; tt = (it >> 2) & 3; h0 = (it & 3) * 4; nh = 4; }
          else { const int j = G * 8 - 1 - (it - 2048); if (j >= 128) continue; cidx = 128 + (j >> 6); tt = (j >> 4) & 3; h0 = j & 15; nh = 1; }
          pre_rwkv_item(lds, l, cidx, tt, h0, nh, wave, lane); } }
    for (int u = blockIdx.x; u < 272; u += G) {
        if (u < 128) pre_gla(lds, l, u, u * 64, 64);
        else if (u < 256) pre_mlstm(lds, l, u - 128, (u - 128) * 64, 64);
        else if (u < 264) pre_gla(lds, l, 128, MP + (u - 256) * 16, 16);
        else pre_mlstm(lds, l, 128, MP + (u - 264) * 16, 16);
    }
    {
        const bf16_t* __restrict__ proj = (const bf16_t*)(ctx_ws(lds) + WS_PROJ);
        for (int i = blockIdx.x * NTHREADS + opaque_tid(); i < 132 * (RC / 8); i += G * NTHREADS) { const int sq = i / (RC / 8), cg8 = i % (RC / 8); float p[8];
            const int m = sq < 4 ? sq * 2048 + 2047 : MP + (sq - 4);
            ld8b(proj + (size_t)m * NINP + cg8 * 8, p);
            st8f(ctx_out(lds) + (sq < 4 ? O_PSHIFT + (size_t)(l * 4 + sq) * RC : O_SSHIFT + (size_t)(l * 128 + (sq - 4)) * RC) + cg8 * 8, p); }
    }
}

__device__ __forceinline__ void scan_rwkv(LAS unsigned char* lds, int l, int u) {
    const int tid = opaque_tid(), bh = u >> 1, half = u & 1, b = bh >> 4, h = bh & 15;
    const int row2 = (tid >> 3) & 31, jg = tid & 7;
    const float* __restrict__ rpre = (const float*)(ctx_ws(lds) + WS_RPRE); bf16_t* __restrict__ rout = (bf16_t*)(ctx_ws(lds) + WS_ROUT);
    LAS float* stage = (LAS float*)lds;
    LAS float* obuf = (LAS float*)(lds + 64 * 352 * 4);
    f32x4 Sa = {0.f, 0.f, 0.f, 0.f}, Sb = {0.f, 0.f, 0.f, 0.f};
    const size_t mb = (size_t)b * 2048;
    const unsigned char* rbase = (const unsigned char*)rpre;
    unsigned off[7], inc[7]; int lo[7];
#pragma unroll
    for (int q = 0; q < 7; ++q) { int i = tid + 512 * q; i = i < 3328 ? i : 3327; const int tok = i / 52, j = i % 52;
        if (j < 32) { const int arr = j >> 3, pc = j & 7; off[q] = (unsigned)(arr * (int)ARR + tok * 1024 + h * 64 + pc * 8) * 2u; inc[q] = 64u * 1024u * 2u; lo[q] = tok * 352 + (arr == 0 ? 0 : arr == 1 ? 64 : arr == 2 ? 192 : 256) + pc * 8; }
        else if (j < 48) { const int pc = j - 32; off[q] = (unsigned)RP_W + (unsigned)(tok * 1024 + h * 64 + pc * 4) * 4u; inc[q] = 64u * 1024u * 4u; lo[q] = -(tok * 352 + 128 + pc * 4) - 1; }
        else { const int pc = j - 48; off[q] = (unsigned)(4 * (int)ARR + tok * 1024 + h * 64 + half * 32 + pc * 8) * 2u; inc[q] = 64u * 1024u * 2u; lo[q] = tok * 352 + 320 + pc * 8; } }
    u32x4 pf[7];
    const size_t cb0 = mb / 64;
#pragma unroll
    for (int q = 0; q < 7; ++q) pf[q] = *(const u32x4*)(rbase + off[q] + cb0 * inc[q]);
    __syncthreads();
    for (int ch = 0; ch < 32; ++ch) {
#pragma unroll
        for (int q = 0; q < 7; ++q) {
            if (lo[q] < 0) *(LAS u32x4*)(stage + (-lo[q] - 1)) = pf[q];
            else { float f[8]; unpack8(pf[q], f); *(LAS f32x4*)(stage + lo[q]) = (f32x4){f[0], f[1], f[2], f[3]}; *(LAS f32x4*)(stage + lo[q] + 4) = (f32x4){f[4], f[5], f[6], f[7]}; } }
        __syncthreads();
        { const size_t chn = cb0 + (ch + 1 < 32 ? ch + 1 : 31);
#pragma unroll
          for (int q = 0; q < 7; ++q) pf[q] = *(const u32x4*)(rbase + off[q] + chn * inc[q]); }
        if (tid < 256) {
        f32x4 B5[2][10]; float Bv[2];
#define RW_LD(slot, t) do { const LAS float* sp_ = stage + (t) * 352 + jg * 8; _Pragma("unroll") for (int v_ = 0; v_ < 5; ++v_) { B5[slot][2 * v_] = *(const LAS f32x4*)(sp_ + 64 * v_); B5[slot][2 * v_ + 1] = *(const LAS f32x4*)(sp_ + 64 * v_ + 4); } \
            Bv[slot] = stage[(t) * 352 + 320 + row2]; } while (0)
        RW_LD(0, 0);
        float os[8] = {0.f, 0.f, 0.f, 0.f, 0.f, 0.f, 0.f, 0.f};
        f32x4 q = {0.f, 0.f, 0.f, 0.f};
#define RW_OSUM(t) do { float o = (q.x + q.y) + (q.z + q.w); o = row8_sum(o); if (((t) & 7) == jg) os[(t) >> 3] = o; } while (0)
#pragma unroll
        for (int t = 0; t < 64; ++t) {
            if (t + 1 < 64) RW_LD((t + 1) & 1, t + 1);
            __builtin_amdgcn_sched_barrier(0);
            const int sl = t & 1; const float vv = Bv[sl];
            f32x4 p = Sa * B5[sl][0]; p = Sb * B5[sl][1] + p;
            float sa = (p.x + p.y) + (p.z + p.w);
            if (t > 0) RW_OSUM(t - 1);
            sa = row8_sum(sa);
            Sa = Sa * B5[sl][4] - sa * B5[sl][2] + vv * B5[sl][6];
            Sb = Sb * B5[sl][5] - sa * B5[sl][3] + vv * B5[sl][7];
            q = Sa * B5[sl][8]; q = Sb * B5[sl][9] + q;
        }
        RW_OSUM(63);
#undef RW_OSUM
#undef RW_LD
#pragma unroll
        for (int i = 0; i < 8; ++i) obuf[(i * 8 + jg) * 32 + row2] = os[i];
        }
        __syncthreads();
        for (int i = tid; i < 1024; i += NTHREADS) *(unsigned*)(rout + (mb + ch * 64 + (i >> 4)) * 1024 + h * 64 + half * 32 + (i & 15) * 2) = pk2(obuf[i * 2], obuf[i * 2 + 1]);
    }
    if (tid < 256) { float* sp = ctx_out(lds) + O_PWKV + ((size_t)((l * 4 + b) * 16 + h) * 64 + half * 32 + row2) * 64 + jg * 8; *(f32x4*)sp = Sa; *(f32x4*)(sp + 4) = Sb; }
    __syncthreads();
}
__device__ __forceinline__ void scan_mlstm(LAS unsigned char* lds, int l, int u) {
    const int tid = opaque_tid(), lane = tid & 63, wave = tid >> 6, lr = lane & 15, lq = lane >> 4;
    const int bh = u >> 2, sl = u & 3, b = bh >> 2, h = bh & 3;
    const bf16_t* __restrict__ proj = (const bf16_t*)(ctx_ws(lds) + WS_PROJ); const bf16_t* __restrict__ qm = (const bf16_t*)(ctx_ws(lds) + WS_QM); const bf16_t* __restrict__ km = (const bf16_t*)(ctx_ws(lds) + WS_KM);
    const float* __restrict__ gates = (const float*)(ctx_ws(lds) + WS_GATES); bf16_t* __restrict__ hm = (bf16_t*)(ctx_ws(lds) + WS_HM);
    LAS bf16_t* kS = (LAS bf16_t*)lds;
    LAS bf16_t* kwT = (LAS bf16_t*)(lds + 33792);
    LAS bf16_t* vT = (LAS bf16_t*)(lds + 33792 + 36864);
    LAS bf16_t* Sp = (LAS bf16_t*)(lds + 33792 + 36864 + 11520);
    LAS bf16_t* CT = (LAS bf16_t*)(lds + 33792 + 36864 + 11520 + 9216);
    LAS float* gF = (LAS float*)(lds + 33792 + 36864 + 11520 + 9216 + 42240);
    LAS float* gU = gF + 64; LAS float* gM = gF + 128; LAS float* gS = gF + 192; LAS float* gD = gF + 196;
    __syncthreads();
    for (int i = tid; i < 80 * 264 / 2; i += NTHREADS) ((LAS unsigned*)CT)[i] = 0u;
    for (int i = tid; i < 16 * 72; i += NTHREADS) vT[64 * 72 + i] = (i < 72) ? (bf16_t)0x3F80 : (bf16_t)0;
    f32x4 acc[2][5];
#pragma unroll
    for (int i = 0; i < 2; ++i)
#pragma unroll
        for (int j = 0; j < 5; ++j) acc[i][j] = (f32x4){0.f, 0.f, 0.f, 0.f};
    float m_prev = 0.f;
    const int tt = wave >> 1, wodd = wave & 1, s = tid & 63, eg = tid >> 6;
    const size_t mb = (size_t)b * 2048;
    u32x4 pv = *(const u32x4*)(proj + (mb + s) * NINP + M0 + 2048 + h * 256 + sl * 64 + eg * 8);
    u32x4 pk[4];
#pragma unroll
    for (int j = 0; j < 4; ++j) pk[j] = *(const u32x4*)(km + (mb + s) * 1024 + h * 256 + (eg + 8 * j) * 8);
    bf16x8 qf[8];
#pragma unroll
    for (int ks = 0; ks < 8; ++ks) qf[ks] = *(const bf16x8*)(qm + (mb + tt * 16 + lr) * 1024 + h * 256 + ks * 32 + lq * 8);
    float pig = gates[(mb + lane) * 8 + h], plf = gates[(mb + lane) * 8 + 4 + h];
    for (int c = 0; c < 32; ++c) {
        const size_t m0 = mb + c * 64;
        if (wave == 0) {
            float F = plf;
#pragma unroll
            for (int o = 1; o < 64; o <<= 1) { const float t = __shfl_up(F, o); if (lane >= o) F += t; }
            const float uu = pig - F; float am = uu;
#pragma unroll
            for (int o = 1; o < 64; o <<= 1) { const float t = __shfl_up(am, o); if (lane >= o) am = fmaxf(am, t); }
            const float Mt = fmaxf(m_prev, am);
            gF[lane] = F; gU[lane] = uu; gM[lane] = Mt;
            if (lane == 63) { gS[0] = __expf(m_prev - Mt); gS[1] = Mt; gS[2] = F + Mt; }
        }
        { vT[(eg * 8 + 0) * 72 + s] = (bf16_t)(pv.x & 0xffffu); vT[(eg * 8 + 1) * 72 + s] = (bf16_t)(pv.x >> 16); vT[(eg * 8 + 2) * 72 + s] = (bf16_t)(pv.y & 0xffffu); vT[(eg * 8 + 3) * 72 + s] = (bf16_t)(pv.y >> 16);
          vT[(eg * 8 + 4) * 72 + s] = (bf16_t)(pv.z & 0xffffu); vT[(eg * 8 + 5) * 72 + s] = (bf16_t)(pv.z >> 16); vT[(eg * 8 + 6) * 72 + s] = (bf16_t)(pv.w & 0xffffu); vT[(eg * 8 + 7) * 72 + s] = (bf16_t)(pv.w >> 16);
#pragma unroll
          for (int j = 0; j < 4; ++j) *(LAS u32x4*)(kS + s * 264 + (eg + 8 * j) * 8) = pk[j]; }
        __syncthreads();
        const float a_c = gS[0], ML = gS[1], m_new = gS[2];
        { const float ws = __expf(gU[s] - ML);
#pragma unroll
          for (int j = 0; j < 4; ++j) { const int d0 = (eg + 8 * j) * 8; float k[8]; unpack8(pk[j], k);
#pragma unroll
              for (int i = 0; i < 8; ++i) kwT[(d0 + i) * 72 + s] = f2bf(k[i] * ws); } }
        const size_t m1 = mb + (size_t)(c + 1 < 32 ? c + 1 : 31) * 64;
        pig = gates[(m1 + lane) * 8 + h]; plf = gates[(m1 + lane) * 8 + 4 + h];
        pv = *(const u32x4*)(proj + (m1 + s) * NINP + M0 + 2048 + h * 256 + sl * 64 + eg * 8);
#pragma unroll
        for (int j = 0; j < 4; ++j) pk[j] = *(const u32x4*)(km + (m1 + s) * 1024 + h * 256 + (eg + 8 * j) * 8);
#pragma unroll
        for (int q = 0; q < 2; ++q) { const int ts = 2 * wodd + q;
            f32x4 sacc = {0.f, 0.f, 0.f, 0.f};
            if (ts <= tt) {
#pragma unroll
                for (int ks = 0; ks < 8; ++ks) { const bf16x8 kf = *(const LAS bf16x8*)(kS + (ts * 16 + lr) * 264 + ks * 32 + lq * 8); sacc = MFMA16(qf[ks], kf, sacc); }
            }
            const int sc = ts * 16 + lr; const float us = gU[sc];
#pragma unroll
            for (int r = 0; r < 4; ++r) { const int t = tt * 16 + lq * 4 + r; const float v = (sc <= t) ? sacc[r] * __expf(us - gM[t]) : 0.f; Sp[t * 72 + sc] = f2bf(v); }
        }
        __syncthreads();
        f32x4 hn[3];
#pragma unroll
        for (int q = 0; q < 3; ++q) { const int te = wodd ? 3 + q : q; hn[q] = (f32x4){0.f, 0.f, 0.f, 0.f}; if (te < 5) {
            f32x4 aq = {0.f, 0.f, 0.f, 0.f}, as = {0.f, 0.f, 0.f, 0.f};
#pragma unroll
            for (int ks = 0; ks < 8; ++ks) { const bf16x8 cf = *(const LAS bf16x8*)(CT + (te * 16 + lr) * 264 + ks * 32 + lq * 8); aq = MFMA16(qf[ks], cf, aq); }
#pragma unroll
            for (int ks = 0; ks < 2; ++ks) { const bf16x8 sf = *(const LAS bf16x8*)(Sp + (tt * 16 + lr) * 72 + ks * 32 + lq * 8); const bf16x8 vf = *(const LAS bf16x8*)(vT + (te * 16 + lr) * 72 + ks * 32 + lq * 8); as = MFMA16(sf, vf, as); }
#pragma unroll
            for (int r = 0; r < 4; ++r) { const int t = tt * 16 + lq * 4 + r; hn[q][r] = __expf(m_prev - gM[t]) * aq[r] + as[r]; }
            if (te == 4 && lr == 0) {
#pragma unroll
                for (int r = 0; r < 4; ++r) gD[tt * 16 + lq * 4 + r] = hn[q][r]; }
        } }
#pragma unroll
        for (int ks = 0; ks < 8; ++ks) qf[ks] = *(const bf16x8*)(qm + (m1 + tt * 16 + lr) * 1024 + h * 256 + ks * 32 + lq * 8);
#pragma unroll
        for (int i = 0; i < 2; ++i) { const int dt = wave * 2 + i;
            bf16x8 kf[2];
#pragma unroll
            for (int ks = 0; ks < 2; ++ks) kf[ks] = *(const LAS bf16x8*)(kwT + (dt * 16 + lr) * 72 + ks * 32 + lq * 8);
#pragma unroll
            for (int et = 0; et < 5; ++et) { acc[i][et] = acc[i][et] * a_c;
#pragma unroll
                for (int ks = 0; ks < 2; ++ks) { const bf16x8 vf = *(const LAS bf16x8*)(vT + (et * 16 + lr) * 72 + ks * 32 + lq * 8); acc[i][et] = MFMA16(kf[ks], vf, acc[i][et]); } } }
        __syncthreads();
#pragma unroll
        for (int i = 0; i < 2; ++i) { const int dt = wave * 2 + i;
#pragma unroll
            for (int et = 0; et < 5; ++et) { u32x2 w; w.x = pk2(acc[i][et][0], acc[i][et][1]); w.y = pk2(acc[i][et][2], acc[i][et][3]);
                *(LAS u32x2*)(CT + (et * 16 + lr) * 264 + dt * 16 + lq * 4) = w; } }
        { float dd[4];
#pragma unroll
          for (int r = 0; r < 4; ++r) { const int t = tt * 16 + lq * 4 + r; dd[r] = 1.f / fmaxf(fabsf(gD[t]), __expf(-(gF[t] + gM[t]))); }
#pragma unroll
          for (int q = 0; q < 3; ++q) { const int te = wodd ? 3 + q : q; if (te < 4) {
#pragma unroll
              for (int r = 0; r < 4; ++r) hm[(m0 + tt * 16 + lq * 4 + r) * 1024 + h * 256 + sl * 64 + te * 16 + lr] = f2bf(hn[q][r] * dd[r]); } } }
        m_prev = m_new;
        __syncthreads();
    }
#pragma unroll
    for (int i = 0; i < 2; ++i) { const int dt = wave * 2 + i;
#pragma unroll
        for (int et = 0; et < 5; ++et)
#pragma unroll
            for (int r = 0; r < 4; ++r) { const int d = dt * 16 + lq * 4 + r;
                if (et < 4) ctx_out(lds)[O_PC + ((size_t)((l * 4 + b) * 4 + h) * 256 + d) * 256 + sl * 64 + et * 16 + lr] = acc[i][et][r];
                else if (sl == 0 && lr == 0) ctx_out(lds)[O_PN + (size_t)((l * 4 + b) * 4 + h) * 256 + d] = acc[i][et][r]; } }
    if (sl == 0 && tid == 0) ctx_out(lds)[O_PM + (l * 4 + b) * 4 + h] = m_prev;
    __syncthreads();
}
__device__ __forceinline__ void scan_gla(LAS unsigned char* lds, int l, int u) {
    const int tid = opaque_tid(), lane = tid & 63, wave = tid >> 6, lr = lane & 15, lq = lane >> 4;
    const int bh = u >> 2, sl = u & 3, b = bh >> 2, h = bh & 3;
    const bf16_t* __restrict__ proj = (const bf16_t*)(ctx_ws(lds) + WS_PROJ); const bf16_t* __restrict__ gq = (const bf16_t*)(ctx_ws(lds) + WS_GQ); const bf16_t* __restrict__ gk = (const bf16_t*)(ctx_ws(lds) + WS_GK); const bf16_t* __restrict__ gkh = (const bf16_t*)(ctx_ws(lds) + WS_GKH);
    const float* __restrict__ egl = (const float*)(ctx_ws(lds) + WS_EGL); bf16_t* __restrict__ og = (bf16_t*)(ctx_ws(lds) + WS_OG);
    LAS bf16_t* khT = (LAS bf16_t*)lds;
    LAS bf16_t* vT = (LAS bf16_t*)(lds + 18432);
    LAS bf16_t* Ap = (LAS bf16_t*)(lds + 18432 + 9216);
    LAS bf16_t* ST = (LAS bf16_t*)(lds + 36864);
    LAS bf16_t* kS = (LAS bf16_t*)(lds + 36864 + 17408);
    __syncthreads();
    for (int i = tid; i < 64 * 136 / 2; i += NTHREADS) ((LAS unsigned*)ST)[i] = 0u;
    f32x4 acc[4];
#pragma unroll
    for (int j = 0; j < 4; ++j) acc[j] = (f32x4){0.f, 0.f, 0.f, 0.f};
    const int tt = wave >> 1, wodd = wave & 1, s = tid & 63, eg = tid >> 6;
    const size_t mb = (size_t)b * 2048;
    u32x4 pv = *(const u32x4*)(proj + (mb + s) * NINP + G0 + 1024 + h * 256 + sl * 64 + eg * 8);
    u32x4 pkh[2], pgk[2];
#pragma unroll
    for (int j = 0; j < 2; ++j) { pkh[j] = *(const u32x4*)(gkh + (mb + s) * 512 + h * 128 + (eg + 8 * j) * 8); pgk[j] = *(const u32x4*)(gk + (mb + s) * 512 + h * 128 + (eg + 8 * j) * 8); }
    bf16x8 qf[4];
#pragma unroll
    for (int ks = 0; ks < 4; ++ks) qf[ks] = *(const bf16x8*)(gq + (mb + tt * 16 + lr) * 512 + h * 128 + ks * 32 + lq * 8);
    float eg4[4];
#pragma unroll
    for (int r = 0; r < 4; ++r) eg4[r] = egl[(size_t)(b * 32) * 512 + h * 128 + wave * 16 + lq * 4 + r];
    for (int c = 0; c < 32; ++c) {
        const int cidx = b * 32 + c; const size_t m0 = (size_t)cidx * 64;
        { vT[(eg * 8 + 0) * 72 + s] = (bf16_t)(pv.x & 0xffffu); vT[(eg * 8 + 1) * 72 + s] = (bf16_t)(pv.x >> 16); vT[(eg * 8 + 2) * 72 + s] = (bf16_t)(pv.y & 0xffffu); vT[(eg * 8 + 3) * 72 + s] = (bf16_t)(pv.y >> 16);
          vT[(eg * 8 + 4) * 72 + s] = (bf16_t)(pv.z & 0xffffu); vT[(eg * 8 + 5) * 72 + s] = (bf16_t)(pv.z >> 16); vT[(eg * 8 + 6) * 72 + s] = (bf16_t)(pv.w & 0xffffu); vT[(eg * 8 + 7) * 72 + s] = (bf16_t)(pv.w >> 16);
#pragma unroll
          for (int j = 0; j < 2; ++j) { const int d0 = (eg + 8 * j) * 8; const u32x4 w = pkh[j];
              khT[(d0 + 0) * 72 + s] = (bf16_t)(w.x & 0xffffu); khT[(d0 + 1) * 72 + s] = (bf16_t)(w.x >> 16); khT[(d0 + 2) * 72 + s] = (bf16_t)(w.y & 0xffffu); khT[(d0 + 3) * 72 + s] = (bf16_t)(w.y >> 16);
              khT[(d0 + 4) * 72 + s] = (bf16_t)(w.z & 0xffffu); khT[(d0 + 5) * 72 + s] = (bf16_t)(w.z >> 16); khT[(d0 + 6) * 72 + s] = (bf16_t)(w.w & 0xffffu); khT[(d0 + 7) * 72 + s] = (bf16_t)(w.w >> 16);
              *(LAS u32x4*)(kS + s * 136 + d0) = pgk[j]; } }
        __syncthreads();
        const float e0 = eg4[0], e1 = eg4[1], e2 = eg4[2], e3 = eg4[3];
        const int cn = c + 1 < 32 ? cidx + 1 : cidx; const size_t m1 = (size_t)cn * 64;
        pv = *(const u32x4*)(proj + (m1 + s) * NINP + G0 + 1024 + h * 256 + sl * 64 + eg * 8);
#pragma unroll
        for (int j = 0; j < 2; ++j) { pkh[j] = *(const u32x4*)(gkh + (m1 + s) * 512 + h * 128 + (eg + 8 * j) * 8); pgk[j] = *(const u32x4*)(gk + (m1 + s) * 512 + h * 128 + (eg + 8 * j) * 8); }
#pragma unroll
        for (int r = 0; r < 4; ++r) eg4[r] = egl[(size_t)cn * 512 + h * 128 + wave * 16 + lq * 4 + r];
#pragma unroll
        for (int q = 0; q < 2; ++q) { const int ts = 2 * wodd + q;
            f32x4 sacc = {0.f, 0.f, 0.f, 0.f};
            if (ts <= tt) {
#pragma unroll
                for (int ks = 0; ks < 4; ++ks) { const bf16x8 kf = *(const LAS bf16x8*)(kS + (ts * 16 + lr) * 136 + ks * 32 + lq * 8); sacc = MFMA16(qf[ks], kf, sacc); }
            }
            const int sc = ts * 16 + lr;
#pragma unroll
            for (int r = 0; r < 4; ++r) { const int t = tt * 16 + lq * 4 + r; Ap[t * 72 + sc] = f2bf((sc <= t) ? sacc[r] : 0.f); }
        }
        __syncthreads();
#pragma unroll
        for (int q = 0; q < 2; ++q) { const int te = 2 * wodd + q;
            f32x4 ao = {0.f, 0.f, 0.f, 0.f};
#pragma unroll
            for (int ks = 0; ks < 4; ++ks) { const bf16x8 sf = *(const LAS bf16x8*)(ST + (te * 16 + lr) * 136 + ks * 32 + lq * 8); ao = MFMA16(qf[ks], sf, ao); }
#pragma unroll
            for (int ks = 0; ks < 2; ++ks) { const bf16x8 af = *(const LAS bf16x8*)(Ap + (tt * 16 + lr) * 72 + ks * 32 + lq * 8); const bf16x8 vf = *(const LAS bf16x8*)(vT + (te * 16 + lr) * 72 + ks * 32 + lq * 8); ao = MFMA16(af, vf, ao); }
#pragma unroll
            for (int r = 0; r < 4; ++r) og[(m0 + tt * 16 + lq * 4 + r) * 1024 + h * 256 + sl * 64 + te * 16 + lr] = f2bf(ao[r]);
        }
#pragma unroll
        for (int ks = 0; ks < 4; ++ks) qf[ks] = *(const bf16x8*)(gq + (m1 + tt * 16 + lr) * 512 + h * 128 + ks * 32 + lq * 8);
        { const int dt = wave;
          bf16x8 kf[2];
#pragma unroll
          for (int ks = 0; ks < 2; ++ks) kf[ks] = *(const LAS bf16x8*)(khT + (dt * 16 + lr) * 72 + ks * 32 + lq * 8);
#pragma unroll
          for (int et = 0; et < 4; ++et) {
              acc[et][0] *= e0; acc[et][1] *= e1; acc[et][2] *= e2; acc[et][3] *= e3;
#pragma unroll
              for (int ks = 0; ks < 2; ++ks) { const bf16x8 vf = *(const LAS bf16x8*)(vT + (et * 16 + lr) * 72 + ks * 32 + lq * 8); acc[et] = MFMA16(kf[ks], vf, acc[et]); } } }
        __syncthreads();
#pragma unroll
        for (int et = 0; et < 4; ++et) { u32x2 w; w.x = pk2(acc[et][0], acc[et][1]); w.y = pk2(acc[et][2], acc[et][3]);
            *(LAS u32x2*)(ST + (et * 16 + lr) * 136 + wave * 16 + lq * 4) = w; }
        __syncthreads();
    }
#pragma unroll
    for (int et = 0; et < 4; ++et)
#pragma unroll
        for (int r = 0; r < 4; ++r) ctx_out(lds)[O_PGLA + ((size_t)((l * 4 + b) * 4 + h) * 128 + wave * 16 + lq * 4 + r) * 256 + sl * 64 + et * 16 + lr] = acc[et][r];
    __syncthreads();
}
#ifndef SC_MASK
#define SC_MASK 63
#endif
constexpr unsigned N_SITEMS = 8192u;
__device__ __forceinline__ f32x4 xsum4(const f32x4 v, int o) { return (f32x4){v.x + __shfl_xor(v.x, o), v.y + __shfl_xor(v.y, o), v.z + __shfl_xor(v.z, o), v.w + __shfl_xor(v.w, o)}; }
__device__ __forceinline__ f32x4 bf4(const u32x2 w) { return (f32x4){__uint_as_float(w.x << 16), __uint_as_float(w.x & 0xffff0000u), __uint_as_float(w.y << 16), __uint_as_float(w.y & 0xffff0000u)}; }
#define PIN8(a, i0) asm volatile("" : "+v"(a[i0]), "+v"(a[i0 + 1]), "+v"(a[i0 + 2]), "+v"(a[i0 + 3]), "+v"(a[i0 + 4]), "+v"(a[i0 + 5]), "+v"(a[i0 + 6]), "+v"(a[i0 + 7]))
__device__ __forceinline__ void witem_mlstm(LAS unsigned char* lds, LAS float* wl, int l, int it, int lane) {
    const int es = it & 7, h = (it >> 3) & 3, s = it >> 5, c = lane & 7, rr = lane >> 3, e0 = es * 32 + c * 4;
    const bf16_t* __restrict__ proj = (const bf16_t*)(ctx_ws(lds) + WS_PROJ); const bf16_t* __restrict__ qm = (const bf16_t*)(ctx_ws(lds) + WS_QM); const bf16_t* __restrict__ km = (const bf16_t*)(ctx_ws(lds) + WS_KM);
    const float* __restrict__ gates = (const float*)(ctx_ws(lds) + WS_GATES); bf16_t* __restrict__ hm = (bf16_t*)(ctx_ws(lds) + WS_HM);
    const size_t m = MP + s; const size_t sb = (size_t)(l * 128 + s) * 4 + h;
    const float* __restrict__ Cs = ctx_in(lds, I_SC) + sb * 65536 + (size_t)(rr * 32) * 256 + e0; float* Co = ctx_out(lds) + O_SC + sb * 65536 + (size_t)(rr * 32) * 256 + e0;
    f32x4 cb[32];
#pragma unroll
    for (int i = 0; i < 32; ++i) cb[i] = *(const f32x4*)(Cs + (size_t)i * 256);
    const float* __restrict__ nin = ctx_in(lds, I_SN) + sb * 256;
    const f32x4 q4 = bf4(*(const u32x2*)(qm + m * 1024 + h * 256 + lane * 4)), k4 = bf4(*(const u32x2*)(km + m * 1024 + h * 256 + lane * 4)), n4 = *(const f32x4*)(nin + lane * 4);
    const f32x4 v4 = bf4(*(const u32x2*)(proj + m * NINP + M0 + 2048 + h * 256 + e0)), nE = *(const f32x4*)(nin + e0);
    const float ig = gates[m * 8 + h], lf = gates[m * 8 + 4 + h], m_prev = ctx_in(lds, I_SM)[sb];
    *(LAS f32x4*)(wl + lane * 4) = q4; *(LAS f32x4*)(wl + 256 + lane * 4) = k4;
    const float qk = wave_sum((q4.x * k4.x + q4.y * k4.y) + (q4.z * k4.z + q4.w * k4.w)), qn = wave_sum((q4.x * n4.x + q4.y * n4.y) + (q4.z * n4.z + q4.w * n4.w));
    const float uu = ig - lf, Mx = fmaxf(m_prev, uu), m_t = lf + Mx, w_inter = __expf(m_prev - Mx), ws = __expf(uu - Mx), Sv = qk * ws;
    __builtin_amdgcn_wave_barrier();
    PIN8(cb, 0); PIN8(cb, 8); PIN8(cb, 16); PIN8(cb, 24);
    f32x4 num = {0.f, 0.f, 0.f, 0.f};
#pragma unroll
    for (int i4 = 0; i4 < 8; ++i4) { const f32x4 qd = *(const LAS f32x4*)(wl + rr * 32 + i4 * 4), kd = *(const LAS f32x4*)(wl + 256 + rr * 32 + i4 * 4);
#pragma unroll
        for (int j = 0; j < 4; ++j) { const f32x4 c4 = cb[i4 * 4 + j]; num = num + qd[j] * c4; *(f32x4*)(Co + (size_t)(i4 * 4 + j) * 256) = w_inter * c4 + (ws * kd[j]) * v4; } }
    num = xsum4(num, 8); num = xsum4(num, 16); num = xsum4(num, 32);
    if (rr == 0) { const f32x4 kE = *(const LAS f32x4*)(wl + 256 + e0);
        const float den = w_inter * qn + Sv, dinv = 1.f / fmaxf(fabsf(den), __expf(-m_t));
        const f32x4 nm = w_inter * num + Sv * v4;
        u32x2 w; w.x = pk2(nm.x * dinv, nm.y * dinv); w.y = pk2(nm.z * dinv, nm.w * dinv);
        *(u32x2*)(hm + m * 1024 + h * 256 + e0) = w;
        *(f32x4*)(ctx_out(lds) + O_SN + sb * 256 + e0) = w_inter * nE + ws * kE;
        if (es == 0 && lane == 0) ctx_out(lds)[O_SM + sb] = m_t; }
    __builtin_amdgcn_wave_barrier();
}
__device__ __forceinline__ void witem_gla(LAS unsigned char* lds, LAS float* wl, int l, int it, int lane) {
    const int es = it & 3, h = (it >> 2) & 3, s = it >> 4, c = lane & 15, rr = lane >> 4, e0 = es * 64 + c * 4;
    const bf16_t* __restrict__ proj = (const bf16_t*)(ctx_ws(lds) + WS_PROJ); const bf16_t* __restrict__ gq = (const bf16_t*)(ctx_ws(lds) + WS_GQ); const bf16_t* __restrict__ gk = (const bf16_t*)(ctx_ws(lds) + WS_GK); const bf16_t* __restrict__ gkh = (const bf16_t*)(ctx_ws(lds) + WS_GKH);
    const float* __restrict__ egl = (const float*)(ctx_ws(lds) + WS_EGL); bf16_t* __restrict__ og = (bf16_t*)(ctx_ws(lds) + WS_OG);
    const size_t m = MP + s; const size_t sb = (size_t)(l * 128 + s) * 4 + h;
    const float* __restrict__ Ss = ctx_in(lds, I_SGLA) + sb * 32768 + (size_t)(rr * 32) * 256 + e0; float* So = ctx_out(lds) + O_SGLA + sb * 32768 + (size_t)(rr * 32) * 256 + e0;
    f32x4 st[32];
#pragma unroll
    for (int i = 0; i < 32; ++i) st[i] = *(const f32x4*)(Ss + (size_t)i * 256);
    const unsigned qw = *(const unsigned*)(gq + m * 512 + h * 128 + lane * 2), kw = *(const unsigned*)(gk + m * 512 + h * 128 + lane * 2), hw = *(const unsigned*)(gkh + m * 512 + h * 128 + lane * 2);
    const f32x2_t e2 = *(const f32x2_t*)(egl + (size_t)(128 + s) * 512 + h * 128 + lane * 2);
    const f32x4 v4 = bf4(*(const u32x2*)(proj + m * NINP + G0 + 1024 + h * 256 + e0));
    const float q0 = __uint_as_float(qw << 16), q1 = __uint_as_float(qw & 0xffff0000u);
    *(LAS f32x2_t*)(wl + lane * 2) = (f32x2_t){q0, q1}; *(LAS f32x2_t*)(wl + 128 + lane * 2) = (f32x2_t){__uint_as_float(hw << 16), __uint_as_float(hw & 0xffff0000u)}; *(LAS f32x2_t*)(wl + 256 + lane * 2) = e2;
    const float A = wave_sum(q0 * __uint_as_float(kw << 16) + q1 * __uint_as_float(kw & 0xffff0000u));
    __builtin_amdgcn_wave_barrier();
    PIN8(st, 0); PIN8(st, 8); PIN8(st, 16); PIN8(st, 24);
    f32x4 o4 = {0.f, 0.f, 0.f, 0.f};
#pragma unroll
    for (int i4 = 0; i4 < 8; ++i4) { const f32x4 qd = *(const LAS f32x4*)(wl + rr * 32 + i4 * 4), hd = *(const LAS f32x4*)(wl + 128 + rr * 32 + i4 * 4), ed = *(const LAS f32x4*)(wl + 256 + rr * 32 + i4 * 4);
#pragma unroll
        for (int j = 0; j < 4; ++j) { const f32x4 s4 = st[i4 * 4 + j]; o4 = o4 + qd[j] * s4; *(f32x4*)(So + (size_t)(i4 * 4 + j) * 256) = ed[j] * s4 + hd[j] * v4; } }
    o4 = xsum4(o4, 16); o4 = xsum4(o4, 32);
    if (rr == 0) { const f32x4 r = o4 + A * v4; u32x2 w; w.x = pk2(r.x, r.y); w.y = pk2(r.z, r.w); *(u32x2*)(og + m * 1024 + h * 256 + e0) = w; }
    __builtin_amdgcn_wave_barrier();
}
__device__ __forceinline__ void witem_rwkv(LAS unsigned char* lds, int l, int it, int lane) {
    const int s = it >> 4, h = it & 15, r0 = lane >> 2, kq = lane & 3;
    const float* __restrict__ rpre = (const float*)(ctx_ws(lds) + WS_RPRE); bf16_t* __restrict__ rout = (bf16_t*)(ctx_ws(lds) + WS_ROUT);
    const size_t m = MP + s, po = m * 1024 + h * 64 + kq * 16;
    const size_t so = ((size_t)((l * 128 + s) * 16 + h) * 64 + r0) * 64 + kq * 16;
    const float* __restrict__ sp = ctx_in(lds, I_SWKV) + so; float* So = ctx_out(lds) + O_SWKV + so;
    const bf16_t* rb = (const bf16_t*)rpre; const float* rw = (const float*)((const unsigned char*)rpre + RP_W);
    f32x4 S[16];
#pragma unroll
    for (int p = 0; p < 4; ++p)
#pragma unroll
        for (int k = 0; k < 4; ++k) S[p * 4 + k] = *(const f32x4*)(sp + p * 1024 + k * 4);
    f32x4 kk[4], bb[4], ww[4], k2[4], rr[4];
    { float t0[16], t1[16], t2[16], t3[16];
      ld16b(rb + po, t0); ld16b(rb + ARR + po, t1); ld16b(rb + 2 * ARR + po, t2); ld16b(rb + 3 * ARR + po, t3);
#pragma unroll
      for (int k = 0; k < 4; ++k) { ww[k] = *(const f32x4*)(rw + po + k * 4);
          kk[k] = (f32x4){t0[4 * k], t0[4 * k + 1], t0[4 * k + 2], t0[4 * k + 3]}; bb[k] = (f32x4){t1[4 * k], t1[4 * k + 1], t1[4 * k + 2], t1[4 * k + 3]};
          k2[k] = (f32x4){t2[4 * k], t2[4 * k + 1], t2[4 * k + 2], t2[4 * k + 3]}; rr[k] = (f32x4){t3[4 * k], t3[4 * k + 1], t3[4 * k + 2], t3[4 * k + 3]}; } }
    float vv[4];
#pragma unroll
    for (int p = 0; p < 4; ++p) vv[p] = bf2f(rb[4 * ARR + m * 1024 + h * 64 + r0 + 16 * p]);
    PIN8(S, 0); PIN8(S, 8);
#pragma unroll
    for (int p = 0; p < 4; ++p) {
        float sa = 0.f;
#pragma unroll
        for (int k = 0; k < 4; ++k) { const f32x4 x = S[p * 4 + k]; sa += (x.x * kk[k].x + x.y * kk[k].y) + (x.z * kk[k].z + x.w * kk[k].w); }
        sa = quad_sum(sa);
        float o = 0.f;
#pragma unroll
        for (int k = 0; k < 4; ++k) { const f32x4 n4 = S[p * 4 + k] * ww[k] - sa * bb[k] + vv[p] * k2[k]; o += (n4.x * rr[k].x + n4.y * rr[k].y) + (n4.z * rr[k].z + n4.w * rr[k].w);
            *(f32x4*)(So + p * 1024 + k * 4) = n4; }
        o = quad_sum(o);
        if (kq == 0) rout[m * 1024 + h * 64 + r0 + 16 * p] = f2bf(o);
    }
}
__device__ __forceinline__ unsigned wave_pop(unsigned* queue, int lane) {
    unsigned v = 0u;
    if (lane == 0) v = __hip_atomic_fetch_add(queue, 1u, __ATOMIC_RELAXED, __HIP_MEMORY_SCOPE_AGENT);
    return (unsigned)__builtin_amdgcn_readfirstlane((int)v);
}
__device__ __forceinline__ void wave_item(LAS unsigned char* lds, int l, unsigned it, int tid) {
    LAS float* wl = (LAS float*)(lds + 102400 + (tid >> 6) * 4096); const int lane = tid & 63;
    if (it < 4096u) { if (SC_MASK & 16) witem_mlstm(lds, wl, l, (int)it, lane); }
    else if (it < 6144u) { if (SC_MASK & 32) witem_gla(lds, wl, l, (int)it - 4096, lane); }
    else { if (SC_MASK & 8) witem_rwkv(lds, l, (int)it - 6144, lane); }
}
__device__ __forceinline__ void phase_scan(LAS unsigned char* lds, int l, int G, unsigned* queue, int rmask) {
    for (int u = blockIdx.x; u < 256; u += G) {
        const int slot = u >> 3, x = u & 7, role = slot & 3, s2 = slot >> 2;
        const int idx = role < 2 ? (s2 * 8 + x) : ((x * 2 + (s2 >> 2)) * 4 + (s2 & 3));
        if (rmask && !((rmask >> (role < 2 ? 0 : role - 1)) & 1)) continue;
        if (role < 2) { if (SC_MASK & 1) scan_rwkv(lds, l, idx * 2 + role); }
        else if (role == 2) { if (SC_MASK & 2) scan_mlstm(lds, l, idx); }
        else { if (SC_MASK & 4) scan_gla(lds, l, idx); }
    }
    __syncthreads();
    for (;;) { const unsigned it = wave_pop(queue, (int)threadIdx.x & 63); if (it >= N_SITEMS) break; wave_item(lds, l, it, opaque_tid()); }
}

__device__ __forceinline__ void ld16l(const LAS float* p, float (&f)[16]) {
#pragma unroll
    for (int k = 0; k < 4; ++k) { const f32x4 t = *(const LAS f32x4*)(p + 4 * k); f[4 * k] = t.x; f[4 * k + 1] = t.y; f[4 * k + 2] = t.z; f[4 * k + 3] = t.w; }
}
__device__ __forceinline__ void phase_post(LAS unsigned char* lds, int l, int G) {
    const int tid = opaque_tid(), lane = tid & 63, wave = tid >> 6, c0 = lane * 16;
    const bf16_t* __restrict__ proj = (const bf16_t*)(ctx_ws(lds) + WS_PROJ); const float* __restrict__ rpre = (const float*)(ctx_ws(lds) + WS_RPRE); const bf16_t* __restrict__ rout = (const bf16_t*)(ctx_ws(lds) + WS_ROUT);
    const bf16_t* __restrict__ hm = (const bf16_t*)(ctx_ws(lds) + WS_HM); const bf16_t* __restrict__ og = (const bf16_t*)(ctx_ws(lds) + WS_OG); bf16_t* __restrict__ obr = (bf16_t*)(ctx_ws(lds) + WS_QM);
    LAS float* pl = (LAS float*)lds;
    __syncthreads();
    for (int i = tid; i < 11264; i += NTHREADS) { float v;
        if (i < 1024) v = ctx_in(lds, I_RK)[l * 1024 + i]; else if (i < 2048) v = ctx_in(lds, I_LNG)[l * 1024 + i - 1024]; else if (i < 3072) v = ctx_in(lds, I_LNB)[l * 1024 + i - 2048];
        else if (i < 4096) v = ctx_in(lds, I_MNORM)[l * 1024 + i - 3072]; else if (i < 5120) v = ctx_in(lds, I_GNORM)[l * 1024 + i - 4096]; else v = ctx_in(lds, I_GATEB)[(size_t)l * 6144 + i - 5120];
        pl[i] = v; }
    __syncthreads();
    for (int it = blockIdx.x * 8 + wave; it < MP + 512; it += G * 8) {
        const int m = it < MP ? it : MP + ((it - MP) >> 2); const int part = it < MP ? -1 : (it - MP) & 3;
        const size_t o = (size_t)m * 1024 + c0;
        const bf16_t* prow = proj + (size_t)m * NINP;
        u32x4 L[30];
#define POST_LD(slot, ptr) do { L[slot] = *(const u32x4*)(ptr); L[(slot) + 1] = *(const u32x4*)((ptr) + 8); } while (0)
        if (part < 0 || part == 0) { POST_LD(0, rout + o); POST_LD(2, (const bf16_t*)rpre + 3 * ARR + o); POST_LD(4, (const bf16_t*)rpre + 2 * ARR + o); POST_LD(6, (const bf16_t*)rpre + 4 * ARR + o); POST_LD(8, (const bf16_t*)rpre + 5 * ARR + o); }
        if (part < 0 || part == 1) { POST_LD(10, hm + o); POST_LD(12, prow + M0 + 3080 + c0); }
        if (part < 0 || part == 2) { POST_LD(14, og + o); POST_LD(16, prow + G0 + 2064 + c0); }
        if (part < 0 || part == 3) {
#pragma unroll
            for (int q = 0; q < 2; ++q)
#pragma unroll
                for (int j = 0; j < 3; ++j) POST_LD(18 + (q * 3 + j) * 2, prow + GT0 + j * 2048 + q * 1024 + c0); }
#undef POST_LD
#define POST_UP(slot, arr) do { unpack8(L[slot], *(float(*)[8])&arr[0]); unpack8(L[(slot) + 1], *(float(*)[8])&arr[8]); } while (0)
        if (part < 0 || part == 0) {
            float x[16], r[16], k2[16], v[16], g[16], rk[16], lg[16], lb[16];
            POST_UP(0, x); POST_UP(2, r); POST_UP(4, k2); POST_UP(6, v); POST_UP(8, g);
            ld16l(pl + c0, rk); ld16l(pl + 1024 + c0, lg); ld16l(pl + 2048 + c0, lb);
            float s = 0.f, bs = 0.f;
#pragma unroll
            for (int j = 0; j < 16; ++j) { s += x[j]; bs += r[j] * k2[j] * rk[j]; }
            s += __shfl_xor(s, 1); s += __shfl_xor(s, 2); bs += __shfl_xor(bs, 1); bs += __shfl_xor(bs, 2);
            const float mean = s * (1.f / 64.f); float q = 0.f;
#pragma unroll
            for (int j = 0; j < 16; ++j) { const float d = x[j] - mean; q += d * d; }
            q += __shfl_xor(q, 1); q += __shfl_xor(q, 2);
            const float rstd = rsqrtf(q * (1.f / 64.f) + 64e-5f);
            float y[16];
#pragma unroll
            for (int j = 0; j < 16; ++j) y[j] = ((x[j] - mean) * rstd * lg[j] + lb[j] + bs * v[j]) * g[j];
            st16b(obr + (size_t)m * 3072 + c0, y);
        }
        if (part < 0 || part == 1) {
            float x[16], ng[16], go[16];
            POST_UP(10, x); POST_UP(12, go); ld16l(pl + 3072 + c0, ng);
            float q = 0.f;
#pragma unroll
            for (int j = 0; j < 16; ++j) q += x[j] * x[j];
            q += __shfl_xor(q, 1); q += __shfl_xor(q, 2); q += __shfl_xor(q, 4); q += __shfl_xor(q, 8);
            const float rs = rsqrtf(q * (1.f / 256.f) + 1e-6f);
            float y[16];
#pragma unroll
            for (int j = 0; j < 16; ++j) y[j] = x[j] * rs * ng[j] * sigm(go[j]);
            st16b(obr + (size_t)m * 3072 + 1024 + c0, y);
        }
        if (part < 0 || part == 2) {
            float x[16], ng[16], go[16];
            POST_UP(14, x); POST_UP(16, go); ld16l(pl + 4096 + c0, ng);
            float q = 0.f;
#pragma unroll
            for (int j = 0; j < 16; ++j) q += x[j] * x[j];
            q += __shfl_xor(q, 1); q += __shfl_xor(q, 2); q += __shfl_xor(q, 4); q += __shfl_xor(q, 8);
            const float rs = rsqrtf(q * (1.f / 256.f) + 1e-6f);
            float y[16];
#pragma unroll
            for (int j = 0; j < 16; ++j) y[j] = x[j] * rs * ng[j] * siluf(go[j]);
            st16b(obr + (size_t)m * 3072 + 2048 + c0, y);
        }
        if (part < 0 || part == 3) {
            bf16_t* __restrict__ gr = (bf16_t*)(ctx_ws(lds) + WS_RPRE + RP_GR) + (size_t)m * 6144; const float* __restrict__ gbv = ctx_in(lds, I_GATEB) + (size_t)l * 3 * 2048;
#pragma unroll
            for (int q = 0; q < 2; ++q) { const int d0 = q * 1024 + c0;
                float e0[16], e1[16], e2[16], gb[16];
                POST_UP(18 + (q * 3 + 0) * 2, e0); POST_UP(18 + (q * 3 + 1) * 2, e1); POST_UP(18 + (q * 3 + 2) * 2, e2);
                ld16l(pl + 5120 + d0, gb);
#pragma unroll
                for (int j = 0; j < 16; ++j) e0[j] = 1.f + __expf(-(e0[j] + gb[j]));
                ld16l(pl + 5120 + 2048 + d0, gb);
#pragma unroll
                for (int j = 0; j < 16; ++j) e1[j] = 1.f + __expf(-(e1[j] + gb[j]));
                ld16l(pl + 5120 + 4096 + d0, gb);
#pragma unroll
                for (int j = 0; j < 16; ++j) { e2[j] = 1.f + __expf(-(e2[j] + gb[j])); const float i0 = __builtin_amdgcn_rcpf(e0[j]), i1 = __builtin_amdgcn_rcpf(e1[j]), i2 = __builtin_amdgcn_rcpf(e2[j]);
                    e0[j] = e1[j] * i0; e1[j] = e2[j] * i1; e2[j] = i2; }
                st16b(gr + d0, e0); st16b(gr + 2048 + d0, e1); st16b(gr + 4096 + d0, e2); }
        }
#undef POST_UP
    }
}

template <int MODE>
__device__ __forceinline__ void skinny_phase(LAS unsigned char* lds, const bf16_t* A, int lda, const bf16_t* Bt, int ldb, int K, float* X, bf16_t* merged, const bf16_t* gr, const float* unused, int G) {
    const int tid = opaque_tid(), lane = tid & 63, wave = tid >> 6, lr = lane & 15, lq = lane >> 4, rt = wave & 3, kh = wave >> 2;
    LAS float* xch = (LAS float*)lds;
    for (int u = blockIdx.x; u < 256; u += G) {
        const int cg = u >> 1, rh = u & 1;
        const bf16_t* ap = A + (size_t)(MP + rh * 64 + rt * 16 + lr) * lda + lq * 8;
        const bf16_t* bp = Bt + (size_t)(cg * 16 + lr) * ldb + lq * 8;
        const int row0 = MP + rh * 64 + rt * 16 + lq * 4, col = cg * 16 + lr;
        constexpr int NJ = MODE == 0 ? 1 : 3;
        const int Kj = MODE == 0 ? K : 1024, Kh = Kj / 2;
        f32x4 acc[NJ];
#pragma unroll
        for (int j = 0; j < NJ; ++j) {
            f32x4 a0c = {0.f, 0.f, 0.f, 0.f}, a1c = {0.f, 0.f, 0.f, 0.f};
            const bf16_t* aj = ap + j * 1024 + kh * Kh; const bf16_t* bj = bp + j * 1024 + kh * Kh;
            bf16x8 av[8], bv[8], an[8], bn[8];
#pragma unroll
            for (int i = 0; i < 8; ++i) { av[i] = *(const bf16x8*)(aj + i * 32); bv[i] = *(const bf16x8*)(bj + i * 32); }
            for (int k0 = 0; k0 < Kh; k0 += 256) {
                const int kn = k0 + 256 < Kh ? k0 + 256 : k0;
#pragma unroll
                for (int i = 0; i < 8; ++i) { an[i] = *(const bf16x8*)(aj + kn + i * 32); bn[i] = *(const bf16x8*)(bj + kn + i * 32); }
#pragma unroll
                for (int i = 0; i < 8; i += 2) { a0c = MFMA16(av[i], bv[i], a0c); a1c = MFMA16(av[i + 1], bv[i + 1], a1c); }
#pragma unroll
                for (int i = 0; i < 8; ++i) { av[i] = an[i]; bv[i] = bn[i]; }
            }
            acc[j] = a0c + a1c;
        }
        __syncthreads();
        if (kh == 1) {
#pragma unroll
            for (int j = 0; j < NJ; ++j) *(LAS f32x4*)(xch + ((j * 4 + rt) * 64 + lane) * 4) = acc[j]; }
        __syncthreads();
        if (kh == 0) {
#pragma unroll
            for (int j = 0; j < NJ; ++j) acc[j] = acc[j] + *(const LAS f32x4*)(xch + ((j * 4 + rt) * 64 + lane) * 4);
            if (MODE == 0) {
                { float xo[4];
#pragma unroll
                  for (int r = 0; r < 4; ++r) xo[r] = X[(size_t)(row0 + r) * 2048 + col];
                  asm volatile("" : "+v"(xo[0]), "+v"(xo[1]), "+v"(xo[2]), "+v"(xo[3]));
#pragma unroll
                  for (int r = 0; r < 4; ++r) X[(size_t)(row0 + r) * 2048 + col] = xo[r] + acc[0][r]; }
            } else {
#pragma unroll
                for (int r = 0; r < 4; ++r) { float o = 0.f;
#pragma unroll
                    for (int j = 0; j < NJ; ++j) o = (o + acc[j][r]) * bf2f(gr[(size_t)(row0 + r) * 6144 + j * 2048 + col]);
                    merged[(size_t)(row0 + r) * 2048 + col] = f2bf(o); }
            }
        }
    }
}

constexpr int N_PHASES = 22;
constexpr int CW_BAR = 1024, CW_QUEUE = 8192;

__global__ void __launch_bounds__(NTHREADS, 2) fwd_kernel(Args a) {
    extern __shared__ __attribute__((aligned(16))) unsigned char lds_raw[];
    LAS unsigned char* lds = (LAS unsigned char*)lds_raw;
    const int tid = opaque_tid(), G = gridDim.x;
    volatile LAS unsigned* misc = (volatile LAS unsigned*)(lds + 147456 - 64);
    if (tid < 16) misc[tid] = 0u;
    if (tid < 39) ((LAS unsigned long long*)(lds + PTAB_OFF))[tid] = ((const unsigned long long*)&a)[tid];
    __syncthreads();
    unsigned* ctl = (unsigned*)(ctx_ws(lds) + WS_CTL);
    XcdBarrier bar; bar.bar = ctl + CW_BAR; bar.x = 0; bar.st = misc;
    if (MK_N_LAUNCHES == 1) bar = xcd_barrier_post(ctl + CW_BAR, misc);
    const int lo = a.ph_lo, hi = a.ph_hi & 0xff, rmask = (a.ph_hi >> 8) & 0xff;
#ifndef PH_MASK
#define PH_MASK 0xFFFu
#endif
#define PHM(b) ((PH_MASK >> (b)) & 1u)
#define IN(k) (lo <= (k) && (k) < hi)
#define SEAM(k) do { if (MK_N_LAUNCHES == 1 && IN(k) && IN((k) + 1)) xcd_barrier(bar); } while (0)
    if (PHM(0) && IN(0)) { phase_prologue(lds, opq(G)); SEAM(0); }
#pragma nounroll
    for (int l = 0; l < 2; ++l) {
        const int pb = 1 + 10 * l;
        if (PHM(1) && IN(pb + 0)) { phase_norm(lds, opq(G), ctx_in(lds, I_NORM1) + opq(l) * 2048, opq(l) == 0); SEAM(pb + 0); }
        if (PHM(2) && IN(pb + 1)) {
            pg8::Gemm g{(const bf16_t*)(ctx_ws(lds) + WS_H), (const bf16_t*)(ctx_ws(lds) + WS_W + (size_t)opq(l) * LW_BYTES + LW_WIN), MPAD, NINP, 2048, 2048, 2048};
            pg8::StaticOrder S; S.init(MPAD, NINP, opq(G), (int)blockIdx.x);
            pg8::EpiProj E{(bf16_t*)(ctx_ws(lds) + WS_PROJ), NINP};
            pg8::gemm_phase(lds, g, S, E);
            SEAM(pb + 1);
        }
        if (PHM(3) && IN(pb + 2)) { phase_pre(lds, opq(l), opq(G)); SEAM(pb + 2); }
        if (PHM(4) && IN(pb + 3)) { phase_scan(lds, opq(l), opq(G), (unsigned*)(ctx_ws(lds) + WS_CTL) + CW_QUEUE + 64 * opq(l), rmask); SEAM(pb + 3); }
        if (PHM(5) && IN(pb + 4)) { phase_post(lds, opq(l), opq(G)); SEAM(pb + 4); }
        if (PHM(6) && IN(pb + 5)) {
            pg8::StaticOrder S; S.init(MP, 2048, opq(G), (int)blockIdx.x);
            const bf16_t* obr = (const bf16_t*)(ctx_ws(lds) + WS_QM); const bf16_t* wbr = (const bf16_t*)(ctx_ws(lds) + WS_W + (size_t)opq(l) * LW_BYTES + LW_WBR);
            bf16_t* merged = (bf16_t*)(ctx_ws(lds) + WS_H); const bf16_t* gr = (const bf16_t*)(ctx_ws(lds) + WS_RPRE + RP_GR);
            { pg8::Gemm g{obr, wbr, MP, 2048, 3072, 3072, 3072}; pg8::EpiBranchK E{merged, gr}; pg8::gemm_phase(lds, g, S, E); }
            skinny_phase<1>(lds, obr, 3072, wbr, 3072, 3072, nullptr, merged, gr, nullptr, opq(G));
            SEAM(pb + 5);
        }
        if (PHM(7) && IN(pb + 6)) {
            pg8::Gemm g{(const bf16_t*)(ctx_ws(lds) + WS_H), (const bf16_t*)(ctx_ws(lds) + WS_W + (size_t)opq(l) * LW_BYTES + LW_WOUT), MP, 2048, 2048, 2048, 2048};
            pg8::StaticOrder S; S.init(MP, 2048, opq(G), (int)blockIdx.x);
            pg8::EpiResid E{(float*)(ctx_ws(lds) + WS_X), 2048};
            pg8::gemm_phase(lds, g, S, E);
            skinny_phase<0>(lds, g.A, 2048, g.Bt, 2048, 2048, (float*)(ctx_ws(lds) + WS_X), nullptr, nullptr, nullptr, opq(G));
            SEAM(pb + 6);
        }
        if (PHM(8) && IN(pb + 7)) { phase_norm(lds, opq(G), ctx_in(lds, I_NORM2) + opq(l) * 2048, false); SEAM(pb + 7); }
        if (PHM(9) && IN(pb + 8)) {
            pg8::Gemm g{(const bf16_t*)(ctx_ws(lds) + WS_H), (const bf16_t*)(ctx_ws(lds) + WS_W + (size_t)opq(l) * LW_BYTES + LW_WGU), MPAD, 11264, 2048, 2048, 2048};
            pg8::StaticOrder S; S.init(MPAD, 11264, opq(G), (int)blockIdx.x);
            pg8::EpiSwiGLU E{(bf16_t*)(ctx_ws(lds) + WS_PROJ), DFF};
            pg8::gemm_phase(lds, g, S, E);
            SEAM(pb + 8);
        }
        if (PHM(10) && IN(pb + 9)) {
            pg8::Gemm g{(const bf16_t*)(ctx_ws(lds) + WS_PROJ), (const bf16_t*)(ctx_ws(lds) + WS_W + (size_t)opq(l) * LW_BYTES + LW_WDN), MP, 2048, DFF, DFF, DFF};
            pg8::StaticOrder S; S.init(MP, 2048, opq(G), (int)blockIdx.x);
            pg8::EpiResid E{(float*)(ctx_ws(lds) + WS_X), 2048};
            pg8::gemm_phase(lds, g, S, E);
            skinny_phase<0>(lds, g.A, DFF, g.Bt, DFF, DFF, (float*)(ctx_ws(lds) + WS_X), nullptr, nullptr, nullptr, opq(G));
            SEAM(pb + 9);
        }
    }
    if (PHM(11) && IN(21)) phase_final(lds, opq(G));
    if (IN(22)) phase_dump(lds, G);
#undef IN
#undef SEAM
}

extern "C" void kernel_launch(void* const* d_in, const int* in_sizes, int n_in, void* d_out, int out_size, void* d_ws, size_t ws_size, hipStream_t stream) {
    static int grid = 0;
    if (grid == 0) {
        if (n_in != 37 || ws_size < WS_END) { fprintf(stderr, "kernel_launch: expected 37 inputs and >= %zu bytes of workspace; got %d, %zu\n", (size_t)WS_END, n_in, ws_size); grid = -1; return; }
        int dev = 0, cus = 0, per_cu = 0;
        if (hipGetDevice(&dev) != hipSuccess || hipDeviceGetAttribute(&cus, hipDeviceAttributeMultiprocessorCount, dev) != hipSuccess) { grid = -1; return; }
        if (hipFuncSetAttribute((const void*)fwd_kernel, hipFuncAttributeMaxDynamicSharedMemorySize, LDS_BYTES) != hipSuccess) { fprintf(stderr, "kernel_launch: hipFuncSetAttribute failed\n"); grid = -1; return; }
        if (hipOccupancyMaxActiveBlocksPerMultiprocessor(&per_cu, (const void*)fwd_kernel, NTHREADS, LDS_BYTES) != hipSuccess || per_cu < 1) { fprintf(stderr, "kernel_launch: occupancy query says %d\n", per_cu); }
        (void)hipGetLastError();
        grid = cus;
    }
    if (grid < 0) return;
    (void)hipMemsetAsync((char*)d_ws + WS_CTL, 0, CTL_BYTES, stream);
    Args a{};
    for (int i = 0; i < 37; ++i) a.in[i] = (const float*)d_in[i];
    a.out = (float*)d_out; a.ws = (unsigned char*)d_ws;
    if (MK_N_LAUNCHES == 1) { a.ph_lo = 0; a.ph_hi = N_PHASES; hipLaunchKernelGGL(fwd_kernel, dim3(grid), dim3(NTHREADS), LDS_BYTES, stream, a); }
    else { for (int p = 0; p < DBG_LIM; ++p) { a.ph_lo = p; a.ph_hi = p + 1; hipLaunchKernelGGL(fwd_kernel, dim3(grid), dim3(NTHREADS), LDS_BYTES, stream, a);
            const int kind = p == 0 ? 0 : (p == 21 ? 11 : 1 + (p - 1) % 10);
            if ((DBG_REP_MASK >> kind) & 1) { a.ph_hi = (p + 1) | (DBG_ROLE_MASK << 8); hipLaunchKernelGGL(fwd_kernel, dim3(grid), dim3(NTHREADS), LDS_BYTES, stream, a); } }
        if (DBG_LIM < 22) { a.ph_lo = 22; a.ph_hi = 23; hipLaunchKernelGGL(fwd_kernel, dim3(grid), dim3(NTHREADS), LDS_BYTES, stream, a); } }
}
```

```cpp
#include <hip/hip_runtime.h>
#include <cstdio>
#include <cstdint>

#ifndef MK_N_LAUNCHES
#define MK_N_LAUNCHES 1
#endif

#ifndef DBG_LIM
#define DBG_LIM 22
#ifndef DBG_ROLE_MASK
#define DBG_ROLE_MASK 0
#endif
#ifndef DBG_REP_MASK
#define DBG_REP_MASK 0
#endif
#define DBG_SEL 2
#endif
#define LAS __attribute__((address_space(3)))
typedef unsigned short bf16_t;
typedef short bf16x8 __attribute__((ext_vector_type(8)));
typedef float f32x4 __attribute__((ext_vector_type(4)));
typedef unsigned u32x4 __attribute__((ext_vector_type(4)));
typedef unsigned u32x2 __attribute__((ext_vector_type(2)));

constexpr int DM = 2048, MP = 8192, MT = 8320, MPAD = 8448, NINP = 16640, NIN = 16600;
constexpr int RC = 3264, M0 = 3264, G0 = 7368, GT0 = 10456, DFF = 5632;
constexpr int NTHREADS = 512;
constexpr size_t O_YP = 0, O_YS = 16777216, O_PSHIFT = 17039360, O_PWKV = 17065472, O_PCONV = 17589760, O_PC = 17638912, O_PN = 19736064, O_PM = 19744256,
                 O_PGLA = 19744288, O_SSHIFT = 20792864, O_SWKV = 21628448, O_SCONV = 38405664, O_SC = 39978528, O_SN = 107087392, O_SM = 107349536, O_SGLA = 107350560;
constexpr size_t AL(size_t x) { return (x + 255) & ~(size_t)255; }
constexpr size_t WS_CTL = 0, CTL_BYTES = 1u << 20;
constexpr int CW_DEFQ = 8192 + 256;
constexpr size_t LW_WIN = 0, LW_WBR = LW_WIN + (size_t)NINP * 2048 * 2, LW_WOUT = LW_WBR + (size_t)3 * 2048 * 1024 * 2, LW_WGU = LW_WOUT + (size_t)2048 * 2048 * 2,
                 LW_WDN = LW_WGU + (size_t)11264 * 2048 * 2, LW_LORA = LW_WDN + (size_t)2048 * 5632 * 2, LW_GA2 = LW_LORA + (size_t)3 * 1024 * 64 * 2, LW_BYTES = LW_GA2 + (size_t)512 * 32 * 2;
constexpr size_t WS_W = CTL_BYTES;
constexpr size_t WS_X = AL(WS_W + 2 * LW_BYTES);
constexpr size_t WS_H = AL(WS_X + (size_t)MPAD * 2048 * 4);
constexpr size_t WS_PROJ = AL(WS_H + (size_t)MPAD * 2048 * 2);
constexpr size_t ARR = (size_t)MT * 1024;
constexpr size_t WS_RPRE = AL(WS_PROJ + (size_t)MPAD * NINP * 2);
constexpr size_t WS_ROUT = AL(WS_RPRE + 7 * ARR * 4);
constexpr size_t WS_QM = AL(WS_ROUT + ARR * 4);
constexpr size_t WS_KM = WS_QM + ARR * 2, WS_GQ = WS_KM + ARR * 2, WS_GK = WS_GQ + ARR, WS_GKH = WS_GK + ARR;
constexpr size_t WS_GATES = AL(WS_GKH + ARR);
constexpr size_t WS_EGL = AL(WS_GATES + (size_t)MT * 8 * 4);
constexpr size_t WS_HM = AL(WS_EGL + (size_t)256 * 512 * 4);
constexpr size_t WS_OG = AL(WS_HM + ARR * 4);
constexpr size_t WS_END = AL(WS_OG + ARR * 4);
static_assert((size_t)MPAD * 3072 * 2 <= WS_GATES - WS_QM, "obr alias");
static_assert((size_t)MPAD * 2048 * 4 <= 7 * ARR * 4, "macc alias");

__device__ __forceinline__ float bf2f(bf16_t b) { return __uint_as_float(((unsigned)b) << 16); }
typedef __bf16 bf16x2_t __attribute__((ext_vector_type(2)));
typedef float f32x2_t __attribute__((ext_vector_type(2)));
__device__ __forceinline__ unsigned pk2(float lo, float hi) { const f32x2_t v = {lo, hi}; return __builtin_bit_cast(unsigned, __builtin_convertvector(v, bf16x2_t)); }
__device__ __forceinline__ bf16_t f2bf(float f) { return (bf16_t)(pk2(f, 0.f) & 0xffffu); }
__device__ __forceinline__ void unpack8(const u32x4 w, float (&f)[8]) {
    f[0] = __uint_as_float(w.x << 16); f[1] = __uint_as_float(w.x & 0xffff0000u); f[2] = __uint_as_float(w.y << 16); f[3] = __uint_as_float(w.y & 0xffff0000u);
    f[4] = __uint_as_float(w.z << 16); f[5] = __uint_as_float(w.z & 0xffff0000u); f[6] = __uint_as_float(w.w << 16); f[7] = __uint_as_float(w.w & 0xffff0000u);
}
__device__ __forceinline__ u32x4 pack8(const float (&f)[8]) { u32x4 w; w.x = pk2(f[0], f[1]); w.y = pk2(f[2], f[3]); w.z = pk2(f[4], f[5]); w.w = pk2(f[6], f[7]); return w; }
__device__ __forceinline__ void ld8f(const float* p, float (&f)[8]) { const f32x4 a = *(const f32x4*)p, b = *(const f32x4*)(p + 4); f[0] = a.x; f[1] = a.y; f[2] = a.z; f[3] = a.w; f[4] = b.x; f[5] = b.y; f[6] = b.z; f[7] = b.w; }
__device__ __forceinline__ void st8f(float* p, const float (&f)[8]) { *(f32x4*)p = (f32x4){f[0], f[1], f[2], f[3]}; *(f32x4*)(p + 4) = (f32x4){f[4], f[5], f[6], f[7]}; }
__device__ __forceinline__ void ld8b(const bf16_t* p, float (&f)[8]) { unpack8(*(const u32x4*)p, f); }
__device__ __forceinline__ float sigm(float x) { return 1.f / (1.f + __expf(-x)); }
__device__ __forceinline__ float siluf(float x) { return x / (1.f + __expf(-x)); }
__device__ __forceinline__ float tanh_fast(float x) { const float e = __expf(2.f * x); return 1.f - 2.f / (e + 1.f); }
__device__ __forceinline__ float logsig_fast(float x) { return fminf(x, 0.f) - __logf(1.f + __expf(-fabsf(x))); }
__device__ __forceinline__ float wave_sum(float v) {
#pragma unroll
    for (int o = 1; o < 64; o <<= 1) v += __shfl_xor(v, o);
    return v;
}
template <int CTRL> __device__ __forceinline__ float dppf(float v) { return __int_as_float(__builtin_amdgcn_update_dpp(0, __float_as_int(v), CTRL, 0xF, 0xF, true)); }
__device__ __forceinline__ float row16_sum(float x) { x += dppf<0xB1>(x); x += dppf<0x4E>(x); x += dppf<0x141>(x); x += dppf<0x140>(x); return x; }
__device__ __forceinline__ float row8_sum(float x) { x += dppf<0xB1>(x); x += dppf<0x4E>(x); x += dppf<0x141>(x); return x; }
__device__ __forceinline__ float quad_sum(float x) { x += dppf<0xB1>(x); x += dppf<0x4E>(x); return x; }
__device__ __forceinline__ int opq(int x) { asm volatile("" : "+s"(x)); return x; }
__device__ __forceinline__ int opaque_tid() { int t = threadIdx.x; asm volatile("" : "+v"(t)); return t; }
__device__ __forceinline__ f32x4 mfma16_safe(const bf16x8 a, const bf16x8 b, const f32x4 c) { f32x4 d = __builtin_amdgcn_mfma_f32_16x16x32_bf16(a, b, c, 0, 0, 0); asm volatile("" : "+v"(d) : "v"(a), "v"(b)); return d; }
#define MFMA16(a, b, c) mfma16_safe((a), (b), (c))
#define LDS_WAIT() asm volatile("s_waitcnt lgkmcnt(0)" ::: "memory")

#define XB_TMO      128
#define XB_XCNT(j)  (256  + 64 * (j))
#define XB_XSUB(j)  (1280 + 64 * (j))
#define XB_XGEN(j)  (2304 + 64 * (j))
#define XB_TOP      3328
#define XB_TOPGEN   3392
#define XCD_BAR_WORDS 3456
#define XB_SPIN_CAP (1u << 18)
__device__ __forceinline__ unsigned xb_ld(unsigned* p)              { return __hip_atomic_load(p, __ATOMIC_RELAXED, __HIP_MEMORY_SCOPE_AGENT); }
__device__ __forceinline__ unsigned xb_add(unsigned* p, unsigned v) { return __hip_atomic_fetch_add(p, v, __ATOMIC_RELAXED, __HIP_MEMORY_SCOPE_AGENT); }
__device__ __forceinline__ unsigned xb_xcc_id() { return (unsigned)__builtin_amdgcn_s_getreg((3 << 11) | 20) & 0xFu; }
#define XB_SPIN(cond, bar) do { unsigned _sp = 0; while (cond) { __builtin_amdgcn_s_sleep(1); \
    if ((++_sp & 255u) == 0u) { if (xb_ld(&(bar)[XB_TMO])) break; if (_sp > XB_SPIN_CAP) { atomicAdd(&(bar)[XB_TMO], 1u); break; } } } } while (0)
struct XcdBarrier { unsigned* bar; unsigned x; volatile LAS unsigned* st; };
__device__ __forceinline__ XcdBarrier xcd_barrier_post(unsigned* bar, volatile LAS unsigned* st) {
    XcdBarrier b; b.bar = bar; b.x = xb_xcc_id(); b.st = st;
    if (threadIdx.x == 0) (void)xb_add(&bar[XB_XCNT(b.x)], 1u);
    return b;
}
__device__ __forceinline__ void xcd_barrier_complete(unsigned* bar, unsigned x, unsigned& nloc, unsigned& nx) {
    const unsigned G = gridDim.x * gridDim.y * gridDim.z;
    unsigned sum, cnt, mine, sp = 0u;
    for (;;) {
        sum = 0u; cnt = 0u; mine = 0u;
#pragma unroll
        for (unsigned j = 0; j < 16; ++j) { const unsigned c = xb_ld(&bar[XB_XCNT(j)]); sum += c; cnt += (c > 0u) ? 1u : 0u; mine = (j == x) ? c : mine; }
        if (sum == G) break;
        __builtin_amdgcn_s_sleep(1);
        if ((++sp & 255u) == 0u) { if (xb_ld(&bar[XB_TMO])) break; if (sp > XB_SPIN_CAP) { atomicAdd(&bar[XB_TMO], 1u); break; } }
    }
    nloc = mine > 0u ? mine : 1u; nx = cnt > 0u ? cnt : 1u;
}
__device__ __forceinline__ void xcd_barrier(const XcdBarrier& b) {
    asm volatile("s_waitcnt vmcnt(0)" ::: "memory");
    __syncthreads();
    if (threadIdx.x == 0) {
        unsigned* bar = b.bar;
        __builtin_amdgcn_s_waitcnt(0);
        unsigned nloc = b.st[0], nx = b.st[1];
        if (nloc == 0u) { xcd_barrier_complete(bar, b.x, nloc, nx); b.st[0] = nloc; b.st[1] = nx; }
        const unsigned old = xb_add(&bar[XB_XSUB(b.x)], 1u);
        const unsigned gen = old / nloc;
        if (old + 1u == (gen + 1u) * nloc) {
            __builtin_amdgcn_fence(__ATOMIC_RELEASE, "agent");
            asm volatile("s_waitcnt vmcnt(0)" ::: "memory");
            const unsigned og = xb_add(&bar[XB_TOP], 1u);
            const unsigned tg = og / nx;
            if (og + 1u == (tg + 1u) * nx) xb_add(&bar[XB_TOPGEN], 1u);
            else XB_SPIN(xb_ld(&bar[XB_TOPGEN]) == tg, bar);
            __builtin_amdgcn_fence(__ATOMIC_ACQUIRE, "agent");
            xb_add(&bar[XB_XGEN(b.x)], 1u);
            asm volatile("s_waitcnt vmcnt(0)" ::: "memory");
        } else {
            XB_SPIN(xb_ld(&bar[XB_XGEN(b.x)]) == gen, bar);
            __builtin_amdgcn_fence(__ATOMIC_ACQUIRE, "agent");
            asm volatile("s_waitcnt vmcnt(0)" ::: "memory");
        }
    }
    __syncthreads();
}

namespace pg8 {
constexpr int BM = 256, BK = 64, HALF = 128, HTB = HALF * BK * 2, STAGE_BYTES = 8 * HTB, NXCD = 8, WGM = 8;
__host__ __device__ __forceinline__ int lds_byte(int r, int c) { const int st = (r >> 4) * 2 + (c >> 5), rr = r & 15, cc = c & 31, ob = rr * 64 + cc * 2; return st * 1024 + (ob ^ (((ob >> 9) & 1) << 5)); }
__host__ __device__ __forceinline__ void stage_rc(int b, int& R, int& C) { const int st = b / 1024, sb = b % 1024, swz = sb ^ (((sb >> 9) & 1) << 5); R = (st >> 1) * 16 + swz / 64; C = (st & 1) * 32 + (swz % 64) / 2; }
__host__ __device__ __forceinline__ int perm32(int rho) { const int n = rho >> 4, i = rho & 15; return 8 * (i >> 2) + 4 * n + (i & 3); }
struct Unit { int pm, pn; };
struct Gemm { const bf16_t* A; const bf16_t* Bt; int M, N, K, lda, ldb; };
struct StaticOrder {
    int nM, nN, nwg, G, c;
    __device__ void init(int M, int N, int G_, int c_) { nM = M / BM; nN = N / BM; nwg = nM * nN; G = G_; c = c_; }
    __device__ bool next(int i, Unit& u) const {
        const long L = (long)i * G + c; if (L >= nwg) return false;
        int wgid = (int)L; { const int q = nwg / NXCD, r = nwg % NXCD, xcd = wgid % NXCD, off = wgid / NXCD; wgid = (xcd < r ? xcd * (q + 1) : r * (q + 1) + (xcd - r) * q) + off; }
        const int nig = WGM * nN, gid = wgid / nig, fm = gid * WGM, gsz = (nM - fm) < WGM ? (nM - fm) : WGM;
        u.pm = fm + ((wgid % nig) % gsz); u.pn = (wgid % nig) / gsz; return true;
    }
};
struct EpiProj {
    static constexpr bool PERM = true, HOOK = false;
    bf16_t* O; int ldc;
    __device__ __forceinline__ void operator()(const f32x4 (&acc)[2][2][4][2], const Unit& u, int wr, int wc, int fr, int fq) const {
        const int row0 = u.pm * BM + wr * 64 + fr, col0 = u.pn * BM + wc * 32 + 8 * fq;
#pragma unroll
        for (int ai = 0; ai < 2; ++ai)
#pragma unroll
            for (int m = 0; m < 4; ++m) { bf16_t* rowp = O + (size_t)(row0 + ai * HALF + m * 16) * ldc + col0;
#pragma unroll
                for (int bj = 0; bj < 2; ++bj) { const f32x4 v0 = acc[ai][bj][m][0], v1 = acc[ai][bj][m][1];
                    u32x4 w; w.x = pk2(v0[0], v0[1]); w.y = pk2(v0[2], v0[3]); w.z = pk2(v1[0], v1[1]); w.w = pk2(v1[2], v1[3]);
                    *(u32x4*)(rowp + bj * HALF) = w; } }
    }
};
struct EpiSwiGLU {
    static constexpr bool PERM = true, HOOK = false;
    bf16_t* O; int ldc;
    __device__ __forceinline__ void operator()(const f32x4 (&acc)[2][2][4][2], const Unit& u, int wr, int wc, int fr, int fq) const {
        const int row0 = u.pm * BM + wr * 64 + fr, col0 = u.pn * HALF + wc * 32 + 8 * fq;
#pragma unroll
        for (int ai = 0; ai < 2; ++ai)
#pragma unroll
            for (int m = 0; m < 4; ++m) { bf16_t* rowp = O + (size_t)(row0 + ai * HALF + m * 16) * ldc + col0;
                float o[8];
#pragma unroll
                for (int n = 0; n < 2; ++n)
#pragma unroll
                    for (int j = 0; j < 4; ++j) o[n * 4 + j] = siluf(acc[ai][0][m][n][j]) * acc[ai][1][m][n][j];
                *(u32x4*)rowp = pack8(o); }
    }
};
struct EpiResid {
    static constexpr bool PERM = false, HOOK = false;
    float* X; int ldc;
    __device__ __forceinline__ void operator()(const f32x4 (&acc)[2][2][4][2], const Unit& u, int wr, int wc, int fr, int fq) const {
        const int row0 = u.pm * BM + wr * 64 + fr, col0 = u.pn * BM + wc * 32 + 4 * fq;
#pragma unroll
        for (int ai = 0; ai < 2; ++ai) {
            f32x4 xv[4][2][2];
#pragma unroll
            for (int m = 0; m < 4; ++m)
#pragma unroll
                for (int bj = 0; bj < 2; ++bj)
#pragma unroll
                    for (int n = 0; n < 2; ++n) xv[m][bj][n] = *(const f32x4*)(X + (size_t)(row0 + ai * HALF + m * 16) * ldc + col0 + bj * HALF + n * 16);
#pragma unroll
            for (int m = 0; m < 4; ++m) asm volatile("" : "+v"(xv[m][0][0]), "+v"(xv[m][0][1]), "+v"(xv[m][1][0]), "+v"(xv[m][1][1]));
#pragma unroll
            for (int m = 0; m < 4; ++m)
#pragma unroll
                for (int bj = 0; bj < 2; ++bj)
#pragma unroll
                    for (int n = 0; n < 2; ++n) *(f32x4*)(X + (size_t)(row0 + ai * HALF + m * 16) * ldc + col0 + bj * HALF + n * 16) = xv[m][bj][n] + acc[ai][bj][m][n];
        }
    }
};
struct EpiBranchK {
    static constexpr bool PERM = true, HOOK = true;
    bf16_t* merged; const bf16_t* gr;
    __device__ __forceinline__ void hook(f32x4 (&acc)[2][2][4][2], const Unit& u, int jn, int wr, int wc, int fr, int fq) const {
        int row0 = u.pm * BM + wr * 64 + fr, col0 = u.pn * BM + wc * 32 + 8 * fq;
        asm volatile("" : "+v"(row0), "+v"(col0));
        u32x4 rv[2][4][2];
#pragma unroll
        for (int ai = 0; ai < 2; ++ai)
#pragma unroll
            for (int m = 0; m < 4; ++m)
#pragma unroll
                for (int bj = 0; bj < 2; ++bj) rv[ai][m][bj] = *(const u32x4*)(gr + (size_t)(row0 + ai * HALF + m * 16) * 6144 + (jn - 1) * 2048 + col0 + bj * HALF);
#pragma unroll
        for (int ai = 0; ai < 2; ++ai)
#pragma unroll
            for (int m = 0; m < 4; ++m)
#pragma unroll
                for (int bj = 0; bj < 2; ++bj) { float r[8]; unpack8(rv[ai][m][bj], r);
#pragma unroll
                    for (int i = 0; i < 8; ++i) acc[ai][bj][m][i >> 2][i & 3] *= r[i]; }
    }
    __device__ __forceinline__ void operator()(const f32x4 (&acc)[2][2][4][2], const Unit& u, int wr, int wc, int fr, int fq) const {
        const int row0 = u.pm * BM + wr * 64 + fr, col0 = u.pn * BM + wc * 32 + 8 * fq;
        u32x4 rv[2][4][2];
#pragma unroll
        for (int ai = 0; ai < 2; ++ai)
#pragma unroll
            for (int m = 0; m < 4; ++m)
#pragma unroll
                for (int bj = 0; bj < 2; ++bj) rv[ai][m][bj] = *(const u32x4*)(gr + (size_t)(row0 + ai * HALF + m * 16) * 6144 + 4096 + col0 + bj * HALF);
#pragma unroll
        for (int ai = 0; ai < 2; ++ai)
#pragma unroll
            for (int m = 0; m < 4; ++m) asm volatile("" : "+v"(rv[ai][m][0]), "+v"(rv[ai][m][1]));
#pragma unroll
        for (int ai = 0; ai < 2; ++ai)
#pragma unroll
            for (int m = 0; m < 4; ++m) { const int row = row0 + ai * HALF + m * 16;
#pragma unroll
                for (int bj = 0; bj < 2; ++bj) { float r[8], o[8]; unpack8(rv[ai][m][bj], r);
#pragma unroll
                    for (int i = 0; i < 8; ++i) o[i] = acc[ai][bj][m][i >> 2][i & 3] * r[i];
                    *(u32x4*)(merged + (size_t)row * 2048 + col0 + bj * HALF) = pack8(o); } }
    }
};

template <class Epi>
__device__ __forceinline__ void gemm_phase(LAS unsigned char* lds, const Gemm g, const StaticOrder& S, const Epi& E) {
    const int tid = opaque_tid(), wid = __builtin_amdgcn_readfirstlane(tid >> 6), lane = tid & 63, wr = wid >> 2, wc = wid & 3, fr = lane & 15, fq = lane >> 4;
    const int K = g.K, nt = K / BK;
    unsigned voffA[2], voffB[2];
#pragma unroll
    for (int i = 0; i < 2; ++i) { int R, C; stage_rc(tid * 16 + i * 8192, R, C); const int Rb = Epi::PERM ? ((R & ~31) + perm32(R & 31)) : R;
        voffA[i] = (unsigned)(R * g.lda + C) * 2u; voffB[i] = (unsigned)(Rb * g.ldb + C) * 2u; }
    const size_t kstep = (size_t)(BK * 2);
    const size_t hstepA = (size_t)HALF * g.lda * 2, hstepB = (size_t)HALF * g.ldb * 2;
    const size_t tstepA = 2 * hstepA, tstepB = 2 * hstepB;
    const unsigned ldsw = (unsigned)wid * 1024u;
    const int aoff = lds_byte(wr * 64 + fr, fq * 8), boff = lds_byte(wc * 32 + fr, fq * 8);
#define PG8_SA(b, h) (((b) * 2 + (h)) * HTB)
#define PG8_SB(b, h) ((4 + (b) * 2 + (h)) * HTB)
#define PG8_STAGE(bufoff, gbase, voff) do { _Pragma("unroll") for (int _i = 0; _i < 2; ++_i) \
        __builtin_amdgcn_global_load_lds((const unsigned*)((const char*)(gbase) + (voff)[_i]), (LAS unsigned*)(lds + (bufoff) + ldsw + _i * 8192), 16, 0, 0); } while (0)
#define PG8_LDA(dst, b, h) do { _Pragma("unroll") for (int m = 0; m < 4; ++m) _Pragma("unroll") for (int k = 0; k < 2; ++k) dst[m][k] = *(const LAS bf16x8*)(lds + PG8_SA(b, h) + aoff + m * 2048 + k * 1024); } while (0)
#define PG8_LDB(dst, b, h) do { _Pragma("unroll") for (int n = 0; n < 2; ++n) _Pragma("unroll") for (int k = 0; k < 2; ++k) dst[n][k] = *(const LAS bf16x8*)(lds + PG8_SB(b, h) + boff + n * 2048 + k * 1024); } while (0)
#define PG8_MMA(ai, bj, At, Bt) do { __builtin_amdgcn_s_setprio(1); _Pragma("unroll") for (int m = 0; m < 4; ++m) _Pragma("unroll") for (int n = 0; n < 2; ++n) _Pragma("unroll") for (int k = 0; k < 2; ++k) \
        acc[ai][bj][m][n] = __builtin_amdgcn_mfma_f32_16x16x32_bf16(Bt[n][k], At[m][k], acc[ai][bj][m][n], 0, 0, 0); __builtin_amdgcn_s_setprio(0); } while (0)
#define PG8_WAIT_V(n) asm volatile("s_waitcnt vmcnt(" #n ")" ::: "memory")
#define PG8_WAIT_L(n) asm volatile("s_waitcnt lgkmcnt(" #n ")" ::: "memory")
#define PG8_BAR __builtin_amdgcn_s_barrier()
#define PG8_SCHED __builtin_amdgcn_sched_barrier(0)
    Unit cur, nxt; int ui = 0;
    if (!S.next(0, cur)) return;
    f32x4 acc[2][2][4][2];
#pragma unroll
    for (int a = 0; a < 2; ++a)
#pragma unroll
        for (int b = 0; b < 2; ++b)
#pragma unroll
            for (int m = 0; m < 4; ++m)
#pragma unroll
                for (int n = 0; n < 2; ++n) acc[a][b][m][n] = (f32x4){0.f, 0.f, 0.f, 0.f};
    bf16x8 At[4][2], B0[2][2], B1[2][2];
    const char* cA = (const char*)g.A + (size_t)cur.pm * tstepA; const char* cB = (const char*)g.Bt + (size_t)cur.pn * tstepB;
    PG8_STAGE(PG8_SB(0, 0), cB, voffB); PG8_STAGE(PG8_SA(0, 0), cA, voffA); PG8_STAGE(PG8_SB(0, 1), cB + hstepB, voffB); PG8_STAGE(PG8_SA(0, 1), cA + hstepA, voffA);
    if (wr == 1) PG8_BAR;
    PG8_WAIT_V(4); PG8_BAR;
    PG8_STAGE(PG8_SB(1, 0), cB + kstep, voffB); PG8_STAGE(PG8_SA(1, 0), cA + kstep, voffA); PG8_STAGE(PG8_SB(1, 1), cB + hstepB + kstep, voffB);
    PG8_WAIT_V(6); PG8_BAR;
    for (;;) {
        const bool has_next = S.next(ui + 1, nxt);
        const char* nA = has_next ? (const char*)g.A + (size_t)nxt.pm * tstepA : cA; const char* nB = has_next ? (const char*)g.Bt + (size_t)nxt.pn * tstepB : cB;
        for (int t = 0; t < nt; t += 2) {
            const bool last = (t == nt - 2);
            const char* a1 = cA + (size_t)(t + 1) * kstep;
            const char* a2 = last ? nA : cA + (size_t)(t + 2) * kstep; const char* b2 = last ? nB : cB + (size_t)(t + 2) * kstep;
            const char* a3 = a2 + kstep; const char* b3 = b2 + kstep;
            if constexpr (Epi::HOOK) { if (t == 16 || t == 32) E.hook(acc, cur, t >> 4, wr, wc, fr, fq); }
            PG8_LDB(B0, 0, 0); PG8_SCHED; PG8_LDA(At, 0, 0); PG8_STAGE(PG8_SA(1, 1), a1 + hstepA, voffA);
            PG8_WAIT_L(8); PG8_BAR; PG8_WAIT_L(0); PG8_MMA(0, 0, At, B0); PG8_BAR; PG8_SCHED;
            PG8_LDB(B1, 0, 1); PG8_STAGE(PG8_SB(0, 0), b2, voffB);
            PG8_BAR; PG8_WAIT_L(0); PG8_MMA(0, 1, At, B1); PG8_BAR;
            PG8_LDA(At, 0, 1); PG8_STAGE(PG8_SA(0, 0), a2, voffA);
            PG8_BAR; PG8_WAIT_L(0); PG8_MMA(1, 0, At, B0); PG8_BAR; PG8_SCHED;
            PG8_STAGE(PG8_SB(0, 1), b2 + hstepB, voffB);
            PG8_WAIT_V(6); PG8_BAR; PG8_MMA(1, 1, At, B1); PG8_BAR;
            PG8_LDB(B0, 1, 0); PG8_SCHED; PG8_LDA(At, 1, 0); PG8_STAGE(PG8_SA(0, 1), a2 + hstepA, voffA);
            PG8_WAIT_L(8); PG8_BAR; PG8_WAIT_L(0); PG8_MMA(0, 0, At, B0); PG8_BAR; PG8_SCHED;
            PG8_LDB(B1, 1, 1); PG8_STAGE(PG8_SB(1, 0), b3, voffB);
            PG8_BAR; PG8_WAIT_L(0); PG8_MMA(0, 1, At, B1); PG8_BAR;
            PG8_LDA(At, 1, 1); PG8_STAGE(PG8_SA(1, 0), a3, voffA);
            PG8_BAR; PG8_WAIT_L(0); PG8_MMA(1, 0, At, B0); PG8_BAR; PG8_SCHED;
            PG8_STAGE(PG8_SB(1, 1), b3 + hstepB, voffB);
            PG8_WAIT_V(6); PG8_BAR; PG8_MMA(1, 1, At, B1); PG8_BAR;
        }
        E(acc, cur, wr, wc, fr, fq);
        if (!has_next) break;
#pragma unroll
        for (int a = 0; a < 2; ++a)
#pragma unroll
            for (int b = 0; b < 2; ++b)
#pragma unroll
                for (int m = 0; m < 4; ++m)
#pragma unroll
                    for (int n = 0; n < 2; ++n) acc[a][b][m][n] = (f32x4){0.f, 0.f, 0.f, 0.f};
        cur = nxt; cA = nA; cB = nB; ++ui;
    }
    PG8_WAIT_V(0);
    if (wr == 0) PG8_BAR;
    PG8_BAR;
#undef PG8_SA
#undef PG8_SB
#undef PG8_STAGE
#undef PG8_LDA
#undef PG8_LDB
#undef PG8_MMA
#undef PG8_WAIT_V
#undef PG8_WAIT_L
#undef PG8_BAR
#undef PG8_SCHED
}
}

constexpr size_t RP_W = 6 * ARR * 2, RP_GR = RP_W + ARR * 4;
static_assert(RP_GR + (size_t)MT * 6144 * 2 <= 7 * ARR * 4, "RPRE region");
struct Args { const float* in[37]; float* out; unsigned char* ws; int ph_lo, ph_hi; };
enum { I_XP = 0, I_XS, I_SSHIFT, I_SWKV, I_SCONV, I_SC, I_SN, I_SM, I_SGLA, I_NORM1, I_WIN, I_GATEB, I_MU, I_W0, I_W2, I_A0, I_A2, I_G2, I_KK, I_KA, I_RK, I_LNG, I_LNB,
       I_CONVW, I_CONVB, I_IB, I_FB, I_MNORM, I_GA2, I_GAB, I_GNORM, I_WBR, I_WOUT, I_NORM2, I_WGU, I_WDN, I_FNORM };

constexpr int LDS_BYTES = 147456;
constexpr int PTAB_OFF = LDS_BYTES - 1024;
__device__ __forceinline__ unsigned long long ctx_raw(LAS unsigned char* lds, int i) {
    const unsigned long long v = ((const LAS unsigned long long*)(lds + PTAB_OFF))[i];
    const unsigned lo = __builtin_amdgcn_readfirstlane((unsigned)v), hi = __builtin_amdgcn_readfirstlane((unsigned)(v >> 32));
    return ((unsigned long long)hi << 32) | lo;
}
#define GAS __attribute__((address_space(1)))
__device__ __forceinline__ const float* ctx_in(LAS unsigned char* lds, int i) { return (const float*)(const GAS float*)ctx_raw(lds, i); }
__device__ __forceinline__ float* ctx_out(LAS unsigned char* lds) { return (float*)(GAS float*)ctx_raw(lds, 37); }
__device__ __forceinline__ unsigned char* ctx_ws(LAS unsigned char* lds) { return (unsigned char*)(GAS unsigned char*)ctx_raw(lds, 38); }

constexpr int P0_PER_L = 32 * 519 + 3 * 16 * 64 + 32 * 64 + 32 * 352 + 88 * 64 + 3 * 32;
constexpr int P0_DN0 = 32 * 519 + 3 * 16 * 64 + 32 * 64 + 32 * 352, P0_GU1 = P0_PER_L + 32 * 519 + 3 * 16 * 64 + 32 * 64, P0_DN1 = P0_PER_L + P0_DN0, P0_DEF = 88 * 64 + 32 * 352 + 88 * 64;
constexpr int DEF_S0 = 7000, DEF_S1 = 4496, DEF_S2 = 7032, DEF_S3 = 4000;
static_assert(DEF_S0 + DEF_S1 + DEF_S2 + DEF_S3 == P0_DEF, "deferred ranges");
__device__ __forceinline__ int def_item(int stage, int e) {
    if (stage == 0) return e < 1864 ? P0_GU1 + 9400 + e : P0_DN0 + (e - 1864);
    if (stage == 1) return e < 496 ? P0_DN0 + 5136 + e : P0_GU1 + 5400 + (e - 496);
    if (stage == 2) return e < 5400 ? P0_GU1 + e : P0_DN1 + 4000 + (e - 5400);
    return P0_DN1 + e;
}
struct TrD { const float* p; bf16_t* dst; int ldw, K; bool ok; };
__device__ __forceinline__ TrD tr_decode(LAS unsigned char* lds, int it, int lane) {
    constexpr int I_IN = 32 * 519, I_BR = 3 * 16 * 64, I_OUT = 32 * 64, I_GU = 32 * 352, I_DN = 88 * 64, I_LO = 3 * 32, PER_L = I_IN + I_BR + I_OUT + I_GU + I_DN + I_LO;
    const int l = it / PER_L; int r = it % PER_L;
    unsigned char* wl = ctx_ws(lds) + WS_W + (size_t)l * LW_BYTES;
    const float* W; bf16_t* WT; int ldw, K, k0, n0, nv = 32, drow0, dk = 0;
    if (r < I_IN) { const int kb = r / 519, nb = r % 519; nv = (NIN - nb * 32) < 32 ? (NIN - nb * 32) : 32;
        W = ctx_in(lds, I_WIN) + (size_t)l * 2048 * NIN; ldw = NIN; k0 = kb * 64; n0 = nb * 32; WT = (bf16_t*)(wl + LW_WIN); K = 2048; drow0 = nb * 32; }
    else if ((r -= I_IN) < I_BR) { const int j = r / 1024, q = r % 1024, kb = q / 64, nb = q % 64;
        W = ctx_in(lds, I_WBR) + (size_t)(l * 3 + j) * 1024 * 2048; ldw = 2048; k0 = kb * 64; n0 = nb * 32; WT = (bf16_t*)(wl + LW_WBR); K = 3072; drow0 = nb * 32; dk = j * 1024; }
    else if ((r -= I_BR) < I_OUT) { const int kb = r / 64, nb = r % 64;
        W = ctx_in(lds, I_WOUT) + (size_t)l * 2048 * 2048; ldw = 2048; k0 = kb * 64; n0 = nb * 32; WT = (bf16_t*)(wl + LW_WOUT); K = 2048; drow0 = nb * 32; }
    else if ((r -= I_OUT) < I_GU) { const int kb = r / 352, nb = r % 352; n0 = nb * 32; const int np = n0 < DFF ? n0 : n0 - DFF;
        W = ctx_in(lds, I_WGU) + (size_t)l * 2048 * 11264; ldw = 11264; k0 = kb * 64; WT = (bf16_t*)(wl + LW_WGU); K = 2048; drow0 = 256 * (np / 128) + (np % 128) + (n0 < DFF ? 0 : 128); }
    else if ((r -= I_GU) < I_DN) { const int kb = r / 64, nb = r % 64;
        W = ctx_in(lds, I_WDN) + (size_t)l * DFF * 2048; ldw = 2048; k0 = kb * 64; n0 = nb * 32; WT = (bf16_t*)(wl + LW_WDN); K = DFF; drow0 = nb * 32; }
    else { r -= I_DN; const int mat = r / 32, nb = r % 32;
        W = (mat == 0 ? ctx_in(lds, I_W2) : (mat == 1 ? ctx_in(lds, I_A2) : ctx_in(lds, I_G2))) + (size_t)l * 64 * 1024; ldw = 1024; k0 = 0; n0 = nb * 32; WT = (bf16_t*)(wl + LW_LORA) + (size_t)mat * 1024 * 64; K = 64; drow0 = nb * 32; }
    TrD t; const int n = lane & 31; t.ok = n < nv; t.ldw = ldw; t.K = K;
    t.p = W + (size_t)(k0 + (lane >> 5)) * ldw + n0 + (t.ok ? n : 0); t.dst = WT + (size_t)drow0 * K + dk + k0; return t;
}
#define TR_PIN16(v, o) asm volatile("" : "+v"(v[o]), "+v"(v[o + 1]), "+v"(v[o + 2]), "+v"(v[o + 3]), "+v"(v[o + 4]), "+v"(v[o + 5]), "+v"(v[o + 6]), "+v"(v[o + 7]), "+v"(v[o + 8]), "+v"(v[o + 9]), "+v"(v[o + 10]), "+v"(v[o + 11]), "+v"(v[o + 12]), "+v"(v[o + 13]), "+v"(v[o + 14]), "+v"(v[o + 15]))
__device__ __forceinline__ void tr_load(const TrD& t, float (&v)[32]) {
#pragma unroll
    for (int i = 0; i < 32; ++i) v[i] = __builtin_nontemporal_load(t.p + (size_t)(2 * i) * t.ldw);
}
__device__ __forceinline__ void tr_store(const TrD& t, const float (&v)[32], LAS float* scr, int lane) {
    const int n = lane & 31;
#pragma unroll
    for (int i = 0; i < 32; ++i) scr[(2 * i + (lane >> 5)) * 33 + n] = t.ok ? v[i] : 0.f;
    LDS_WAIT();
    const int c = lane & 7;
#pragma unroll
    for (int j = 0; j < 4; ++j) { const int nn = (lane >> 3) + 8 * j; const LAS float* s = scr + (8 * c) * 33 + nn;
        u32x4 o; o.x = pk2(s[0 * 33], s[1 * 33]); o.y = pk2(s[2 * 33], s[3 * 33]); o.z = pk2(s[4 * 33], s[5 * 33]); o.w = pk2(s[6 * 33], s[7 * 33]);
        *(u32x4*)(t.dst + (size_t)nn * t.K + 8 * c) = o; }
    LDS_WAIT();
}
__device__ __forceinline__ void phase_prologue(LAS unsigned char* lds, int G) {
    const int tid = opaque_tid(), lane = tid & 63, wave = tid >> 6;
    LAS float* scr = (LAS float*)(lds + wave * 8704);
    const int gw = blockIdx.x * 8 + wave, NGW = G * 8;
    constexpr int NITEMS = 2 * P0_PER_L - P0_DEF;
#define P0MAP(i) ((i) < P0_DN0 ? (i) : ((i) + 88 * 64 < P0_GU1 ? (i) + 88 * 64 : (i) + P0_DEF))
    if (gw < NITEMS) {
        const int last = gw + ((NITEMS - 1 - gw) / NGW) * NGW;
        TrD ta = tr_decode(lds, P0MAP(gw), lane); float va[32]; tr_load(ta, va);
        for (int it = gw; it < NITEMS; it += 2 * NGW) {
            const int i1 = it + NGW <= last ? it + NGW : last, i2 = it + 2 * NGW <= last ? it + 2 * NGW : last;
            const TrD tb = tr_decode(lds, P0MAP(i1), lane); float vb[32]; tr_load(tb, vb);
            TR_PIN16(va, 0); TR_PIN16(va, 16);
            tr_store(ta, va, scr, lane);
            ta = tr_decode(lds, P0MAP(i2), lane); tr_load(ta, va);
            TR_PIN16(vb, 0); TR_PIN16(vb, 16);
            if (it + NGW < NITEMS) tr_store(tb, vb, scr, lane);
        }
    }
#undef P0MAP
    const int gt = blockIdx.x * NTHREADS + tid, NGT = G * NTHREADS;
    for (int i = gt; i < 2 * 32 * 2048 / 8; i += NGT) { const int l = i / (32 * 256), q = i % (32 * 256);
        *(u32x4*)((bf16_t*)(ctx_ws(lds) + WS_W + (size_t)l * LW_BYTES + LW_WIN) + (size_t)16608 * 2048 + (size_t)q * 8) = (u32x4){0u, 0u, 0u, 0u}; }
    for (int i = gt; i < 2 * 512 * 32; i += NGT) { const int l = i / (512 * 32), q = i % (512 * 32), c = q / 32, k = q % 32;
        ((bf16_t*)(ctx_ws(lds) + WS_W + (size_t)l * LW_BYTES + LW_GA2))[q] = k < 16 ? f2bf(ctx_in(lds, I_GA2)[(size_t)l * 16 * 512 + k * 512 + c]) : (bf16_t)0; }
}

__device__ __forceinline__ unsigned wave_pop(unsigned* queue, int lane);
__device__ __forceinline__ void deferred_convert(LAS unsigned char* lds, int stage) {
    const int tid = opaque_tid(), lane = tid & 63, wave = tid >> 6;
    LAS float* scr = (LAS float*)(lds + wave * 8704);
    __syncthreads();
    const int nb = (stage == 0 ? DEF_S0 : stage == 1 ? DEF_S1 : stage == 2 ? DEF_S2 : DEF_S3) / 4;
    unsigned* q = (unsigned*)(ctx_ws(lds) + WS_CTL) + CW_DEFQ + 16 * stage;
    for (;;) { const unsigned b = wave_pop(q, lane); if (b >= (unsigned)nb) break;
#pragma unroll 1
        for (int j = 0; j < 4; ++j) { const TrD t = tr_decode(lds, def_item(stage, (int)b * 4 + j), lane); float v[32]; tr_load(t, v); TR_PIN16(v, 0); TR_PIN16(v, 16); tr_store(t, v, scr, lane); } }
    __syncthreads();
}

__device__ __forceinline__ void phase_norm(LAS unsigned char* lds, int G, const float* gvec, bool from_input) {
    const int tid = opaque_tid(), lane = tid & 63, wave = tid >> 6;
    float* __restrict__ xbuf = (float*)(ctx_ws(lds) + WS_X); bf16_t* __restrict__ hb = (bf16_t*)(ctx_ws(lds) + WS_H);
    f32x4 gg[8];
#pragma unroll
    for (int j = 0; j < 8; ++j) gg[j] = *(const f32x4*)(gvec + (lane + 64 * j) * 4);
    for (int m = blockIdx.x * 8 + wave; m < MPAD; m += G * 8) {
        if (m >= MT) { if (from_input) {
#pragma unroll
            for (int j = 0; j < 4; ++j) *(u32x4*)(hb + (size_t)m * 2048 + (lane + 64 * j) * 8) = (u32x4){0u, 0u, 0u, 0u}; } continue; }
        const float* src = from_input ? (m < MP ? ctx_in(lds, I_XP) + (size_t)m * 2048 : ctx_in(lds, I_XS) + (size_t)(m - MP) * 2048) : xbuf + (size_t)m * 2048;
        f32x4 v[8]; float s = 0.f;
#pragma unroll
        for (int j = 0; j < 8; ++j) v[j] = *(const f32x4*)(src + (lane + 64 * j) * 4);
#pragma unroll
        for (int j = 0; j < 8; ++j) s += (v[j].x * v[j].x + v[j].y * v[j].y) + (v[j].z * v[j].z + v[j].w * v[j].w);
        const float rs = rsqrtf(wave_sum(s) * (1.f / 2048.f) + 1e-6f);
#pragma unroll
        for (int j = 0; j < 8; ++j) { const int c = (lane + 64 * j) * 4;
            if (from_input) *(f32x4*)(xbuf + (size_t)m * 2048 + c) = v[j];
            u32x2 w; w.x = pk2(v[j].x * rs * gg[j].x, v[j].y * rs * gg[j].y); w.y = pk2(v[j].z * rs * gg[j].z, v[j].w * rs * gg[j].w);
            *(u32x2*)(hb + (size_t)m * 2048 + c) = w; }
    }
}
__device__ __forceinline__ void dump_words(const unsigned* src, unsigned* dst, size_t n, int G) {
    for (size_t i = (size_t)blockIdx.x * NTHREADS + threadIdx.x; i < n; i += (size_t)G * NTHREADS) dst[i] = src[i];
}
__device__ __forceinline__ void phase_dump(LAS unsigned char* lds, int G) {
    unsigned char* ws = ctx_ws(lds); unsigned* out = (unsigned*)ctx_out(lds);
    if (DBG_LIM == 5) { if (DBG_SEL == 0) dump_words((const unsigned*)(ws + WS_ROUT), out + O_YP, ARR, G); if (DBG_SEL == 1) dump_words((const unsigned*)(ws + WS_HM), out + O_YP, ARR, G); if (DBG_SEL == 2) { dump_words((const unsigned*)(ws + WS_OG), out + O_YP, ARR, G); dump_words((const unsigned*)(ws + WS_HM), out + O_SC, ARR, G); } if (DBG_SEL == 3) dump_words((const unsigned*)(ws + WS_QM), out + O_YP, ARR, G); if (DBG_SEL == 4) dump_words((const unsigned*)(ws + WS_HM), out + O_YP, (size_t)MP * 1024, G); }
    else if (DBG_LIM == 6) { dump_words((const unsigned*)(ws + WS_QM), out + O_YP, (size_t)MT * 3072 / 2, G); }
    else if (DBG_LIM == 7) { dump_words((const unsigned*)(ws + WS_H), out + O_YP, (size_t)MT * 2048 / 2, G); }
    else { dump_words((const unsigned*)(ws + WS_X), out + O_YP, (size_t)MP * 2048, G); }
}
__device__ __forceinline__ void phase_final(LAS unsigned char* lds, int G) {
    const int tid = opaque_tid(), lane = tid & 63, wave = tid >> 6;
    const float* __restrict__ xbuf = (const float*)(ctx_ws(lds) + WS_X); const float* __restrict__ gvec = ctx_in(lds, I_FNORM);
    f32x4 gg[8];
#pragma unroll
    for (int j = 0; j < 8; ++j) gg[j] = *(const f32x4*)(gvec + (lane + 64 * j) * 4);
    for (int m = blockIdx.x * 8 + wave; m < MT; m += G * 8) {
        const float* src = xbuf + (size_t)m * 2048; float* __restrict__ dst = ctx_out(lds) + (m < MP ? O_YP + (size_t)m * 2048 : O_YS + (size_t)(m - MP) * 2048);
        f32x4 v[8]; float s = 0.f;
#pragma unroll
        for (int j = 0; j < 8; ++j) v[j] = *(const f32x4*)(src + (lane + 64 * j) * 4);
#pragma unroll
        for (int j = 0; j < 8; ++j) s += (v[j].x * v[j].x + v[j].y * v[j].y) + (v[j].z * v[j].z + v[j].w * v[j].w);
        const float rs = rsqrtf(wave_sum(s) * (1.f / 2048.f) + 1e-6f);
#pragma unroll
        for (int j = 0; j < 8; ++j) { const int c = (lane + 64 * j) * 4;
            *(f32x4*)(dst + c) = (f32x4){v[j].x * rs * gg[j].x, v[j].y * rs * gg[j].y, v[j].z * rs * gg[j].z, v[j].w * rs * gg[j].w}; }
    }
}

__device__ __forceinline__ void load_prev8(const bf16_t* proj, const float* shift_l, int m, int col, float (&o)[8]) {
    if (m >= MP) ld8f(shift_l + (size_t)(m - MP) * RC + col, o);
    else if ((m & 2047) == 0) {
#pragma unroll
        for (int i = 0; i < 8; ++i) o[i] = 0.f; }
    else ld8b(proj + (size_t)(m - 1) * NINP + col, o);
}
__device__ __forceinline__ void ld16b(const bf16_t* p, float (&f)[16]) { ld8b(p, *(float(*)[8])&f[0]); ld8b(p + 8, *(float(*)[8])&f[8]); }
__device__ __forceinline__ void ld16f(const float* p, float (&f)[16]) { ld8f(p, *(float(*)[8])&f[0]); ld8f(p + 8, *(float(*)[8])&f[8]); }
__device__ __forceinline__ void st16f(float* p, const float (&f)[16]) { st8f(p, *(const float(*)[8])&f[0]); st8f(p + 8, *(const float(*)[8])&f[8]); }
__device__ __forceinline__ void st16b(bf16_t* p, const float (&f)[16]) { *(u32x4*)p = pack8(*(const float(*)[8])&f[0]); *(u32x4*)(p + 8) = pack8(*(const float(*)[8])&f[8]); }
__device__ __forceinline__ void pre_rwkv_item(LAS unsigned char* lds, int l, int cidx, int tt, int h0, int nh, int wave, int lane) {
    const int lr = lane & 15, lq = lane >> 4;
    const int m0 = cidx * 64 + tt * 16;
    const bf16_t* __restrict__ proj = (const bf16_t*)(ctx_ws(lds) + WS_PROJ);
    const float* __restrict__ shift_l = ctx_in(lds, I_SSHIFT) + (size_t)l * 128 * RC;
    const float* __restrict__ mu = ctx_in(lds, I_MU) + (size_t)l * RC;
    const bf16_t* __restrict__ loraT = (const bf16_t*)(ctx_ws(lds) + WS_W + (size_t)l * LW_BYTES + LW_LORA);
    bf16_t* __restrict__ rb = (bf16_t*)(ctx_ws(lds) + WS_RPRE); float* __restrict__ rw = (float*)(ctx_ws(lds) + WS_RPRE + RP_W);
    LAS bf16_t* loraA = (LAS bf16_t*)(lds + wave * 14336);
    LAS bf16_t* loraO = (LAS bf16_t*)(lds + wave * 14336 + 7168);
    const int tok = lane >> 2, c4 = lane & 3, m = m0 + tok;
    {
#pragma unroll
        for (int i = 0; i < 6; ++i) {
            const int cgp = c4 + 4 * i, col = 3072 + cgp * 8, mat = cgp >> 3, kc = (cgp & 7) * 8;
            float p[8], pv[8], mm[8], x[8];
            ld8b(proj + (size_t)m * NINP + col, p); load_prev8(proj, shift_l, m, col, pv); ld8f(mu + col, mm);
#pragma unroll
            for (int j = 0; j < 8; ++j) { const float xs = p[j] + (pv[j] - p[j]) * mm[j]; x[j] = mat == 0 ? tanh_fast(xs) : (mat == 1 ? xs : sigm(xs)); }
            *(LAS u32x4*)(loraA + (mat * 16 + tok) * 72 + kc) = pack8(x);
        }
    }
    LDS_WAIT();
    const bool samp = m >= MP, first = !samp && ((m & 2047) == 0);
    const bf16_t* prow = proj + (size_t)m * NINP;
    const bf16_t* qrow = proj + (size_t)((samp || first) ? m : m - 1) * NINP;
    const float* srow = shift_l + (size_t)(samp ? m - MP : 0) * RC;
#pragma unroll 1
    for (int hh = 0; hh < nh; ++hh) {
        const int h = h0 + hh, c0 = h * 64 + c4 * 16;
        bf16x8 bfr[3][4][2];
#pragma unroll
        for (int mat = 0; mat < 3; ++mat)
#pragma unroll
            for (int tc = 0; tc < 4; ++tc)
#pragma unroll
                for (int ks = 0; ks < 2; ++ks) bfr[mat][tc][ks] = *(const bf16x8*)(loraT + (size_t)(mat * 1024 + h * 64 + tc * 16 + lr) * 64 + ks * 32 + lq * 8);
        u32x4 pw[3][2], qw[3][2]; f32x4 qs[3][4];
#pragma unroll
        for (int g = 0; g < 3; ++g) { pw[g][0] = *(const u32x4*)(prow + g * 1024 + c0); pw[g][1] = *(const u32x4*)(prow + g * 1024 + c0 + 8);
            if (samp) {
#pragma unroll
                for (int k = 0; k < 4; ++k) qs[g][k] = *(const f32x4*)(srow + g * 1024 + c0 + 4 * k); }
            else { qw[g][0] = *(const u32x4*)(qrow + g * 1024 + c0); qw[g][1] = *(const u32x4*)(qrow + g * 1024 + c0 + 8); } }
#pragma unroll
        for (int mat = 0; mat < 3; ++mat)
#pragma unroll
            for (int tc = 0; tc < 4; ++tc) { f32x4 acc = {0.f, 0.f, 0.f, 0.f};
#pragma unroll
                for (int ks = 0; ks < 2; ++ks) {
                    const bf16x8 av = *(const LAS bf16x8*)(loraA + (mat * 16 + lr) * 72 + ks * 32 + lq * 8);
                    acc = MFMA16(av, bfr[mat][tc][ks], acc); }
#pragma unroll
                for (int r = 0; r < 4; ++r) loraO[(mat * 16 + lq * 4 + r) * 72 + tc * 16 + lr] = f2bf(acc[r]); }
        LDS_WAIT();
        float xr[16], xk[16], xv[16];
#pragma unroll
        for (int g = 0; g < 3; ++g) { float p[16], q[16], mm[16];
            unpack8(pw[g][0], *(float(*)[8])&p[0]); unpack8(pw[g][1], *(float(*)[8])&p[8]); ld16f(mu + g * 1024 + c0, mm);
            if (samp) {
#pragma unroll
                for (int j = 0; j < 16; ++j) q[j] = qs[g][j >> 2][j & 3]; }
            else { unpack8(qw[g][0], *(float(*)[8])&q[0]); unpack8(qw[g][1], *(float(*)[8])&q[8]);
                if (first) {
#pragma unroll
                    for (int j = 0; j < 16; ++j) q[j] = 0.f; } }
#pragma unroll
            for (int j = 0; j < 16; ++j) { const float x = p[j] + (q[j] - p[j]) * mm[j]; if (g == 0) xr[j] = x; else if (g == 1) xk[j] = x; else xv[j] = x; } }
        const size_t o = (size_t)m * 1024 + c0;
        st16b(rb + 3 * ARR + o, xr); st16b(rb + 4 * ARR + o, xv);
        float lw[16], la[16], lg[16];
        { const LAS bf16_t* lo = loraO + tok * 72 + c4 * 16;
          unpack8(*(const LAS u32x4*)(lo), *(float(*)[8])&lw[0]); unpack8(*(const LAS u32x4*)(lo + 8), *(float(*)[8])&lw[8]);
          unpack8(*(const LAS u32x4*)(lo + 16 * 72), *(float(*)[8])&la[0]); unpack8(*(const LAS u32x4*)(lo + 16 * 72 + 8), *(float(*)[8])&la[8]);
          unpack8(*(const LAS u32x4*)(lo + 32 * 72), *(float(*)[8])&lg[0]); unpack8(*(const LAS u32x4*)(lo + 32 * 72 + 8), *(float(*)[8])&lg[8]); }
        st16b(rb + 5 * ARR + o, lg);
        float pa[16], pb[16], kkr[16], av[16]; float ss = 0.f;
        ld16f(ctx_in(lds, I_KK) + l * 1024 + c0, pa); ld16f(ctx_in(lds, I_A0) + l * 1024 + c0, pb);
#pragma unroll
        for (int j = 0; j < 16; ++j) { kkr[j] = xk[j] * pa[j]; ss += kkr[j] * kkr[j]; av[j] = sigm(pb[j] + la[j]); }
        ss = quad_sum(ss);
        const float inv = 1.f / fmaxf(sqrtf(ss), 1e-12f);
#pragma unroll
        for (int j = 0; j < 16; ++j) { kkr[j] *= inv; pa[j] = kkr[j] * av[j]; }
        st16b(rb + 0 * ARR + o, kkr); st16b(rb + 1 * ARR + o, pa);
        ld16f(ctx_in(lds, I_KA) + l * 1024 + c0, pa); ld16f(ctx_in(lds, I_W0) + l * 1024 + c0, pb);
#pragma unroll
        for (int j = 0; j < 16; ++j) { pa[j] = xk[j] * (1.f + (av[j] - 1.f) * pa[j]);
            const float wp = -(pb[j] + lw[j]); const float sp = fmaxf(wp, 0.f) + __logf(1.f + __expf(-fabsf(wp))); pb[j] = __expf(-__expf(-sp - 0.5f)); }
        st16b(rb + 2 * ARR + o, pa); st16f(rw + o, pb);
        LDS_WAIT();
    }
}
__device__ __forceinline__ void pre_mlstm(LAS unsigned char* lds, int l, int cidx, int m0, int ntok) {
    const int tid = opaque_tid();
    const bf16_t* __restrict__ proj = (const bf16_t*)(ctx_ws(lds) + WS_PROJ);
    bf16_t* __restrict__ qm = (bf16_t*)(ctx_ws(lds) + WS_QM); bf16_t* __restrict__ km = (bf16_t*)(ctx_ws(lds) + WS_KM); float* __restrict__ gates = (float*)(ctx_ws(lds) + WS_GATES);
    const int cgp = tid & 255, th = tid >> 8, c0 = cgp * 8;
    float w0[8], w1[8], w2[8], w3[8], cb[8];
    ld8f(ctx_in(lds, I_CONVW) + (size_t)(l * 4 + 0) * 2048 + c0, w0); ld8f(ctx_in(lds, I_CONVW) + (size_t)(l * 4 + 1) * 2048 + c0, w1);
    ld8f(ctx_in(lds, I_CONVW) + (size_t)(l * 4 + 2) * 2048 + c0, w2); ld8f(ctx_in(lds, I_CONVW) + (size_t)(l * 4 + 3) * 2048 + c0, w3);
    ld8f(ctx_in(lds, I_CONVB) + (size_t)l * 2048 + c0, cb);
    bf16_t* dst = cgp < 128 ? qm + c0 : km + (c0 - 1024); const float sc = cgp < 128 ? 1.f : 0.0625f;
    if (cidx < 128) {
        float x3[8], x2[8], x1[8];
        const int t0 = th * 32, ts0 = (m0 & 2047) + t0;
#pragma unroll
        for (int j = 0; j < 8; ++j) { x3[j] = 0.f; x2[j] = 0.f; x1[j] = 0.f; }
        if (ts0 >= 3) { ld8b(proj + (size_t)(m0 + t0 - 3) * NINP + M0 + c0, x3); ld8b(proj + (size_t)(m0 + t0 - 2) * NINP + M0 + c0, x2); ld8b(proj + (size_t)(m0 + t0 - 1) * NINP + M0 + c0, x1); }
        const bool lastc = (cidx & 31) == 31; const int b = cidx >> 5;
#pragma unroll 1
        for (int tb = t0; tb < t0 + 32; tb += 8) {
            u32x4 xb[8];
#pragma unroll
            for (int i = 0; i < 8; ++i) xb[i] = *(const u32x4*)(proj + (size_t)(m0 + tb + i) * NINP + M0 + c0);
#pragma unroll
            for (int i = 0; i < 8; ++i) { const int m = m0 + tb + i; float x0[8], y[8]; unpack8(xb[i], x0);
#pragma unroll
                for (int j = 0; j < 8; ++j) { const float cv = cb[j] + w0[j] * x3[j] + w1[j] * x2[j] + w2[j] * x1[j] + w3[j] * x0[j]; y[j] = siluf(cv) * sc; x3[j] = x2[j]; x2[j] = x1[j]; x1[j] = x0[j]; }
                *(u32x4*)(dst + (size_t)m * 1024) = pack8(y);
                if (lastc && tb + i >= 61) st8f(ctx_out(lds) + O_PCONV + (size_t)((l * 4 + b) * 3 + (tb + i - 61)) * 2048 + c0, x0); }
        }
    } else {
#pragma unroll 1
        for (int tb = th * (ntok >> 1); tb < (th + 1) * (ntok >> 1); tb += 4) {
            u32x4 xb[4]; f32x4 sa[4][6];
#pragma unroll
            for (int i = 0; i < 4; ++i) { const int m = m0 + tb + i, s = m - MP; const float* __restrict__ cs = ctx_in(lds, I_SCONV) + (size_t)((l * 128 + s) * 3) * 2048 + c0;
                xb[i] = *(const u32x4*)(proj + (size_t)m * NINP + M0 + c0);
#pragma unroll
                for (int k = 0; k < 3; ++k) { sa[i][2 * k] = *(const f32x4*)(cs + k * 2048); sa[i][2 * k + 1] = *(const f32x4*)(cs + k * 2048 + 4); } }
#pragma unroll
            for (int i = 0; i < 4; ++i) { const int m = m0 + tb + i, s = m - MP; float x0[8], y[8]; unpack8(xb[i], x0);
#pragma unroll
                for (int j = 0; j < 8; ++j) { const float x3 = sa[i][0 + (j >> 2)][j & 3], x2 = sa[i][2 + (j >> 2)][j & 3], x1 = sa[i][4 + (j >> 2)][j & 3];
                    const float cv = cb[j] + w0[j] * x3 + w1[j] * x2 + w2[j] * x1 + w3[j] * x0[j]; y[j] = siluf(cv) * sc; }
                *(u32x4*)(dst + (size_t)m * 1024) = pack8(y);
                float* co = ctx_out(lds) + O_SCONV + (size_t)((l * 128 + s) * 3) * 2048 + c0;
                *(f32x4*)co = sa[i][2]; *(f32x4*)(co + 4) = sa[i][3]; *(f32x4*)(co + 2048) = sa[i][4]; *(f32x4*)(co + 2052) = sa[i][5]; st8f(co + 4096, x0); }
        }
    }
    if (tid < ntok * 4) { const int t = tid >> 2, hh = tid & 3, m = m0 + t;
        const float ip = bf2f(proj[(size_t)m * NINP + M0 + 3072 + hh]), fp = bf2f(proj[(size_t)m * NINP + M0 + 3076 + hh]);
        const float xf = fp + ctx_in(lds, I_FB)[l * 4 + hh];
        gates[(size_t)m * 8 + hh] = ip + ctx_in(lds, I_IB)[l * 4 + hh];
        gates[(size_t)m * 8 + 4 + hh] = fminf(xf, 0.f) - log1pf(__expf(-fabsf(xf))); }
}
__device__ __forceinline__ void pre_gla(LAS unsigned char* lds, int l, int cidx, int m0, int ntok) {
    const int tid = opaque_tid(), lane = tid & 63, wave = tid >> 6, lr = lane & 15, lq = lane >> 4;
    const bf16_t* __restrict__ proj = (const bf16_t*)(ctx_ws(lds) + WS_PROJ);
    bf16_t* __restrict__ gq = (bf16_t*)(ctx_ws(lds) + WS_GQ); bf16_t* __restrict__ gk = (bf16_t*)(ctx_ws(lds) + WS_GK); bf16_t* __restrict__ gkh = (bf16_t*)(ctx_ws(lds) + WS_GKH); float* __restrict__ egl = (float*)(ctx_ws(lds) + WS_EGL);
    const bf16_t* __restrict__ a2T = (const bf16_t*)(ctx_ws(lds) + WS_W + (size_t)l * LW_BYTES + LW_GA2);
    LAS float* bb = (LAS float*)lds;
    LAS bf16_t* xa = (LAS bf16_t*)(lds + 64 * 516 * 4);
    const bool samp = cidx >= 128;
    __syncthreads();
    for (int i = tid; i < ntok * 32; i += NTHREADS) { const int t = i >> 5, k = i & 31; xa[t * 40 + k] = k < 16 ? proj[(size_t)(m0 + t) * NINP + G0 + 2048 + k] : (bf16_t)0; }
    __syncthreads();
#pragma unroll
    for (int q = 0; q < 4; ++q) { const int tc = wave * 4 + q;
        const bf16x8 bv = *(const bf16x8*)(a2T + (size_t)(tc * 16 + lr) * 32 + lq * 8);
        const float ab = ctx_in(lds, I_GAB)[l * 512 + tc * 16 + lr];
#pragma unroll
        for (int tt = 0; tt < 4; ++tt) { if (tt * 16 >= ntok) break; const bf16x8 av = *(const LAS bf16x8*)(xa + (tt * 16 + lr) * 40 + lq * 8);
            f32x4 acc = {0.f, 0.f, 0.f, 0.f}; acc = MFMA16(av, bv, acc);
#pragma unroll
            for (int r = 0; r < 4; ++r) bb[(tt * 16 + lq * 4 + r) * 516 + tc * 16 + lr] = logsig_fast(acc[r] + ab) * 0.0625f; } }
    __syncthreads();
    if (!samp) { const int c = tid; float run = 0.f;
#pragma unroll 8
        for (int t = 0; t < 64; ++t) { run += bb[t * 516 + c]; bb[t * 516 + c] = run; }
        egl[(size_t)cidx * 512 + c] = __expf(run); }
    __syncthreads();
    const float scale = 0.08838834764831845f;
    for (int i = tid; i < ntok * 64; i += NTHREADS) { const int t = i >> 6, cg = i & 63, c = cg * 8; const size_t m = m0 + t;
        float q[8], k[8], b8[8], bl[8], oq[8], ok[8], oh[8];
        ld8b(proj + m * NINP + G0 + c, q); ld8b(proj + m * NINP + G0 + 512 + c, k);
#pragma unroll
        for (int j = 0; j < 8; ++j) { b8[j] = bb[t * 516 + c + j]; bl[j] = samp ? b8[j] : bb[63 * 516 + c + j]; }
#pragma unroll
        for (int j = 0; j < 8; ++j) { oq[j] = q[j] * __expf(b8[j]) * scale; ok[j] = k[j] * __expf(-b8[j]); oh[j] = k[j] * __expf(bl[j] - b8[j]); }
        *(u32x4*)(gq + m * 512 + c) = pack8(oq); *(u32x4*)(gk + m * 512 + c) = pack8(ok); *(u32x4*)(gkh + m * 512 + c) = pack8(oh);
        if (samp) { float e[8];
#pragma unroll
            for (int j = 0; j < 8; ++j) e[j] = __expf(b8[j]);
            st8f(egl + (size_t)(128 + (m - MP)) * 512 + c, e); } }
}
__device__ __forceinline__ void phase_pre(LAS unsigned char* lds, int l, int G) {
    { const int tid = opaque_tid(), wave = tid >> 6, lane = tid & 63;
      for (int it = blockIdx.x * 8 + wave; it < 2048 + G * 8; it += G * 8) {
          int cidx, tt, h0, nh;
          if (it < 2048) { cidx = it >> 4; tt = (it >> 2) & 3; h0 = (it & 3) * 4; nh = 4; }
          else { const int j = G * 8 - 1 - (it - 2048); if (j >= 128) continue; cidx = 128 + (j >> 6); tt = (j >> 4) & 3; h0 = j & 15; nh = 1; }
          pre_rwkv_item(lds, l, cidx, tt, h0, nh, wave, lane); } }
    for (int u = blockIdx.x; u < 272; u += G) {
        if (u < 128) pre_gla(lds, l, u, u * 64, 64);
        else if (u < 256) pre_mlstm(lds, l, u - 128, (u - 128) * 64, 64);
        else if (u < 264) pre_gla(lds, l, 128, MP + (u - 256) * 16, 16);
        else pre_mlstm(lds, l, 128, MP + (u - 264) * 16, 16);
    }
    {
        const bf16_t* __restrict__ proj = (const bf16_t*)(ctx_ws(lds) + WS_PROJ);
        for (int i = blockIdx.x * NTHREADS + opaque_tid(); i < 132 * (RC / 8); i += G * NTHREADS) { const int sq = i / (RC / 8), cg8 = i % (RC / 8); float p[8];
            const int m = sq < 4 ? sq * 2048 + 2047 : MP + (sq - 4);
            ld8b(proj + (size_t)m * NINP + cg8 * 8, p);
            st8f(ctx_out(lds) + (sq < 4 ? O_PSHIFT + (size_t)(l * 4 + sq) * RC : O_SSHIFT + (size_t)(l * 128 + (sq - 4)) * RC) + cg8 * 8, p); }
    }
}

__device__ __forceinline__ void scan_rwkv(LAS unsigned char* lds, int l, int u) {
    const int tid = opaque_tid(), bh = u >> 1, half = u & 1, b = bh >> 4, h = bh & 15;
    const int row2 = (tid >> 3) & 31, jg = tid & 7, st = tid & 255;
    const int wv = __builtin_amdgcn_readfirstlane(tid >> 6);
    const float* __restrict__ rpre = (const float*)(ctx_ws(lds) + WS_RPRE); bf16_t* __restrict__ rout = (bf16_t*)(ctx_ws(lds) + WS_ROUT);
    f32x4 Sa = {0.f, 0.f, 0.f, 0.f}, Sb = {0.f, 0.f, 0.f, 0.f};
    const size_t mb = (size_t)b * 2048;
    const unsigned char* rbase = (const unsigned char*)rpre;
    unsigned off[7]; int lo[7];
#pragma unroll
    for (int q = 0; q < 7; ++q) { int i = st + 256 * q; i = i < 1664 ? i : 1663; const int tok = i / 52, j = i % 52;
        if (j < 32) { const int arr = j >> 3, pc = j & 7; off[q] = (unsigned)(arr * (int)ARR + tok * 1024 + h * 64 + pc * 8) * 2u; lo[q] = tok * 352 + (arr == 0 ? 0 : arr == 1 ? 64 : arr == 2 ? 192 : 256) + pc * 8; }
        else if (j < 48) { const int pc = j - 32; off[q] = (unsigned)RP_W + (unsigned)(tok * 1024 + h * 64 + pc * 4) * 4u; lo[q] = -(tok * 352 + 128 + pc * 4) - 1; }
        else { const int pc = j - 48; off[q] = (unsigned)(4 * (int)ARR + tok * 1024 + h * 64 + half * 32 + pc * 8) * 2u; lo[q] = tok * 352 + 320 + pc * 8; } }
    u32x4 pf[7];
    const size_t cb0 = mb / 32;
#define RW_FETCH(chunk) do { _Pragma("unroll") for (int q = 0; q < 7; ++q) pf[q] = *(const u32x4*)(rbase + off[q] + (size_t)(chunk) * (lo[q] < 0 ? 131072u : 65536u)); } while (0)
#define RW_STAGE(buf) do { LAS float* sg_ = (LAS float*)(lds + (buf) * 45056); _Pragma("unroll") for (int q = 0; q < 7; ++q) { \
            if (lo[q] < 0) *(LAS u32x4*)(sg_ + (-lo[q] - 1)) = pf[q]; \
            else { float f[8]; unpack8(pf[q], f); *(LAS f32x4*)(sg_ + lo[q]) = (f32x4){f[0], f[1], f[2], f[3]}; *(LAS f32x4*)(sg_ + lo[q] + 4) = (f32x4){f[4], f[5], f[6], f[7]}; } } } while (0)
#define RW_OUT(buf, chunk) do { const LAS float* ob_ = (const LAS float*)(lds + 90112 + (buf) * 4096); _Pragma("unroll") for (int k = 0; k < 2; ++k) { const int i = st + 256 * k; \
            *(unsigned*)(rout + (mb + (size_t)(chunk) * 32 + (i >> 4)) * 1024 + h * 64 + half * 32 + (i & 15) * 2) = pk2(ob_[i * 2], ob_[i * 2 + 1]); } } while (0)
    if (wv >= 4) { RW_FETCH(cb0); RW_STAGE(0); RW_FETCH(cb0 + 1); }
    __syncthreads();
    for (int ch = 0; ch < 64; ++ch) {
        if (wv < 4) {
        const LAS float* stage = (const LAS float*)(lds + (ch & 1) * 45056); LAS float* obuf = (LAS float*)(lds + 90112 + (ch & 1) * 4096);
        f32x4 B5[2][10]; float Bv[2];
#define RW_LD(slot, t) do { const LAS float* sp_ = stage + (t) * 352 + jg * 8; _Pragma("unroll") for (int v_ = 0; v_ < 5; ++v_) { B5[slot][2 * v_] = *(const LAS f32x4*)(sp_ + 64 * v_); B5[slot][2 * v_ + 1] = *(const LAS f32x4*)(sp_ + 64 * v_ + 4); } \
            Bv[slot] = stage[(t) * 352 + 320 + row2]; } while (0)
        RW_LD(0, 0);
        float os[4] = {0.f, 0.f, 0.f, 0.f};
        f32x4 q = {0.f, 0.f, 0.f, 0.f};
#define RW_OSUM(t) do { float o = (q.x + q.y) + (q.z + q.w); o = row8_sum(o); if (((t) & 7) == jg) os[(t) >> 3] = o; } while (0)
#pragma unroll
        for (int t = 0; t < 32; ++t) {
            if (t + 1 < 32) RW_LD((t + 1) & 1, t + 1);
            __builtin_amdgcn_sched_barrier(0);
            const int sl = t & 1; const float vv = Bv[sl];
            f32x4 p = Sa * B5[sl][0]; p = Sb * B5[sl][1] + p;
            float sa = (p.x + p.y) + (p.z + p.w);
            if (t > 0) {
                float o = (q.x + q.y) + (q.z + q.w);
                sa += dppf<0xB1>(sa); o += dppf<0xB1>(o); sa += dppf<0x4E>(sa); o += dppf<0x4E>(o); sa += dppf<0x141>(sa); o += dppf<0x141>(o);
                if (((t - 1) & 7) == jg) os[(t - 1) >> 3] = o;
            } else sa = row8_sum(sa);
            Sa = Sa * B5[sl][4] - sa * B5[sl][2] + vv * B5[sl][6];
            Sb = Sb * B5[sl][5] - sa * B5[sl][3] + vv * B5[sl][7];
            q = Sa * B5[sl][8]; q = Sb * B5[sl][9] + q;
        }
        RW_OSUM(31);
#undef RW_OSUM
#undef RW_LD
#pragma unroll
        for (int i = 0; i < 4; ++i) obuf[(i * 8 + jg) * 32 + row2] = os[i];
        } else {
            if (ch + 1 < 64) RW_STAGE((ch + 1) & 1);
            RW_FETCH(cb0 + (ch + 2 < 64 ? ch + 2 : 63));
            if (ch > 0) RW_OUT((ch - 1) & 1, ch - 1);
        }
        __syncthreads();
    }
    if (wv >= 4) RW_OUT(1, 63);
#undef RW_FETCH
#undef RW_STAGE
#undef RW_OUT
    if (wv < 4) { float* sp = ctx_out(lds) + O_PWKV + ((size_t)((l * 4 + b) * 16 + h) * 64 + half * 32 + row2) * 64 + jg * 8; *(f32x4*)sp = Sa; *(f32x4*)(sp + 4) = Sb; }
    __syncthreads();
}
__device__ __forceinline__ void scan_mlstm(LAS unsigned char* lds, int l, int u) {
    const int tid = opaque_tid(), lane = tid & 63, wave = tid >> 6, lr = lane & 15, lq = lane >> 4;
    const int bh = u >> 2, sl = u & 3, b = bh >> 2, h = bh & 3;
    const bf16_t* __restrict__ proj = (const bf16_t*)(ctx_ws(lds) + WS_PROJ); const bf16_t* __restrict__ qm = (const bf16_t*)(ctx_ws(lds) + WS_QM); const bf16_t* __restrict__ km = (const bf16_t*)(ctx_ws(lds) + WS_KM);
    const float* __restrict__ gates = (const float*)(ctx_ws(lds) + WS_GATES); bf16_t* __restrict__ hm = (bf16_t*)(ctx_ws(lds) + WS_HM);
    LAS bf16_t* kS = (LAS bf16_t*)lds;
    LAS bf16_t* kwT = (LAS bf16_t*)(lds + 33792);
    LAS bf16_t* vT = (LAS bf16_t*)(lds + 33792 + 36864);
    LAS bf16_t* Sp = (LAS bf16_t*)(lds + 33792 + 36864 + 11520);
    LAS bf16_t* CT = (LAS bf16_t*)(lds + 33792 + 36864 + 11520 + 9216);
    LAS float* gF = (LAS float*)(lds + 33792 + 36864 + 11520 + 9216 + 42240);
    LAS float* gU = gF + 64; LAS float* gM = gF + 128; LAS float* gS = gF + 192; LAS float* gD = gF + 196;
    __syncthreads();
    for (int i = tid; i < 80 * 264 / 2; i += NTHREADS) ((LAS unsigned*)CT)[i] = 0u;
    for (int i = tid; i < 16 * 72; i += NTHREADS) vT[64 * 72 + i] = (i < 72) ? (bf16_t)0x3F80 : (bf16_t)0;
    f32x4 acc[2][5];
#pragma unroll
    for (int i = 0; i < 2; ++i)
#pragma unroll
        for (int j = 0; j < 5; ++j) acc[i][j] = (f32x4){0.f, 0.f, 0.f, 0.f};
    float m_prev = 0.f;
    const int tt = wave >> 1, wodd = wave & 1, s = tid & 63, eg = tid >> 6;
    const size_t mb = (size_t)b * 2048;
    u32x4 pv = *(const u32x4*)(proj + (mb + s) * NINP + M0 + 2048 + h * 256 + sl * 64 + eg * 8);
    u32x4 pk[4];
#pragma unroll
    for (int j = 0; j < 4; ++j) pk[j] = *(const u32x4*)(km + (mb + s) * 1024 + h * 256 + (eg + 8 * j) * 8);
    bf16x8 qf[8];
#pragma unroll
    for (int ks = 0; ks < 8; ++ks) qf[ks] = *(const bf16x8*)(qm + (mb + tt * 16 + lr) * 1024 + h * 256 + ks * 32 + lq * 8);
    float pig = gates[(mb + lane) * 8 + h], plf = gates[(mb + lane) * 8 + 4 + h];
    for (int c = 0; c < 32; ++c) {
        const size_t m0 = mb + c * 64;
        if (wave == 0) {
            float F = plf;
#pragma unroll
            for (int o = 1; o < 64; o <<= 1) { const float t = __shfl_up(F, o); if (lane >= o) F += t; }
            const float uu = pig - F; float am = uu;
#pragma unroll
            for (int o = 1; o < 64; o <<= 1) { const float t = __shfl_up(am, o); if (lane >= o) am = fmaxf(am, t); }
            const float Mt = fmaxf(m_prev, am);
            gF[lane] = F; gU[lane] = uu; gM[lane] = Mt;
            if (lane == 63) { gS[0] = __expf(m_prev - Mt); gS[1] = Mt; gS[2] = F + Mt; }
        }
        { vT[(eg * 8 + 0) * 72 + s] = (bf16_t)(pv.x & 0xffffu); vT[(eg * 8 + 1) * 72 + s] = (bf16_t)(pv.x >> 16); vT[(eg * 8 + 2) * 72 + s] = (bf16_t)(pv.y & 0xffffu); vT[(eg * 8 + 3) * 72 + s] = (bf16_t)(pv.y >> 16);
          vT[(eg * 8 + 4) * 72 + s] = (bf16_t)(pv.z & 0xffffu); vT[(eg * 8 + 5) * 72 + s] = (bf16_t)(pv.z >> 16); vT[(eg * 8 + 6) * 72 + s] = (bf16_t)(pv.w & 0xffffu); vT[(eg * 8 + 7) * 72 + s] = (bf16_t)(pv.w >> 16);
#pragma unroll
          for (int j = 0; j < 4; ++j) *(LAS u32x4*)(kS + s * 264 + (eg + 8 * j) * 8) = pk[j]; }
        __syncthreads();
        const float a_c = gS[0], ML = gS[1], m_new = gS[2];
        { const float ws = __expf(gU[s] - ML);
#pragma unroll
          for (int j = 0; j < 4; ++j) { const int d0 = (eg + 8 * j) * 8; float k[8]; unpack8(pk[j], k);
#pragma unroll
              for (int i = 0; i < 8; ++i) kwT[(d0 + i) * 72 + s] = f2bf(k[i] * ws); } }
        const size_t m1 = mb + (size_t)(c + 1 < 32 ? c + 1 : 31) * 64;
        pig = gates[(m1 + lane) * 8 + h]; plf = gates[(m1 + lane) * 8 + 4 + h];
        pv = *(const u32x4*)(proj + (m1 + s) * NINP + M0 + 2048 + h * 256 + sl * 64 + eg * 8);
#pragma unroll
        for (int j = 0; j < 4; ++j) pk[j] = *(const u32x4*)(km + (m1 + s) * 1024 + h * 256 + (eg + 8 * j) * 8);
#pragma unroll
        for (int q = 0; q < 2; ++q) { const int ts = 2 * wodd + q;
            f32x4 sacc = {0.f, 0.f, 0.f, 0.f};
            if (ts <= tt) {
#pragma unroll
                for (int ks = 0; ks < 8; ++ks) { const bf16x8 kf = *(const LAS bf16x8*)(kS + (ts * 16 + lr) * 264 + ks * 32 + lq * 8); sacc = MFMA16(qf[ks], kf, sacc); }
            }
            const int sc = ts * 16 + lr; const float us = gU[sc];
#pragma unroll
            for (int r = 0; r < 4; ++r) { const int t = tt * 16 + lq * 4 + r; const float v = (sc <= t) ? sacc[r] * __expf(us - gM[t]) : 0.f; Sp[t * 72 + sc] = f2bf(v); }
        }
        __syncthreads();
        f32x4 hn[3];
#pragma unroll
        for (int q = 0; q < 3; ++q) { const int te = wodd ? 3 + q : q; hn[q] = (f32x4){0.f, 0.f, 0.f, 0.f}; if (te < 5) {
            f32x4 aq = {0.f, 0.f, 0.f, 0.f}, as = {0.f, 0.f, 0.f, 0.f};
#pragma unroll
            for (int ks = 0; ks < 8; ++ks) { const bf16x8 cf = *(const LAS bf16x8*)(CT + (te * 16 + lr) * 264 + ks * 32 + lq * 8); aq = MFMA16(qf[ks], cf, aq); }
#pragma unroll
            for (int ks = 0; ks < 2; ++ks) { const bf16x8 sf = *(const LAS bf16x8*)(Sp + (tt * 16 + lr) * 72 + ks * 32 + lq * 8); const bf16x8 vf = *(const LAS bf16x8*)(vT + (te * 16 + lr) * 72 + ks * 32 + lq * 8); as = MFMA16(sf, vf, as); }
#pragma unroll
            for (int r = 0; r < 4; ++r) { const int t = tt * 16 + lq * 4 + r; hn[q][r] = __expf(m_prev - gM[t]) * aq[r] + as[r]; }
            if (te == 4 && lr == 0) {
#pragma unroll
                for (int r = 0; r < 4; ++r) gD[tt * 16 + lq * 4 + r] = hn[q][r]; }
        } }
#pragma unroll
        for (int ks = 0; ks < 8; ++ks) qf[ks] = *(const bf16x8*)(qm + (m1 + tt * 16 + lr) * 1024 + h * 256 + ks * 32 + lq * 8);
#pragma unroll
        for (int i = 0; i < 2; ++i) { const int dt = wave * 2 + i;
            bf16x8 kf[2];
#pragma unroll
            for (int ks = 0; ks < 2; ++ks) kf[ks] = *(const LAS bf16x8*)(kwT + (dt * 16 + lr) * 72 + ks * 32 + lq * 8);
#pragma unroll
            for (int et = 0; et < 5; ++et) { acc[i][et] = acc[i][et] * a_c;
#pragma unroll
                for (int ks = 0; ks < 2; ++ks) { const bf16x8 vf = *(const LAS bf16x8*)(vT + (et * 16 + lr) * 72 + ks * 32 + lq * 8); acc[i][et] = MFMA16(kf[ks], vf, acc[i][et]); } } }
        __syncthreads();
#pragma unroll
        for (int i = 0; i < 2; ++i) { const int dt = wave * 2 + i;
#pragma unroll
            for (int et = 0; et < 5; ++et) { u32x2 w; w.x = pk2(acc[i][et][0], acc[i][et][1]); w.y = pk2(acc[i][et][2], acc[i][et][3]);
                *(LAS u32x2*)(CT + (et * 16 + lr) * 264 + dt * 16 + lq * 4) = w; } }
        { float dd[4];
#pragma unroll
          for (int r = 0; r < 4; ++r) { const int t = tt * 16 + lq * 4 + r; dd[r] = 1.f / fmaxf(fabsf(gD[t]), __expf(-(gF[t] + gM[t]))); }
#pragma unroll
          for (int q = 0; q < 3; ++q) { const int te = wodd ? 3 + q : q; if (te < 4) {
#pragma unroll
              for (int r = 0; r < 4; ++r) hm[(m0 + tt * 16 + lq * 4 + r) * 1024 + h * 256 + sl * 64 + te * 16 + lr] = f2bf(hn[q][r] * dd[r]); } } }
        m_prev = m_new;
        __syncthreads();
    }
#pragma unroll
    for (int i = 0; i < 2; ++i) { const int dt = wave * 2 + i;
#pragma unroll
        for (int et = 0; et < 5; ++et)
#pragma unroll
            for (int r = 0; r < 4; ++r) { const int d = dt * 16 + lq * 4 + r;
                if (et < 4) ctx_out(lds)[O_PC + ((size_t)((l * 4 + b) * 4 + h) * 256 + d) * 256 + sl * 64 + et * 16 + lr] = acc[i][et][r];
                else if (sl == 0 && lr == 0) ctx_out(lds)[O_PN + (size_t)((l * 4 + b) * 4 + h) * 256 + d] = acc[i][et][r]; } }
    if (sl == 0 && tid == 0) ctx_out(lds)[O_PM + (l * 4 + b) * 4 + h] = m_prev;
    __syncthreads();
}
__device__ __forceinline__ void scan_gla(LAS unsigned char* lds, int l, int u) {
    const int tid = opaque_tid(), lane = tid & 63, wave = tid >> 6, lr = lane & 15, lq = lane >> 4;
    const int bh = u >> 2, sl = u & 3, b = bh >> 2, h = bh & 3;
    const bf16_t* __restrict__ proj = (const bf16_t*)(ctx_ws(lds) + WS_PROJ); const bf16_t* __restrict__ gq = (const bf16_t*)(ctx_ws(lds) + WS_GQ); const bf16_t* __restrict__ gk = (const bf16_t*)(ctx_ws(lds) + WS_GK); const bf16_t* __restrict__ gkh = (const bf16_t*)(ctx_ws(lds) + WS_GKH);
    const float* __restrict__ egl = (const float*)(ctx_ws(lds) + WS_EGL); bf16_t* __restrict__ og = (bf16_t*)(ctx_ws(lds) + WS_OG);
    LAS bf16_t* khT = (LAS bf16_t*)lds;
    LAS bf16_t* vT = (LAS bf16_t*)(lds + 18432);
    LAS bf16_t* Ap = (LAS bf16_t*)(lds + 18432 + 9216);
    LAS bf16_t* ST = (LAS bf16_t*)(lds + 36864);
    LAS bf16_t* kS = (LAS bf16_t*)(lds + 36864 + 17408);
    __syncthreads();
    for (int i = tid; i < 64 * 136 / 2; i += NTHREADS) ((LAS unsigned*)ST)[i] = 0u;
    f32x4 acc[4];
#pragma unroll
    for (int j = 0; j < 4; ++j) acc[j] = (f32x4){0.f, 0.f, 0.f, 0.f};
    const int tt = wave >> 1, wodd = wave & 1, s = tid & 63, eg = tid >> 6;
    const size_t mb = (size_t)b * 2048;
    u32x4 pv = *(const u32x4*)(proj + (mb + s) * NINP + G0 + 1024 + h * 256 + sl * 64 + eg * 8);
    u32x4 pkh[2], pgk[2];
#pragma unroll
    for (int j = 0; j < 2; ++j) { pkh[j] = *(const u32x4*)(gkh + (mb + s) * 512 + h * 128 + (eg + 8 * j) * 8); pgk[j] = *(const u32x4*)(gk + (mb + s) * 512 + h * 128 + (eg + 8 * j) * 8); }
    bf16x8 qf[4];
#pragma unroll
    for (int ks = 0; ks < 4; ++ks) qf[ks] = *(const bf16x8*)(gq + (mb + tt * 16 + lr) * 512 + h * 128 + ks * 32 + lq * 8);
    float eg4[4];
#pragma unroll
    for (int r = 0; r < 4; ++r) eg4[r] = egl[(size_t)(b * 32) * 512 + h * 128 + wave * 16 + lq * 4 + r];
    for (int c = 0; c < 32; ++c) {
        const int cidx = b * 32 + c; const size_t m0 = (size_t)cidx * 64;
        { vT[(eg * 8 + 0) * 72 + s] = (bf16_t)(pv.x & 0xffffu); vT[(eg * 8 + 1) * 72 + s] = (bf16_t)(pv.x >> 16); vT[(eg * 8 + 2) * 72 + s] = (bf16_t)(pv.y & 0xffffu); vT[(eg * 8 + 3) * 72 + s] = (bf16_t)(pv.y >> 16);
          vT[(eg * 8 + 4) * 72 + s] = (bf16_t)(pv.z & 0xffffu); vT[(eg * 8 + 5) * 72 + s] = (bf16_t)(pv.z >> 16); vT[(eg * 8 + 6) * 72 + s] = (bf16_t)(pv.w & 0xffffu); vT[(eg * 8 + 7) * 72 + s] = (bf16_t)(pv.w >> 16);
#pragma unroll
          for (int j = 0; j < 2; ++j) { const int d0 = (eg + 8 * j) * 8; const u32x4 w = pkh[j];
              khT[(d0 + 0) * 72 + s] = (bf16_t)(w.x & 0xffffu); khT[(d0 + 1) * 72 + s] = (bf16_t)(w.x >> 16); khT[(d0 + 2) * 72 + s] = (bf16_t)(w.y & 0xffffu); khT[(d0 + 3) * 72 + s] = (bf16_t)(w.y >> 16);
              khT[(d0 + 4) * 72 + s] = (bf16_t)(w.z & 0xffffu); khT[(d0 + 5) * 72 + s] = (bf16_t)(w.z >> 16); khT[(d0 + 6) * 72 + s] = (bf16_t)(w.w & 0xffffu); khT[(d0 + 7) * 72 + s] = (bf16_t)(w.w >> 16);
              *(LAS u32x4*)(kS + s * 136 + d0) = pgk[j]; } }
        __syncthreads();
        const float e0 = eg4[0], e1 = eg4[1], e2 = eg4[2], e3 = eg4[3];
        const int cn = c + 1 < 32 ? cidx + 1 : cidx; const size_t m1 = (size_t)cn * 64;
        pv = *(const u32x4*)(proj + (m1 + s) * NINP + G0 + 1024 + h * 256 + sl * 64 + eg * 8);
#pragma unroll
        for (int j = 0; j < 2; ++j) { pkh[j] = *(const u32x4*)(gkh + (m1 + s) * 512 + h * 128 + (eg + 8 * j) * 8); pgk[j] = *(const u32x4*)(gk + (m1 + s) * 512 + h * 128 + (eg + 8 * j) * 8); }
#pragma unroll
        for (int r = 0; r < 4; ++r) eg4[r] = egl[(size_t)cn * 512 + h * 128 + wave * 16 + lq * 4 + r];
#pragma unroll
        for (int q = 0; q < 2; ++q) { const int ts = 2 * wodd + q;
            f32x4 sacc = {0.f, 0.f, 0.f, 0.f};
            if (ts <= tt) {
#pragma unroll
                for (int ks = 0; ks < 4; ++ks) { const bf16x8 kf = *(const LAS bf16x8*)(kS + (ts * 16 + lr) * 136 + ks * 32 + lq * 8); sacc = MFMA16(qf[ks], kf, sacc); }
            }
            const int sc = ts * 16 + lr;
#pragma unroll
            for (int r = 0; r < 4; ++r) { const int t = tt * 16 + lq * 4 + r; Ap[t * 72 + sc] = f2bf((sc <= t) ? sacc[r] : 0.f); }
        }
        __syncthreads();
#pragma unroll
        for (int q = 0; q < 2; ++q) { const int te = 2 * wodd + q;
            f32x4 ao = {0.f, 0.f, 0.f, 0.f};
#pragma unroll
            for (int ks = 0; ks < 4; ++ks) { const bf16x8 sf = *(const LAS bf16x8*)(ST + (te * 16 + lr) * 136 + ks * 32 + lq * 8); ao = MFMA16(qf[ks], sf, ao); }
#pragma unroll
            for (int ks = 0; ks < 2; ++ks) { const bf16x8 af = *(const LAS bf16x8*)(Ap + (tt * 16 + lr) * 72 + ks * 32 + lq * 8); const bf16x8 vf = *(const LAS bf16x8*)(vT + (te * 16 + lr) * 72 + ks * 32 + lq * 8); ao = MFMA16(af, vf, ao); }
#pragma unroll
            for (int r = 0; r < 4; ++r) og[(m0 + tt * 16 + lq * 4 + r) * 1024 + h * 256 + sl * 64 + te * 16 + lr] = f2bf(ao[r]);
        }
#pragma unroll
        for (int ks = 0; ks < 4; ++ks) qf[ks] = *(const bf16x8*)(gq + (m1 + tt * 16 + lr) * 512 + h * 128 + ks * 32 + lq * 8);
        { const int dt = wave;
          bf16x8 kf[2];
#pragma unroll
          for (int ks = 0; ks < 2; ++ks) kf[ks] = *(const LAS bf16x8*)(khT + (dt * 16 + lr) * 72 + ks * 32 + lq * 8);
#pragma unroll
          for (int et = 0; et < 4; ++et) {
              acc[et][0] *= e0; acc[et][1] *= e1; acc[et][2] *= e2; acc[et][3] *= e3;
#pragma unroll
              for (int ks = 0; ks < 2; ++ks) { const bf16x8 vf = *(const LAS bf16x8*)(vT + (et * 16 + lr) * 72 + ks * 32 + lq * 8); acc[et] = MFMA16(kf[ks], vf, acc[et]); } } }
        __syncthreads();
#pragma unroll
        for (int et = 0; et < 4; ++et) { u32x2 w; w.x = pk2(acc[et][0], acc[et][1]); w.y = pk2(acc[et][2], acc[et][3]);
            *(LAS u32x2*)(ST + (et * 16 + lr) * 136 + wave * 16 + lq * 4) = w; }
        __syncthreads();
    }
#pragma unroll
    for (int et = 0; et < 4; ++et)
#pragma unroll
        for (int r = 0; r < 4; ++r) ctx_out(lds)[O_PGLA + ((size_t)((l * 4 + b) * 4 + h) * 128 + wave * 16 + lq * 4 + r) * 256 + sl * 64 + et * 16 + lr] = acc[et][r];
    __syncthreads();
}
#ifndef SC_MASK
#define SC_MASK 63
#endif
constexpr unsigned N_SITEMS = 8192u;
__device__ __forceinline__ f32x4 xsum4(const f32x4 v, int o) { return (f32x4){v.x + __shfl_xor(v.x, o), v.y + __shfl_xor(v.y, o), v.z + __shfl_xor(v.z, o), v.w + __shfl_xor(v.w, o)}; }
__device__ __forceinline__ f32x4 bf4(const u32x2 w) { return (f32x4){__uint_as_float(w.x << 16), __uint_as_float(w.x & 0xffff0000u), __uint_as_float(w.y << 16), __uint_as_float(w.y & 0xffff0000u)}; }
#define PIN8(a, i0) asm volatile("" : "+v"(a[i0]), "+v"(a[i0 + 1]), "+v"(a[i0 + 2]), "+v"(a[i0 + 3]), "+v"(a[i0 + 4]), "+v"(a[i0 + 5]), "+v"(a[i0 + 6]), "+v"(a[i0 + 7]))
__device__ __forceinline__ void witem_mlstm(LAS unsigned char* lds, LAS float* wl, int l, int it, int lane) {
    const int es = it & 7, h = (it >> 3) & 3, s = it >> 5, c = lane & 7, rr = lane >> 3, e0 = es * 32 + c * 4;
    const bf16_t* __restrict__ proj = (const bf16_t*)(ctx_ws(lds) + WS_PROJ); const bf16_t* __restrict__ qm = (const bf16_t*)(ctx_ws(lds) + WS_QM); const bf16_t* __restrict__ km = (const bf16_t*)(ctx_ws(lds) + WS_KM);
    const float* __restrict__ gates = (const float*)(ctx_ws(lds) + WS_GATES); bf16_t* __restrict__ hm = (bf16_t*)(ctx_ws(lds) + WS_HM);
    const size_t m = MP + s; const size_t sb = (size_t)(l * 128 + s) * 4 + h;
    const float* __restrict__ Cs = ctx_in(lds, I_SC) + sb * 65536 + (size_t)(rr * 32) * 256 + e0; float* Co = ctx_out(lds) + O_SC + sb * 65536 + (size_t)(rr * 32) * 256 + e0;
    f32x4 cb[32];
#pragma unroll
    for (int i = 0; i < 32; ++i) cb[i] = *(const f32x4*)(Cs + (size_t)i * 256);
    const float* __restrict__ nin = ctx_in(lds, I_SN) + sb * 256;
    const f32x4 q4 = bf4(*(const u32x2*)(qm + m * 1024 + h * 256 + lane * 4)), k4 = bf4(*(const u32x2*)(km + m * 1024 + h * 256 + lane * 4)), n4 = *(const f32x4*)(nin + lane * 4);
    const f32x4 v4 = bf4(*(const u32x2*)(proj + m * NINP + M0 + 2048 + h * 256 + e0)), nE = *(const f32x4*)(nin + e0);
    const float ig = gates[m * 8 + h], lf = gates[m * 8 + 4 + h], m_prev = ctx_in(lds, I_SM)[sb];
    *(LAS f32x4*)(wl + lane * 4) = q4; *(LAS f32x4*)(wl + 256 + lane * 4) = k4;
    const float qk = wave_sum((q4.x * k4.x + q4.y * k4.y) + (q4.z * k4.z + q4.w * k4.w)), qn = wave_sum((q4.x * n4.x + q4.y * n4.y) + (q4.z * n4.z + q4.w * n4.w));
    const float uu = ig - lf, Mx = fmaxf(m_prev, uu), m_t = lf + Mx, w_inter = __expf(m_prev - Mx), ws = __expf(uu - Mx), Sv = qk * ws;
    __builtin_amdgcn_wave_barrier();
    PIN8(cb, 0); PIN8(cb, 8); PIN8(cb, 16); PIN8(cb, 24);
    f32x4 num = {0.f, 0.f, 0.f, 0.f};
#pragma unroll
    for (int i4 = 0; i4 < 8; ++i4) { const f32x4 qd = *(const LAS f32x4*)(wl + rr * 32 + i4 * 4), kd = *(const LAS f32x4*)(wl + 256 + rr * 32 + i4 * 4);
#pragma unroll
        for (int j = 0; j < 4; ++j) { const f32x4 c4 = cb[i4 * 4 + j]; num = num + qd[j] * c4; *(f32x4*)(Co + (size_t)(i4 * 4 + j) * 256) = w_inter * c4 + (ws * kd[j]) * v4; } }
    num = xsum4(num, 8); num = xsum4(num, 16); num = xsum4(num, 32);
    if (rr == 0) { const f32x4 kE = *(const LAS f32x4*)(wl + 256 + e0);
        const float den = w_inter * qn + Sv, dinv = 1.f / fmaxf(fabsf(den), __expf(-m_t));
        const f32x4 nm = w_inter * num + Sv * v4;
        u32x2 w; w.x = pk2(nm.x * dinv, nm.y * dinv); w.y = pk2(nm.z * dinv, nm.w * dinv);
        *(u32x2*)(hm + m * 1024 + h * 256 + e0) = w;
        *(f32x4*)(ctx_out(lds) + O_SN + sb * 256 + e0) = w_inter * nE + ws * kE;
        if (es == 0 && lane == 0) ctx_out(lds)[O_SM + sb] = m_t; }
    __builtin_amdgcn_wave_barrier();
}
__device__ __forceinline__ void witem_gla(LAS unsigned char* lds, LAS float* wl, int l, int it, int lane) {
    const int es = it & 3, h = (it >> 2) & 3, s = it >> 4, c = lane & 15, rr = lane >> 4, e0 = es * 64 + c * 4;
    const bf16_t* __restrict__ proj = (const bf16_t*)(ctx_ws(lds) + WS_PROJ); const bf16_t* __restrict__ gq = (const bf16_t*)(ctx_ws(lds) + WS_GQ); const bf16_t* __restrict__ gk = (const bf16_t*)(ctx_ws(lds) + WS_GK); const bf16_t* __restrict__ gkh = (const bf16_t*)(ctx_ws(lds) + WS_GKH);
    const float* __restrict__ egl = (const float*)(ctx_ws(lds) + WS_EGL); bf16_t* __restrict__ og = (bf16_t*)(ctx_ws(lds) + WS_OG);
    const size_t m = MP + s; const size_t sb = (size_t)(l * 128 + s) * 4 + h;
    const float* __restrict__ Ss = ctx_in(lds, I_SGLA) + sb * 32768 + (size_t)(rr * 32) * 256 + e0; float* So = ctx_out(lds) + O_SGLA + sb * 32768 + (size_t)(rr * 32) * 256 + e0;
    f32x4 st[32];
#pragma unroll
    for (int i = 0; i < 32; ++i) st[i] = *(const f32x4*)(Ss + (size_t)i * 256);
    const unsigned qw = *(const unsigned*)(gq + m * 512 + h * 128 + lane * 2), kw = *(const unsigned*)(gk + m * 512 + h * 128 + lane * 2), hw = *(const unsigned*)(gkh + m * 512 + h * 128 + lane * 2);
    const f32x2_t e2 = *(const f32x2_t*)(egl + (size_t)(128 + s) * 512 + h * 128 + lane * 2);
    const f32x4 v4 = bf4(*(const u32x2*)(proj + m * NINP + G0 + 1024 + h * 256 + e0));
    const float q0 = __uint_as_float(qw << 16), q1 = __uint_as_float(qw & 0xffff0000u);
    *(LAS f32x2_t*)(wl + lane * 2) = (f32x2_t){q0, q1}; *(LAS f32x2_t*)(wl + 128 + lane * 2) = (f32x2_t){__uint_as_float(hw << 16), __uint_as_float(hw & 0xffff0000u)}; *(LAS f32x2_t*)(wl + 256 + lane * 2) = e2;
    const float A = wave_sum(q0 * __uint_as_float(kw << 16) + q1 * __uint_as_float(kw & 0xffff0000u));
    __builtin_amdgcn_wave_barrier();
    PIN8(st, 0); PIN8(st, 8); PIN8(st, 16); PIN8(st, 24);
    f32x4 o4 = {0.f, 0.f, 0.f, 0.f};
#pragma unroll
    for (int i4 = 0; i4 < 8; ++i4) { const f32x4 qd = *(const LAS f32x4*)(wl + rr * 32 + i4 * 4), hd = *(const LAS f32x4*)(wl + 128 + rr * 32 + i4 * 4), ed = *(const LAS f32x4*)(wl + 256 + rr * 32 + i4 * 4);
#pragma unroll
        for (int j = 0; j < 4; ++j) { const f32x4 s4 = st[i4 * 4 + j]; o4 = o4 + qd[j] * s4; *(f32x4*)(So + (size_t)(i4 * 4 + j) * 256) = ed[j] * s4 + hd[j] * v4; } }
    o4 = xsum4(o4, 16); o4 = xsum4(o4, 32);
    if (rr == 0) { const f32x4 r = o4 + A * v4; u32x2 w; w.x = pk2(r.x, r.y); w.y = pk2(r.z, r.w); *(u32x2*)(og + m * 1024 + h * 256 + e0) = w; }
    __builtin_amdgcn_wave_barrier();
}
__device__ __forceinline__ void witem_rwkv(LAS unsigned char* lds, int l, int it, int lane) {
    const int s = it >> 4, h = it & 15, r0 = lane >> 2, kq = lane & 3;
    const float* __restrict__ rpre = (const float*)(ctx_ws(lds) + WS_RPRE); bf16_t* __restrict__ rout = (bf16_t*)(ctx_ws(lds) + WS_ROUT);
    const size_t m = MP + s, po = m * 1024 + h * 64 + kq * 16;
    const size_t so = ((size_t)((l * 128 + s) * 16 + h) * 64 + r0) * 64 + kq * 16;
    const float* __restrict__ sp = ctx_in(lds, I_SWKV) + so; float* So = ctx_out(lds) + O_SWKV + so;
    const bf16_t* rb = (const bf16_t*)rpre; const float* rw = (const float*)((const unsigned char*)rpre + RP_W);
    f32x4 S[16];
#pragma unroll
    for (int p = 0; p < 4; ++p)
#pragma unroll
        for (int k = 0; k < 4; ++k) S[p * 4 + k] = *(const f32x4*)(sp + p * 1024 + k * 4);
    f32x4 kk[4], bb[4], ww[4], k2[4], rr[4];
    { float t0[16], t1[16], t2[16], t3[16];
      ld16b(rb + po, t0); ld16b(rb + ARR + po, t1); ld16b(rb + 2 * ARR + po, t2); ld16b(rb + 3 * ARR + po, t3);
#pragma unroll
      for (int k = 0; k < 4; ++k) { ww[k] = *(const f32x4*)(rw + po + k * 4);
          kk[k] = (f32x4){t0[4 * k], t0[4 * k + 1], t0[4 * k + 2], t0[4 * k + 3]}; bb[k] = (f32x4){t1[4 * k], t1[4 * k + 1], t1[4 * k + 2], t1[4 * k + 3]};
          k2[k] = (f32x4){t2[4 * k], t2[4 * k + 1], t2[4 * k + 2], t2[4 * k + 3]}; rr[k] = (f32x4){t3[4 * k], t3[4 * k + 1], t3[4 * k + 2], t3[4 * k + 3]}; } }
    float vv[4];
#pragma unroll
    for (int p = 0; p < 4; ++p) vv[p] = bf2f(rb[4 * ARR + m * 1024 + h * 64 + r0 + 16 * p]);
    PIN8(S, 0); PIN8(S, 8);
#pragma unroll
    for (int p = 0; p < 4; ++p) {
        float sa = 0.f;
#pragma unroll
        for (int k = 0; k < 4; ++k) { const f32x4 x = S[p * 4 + k]; sa += (x.x * kk[k].x + x.y * kk[k].y) + (x.z * kk[k].z + x.w * kk[k].w); }
        sa = quad_sum(sa);
        float o = 0.f;
#pragma unroll
        for (int k = 0; k < 4; ++k) { const f32x4 n4 = S[p * 4 + k] * ww[k] - sa * bb[k] + vv[p] * k2[k]; o += (n4.x * rr[k].x + n4.y * rr[k].y) + (n4.z * rr[k].z + n4.w * rr[k].w);
            *(f32x4*)(So + p * 1024 + k * 4) = n4; }
        o = quad_sum(o);
        if (kq == 0) rout[m * 1024 + h * 64 + r0 + 16 * p] = f2bf(o);
    }
}
__device__ __forceinline__ unsigned wave_pop(unsigned* queue, int lane) {
    unsigned v = 0u;
    if (lane == 0) v = __hip_atomic_fetch_add(queue, 1u, __ATOMIC_RELAXED, __HIP_MEMORY_SCOPE_AGENT);
    return (unsigned)__builtin_amdgcn_readfirstlane((int)v);
}
__device__ __forceinline__ void wave_item(LAS unsigned char* lds, int l, unsigned it, int tid) {
    LAS float* wl = (LAS float*)(lds + 102400 + (tid >> 6) * 4096); const int lane = tid & 63;
    if (it < 4096u) { if (SC_MASK & 16) witem_mlstm(lds, wl, l, (int)it, lane); }
    else if (it < 6144u) { if (SC_MASK & 32) witem_gla(lds, wl, l, (int)it - 4096, lane); }
    else { if (SC_MASK & 8) witem_rwkv(lds, l, (int)it - 6144, lane); }
}
__device__ __forceinline__ void phase_scan(LAS unsigned char* lds, int l, int G, unsigned* queue, int rmask) {
    for (int u = blockIdx.x; u < 256; u += G) {
        const int slot = u >> 3, x = u & 7, role = slot & 3, s2 = slot >> 2;
        const int idx = role < 2 ? (s2 * 8 + x) : ((x * 2 + (s2 >> 2)) * 4 + (s2 & 3));
        if (rmask && !((rmask >> (role < 2 ? 0 : role - 1)) & 1)) continue;
        if (role < 2) { if (SC_MASK & 1) scan_rwkv(lds, l, idx * 2 + role); }
        else if (role == 2) { if (SC_MASK & 2) scan_mlstm(lds, l, idx); }
        else { if (SC_MASK & 4) scan_gla(lds, l, idx); }
    }
    __syncthreads();
    for (;;) { const unsigned it = wave_pop(queue, (int)threadIdx.x & 63); if (it >= N_SITEMS) break; wave_item(lds, l, it, opaque_tid()); }
}

__device__ __forceinline__ void ld16l(const LAS float* p, float (&f)[16]) {
#pragma unroll
    for (int k = 0; k < 4; ++k) { const f32x4 t = *(const LAS f32x4*)(p + 4 * k); f[4 * k] = t.x; f[4 * k + 1] = t.y; f[4 * k + 2] = t.z; f[4 * k + 3] = t.w; }
}
__device__ __forceinline__ void phase_post(LAS unsigned char* lds, int l, int G) {
    const int tid = opaque_tid(), lane = tid & 63, wave = tid >> 6, c0 = lane * 16;
    const bf16_t* __restrict__ proj = (const bf16_t*)(ctx_ws(lds) + WS_PROJ); const float* __restrict__ rpre = (const float*)(ctx_ws(lds) + WS_RPRE); const bf16_t* __restrict__ rout = (const bf16_t*)(ctx_ws(lds) + WS_ROUT);
    const bf16_t* __restrict__ hm = (const bf16_t*)(ctx_ws(lds) + WS_HM); const bf16_t* __restrict__ og = (const bf16_t*)(ctx_ws(lds) + WS_OG); bf16_t* __restrict__ obr = (bf16_t*)(ctx_ws(lds) + WS_QM);
    LAS float* pl = (LAS float*)lds;
    __syncthreads();
    for (int i = tid; i < 11264; i += NTHREADS) { float v;
        if (i < 1024) v = ctx_in(lds, I_RK)[l * 1024 + i]; else if (i < 2048) v = ctx_in(lds, I_LNG)[l * 1024 + i - 1024]; else if (i < 3072) v = ctx_in(lds, I_LNB)[l * 1024 + i - 2048];
        else if (i < 4096) v = ctx_in(lds, I_MNORM)[l * 1024 + i - 3072]; else if (i < 5120) v = ctx_in(lds, I_GNORM)[l * 1024 + i - 4096]; else v = ctx_in(lds, I_GATEB)[(size_t)l * 6144 + i - 5120];
        pl[i] = v; }
    __syncthreads();
    for (int it = blockIdx.x * 8 + wave; it < MP + 512; it += G * 8) {
        const int m = it < MP ? it : MP + ((it - MP) >> 2); const int part = it < MP ? -1 : (it - MP) & 3;
        const size_t o = (size_t)m * 1024 + c0;
        const bf16_t* prow = proj + (size_t)m * NINP;
        u32x4 L[30];
#define POST_LD(slot, ptr) do { L[slot] = *(const u32x4*)(ptr); L[(slot) + 1] = *(const u32x4*)((ptr) + 8); } while (0)
        if (part < 0 || part == 0) { POST_LD(0, rout + o); POST_LD(2, (const bf16_t*)rpre + 3 * ARR + o); POST_LD(4, (const bf16_t*)rpre + 2 * ARR + o); POST_LD(6, (const bf16_t*)rpre + 4 * ARR + o); POST_LD(8, (const bf16_t*)rpre + 5 * ARR + o); }
        if (part < 0 || part == 1) { POST_LD(10, hm + o); POST_LD(12, prow + M0 + 3080 + c0); }
        if (part < 0 || part == 2) { POST_LD(14, og + o); POST_LD(16, prow + G0 + 2064 + c0); }
        if (part < 0 || part == 3) {
#pragma unroll
            for (int q = 0; q < 2; ++q)
#pragma unroll
                for (int j = 0; j < 3; ++j) POST_LD(18 + (q * 3 + j) * 2, prow + GT0 + j * 2048 + q * 1024 + c0); }
#undef POST_LD
#define POST_UP(slot, arr) do { unpack8(L[slot], *(float(*)[8])&arr[0]); unpack8(L[(slot) + 1], *(float(*)[8])&arr[8]); } while (0)
        if (part < 0 || part == 0) {
            float x[16], r[16], k2[16], v[16], g[16], rk[16], lg[16], lb[16];
            POST_UP(0, x); POST_UP(2, r); POST_UP(4, k2); POST_UP(6, v); POST_UP(8, g);
            ld16l(pl + c0, rk); ld16l(pl + 1024 + c0, lg); ld16l(pl + 2048 + c0, lb);
            float s = 0.f, bs = 0.f;
#pragma unroll
            for (int j = 0; j < 16; ++j) { s += x[j]; bs += r[j] * k2[j] * rk[j]; }
            s += __shfl_xor(s, 1); s += __shfl_xor(s, 2); bs += __shfl_xor(bs, 1); bs += __shfl_xor(bs, 2);
            const float mean = s * (1.f / 64.f); float q = 0.f;
#pragma unroll
            for (int j = 0; j < 16; ++j) { const float d = x[j] - mean; q += d * d; }
            q += __shfl_xor(q, 1); q += __shfl_xor(q, 2);
            const float rstd = rsqrtf(q * (1.f / 64.f) + 64e-5f);
            float y[16];
#pragma unroll
            for (int j = 0; j < 16; ++j) y[j] = ((x[j] - mean) * rstd * lg[j] + lb[j] + bs * v[j]) * g[j];
            st16b(obr + (size_t)m * 3072 + c0, y);
        }
        if (part < 0 || part == 1) {
            float x[16], ng[16], go[16];
            POST_UP(10, x); POST_UP(12, go); ld16l(pl + 3072 + c0, ng);
            float q = 0.f;
#pragma unroll
            for (int j = 0; j < 16; ++j) q += x[j] * x[j];
            q += __shfl_xor(q, 1); q += __shfl_xor(q, 2); q += __shfl_xor(q, 4); q += __shfl_xor(q, 8);
            const float rs = rsqrtf(q * (1.f / 256.f) + 1e-6f);
            float y[16];
#pragma unroll
            for (int j = 0; j < 16; ++j) y[j] = x[j] * rs * ng[j] * sigm(go[j]);
            st16b(obr + (size_t)m * 3072 + 1024 + c0, y);
        }
        if (part < 0 || part == 2) {
            float x[16], ng[16], go[16];
            POST_UP(14, x); POST_UP(16, go); ld16l(pl + 4096 + c0, ng);
            float q = 0.f;
#pragma unroll
            for (int j = 0; j < 16; ++j) q += x[j] * x[j];
            q += __shfl_xor(q, 1); q += __shfl_xor(q, 2); q += __shfl_xor(q, 4); q += __shfl_xor(q, 8);
            const float rs = rsqrtf(q * (1.f / 256.f) + 1e-6f);
            float y[16];
#pragma unroll
            for (int j = 0; j < 16; ++j) y[j] = x[j] * rs * ng[j] * siluf(go[j]);
            st16b(obr + (size_t)m * 3072 + 2048 + c0, y);
        }
        if (part < 0 || part == 3) {
            bf16_t* __restrict__ gr = (bf16_t*)(ctx_ws(lds) + WS_RPRE + RP_GR) + (size_t)m * 6144; const float* __restrict__ gbv = ctx_in(lds, I_GATEB) + (size_t)l * 3 * 2048;
#pragma unroll
            for (int q = 0; q < 2; ++q) { const int d0 = q * 1024 + c0;
                float e0[16], e1[16], e2[16], gb[16];
                POST_UP(18 + (q * 3 + 0) * 2, e0); POST_UP(18 + (q * 3 + 1) * 2, e1); POST_UP(18 + (q * 3 + 2) * 2, e2);
                ld16l(pl + 5120 + d0, gb);
#pragma unroll
                for (int j = 0; j < 16; ++j) e0[j] = 1.f + __expf(-(e0[j] + gb[j]));
                ld16l(pl + 5120 + 2048 + d0, gb);
#pragma unroll
                for (int j = 0; j < 16; ++j) e1[j] = 1.f + __expf(-(e1[j] + gb[j]));
                ld16l(pl + 5120 + 4096 + d0, gb);
#pragma unroll
                for (int j = 0; j < 16; ++j) { e2[j] = 1.f + __expf(-(e2[j] + gb[j])); const float i0 = __builtin_amdgcn_rcpf(e0[j]), i1 = __builtin_amdgcn_rcpf(e1[j]), i2 = __builtin_amdgcn_rcpf(e2[j]);
                    e0[j] = e1[j] * i0; e1[j] = e2[j] * i1; e2[j] = i2; }
                st16b(gr + d0, e0); st16b(gr + 2048 + d0, e1); st16b(gr + 4096 + d0, e2); }
        }
#undef POST_UP
    }
}

template <int MODE>
__device__ __forceinline__ void skinny_phase(LAS unsigned char* lds, const bf16_t* A, int lda, const bf16_t* Bt, int ldb, int K, float* X, bf16_t* merged, const bf16_t* gr, const float* unused, int G) {
    const int tid = opaque_tid(), lane = tid & 63, wave = tid >> 6, lr = lane & 15, lq = lane >> 4, rt = wave & 3, kh = wave >> 2;
    LAS float* xch = (LAS float*)lds;
    for (int u = blockIdx.x; u < 256; u += G) {
        const int cg = u >> 1, rh = u & 1;
        const bf16_t* ap = A + (size_t)(MP + rh * 64 + rt * 16 + lr) * lda + lq * 8;
        const bf16_t* bp = Bt + (size_t)(cg * 16 + lr) * ldb + lq * 8;
        const int row0 = MP + rh * 64 + rt * 16 + lq * 4, col = cg * 16 + lr;
        constexpr int NJ = MODE == 0 ? 1 : 3;
        const int Kj = MODE == 0 ? K : 1024, Kh = Kj / 2;
        f32x4 acc[NJ];
#pragma unroll
        for (int j = 0; j < NJ; ++j) {
            f32x4 a0c = {0.f, 0.f, 0.f, 0.f}, a1c = {0.f, 0.f, 0.f, 0.f};
            const bf16_t* aj = ap + j * 1024 + kh * Kh; const bf16_t* bj = bp + j * 1024 + kh * Kh;
            bf16x8 av[8], bv[8], an[8], bn[8];
#pragma unroll
            for (int i = 0; i < 8; ++i) { av[i] = *(const bf16x8*)(aj + i * 32); bv[i] = *(const bf16x8*)(bj + i * 32); }
            for (int k0 = 0; k0 < Kh; k0 += 256) {
                const int kn = k0 + 256 < Kh ? k0 + 256 : k0;
#pragma unroll
                for (int i = 0; i < 8; ++i) { an[i] = *(const bf16x8*)(aj + kn + i * 32); bn[i] = *(const bf16x8*)(bj + kn + i * 32); }
#pragma unroll
                for (int i = 0; i < 8; i += 2) { a0c = MFMA16(av[i], bv[i], a0c); a1c = MFMA16(av[i + 1], bv[i + 1], a1c); }
#pragma unroll
                for (int i = 0; i < 8; ++i) { av[i] = an[i]; bv[i] = bn[i]; }
            }
            acc[j] = a0c + a1c;
        }
        __syncthreads();
        if (kh == 1) {
#pragma unroll
            for (int j = 0; j < NJ; ++j) *(LAS f32x4*)(xch + ((j * 4 + rt) * 64 + lane) * 4) = acc[j]; }
        __syncthreads();
        if (kh == 0) {
#pragma unroll
            for (int j = 0; j < NJ; ++j) acc[j] = acc[j] + *(const LAS f32x4*)(xch + ((j * 4 + rt) * 64 + lane) * 4);
            if (MODE == 0) {
                { float xo[4];
#pragma unroll
                  for (int r = 0; r < 4; ++r) xo[r] = X[(size_t)(row0 + r) * 2048 + col];
                  asm volatile("" : "+v"(xo[0]), "+v"(xo[1]), "+v"(xo[2]), "+v"(xo[3]));
#pragma unroll
                  for (int r = 0; r < 4; ++r) X[(size_t)(row0 + r) * 2048 + col] = xo[r] + acc[0][r]; }
            } else {
#pragma unroll
                for (int r = 0; r < 4; ++r) { float o = 0.f;
#pragma unroll
                    for (int j = 0; j < NJ; ++j) o = (o + acc[j][r]) * bf2f(gr[(size_t)(row0 + r) * 6144 + j * 2048 + col]);
                    merged[(size_t)(row0 + r) * 2048 + col] = f2bf(o); }
            }
        }
    }
}

constexpr int N_PHASES = 22;
constexpr int CW_BAR = 1024, CW_QUEUE = 8192;

__global__ void __launch_bounds__(NTHREADS, 2) fwd_kernel(Args a) {
    extern __shared__ __attribute__((aligned(16))) unsigned char lds_raw[];
    LAS unsigned char* lds = (LAS unsigned char*)lds_raw;
    const int tid = opaque_tid(), G = gridDim.x;
    volatile LAS unsigned* misc = (volatile LAS unsigned*)(lds + 147456 - 64);
    if (tid < 16) misc[tid] = 0u;
    if (tid < 39) ((LAS unsigned long long*)(lds + PTAB_OFF))[tid] = ((const unsigned long long*)&a)[tid];
    __syncthreads();
    unsigned* ctl = (unsigned*)(ctx_ws(lds) + WS_CTL);
    XcdBarrier bar; bar.bar = ctl + CW_BAR; bar.x = 0; bar.st = misc;
    if (MK_N_LAUNCHES == 1) bar = xcd_barrier_post(ctl + CW_BAR, misc);
    const int lo = a.ph_lo, hi = a.ph_hi & 0xff, rmask = (a.ph_hi >> 8) & 0xff;
#ifndef PH_MASK
#define PH_MASK 0xFFFu
#endif
#define PHM(b) ((PH_MASK >> (b)) & 1u)
#define IN(k) (lo <= (k) && (k) < hi)
#define SEAM(k) do { if (MK_N_LAUNCHES == 1 && IN(k) && IN((k) + 1)) xcd_barrier(bar); } while (0)
    if (PHM(0) && IN(0)) { phase_prologue(lds, opq(G)); SEAM(0); }
#pragma nounroll
    for (int l = 0; l < 2; ++l) {
        const int pb = 1 + 10 * l;
        if (PHM(1) && IN(pb + 0)) { phase_norm(lds, opq(G), ctx_in(lds, I_NORM1) + opq(l) * 2048, opq(l) == 0); SEAM(pb + 0); }
        if (PHM(2) && IN(pb + 1)) {
            pg8::Gemm g{(const bf16_t*)(ctx_ws(lds) + WS_H), (const bf16_t*)(ctx_ws(lds) + WS_W + (size_t)opq(l) * LW_BYTES + LW_WIN), MPAD, NINP, 2048, 2048, 2048};
            pg8::StaticOrder S; S.init(MPAD, NINP, opq(G), (int)blockIdx.x);
            pg8::EpiProj E{(bf16_t*)(ctx_ws(lds) + WS_PROJ), NINP};
            pg8::gemm_phase(lds, g, S, E);
            if ((int)blockIdx.x >= (MPAD / 256) * (NINP / 256) % 256 || (int)blockIdx.x == opq(G) - 1) deferred_convert(lds, 2 * opq(l));
            SEAM(pb + 1);
        }
        if (PHM(3) && IN(pb + 2)) { phase_pre(lds, opq(l), opq(G)); SEAM(pb + 2); }
        if (PHM(4) && IN(pb + 3)) { phase_scan(lds, opq(l), opq(G), (unsigned*)(ctx_ws(lds) + WS_CTL) + CW_QUEUE + 64 * opq(l), rmask); SEAM(pb + 3); }
        if (PHM(5) && IN(pb + 4)) { phase_post(lds, opq(l), opq(G)); SEAM(pb + 4); }
        if (PHM(6) && IN(pb + 5)) {
            pg8::StaticOrder S; S.init(MP, 2048, opq(G), (int)blockIdx.x);
            const bf16_t* obr = (const bf16_t*)(ctx_ws(lds) + WS_QM); const bf16_t* wbr = (const bf16_t*)(ctx_ws(lds) + WS_W + (size_t)opq(l) * LW_BYTES + LW_WBR);
            bf16_t* merged = (bf16_t*)(ctx_ws(lds) + WS_H); const bf16_t* gr = (const bf16_t*)(ctx_ws(lds) + WS_RPRE + RP_GR);
            { pg8::Gemm g{obr, wbr, MP, 2048, 3072, 3072, 3072}; pg8::EpiBranchK E{merged, gr}; pg8::gemm_phase(lds, g, S, E); }
            skinny_phase<1>(lds, obr, 3072, wbr, 3072, 3072, nullptr, merged, gr, nullptr, opq(G));
            SEAM(pb + 5);
        }
        if (PHM(7) && IN(pb + 6)) {
            pg8::Gemm g{(const bf16_t*)(ctx_ws(lds) + WS_H), (const bf16_t*)(ctx_ws(lds) + WS_W + (size_t)opq(l) * LW_BYTES + LW_WOUT), MP, 2048, 2048, 2048, 2048};
            pg8::StaticOrder S; S.init(MP, 2048, opq(G), (int)blockIdx.x);
            pg8::EpiResid E{(float*)(ctx_ws(lds) + WS_X), 2048};
            pg8::gemm_phase(lds, g, S, E);
            skinny_phase<0>(lds, g.A, 2048, g.Bt, 2048, 2048, (float*)(ctx_ws(lds) + WS_X), nullptr, nullptr, nullptr, opq(G));
            SEAM(pb + 6);
        }
        if (PHM(8) && IN(pb + 7)) { phase_norm(lds, opq(G), ctx_in(lds, I_NORM2) + opq(l) * 2048, false); SEAM(pb + 7); }
        if (PHM(9) && IN(pb + 8)) {
            pg8::Gemm g{(const bf16_t*)(ctx_ws(lds) + WS_H), (const bf16_t*)(ctx_ws(lds) + WS_W + (size_t)opq(l) * LW_BYTES + LW_WGU), MPAD, 11264, 2048, 2048, 2048};
            pg8::StaticOrder S; S.init(MPAD, 11264, opq(G), (int)blockIdx.x);
            pg8::EpiSwiGLU E{(bf16_t*)(ctx_ws(lds) + WS_PROJ), DFF};
            pg8::gemm_phase(lds, g, S, E);
            if ((int)blockIdx.x >= (MPAD / 256) * (11264 / 256) % 256 || (int)blockIdx.x == opq(G) - 1) deferred_convert(lds, 2 * opq(l) + 1);
            SEAM(pb + 8);
        }
        if (PHM(10) && IN(pb + 9)) {
            pg8::Gemm g{(const bf16_t*)(ctx_ws(lds) + WS_PROJ), (const bf16_t*)(ctx_ws(lds) + WS_W + (size_t)opq(l) * LW_BYTES + LW_WDN), MP, 2048, DFF, DFF, DFF};
            pg8::StaticOrder S; S.init(MP, 2048, opq(G), (int)blockIdx.x);
            pg8::EpiResid E{(float*)(ctx_ws(lds) + WS_X), 2048};
            pg8::gemm_phase(lds, g, S, E);
            skinny_phase<0>(lds, g.A, DFF, g.Bt, DFF, DFF, (float*)(ctx_ws(lds) + WS_X), nullptr, nullptr, nullptr, opq(G));
            SEAM(pb + 9);
        }
    }
    if (PHM(11) && IN(21)) phase_final(lds, opq(G));
    if (IN(22)) phase_dump(lds, G);
#undef IN
#undef SEAM
}

extern "C" void kernel_launch(void* const* d_in, const int* in_sizes, int n_in, void* d_out, int out_size, void* d_ws, size_t ws_size, hipStream_t stream) {
    static int grid = 0;
    if (grid == 0) {
        if (n_in != 37 || ws_size < WS_END) { fprintf(stderr, "kernel_launch: expected 37 inputs and >= %zu bytes of workspace; got %d, %zu\n", (size_t)WS_END, n_in, ws_size); grid = -1; return; }
        int dev = 0, cus = 0, per_cu = 0;
        if (hipGetDevice(&dev) != hipSuccess || hipDeviceGetAttribute(&cus, hipDeviceAttributeMultiprocessorCount, dev) != hipSuccess) { grid = -1; return; }
        if (hipFuncSetAttribute((const void*)fwd_kernel, hipFuncAttributeMaxDynamicSharedMemorySize, LDS_BYTES) != hipSuccess) { fprintf(stderr, "kernel_launch: hipFuncSetAttribute failed\n"); grid = -1; return; }
        if (hipOccupancyMaxActiveBlocksPerMultiprocessor(&per_cu, (const void*)fwd_kernel, NTHREADS, LDS_BYTES) != hipSuccess || per_cu < 1) { fprintf(stderr, "kernel_launch: occupancy query says %d\n", per_cu); }
        (void)hipGetLastError();
        grid = cus;
    }
    if (grid < 0) return;
    (void)hipMemsetAsync((char*)d_ws + WS_CTL, 0, CTL_BYTES, stream);
    Args a{};
    for (int i = 0; i < 37; ++i) a.in[i] = (const float*)d_in[i];
    a.out = (float*)d_out; a.ws = (unsigned char*)d_ws;
    if (MK_N_LAUNCHES == 1) { a.ph_lo = 0; a.ph_hi = N_PHASES; hipLaunchKernelGGL(fwd_kernel, dim3(grid), dim3(NTHREADS), LDS_BYTES, stream, a); }
    else { for (int p = 0; p < DBG_LIM; ++p) { a.ph_lo = p; a.ph_hi = p + 1; hipLaunchKernelGGL(fwd_kernel, dim3(grid), dim3(NTHREADS), LDS_BYTES, stream, a);
            const int kind = p == 0 ? 0 : (p == 21 ? 11 : 1 + (p - 1) % 10);
            if ((DBG_REP_MASK >> kind) & 1) { a.ph_hi = (p + 1) | (DBG_ROLE_MASK << 8); hipLaunchKernelGGL(fwd_kernel, dim3(grid), dim3(NTHREADS), LDS_BYTES, stream, a); } }
        if (DBG_LIM < 22) { a.ph_lo = 22; a.ph_hi = 23; hipLaunchKernelGGL(fwd_kernel, dim3(grid), dim3(NTHREADS), LDS_BYTES, stream, a); } }
}
```
